# Optimizing an MI355X kernel written in HIP

```python
import math
import jax, jax.numpy as jnp
from jax import lax
import numpy as np

D_MODEL = 1024
BATCH = 4
SEQ = 4096
DEPTH = 1

RET_HEADS = 4
RET_DK = 128
RET_DV = 256
RET_CHUNK = 128
ROPE_BASE = 10000.0
ATT_PATTERNS = ((128, 1), (512, 4), (2048, 16))
ATT_GROUPS = 3
ATT_HEADS_PER_GROUP = 4
ATT_HEADS = ATT_GROUPS * ATT_HEADS_PER_GROUP
ATT_DH = 128
ATT_QBLOCK = 128
REL_BUCKETS = 32
REL_MAX_EXACT = REL_BUCKETS // 2
REL_MAX_DIST = 2048
N_EXPERTS = 32
TOP_K = 4
D_EXPERT = D_MODEL
SWIGLU_LIMIT = 7.0
SWIGLU_ALPHA = 1.702
MOE_BLOCK = 128
EPS = 1e-6
GN_EPS = 1e-5

RET_QK_W = RET_HEADS * RET_DK
RET_V_W = RET_HEADS * RET_DV
ATT_W = ATT_HEADS * ATT_DH
ATT_OUT_W = ATT_HEADS_PER_GROUP * ATT_DH
IN_SPLITS = (RET_QK_W, RET_QK_W, RET_V_W, RET_V_W, ATT_W, ATT_W, ATT_W, D_MODEL, D_MODEL)
IN_W = 9728

kernel_name = "hybrid_retention_dilated_moe_block"


def _split_points(sizes):
    pts, acc = [], 0
    for s in sizes[:-1]:
        acc += s
        pts.append(acc)
    return pts


def rms_norm(x, g):
    xf = x.astype(jnp.float32)
    return xf * lax.rsqrt(jnp.mean(xf * xf, axis=-1, keepdims=True) + EPS) * g


def modulate(h, shift, scale):
    return h * (1.0 + scale[:, None, :]) + shift[:, None, :]


def rotary(t, pos):
    half = t.shape[-1] // 2
    inv = ROPE_BASE ** (-jnp.arange(half, dtype=jnp.float32) / half)
    ang = pos[:, None] * inv[None, :]
    cos, sin = jnp.cos(ang)[:, None, :], jnp.sin(ang)[:, None, :]
    t1, t2 = t[..., :half], t[..., half:]
    return jnp.concatenate([t1 * cos - t2 * sin, t1 * sin + t2 * cos], axis=-1)


def retention(q, k, v, g):
    B, S = q.shape[:2]
    H, dk, dv, C = RET_HEADS, RET_DK, RET_DV, RET_CHUNK
    nC = S // C
    pos = jnp.arange(S, dtype=jnp.float32)
    q = rotary(q.astype(jnp.float32).reshape(B, S, H, dk), pos)
    k = rotary(k.astype(jnp.float32).reshape(B, S, H, dk), pos) * (dk ** -0.5)
    v = v.astype(jnp.float32).reshape(B, S, H, dv)
    log_g = jnp.log1p(-jnp.exp2(-5.0 - jnp.arange(H, dtype=jnp.float32)))
    i = jnp.arange(C, dtype=jnp.float32)
    diff = i[:, None] - i[None, :]
    decay = jnp.where(diff[None] >= 0, jnp.exp(jnp.maximum(diff, 0.0)[None] * log_g[:, None, None]), 0.0)
    qc = q.reshape(B, nC, C, H, dk)
    kc = k.reshape(B, nC, C, H, dk)
    vc = v.reshape(B, nC, C, H, dv)
    scores = jnp.einsum('bnihd,bnjhd->bnhij', qc, kc) * decay
    inner = jnp.einsum('bnhij,bnjhe->bnihe', scores, vc)
    zeta = jnp.exp((C - 1.0 - i)[:, None] * log_g[None, :])
    kv = jnp.einsum('bnjhd,bnjhe->nbhde', kc * zeta[:, :, None], vc)
    g_chunk = jnp.exp(C * log_g)[None, :, None, None]

    def step(R, kv_n):
        return g_chunk * R + kv_n, R

    _, R_prev = lax.scan(step, jnp.zeros_like(kv[0]), kv)
    xi = jnp.exp((i + 1.0)[:, None] * log_g[None, :])
    cross = jnp.einsum('bnihd,nbhde->bnihe', qc * xi[:, :, None], R_prev)
    y = (inner + cross).reshape(B, S, H, dv)
    mu = jnp.mean(y, axis=-1, keepdims=True)
    var = jnp.mean(jnp.square(y - mu), axis=-1, keepdims=True)
    y = (y - mu) * lax.rsqrt(var + GN_EPS)
    return jax.nn.silu(g.astype(jnp.float32)) * y.reshape(B, S, H * dv)


def t5_bucket(dist):
    is_small = dist < REL_MAX_EXACT
    ratio = jnp.log(jnp.maximum(dist, 1).astype(jnp.float32) / REL_MAX_EXACT) / math.log(REL_MAX_DIST / REL_MAX_EXACT)
    large = REL_MAX_EXACT + (ratio * (REL_BUCKETS - REL_MAX_EXACT)).astype(jnp.int32)
    large = jnp.minimum(large, REL_BUCKETS - 1)
    return jnp.where(is_small, dist, large)


def dilated_attention(q, k, v, rel_bias):
    B, S = q.shape[:2]
    G, Hg, dh, QB = ATT_GROUPS, ATT_HEADS_PER_GROUP, ATT_DH, ATT_QBLOCK
    nb = S // QB
    q = q.reshape(B, S, G, Hg, dh)
    k = k.reshape(B, S, G, Hg, dh)
    v = v.reshape(B, S, G, Hg, dh)
    qb = q.reshape(B, nb, QB, G, Hg, dh).transpose(1, 0, 2, 3, 4, 5)
    ks = [k[:, :, g] for g in range(G)]
    vs = [v[:, :, g] for g in range(G)]
    biases = []
    for g, (w, r) in enumerate(ATT_PATTERNS):
        nk = w // r + 1
        bkt = t5_bucket(r * jnp.arange(nk, dtype=jnp.int32))
        biases.append(rel_bias[bkt, g * Hg:(g + 1) * Hg].T.astype(jnp.float32))
    scale = dh ** -0.5

    def block(args):
        n, qn = args
        pos = n * QB + jnp.arange(QB, dtype=jnp.int32)
        outs, lses = [], []
        for g, (w, r) in enumerate(ATT_PATTERNS):
            nk = w // r + 1
            idx = pos[:, None] - r * jnp.arange(nk, dtype=jnp.int32)[None, :]
            valid = idx >= 0
            idc = jnp.maximum(idx, 0)
            kg = jnp.take(ks[g], idc, axis=1)
            vg = jnp.take(vs[g], idc, axis=1)
            s = jnp.einsum('bqhd,bqjhd->bhqj', qn[:, :, g], kg).astype(jnp.float32) * scale
            s = s + biases[g][:, None, :]
            s = jnp.where(valid[None, None], s, -jnp.inf)
            m = jnp.max(s, axis=-1, keepdims=True)
            e = jnp.exp(s - m)
            l = jnp.sum(e, axis=-1, keepdims=True)
            o = jnp.einsum('bhqj,bqjhd->bqhd', e / l, vg.astype(jnp.float32))
            outs.append(o)
            lses.append((m + jnp.log(l))[..., 0].transpose(0, 2, 1))
        alpha = jax.nn.softmax(jnp.stack(lses, axis=0), axis=0)
        out = alpha[0][..., None] * outs[0]
        for g in range(1, G):
            out = out + alpha[g][..., None] * outs[g]
        return out

    out = lax.map(block, (jnp.arange(nb, dtype=jnp.int32), qb))
    return out.transpose(1, 0, 2, 3, 4).reshape(B, S, Hg * dh)


def moe(h, w_router, b_router, w1, b1, w2, b2):
    B, S, D = h.shape
    T = B * S
    xf = h.reshape(T, D)
    logits = (xf @ w_router + b_router).astype(jnp.float32)
    top_val, top_idx = lax.top_k(logits, TOP_K)
    gates = jax.nn.softmax(top_val, axis=-1)
    A = T * TOP_K
    flat_e = top_idx.reshape(A).astype(jnp.int32)
    flat_tok = jnp.arange(A, dtype=jnp.int32) // TOP_K
    flat_gate = gates.reshape(A)
    order = jnp.argsort(flat_e, stable=True)
    se = flat_e[order]
    counts = jnp.bincount(flat_e, length=N_EXPERTS)
    starts = jnp.cumsum(counts) - counts
    padded = (counts + MOE_BLOCK - 1) // MOE_BLOCK * MOE_BLOCK
    pend = jnp.cumsum(padded)
    pstart = pend - padded
    dest = pstart[se] + jnp.arange(A, dtype=jnp.int32) - starts[se]
    nblk = -(-A // MOE_BLOCK) + N_EXPERTS
    n_rows = nblk * MOE_BLOCK
    row_tok = jnp.full((n_rows,), T, jnp.int32).at[dest].set(flat_tok[order])
    row_gate = jnp.zeros((n_rows,), jnp.float32).at[dest].set(flat_gate[order])
    block_e = jnp.minimum(jnp.searchsorted(pend, jnp.arange(nblk, dtype=jnp.int32) * MOE_BLOCK, side='right'), N_EXPERTS - 1)
    x_pad = jnp.concatenate([xf, jnp.zeros((1, D), xf.dtype)], axis=0)
    xin = x_pad[row_tok].reshape(nblk, MOE_BLOCK, D)

    def expert_block(args):
        xb, e = args
        u = xb @ w1[e] + b1[e]
        glu = jnp.minimum(u[:, ::2], SWIGLU_LIMIT)
        lin = jnp.clip(u[:, 1::2], -SWIGLU_LIMIT, SWIGLU_LIMIT)
        a = glu * jax.nn.sigmoid(SWIGLU_ALPHA * glu) * (lin + 1.0)
        return a @ w2[e] + b2[e]

    yb = lax.map(expert_block, (xin, block_e)).reshape(n_rows, D)
    y = jnp.zeros((T + 1, D), jnp.float32).at[row_tok].add(yb.astype(jnp.float32) * row_gate[:, None])
    return y[:T].reshape(B, S, D)


def setup_inputs(seed: int = 0) -> dict:
    key = jax.random.key(seed)
    ks = jax.random.split(key, 20)
    D, L, E, F = D_MODEL, DEPTH, N_EXPERTS, D_EXPERT
    nrm = jax.random.normal
    f32 = jnp.float32
    return {
        "x": nrm(ks[0], (BATCH, SEQ, D), f32),
        "c": nrm(ks[1], (BATCH, D), f32),
        "w_ada": nrm(ks[2], (L, D, 6 * D), f32) * (0.5 * D ** -0.5),
        "b_ada": nrm(ks[3], (L, 6 * D), f32) * 0.02,
        "g_mix": 1.0 + 0.02 * nrm(ks[4], (L, D), f32),
        "w_in": nrm(ks[5], (L, D, IN_W), f32) * D ** -0.5,
        "rel_bias": nrm(ks[6], (REL_BUCKETS, ATT_HEADS), f32) * 0.2,
        "w_ret_o": nrm(ks[7], (L, RET_V_W, D), f32) * RET_V_W ** -0.5,
        "w_att_o": nrm(ks[8], (L, ATT_OUT_W, D), f32) * ATT_OUT_W ** -0.5,
        "w_o": nrm(ks[9], (L, D, D), f32) * D ** -0.5,
        "g_ffn": 1.0 + 0.02 * nrm(ks[10], (L, D), f32),
        "w_router": nrm(ks[11], (L, D, E), f32) * D ** -0.5,
        "b_router": nrm(ks[12], (L, E), f32) * 0.01,
        "w_mlp1": nrm(ks[13], (L, E, D, 2 * F), f32) * D ** -0.5,
        "b_mlp1": nrm(ks[14], (L, E, 2 * F), f32) * 0.01,
        "w_mlp2": nrm(ks[15], (L, E, F, D), f32) * F ** -0.5,
        "b_mlp2": nrm(ks[16], (L, E, D), f32) * 0.01,
        "g_final": 1.0 + 0.02 * nrm(ks[17], (D,), f32),
    }


def reference(x, c, w_ada, b_ada, g_mix, w_in, rel_bias, w_ret_o, w_att_o, w_o, g_ffn,
              w_router, b_router, w_mlp1, b_mlp1, w_mlp2, b_mlp2, g_final):
    cs = jax.nn.silu(c.astype(jnp.float32))
    pts = _split_points(IN_SPLITS)
    for l in range(DEPTH):
        mod = cs @ w_ada[l] + b_ada[l]
        sh_a, sc_a, gt_a, sh_f, sc_f, gt_f = jnp.split(mod, 6, axis=-1)
        h = modulate(rms_norm(x, g_mix[l]), sh_a, sc_a)
        u = h @ w_in[l]
        rq, rk, rv, rg, aq, ak, av, ga, gb = jnp.split(u, pts, axis=-1)
        ret = retention(rq, rk, rv, rg)
        att = dilated_attention(aq, ak, av, rel_bias)
        merged = jax.nn.sigmoid(ga) * (ret @ w_ret_o[l]) + jax.nn.sigmoid(gb) * (att @ w_att_o[l])
        x = x + gt_a[:, None, :] * (merged @ w_o[l])
        h = modulate(rms_norm(x, g_ffn[l]), sh_f, sc_f)
        x = x + gt_f[:, None, :] * moe(h, w_router[l], b_router[l], w_mlp1[l], b_mlp1[l], w_mlp2[l], b_mlp2[l])
    return rms_norm(x, g_final)
```

```cpp
#define ONE_LAUNCH 0
#include <hip/hip_runtime.h>
#include <cstdio>
#include <cstdint>
namespace pg8 {
#define PG8_LAS __attribute__((address_space(3)))
typedef unsigned short bf16_t;
typedef short bf16x8 __attribute__((ext_vector_type(8)));
typedef float f32x4 __attribute__((ext_vector_type(4)));
typedef unsigned u32x4 __attribute__((ext_vector_type(4)));
constexpr int BM = 256, BK = 64, HALF = 128, HTB = HALF * BK * 2  , STAGE_BYTES = 8 * HTB, NXCD = 8, WGM = 8;

__host__ __device__ __forceinline__ int lds_byte(int r, int c) { const int st = (r >> 4) * 2 + (c >> 5), rr = r & 15, cc = c & 31, ob = rr * 64 + cc * 2; return st * 1024 + (ob ^ (((ob >> 9) & 1) << 5)); }
__host__ __device__ __forceinline__ void stage_rc(int b, int& R, int& C) { const int st = b / 1024, sb = b % 1024, swz = sb ^ (((sb >> 9) & 1) << 5); R = (st >> 1) * 16 + swz / 64; C = (st & 1) * 32 + (swz % 64) / 2; }
__host__ __device__ __forceinline__ int perm32(int rho) { const int n = rho >> 4, i = rho & 15; return 8 * (i >> 2) + 4 * n + (i & 3); }

struct Unit { int pm, pn; };
struct Gemm { const bf16_t* A; const bf16_t* Bt; int M, N, K; };

struct StaticOrder {
    int nM, nN, nwg, G, c;
    __host__ __device__ void init(int M, int N, int G_, int c_) { nM = M / BM; nN = N / BM; nwg = nM * nN; G = G_; c = c_; }
    __host__ __device__ bool next(int i, Unit& u) const {
        const long L = (long)i * G + c; if (L >= nwg) return false;
        int wgid = (int)L; { const int q = nwg / NXCD, r = nwg % NXCD, xcd = wgid % NXCD, off = wgid / NXCD; wgid = (xcd < r ? xcd * (q + 1) : r * (q + 1) + (xcd - r) * q) + off; }
        const int nig = WGM * nN, gid = wgid / nig, fm = gid * WGM, gsz = (nM - fm) < WGM ? (nM - fm) : WGM;
        u.pm = fm + ((wgid % nig) % gsz); u.pn = (wgid % nig) / gsz; return true;
    }
    __device__ __forceinline__ void a_ready(const Unit&) const {}
    __device__ __forceinline__ void done(const Unit&) const {}
};

__device__ __forceinline__ unsigned cvt_pk_bf16(float lo, float hi) { unsigned r; asm volatile("v_cvt_pk_bf16_f32 %0, %1, %2" : "=v"(r) : "v"(lo), "v"(hi)); return r; }
typedef float f32x2 __attribute__((ext_vector_type(2)));
__device__ __forceinline__ f32x2 gelu_pk(f32x2 v) {
    const f32x2 av = __builtin_elementwise_abs(v), d = av * 0.2316418882f + 1.0f;
    f32x2 t; t.x = __builtin_amdgcn_rcpf(d.x); t.y = __builtin_amdgcn_rcpf(d.y);
    f32x2 q = t * 0.5307027145f + (-0.7265760135f); q = q * t + 0.7107068705f; q = q * t + (-0.142248368f); q = q * t + 0.127414796f; q = q * t;
    const f32x2 s = (v * v) * (-0.72134752044f);
    f32x2 e; e.x = __builtin_amdgcn_exp2f(s.x); e.y = __builtin_amdgcn_exp2f(s.y);
    const f32x2 m = v * (q * e), r = v - m;
    f32x2 o; o.x = v.x < 0.f ? m.x : r.x; o.y = v.y < 0.f ? m.y : r.y; return o;
}

template <int ACT  > struct EpiBf16 {
    static constexpr bool PERM = true, AFTER_DRAIN = false; static_assert(ACT == 0 || ACT == 1, "EpiBf16: ACT is 0 (none) or 1 (gelu_pk)");
    bf16_t* O; int ldc; const float* bias; int split_cols; size_t split_stride; float scale0;
    __device__ __forceinline__ void operator()(const f32x4 (&acc)[2][2][4][2], const Unit& u, int wr, int wc, int fr, int fq) const {
        const int row0 = u.pm * BM + wr * 64 + fr; int colt = u.pn * BM; bf16_t* base = O;
        float sc = 1.f; if (split_cols) { const int t = colt / split_cols; base += (size_t)t * split_stride; colt -= t * split_cols; if (t == 0) sc = scale0; }
        const int col0 = colt + wc * 32 + 8 * fq, bcol0 = u.pn * BM + wc * 32 + 8 * fq;
        f32x4 bv[2][2];
#pragma unroll
        for (int bj = 0; bj < 2; ++bj)
#pragma unroll
            for (int n = 0; n < 2; ++n) bv[bj][n] = bias ? *(const f32x4*)(bias + bcol0 + bj * HALF + 4 * n) : (f32x4){0.f, 0.f, 0.f, 0.f};
#pragma unroll
        for (int ai = 0; ai < 2; ++ai)
#pragma unroll
            for (int m = 0; m < 4; ++m) { bf16_t* rowp = base + (size_t)(row0 + ai * HALF + m * 16) * ldc + col0;
#pragma unroll
                for (int bj = 0; bj < 2; ++bj) { f32x4 v0 = acc[ai][bj][m][0] + bv[bj][0], v1 = acc[ai][bj][m][1] + bv[bj][1];
                    if (ACT == 1) { f32x2 a = gelu_pk((f32x2){v0[0], v0[1]}), b = gelu_pk((f32x2){v0[2], v0[3]}), c = gelu_pk((f32x2){v1[0], v1[1]}), d = gelu_pk((f32x2){v1[2], v1[3]});
                        v0 = (f32x4){a.x, a.y, b.x, b.y}; v1 = (f32x4){c.x, c.y, d.x, d.y}; }
                    v0 = v0 * sc; v1 = v1 * sc; u32x4 w; w.x = cvt_pk_bf16(v0[0], v0[1]); w.y = cvt_pk_bf16(v0[2], v0[3]); w.z = cvt_pk_bf16(v1[0], v1[1]); w.w = cvt_pk_bf16(v1[2], v1[3]);
                    *(u32x4*)(rowp + bj * HALF) = w; } }
    }
};
__device__ __forceinline__ float bf_lo(unsigned w) { return __uint_as_float(w << 16); }
__device__ __forceinline__ float bf_hi(unsigned w) { return __uint_as_float(w & 0xffff0000u); }
__device__ __forceinline__ float sigmf(float x) { return __builtin_amdgcn_rcpf(1.0f + __expf(-x)); }

struct EpiGateF32 {
    static constexpr bool PERM = true, AFTER_DRAIN = false;
    float* O; int ldc; const bf16_t* Gt; int ldg;
    __device__ __forceinline__ void operator()(const f32x4 (&acc)[2][2][4][2], const Unit& u, int wr, int wc, int fr, int fq) const {
        const int row0 = u.pm * BM + wr * 64 + fr, col0 = u.pn * BM + wc * 32 + 8 * fq;
#pragma unroll
        for (int ai = 0; ai < 2; ++ai)
#pragma unroll
            for (int m = 0; m < 4; ++m) { const size_t row = (size_t)(row0 + ai * HALF + m * 16);
#pragma unroll
                for (int bj = 0; bj < 2; ++bj) { const int col = col0 + bj * HALF;
                    const u32x4 g = *(const u32x4*)(Gt + row * ldg + col);
                    f32x4 v0 = acc[ai][bj][m][0], v1 = acc[ai][bj][m][1];
                    v0[0] *= sigmf(bf_lo(g.x)); v0[1] *= sigmf(bf_hi(g.x)); v0[2] *= sigmf(bf_lo(g.y)); v0[3] *= sigmf(bf_hi(g.y));
                    v1[0] *= sigmf(bf_lo(g.z)); v1[1] *= sigmf(bf_hi(g.z)); v1[2] *= sigmf(bf_lo(g.w)); v1[3] *= sigmf(bf_hi(g.w));
                    *(f32x4*)(O + row * ldc + col) = v0; *(f32x4*)(O + row * ldc + col + 4) = v1; } }
    }
};
struct EpiGateAddBf16 {
    static constexpr bool PERM = true, AFTER_DRAIN = false;
    bf16_t* O; int ldc; const float* Tm; int ldt; const bf16_t* Gt; int ldg;
    __device__ __forceinline__ void operator()(const f32x4 (&acc)[2][2][4][2], const Unit& u, int wr, int wc, int fr, int fq) const {
        const int row0 = u.pm * BM + wr * 64 + fr, col0 = u.pn * BM + wc * 32 + 8 * fq;
#pragma unroll
        for (int ai = 0; ai < 2; ++ai)
#pragma unroll
            for (int m = 0; m < 4; ++m) { const size_t row = (size_t)(row0 + ai * HALF + m * 16);
#pragma unroll
                for (int bj = 0; bj < 2; ++bj) { const int col = col0 + bj * HALF;
                    const u32x4 g = *(const u32x4*)(Gt + row * ldg + col);
                    const f32x4 t0 = *(const f32x4*)(Tm + row * ldt + col), t1 = *(const f32x4*)(Tm + row * ldt + col + 4);
                    f32x4 v0 = acc[ai][bj][m][0], v1 = acc[ai][bj][m][1];
                    v0[0] = t0[0] + v0[0] * sigmf(bf_lo(g.x)); v0[1] = t0[1] + v0[1] * sigmf(bf_hi(g.x)); v0[2] = t0[2] + v0[2] * sigmf(bf_lo(g.y)); v0[3] = t0[3] + v0[3] * sigmf(bf_hi(g.y));
                    v1[0] = t1[0] + v1[0] * sigmf(bf_lo(g.z)); v1[1] = t1[1] + v1[1] * sigmf(bf_hi(g.z)); v1[2] = t1[2] + v1[2] * sigmf(bf_lo(g.w)); v1[3] = t1[3] + v1[3] * sigmf(bf_hi(g.w));
                    u32x4 w; w.x = cvt_pk_bf16(v0[0], v0[1]); w.y = cvt_pk_bf16(v0[2], v0[3]); w.z = cvt_pk_bf16(v1[0], v1[1]); w.w = cvt_pk_bf16(v1[2], v1[3]);
                    *(u32x4*)(O + row * ldc + col) = w; } }
    }
};
struct EpiResid {
    static constexpr bool PERM = false, AFTER_DRAIN = false;
    float* O; const float* base; int ldc; const float* gvec; int gstride; int tiles_per_b;
    __device__ __forceinline__ void operator()(const f32x4 (&acc)[2][2][4][2], const Unit& u, int wr, int wc, int fr, int fq) const {
        const int row0 = u.pm * BM + wr * 64 + fr, col0 = u.pn * BM + wc * 32 + 4 * fq;
        const float* gv = gvec + (size_t)(u.pm / tiles_per_b) * gstride;
#pragma unroll
        for (int bj = 0; bj < 2; ++bj)
#pragma unroll
            for (int n = 0; n < 2; ++n) { const int col = col0 + bj * HALF + n * 16; const f32x4 gt = *(const f32x4*)(gv + col);
#pragma unroll
                for (int ai = 0; ai < 2; ++ai)
#pragma unroll
                    for (int m = 0; m < 4; ++m) { const size_t off = (size_t)(row0 + ai * HALF + m * 16) * ldc + col;
                        const f32x4 b = *(const f32x4*)(base + off); *(f32x4*)(O + off) = b + gt * acc[ai][bj][m][n]; } }
    }
};
struct EpiSwiglu {
    static constexpr bool PERM = true, AFTER_DRAIN = false;
    bf16_t* O; int lda; const float* bias; int nN;
    __device__ __forceinline__ void operator()(const f32x4 (&acc)[2][2][4][2], const Unit& u, int wr, int wc, int fr, int fq) const {
        const int row0 = u.pm * BM + wr * 64 + fr; const int pnl = u.pn % nN;
        const int bcol0 = u.pn * BM + wc * 32 + 8 * fq, col0 = pnl * BM + wc * 32 + 8 * fq;
        f32x4 bv[2][2];
#pragma unroll
        for (int bj = 0; bj < 2; ++bj)
#pragma unroll
            for (int n = 0; n < 2; ++n) bv[bj][n] = *(const f32x4*)(bias + bcol0 + bj * HALF + 4 * n);
#pragma unroll
        for (int ai = 0; ai < 2; ++ai)
#pragma unroll
            for (int m = 0; m < 4; ++m) { bf16_t* rowp = O + (size_t)(row0 + ai * HALF + m * 16) * lda;
#pragma unroll
                for (int bj = 0; bj < 2; ++bj) { const f32x4 v0 = acc[ai][bj][m][0] + bv[bj][0], v1 = acc[ai][bj][m][1] + bv[bj][1];
                    float a[4];
#pragma unroll
                    for (int k = 0; k < 4; ++k) { const float gl = fminf(k < 2 ? v0[2 * k] : v1[2 * k - 4], 7.0f); const float li = fminf(fmaxf(k < 2 ? v0[2 * k + 1] : v1[2 * k - 3], -7.0f), 7.0f);
                        a[k] = gl * sigmf(1.702f * gl) * (li + 1.0f); }
                    unsigned w0 = cvt_pk_bf16(a[0], a[1]), w1 = cvt_pk_bf16(a[2], a[3]);
                    typedef unsigned u32x2 __attribute__((ext_vector_type(2)));
                    *(u32x2*)(rowp + ((col0 + bj * HALF) >> 1)) = (u32x2){w0, w1}; } }
    }
};
struct MoeOrder {
    int ntiles, nN, G, c; const int* tile_e;
    __device__ bool next(int i, Unit& u) const {
        const long L = (long)i * G + c; if (L >= (long)ntiles * nN) return false;
        const int t = (int)(L / nN), pnl = (int)(L % nN);
        u.pm = t; u.pn = __builtin_amdgcn_readfirstlane((int)__hip_atomic_load((const unsigned*)tile_e + t, __ATOMIC_RELAXED, __HIP_MEMORY_SCOPE_AGENT)) * nN + pnl; return true;
    }
    __device__ __forceinline__ void a_ready(const Unit&) const {}
    __device__ __forceinline__ void done(const Unit&) const {}
};
template <class Epi, class Sched, bool ALIGN_EPI = false, bool SP2 = false>
__device__ __forceinline__ void gemm_phase(PG8_LAS unsigned char* lds, const Gemm g, const Sched& S, const Epi& E) {
    const int tid = threadIdx.x, wid = __builtin_amdgcn_readfirstlane(tid >> 6), lane = tid & 63, wr = wid >> 2, wc = wid & 3, fr = lane & 15, fq = lane >> 4;
    const int K = g.K, nt = K / BK;
    unsigned voffA[2], voffB[2];
#pragma unroll
    for (int i = 0; i < 2; ++i) { int R, C; stage_rc(tid * 16 + i * 8192, R, C); const int Rb = Epi::PERM ? ((R & ~31) + perm32(R & 31)) : R;
        voffA[i] = (unsigned)(R * K + C) * 2u; voffB[i] = (unsigned)(Rb * K + C) * 2u; }
    const size_t kstep = (size_t)(BK * 2);
    const size_t hstep = (size_t)HALF * K * 2;
    const size_t tstep = 2 * hstep;
    const unsigned ldsw = (unsigned)wid * 1024u;
    const int aoff = lds_byte(wr * 64 + fr, fq * 8), boff = lds_byte(wc * 32 + fr, fq * 8);
#define PG8_SA(b, h) (((b) * 2 + (h)) * HTB)
#define PG8_SB(b, h) ((4 + (b) * 2 + (h)) * HTB)
#define PG8_STAGE(bufoff, gbase, voff) do { _Pragma("unroll") for (int _i = 0; _i < 2; ++_i) \
        __builtin_amdgcn_global_load_lds((const unsigned*)((const char*)(gbase) + (voff)[_i]), (PG8_LAS unsigned*)(lds + (bufoff) + ldsw + _i * 8192), 16, 0, 0); } while (0)
#define PG8_LDA(dst, b, h) do { _Pragma("unroll") for (int m = 0; m < 4; ++m) _Pragma("unroll") for (int k = 0; k < 2; ++k) dst[m][k] = *(const PG8_LAS bf16x8*)(lds + PG8_SA(b, h) + aoff + m * 2048 + k * 1024); } while (0)
#define PG8_LDB(dst, b, h) do { _Pragma("unroll") for (int n = 0; n < 2; ++n) _Pragma("unroll") for (int k = 0; k < 2; ++k) dst[n][k] = *(const PG8_LAS bf16x8*)(lds + PG8_SB(b, h) + boff + n * 2048 + k * 1024); } while (0)
#define PG8_MMA(ai, bj, At, Bt) do { __builtin_amdgcn_s_setprio(1); _Pragma("unroll") for (int m = 0; m < 4; ++m) _Pragma("unroll") for (int n = 0; n < 2; ++n) _Pragma("unroll") for (int k = 0; k < 2; ++k) \
        acc[ai][bj][m][n] = __builtin_amdgcn_mfma_f32_16x16x32_bf16(Bt[n][k], At[m][k], acc[ai][bj][m][n], 0, 0, 0); __builtin_amdgcn_s_setprio(0); } while (0)
#define PG8_WAIT_V(n) asm volatile("s_waitcnt vmcnt(" #n ")" ::: "memory")
#define PG8_WAIT_L(n) asm volatile("s_waitcnt lgkmcnt(" #n ")" ::: "memory")
#define PG8_BAR __builtin_amdgcn_s_barrier()
#define PG8_SCHED __builtin_amdgcn_sched_barrier(0)
    Unit cur, nxt; int ui = 0;
    if (!S.next(0, cur)) return;
    f32x4 acc[2][2][4][2];
#pragma unroll
    for (int a = 0; a < 2; ++a)
#pragma unroll
        for (int b = 0; b < 2; ++b)
#pragma unroll
            for (int m = 0; m < 4; ++m)
#pragma unroll
                for (int n = 0; n < 2; ++n) acc[a][b][m][n] = (f32x4){0.f, 0.f, 0.f, 0.f};
    bf16x8 At[4][2], B0[2][2], B1[2][2];
    const char* cA = (const char*)g.A + (size_t)cur.pm * tstep; const char* cB = (const char*)g.Bt + (size_t)cur.pn * tstep;
    S.a_ready(cur);
    if constexpr (SP2) {
        PG8_STAGE(PG8_SB(0, 0), cB, voffB); PG8_STAGE(PG8_SB(0, 1), cB + hstep, voffB); PG8_STAGE(PG8_SA(0, 0), cA, voffA); PG8_STAGE(PG8_SA(0, 1), cA + hstep, voffA);
        if (wr == 1) PG8_BAR;
        PG8_WAIT_V(2); PG8_BAR;
        PG8_STAGE(PG8_SB(1, 0), cB + kstep, voffB); PG8_STAGE(PG8_SA(1, 0), cA + kstep, voffA); PG8_STAGE(PG8_SB(1, 1), cB + hstep + kstep, voffB);
        PG8_WAIT_V(6); PG8_BAR;
    } else {
        PG8_STAGE(PG8_SB(0, 0), cB, voffB); PG8_STAGE(PG8_SA(0, 0), cA, voffA); PG8_STAGE(PG8_SB(0, 1), cB + hstep, voffB); PG8_STAGE(PG8_SA(0, 1), cA + hstep, voffA);
        if (wr == 1) PG8_BAR;
        PG8_WAIT_V(4); PG8_BAR;
        PG8_STAGE(PG8_SB(1, 0), cB + kstep, voffB); PG8_STAGE(PG8_SA(1, 0), cA + kstep, voffA); PG8_STAGE(PG8_SB(1, 1), cB + hstep + kstep, voffB);
        PG8_WAIT_V(6); PG8_BAR;
    }
    for (;;) {
        const bool has_next = S.next(ui + 1, nxt);
        const char* nA = has_next ? (const char*)g.A + (size_t)nxt.pm * tstep : cA; const char* nB = has_next ? (const char*)g.Bt + (size_t)nxt.pn * tstep : cB;
        for (int t = 0; t < nt; t += 2) {
            const bool last = (t == nt - 2);
            const char* a1 = cA + (size_t)(t + 1) * kstep;
            const char* a2 = last ? nA : cA + (size_t)(t + 2) * kstep; const char* b2 = last ? nB : cB + (size_t)(t + 2) * kstep;
            const char* a3 = a2 + kstep; const char* b3 = b2 + kstep;
            if (last && has_next) S.a_ready(nxt);
            if constexpr (SP2) {
            PG8_LDB(B0, 0, 0); PG8_LDB(B1, 0, 1); PG8_SCHED; PG8_LDA(At, 0, 0); PG8_STAGE(PG8_SA(1, 1), a1 + hstep, voffA);
            PG8_WAIT_V(8); PG8_WAIT_L(0); PG8_BAR; PG8_MMA(0, 0, At, B0); PG8_MMA(0, 1, At, B1); PG8_BAR; PG8_SCHED;
            PG8_LDA(At, 0, 1); PG8_STAGE(PG8_SB(0, 0), b2, voffB); PG8_STAGE(PG8_SB(0, 1), b2 + hstep, voffB); PG8_STAGE(PG8_SA(0, 0), a2, voffA);
            PG8_WAIT_V(8); PG8_WAIT_L(0); PG8_BAR; PG8_MMA(1, 0, At, B0); PG8_MMA(1, 1, At, B1); PG8_BAR; PG8_SCHED;
            PG8_LDB(B0, 1, 0); PG8_LDB(B1, 1, 1); PG8_SCHED; PG8_LDA(At, 1, 0); PG8_STAGE(PG8_SA(0, 1), a2 + hstep, voffA);
            PG8_WAIT_V(8); PG8_WAIT_L(0); PG8_BAR; PG8_MMA(0, 0, At, B0); PG8_MMA(0, 1, At, B1); PG8_BAR; PG8_SCHED;
            PG8_LDA(At, 1, 1); PG8_STAGE(PG8_SB(1, 0), b3, voffB); PG8_STAGE(PG8_SB(1, 1), b3 + hstep, voffB); PG8_STAGE(PG8_SA(1, 0), a3, voffA);
            PG8_WAIT_V(8); PG8_WAIT_L(0); PG8_BAR; PG8_MMA(1, 0, At, B0); PG8_MMA(1, 1, At, B1); PG8_BAR; PG8_SCHED;
            } else {
            PG8_LDB(B0, 0, 0); PG8_SCHED; PG8_LDA(At, 0, 0); PG8_STAGE(PG8_SA(1, 1), a1 + hstep, voffA);
            PG8_WAIT_L(8); PG8_BAR; PG8_WAIT_L(0); PG8_MMA(0, 0, At, B0); PG8_BAR; PG8_SCHED;
            PG8_LDB(B1, 0, 1); PG8_STAGE(PG8_SB(0, 0), b2, voffB);
            PG8_BAR; PG8_WAIT_L(0); PG8_MMA(0, 1, At, B1); PG8_BAR;
            PG8_LDA(At, 0, 1); PG8_STAGE(PG8_SA(0, 0), a2, voffA);
            PG8_BAR; PG8_WAIT_L(0); PG8_MMA(1, 0, At, B0); PG8_BAR; PG8_SCHED;
            PG8_STAGE(PG8_SB(0, 1), b2 + hstep, voffB);
            PG8_WAIT_V(6); PG8_BAR; PG8_MMA(1, 1, At, B1); PG8_BAR;
            PG8_LDB(B0, 1, 0); PG8_SCHED; PG8_LDA(At, 1, 0); PG8_STAGE(PG8_SA(0, 1), a2 + hstep, voffA);
            PG8_WAIT_L(8); PG8_BAR; PG8_WAIT_L(0); PG8_MMA(0, 0, At, B0); PG8_BAR; PG8_SCHED;
            PG8_LDB(B1, 1, 1); PG8_STAGE(PG8_SB(1, 0), b3, voffB);
            PG8_BAR; PG8_WAIT_L(0); PG8_MMA(0, 1, At, B1); PG8_BAR;
            PG8_LDA(At, 1, 1); PG8_STAGE(PG8_SA(1, 0), a3, voffA);
            PG8_BAR; PG8_WAIT_L(0); PG8_MMA(1, 0, At, B0); PG8_BAR; PG8_SCHED;
            PG8_STAGE(PG8_SB(1, 1), b3 + hstep, voffB);
            PG8_WAIT_V(6); PG8_BAR; PG8_MMA(1, 1, At, B1); PG8_BAR;
            }
        }
        if constexpr (ALIGN_EPI) { if (wr == 0) PG8_BAR; }
        if constexpr (!Epi::AFTER_DRAIN) { E(acc, cur, wr, wc, fr, fq); S.done(cur); }
        if (!has_next) break;
#pragma unroll
        for (int a = 0; a < 2; ++a)
#pragma unroll
            for (int b = 0; b < 2; ++b)
#pragma unroll
                for (int m = 0; m < 4; ++m)
#pragma unroll
                    for (int n = 0; n < 2; ++n) acc[a][b][m][n] = (f32x4){0.f, 0.f, 0.f, 0.f};
        cur = nxt; cA = nA; cB = nB; ++ui;
        if constexpr (ALIGN_EPI) { if (wr == 1) PG8_BAR; }
    }
    PG8_WAIT_V(0);
    if constexpr (!ALIGN_EPI) { if (wr == 0) PG8_BAR; }
    PG8_BAR;
    if constexpr (Epi::AFTER_DRAIN) { E.fused(acc, cur, wr, wc, fr, fq, lds, wid, lane); S.done(cur); }
#undef PG8_SA
#undef PG8_SB
#undef PG8_STAGE
#undef PG8_LDA
#undef PG8_LDB
#undef PG8_MMA
#undef PG8_WAIT_V
#undef PG8_WAIT_L
#undef PG8_BAR
#undef PG8_SCHED
}
}
#define GAS __attribute__((address_space(1)))
#define LAS __attribute__((address_space(3)))
typedef unsigned short bf16;
typedef unsigned v4u __attribute__((ext_vector_type(4)));
typedef float f32x4 __attribute__((ext_vector_type(4)));
typedef short bf16x8 __attribute__((ext_vector_type(8)));
typedef GAS unsigned gu32;
typedef GAS unsigned long long gu64;
#define RLX_AGENT __ATOMIC_RELAXED, __HIP_MEMORY_SCOPE_AGENT
#define LDS_WAIT() asm volatile("s_waitcnt lgkmcnt(0)" ::: "memory")
#define VM_WAIT() asm volatile("s_waitcnt vmcnt(0)" ::: "memory")
__device__ __forceinline__ unsigned long long rt() { return __builtin_amdgcn_s_memrealtime(); }
__device__ __forceinline__ unsigned f2bf(float f) { unsigned u = __builtin_bit_cast(unsigned, f); return (u + 0x7fffu + ((u >> 16) & 1u)) >> 16; }
__device__ __forceinline__ unsigned pk2(float lo, float hi) { return f2bf(lo) | (f2bf(hi) << 16); }

#define XB_TMO      128
#define XB_XCNT(j)  (256  + 64 * (j))
#define XB_XSUB(j)  (1280 + 64 * (j))
#define XB_XGEN(j)  (2304 + 64 * (j))
#define XB_TOP      3328
#define XB_TOPGEN   3392
#define XCD_BAR_WORDS 3456
#define XB_SPIN_CAP (1u << 18)

__device__ __forceinline__ unsigned xb_ld(unsigned* p)              { return __hip_atomic_load(p, __ATOMIC_RELAXED, __HIP_MEMORY_SCOPE_AGENT); }
__device__ __forceinline__ unsigned xb_add(unsigned* p, unsigned v) { return __hip_atomic_fetch_add(p, v, __ATOMIC_RELAXED, __HIP_MEMORY_SCOPE_AGENT); }
__device__ __forceinline__ unsigned xb_xcc_id() { return (unsigned)__builtin_amdgcn_s_getreg((3 << 11) | 20) & 0xFu; }
#define XB_SPIN(cond, bar) do { unsigned _sp = 0; while (cond) { __builtin_amdgcn_s_sleep(1); \
    if ((++_sp & 255u) == 0u) { if (xb_ld(&(bar)[XB_TMO])) break; if (_sp > XB_SPIN_CAP) { atomicAdd(&(bar)[XB_TMO], 1u); break; } } } } while (0)

struct XcdBarrier {
    unsigned* bar; unsigned x;
    volatile LAS unsigned* st;
};

__device__ __forceinline__ XcdBarrier xcd_barrier_post(unsigned* bar, volatile LAS unsigned* st) {
    XcdBarrier b; b.bar = bar; b.x = xb_xcc_id(); b.st = st;
    if (threadIdx.x == 0) (void)xb_add(&bar[XB_XCNT(b.x)], 1u);
    return b;
}
__device__ __forceinline__ void xcd_barrier_complete(unsigned* bar, unsigned x, unsigned& nloc, unsigned& nx) {
    const unsigned G = gridDim.x * gridDim.y * gridDim.z;
    unsigned sum, cnt, mine, sp = 0u;
    for (;;) {
        sum = 0u; cnt = 0u; mine = 0u;
#pragma unroll
        for (unsigned j = 0; j < 16; ++j) { const unsigned c = xb_ld(&bar[XB_XCNT(j)]); sum += c; cnt += (c > 0u) ? 1u : 0u; mine = (j == x) ? c : mine; }
        if (sum == G) break;
        __builtin_amdgcn_s_sleep(1);
        if ((++sp & 255u) == 0u) { if (xb_ld(&bar[XB_TMO])) break; if (sp > XB_SPIN_CAP) { atomicAdd(&bar[XB_TMO], 1u); break; } }
    }
    nloc = mine > 0u ? mine : 1u; nx = cnt > 0u ? cnt : 1u;
}

__device__ __forceinline__ void xcd_barrier(const XcdBarrier& b) {
    asm volatile("s_waitcnt vmcnt(0)" ::: "memory");
    __syncthreads();
    if (threadIdx.x == 0) {
        unsigned* bar = b.bar;
        __builtin_amdgcn_s_waitcnt(0);
        unsigned nloc = b.st[0], nx = b.st[1];
        if (nloc == 0u) { xcd_barrier_complete(bar, b.x, nloc, nx); b.st[0] = nloc; b.st[1] = nx; }
        const unsigned old = xb_add(&bar[XB_XSUB(b.x)], 1u);
        const unsigned gen = old / nloc;
        if (old + 1u == (gen + 1u) * nloc) {
            __builtin_amdgcn_fence(__ATOMIC_RELEASE, "agent");
            asm volatile("s_waitcnt vmcnt(0)" ::: "memory");
            const unsigned og = xb_add(&bar[XB_TOP], 1u);
            const unsigned tg = og / nx;
            if (og + 1u == (tg + 1u) * nx) xb_add(&bar[XB_TOPGEN], 1u);
            else XB_SPIN(xb_ld(&bar[XB_TOPGEN]) == tg, bar);
            __builtin_amdgcn_fence(__ATOMIC_ACQUIRE, "agent");
            xb_add(&bar[XB_XGEN(b.x)], 1u);
            asm volatile("s_waitcnt vmcnt(0)" ::: "memory");
        } else {
            XB_SPIN(xb_ld(&bar[XB_XGEN(b.x)]) == gen, bar);
            __builtin_amdgcn_fence(__ATOMIC_ACQUIRE, "agent");
            asm volatile("s_waitcnt vmcnt(0)" ::: "memory");
        }
    }
    __syncthreads();
}

constexpr int NWAVES = 8, NTHR = 512;
constexpr int BATCH = 4, SEQ = 4096, DM = 1024, TOK = BATCH * SEQ;
constexpr int INW = 9728;
constexpr int C_RQ = 0, C_RK = 512, C_RV = 1024, C_RG = 2048, C_AQ = 3072, C_AK = 4608, C_AV = 6144, C_GA = 7680, C_GB = 8704;
constexpr int NEXP = 32, FF = 1024, FF2 = 2048;
constexpr int MAXROWS = TOK * 4 + NEXP * 256;
constexpr float RMS_EPS = 1e-6f, GN_EPS = 1e-5f;
constexpr size_t MiB = 1u << 20;
constexpr size_t WS_CTL = 0, CTL_ZERO_BYTES = 1 * MiB;
constexpr size_t WS_ROPE = 1 * MiB;
constexpr size_t WS_WIN = 4 * MiB, WS_WRET = 24 * MiB, WS_WATT = 26 * MiB, WS_WO = 27 * MiB;
constexpr size_t WS_W1 = 32 * MiB, WS_W2 = 160 * MiB;
constexpr size_t WS_H = 224 * MiB;
constexpr size_t WS_U = 256 * MiB;
constexpr size_t WS_KV = 560 * MiB;
constexpr size_t WS_RT = 624 * MiB;
constexpr size_t WS_RET = 656 * MiB;
constexpr size_t WS_OG = 688 * MiB;
constexpr size_t WS_LSE = 736 * MiB;
constexpr size_t WS_ATT = 737 * MiB;
constexpr size_t WS_MTMP = 753 * MiB;
constexpr size_t WS_MERGED = 817 * MiB;
constexpr size_t WS_XMID = 849 * MiB;
constexpr size_t WS_TE = 913 * MiB, WS_TP = WS_TE + 256 * 1024, WS_TG = WS_TP + 256 * 1024, WS_SLOT = WS_TG + 256 * 1024;
constexpr size_t WS_BB = 914 * MiB;
constexpr size_t WS_TILE = WS_BB + 64 * 1024;
constexpr size_t WS_XIN = WS_U;
constexpr size_t WS_A = WS_U + 144 * MiB;
constexpr size_t WS_YB = WS_KV;
constexpr size_t WS_END = 915 * MiB;
static_assert(WS_A + (size_t)MAXROWS * 1024 * 2 <= WS_KV && WS_YB + (size_t)MAXROWS * 1024 * 2 <= WS_ATT, "overlay map");
constexpr int CW_BAR = 4096;
constexpr int CW_MOD = 8192;
constexpr int CW_CNT = 40960;
static_assert((CW_CNT + 64) * 4 <= (int)CTL_ZERO_BYTES, "ctl");
constexpr int LDS_BYTES = 160 * 1024 - 512, MISC_OFF = LDS_BYTES - 256;

__device__ __forceinline__ float bflo(unsigned w) { return __uint_as_float(w << 16); }
__device__ __forceinline__ float bfhi(unsigned w) { return __uint_as_float(w & 0xffff0000u); }
__device__ __forceinline__ unsigned cvtpk(float lo, float hi) { unsigned r; asm volatile("v_cvt_pk_bf16_f32 %0, %1, %2" : "=v"(r) : "v"(lo), "v"(hi)); return r; }
__device__ __forceinline__ float wave_sum(float v) {
#pragma unroll
    for (int o = 1; o < 64; o <<= 1) v += __shfl_xor(v, o);
    return v;
}
static __device__ const double ROPE_C[64] = {0.15915494309189535, 0.13782250260398285, 0.11934937021124886, 0.10335229661843406, 0.089499401608891013, 0.077503288755374058, 0.067115083005227255, 0.058119267441876246, 0.050329212104487035, 0.04358330210530733, 0.037741584717419771, 0.032682865872356998, 0.028302195830623399, 0.024508691862069852, 0.02122365276477766, 0.018378926105679667, 0.015915494309189534, 0.013782250260398284, 0.011934937021124886, 0.010335229661843406, 0.0089499401608891024, 0.0077503288755374055, 0.0067115083005227253, 0.0058119267441876241, 0.0050329212104487037, 0.0043583302105307331, 0.0037741584717419772, 0.0032682865872356993, 0.0028302195830623399, 0.0024508691862069852, 0.0021223652764777662, 0.0018378926105679667, 0.0015915494309189536, 0.0013782250260398288, 0.0011934937021124885, 0.0010335229661843405, 0.00089499401608891024, 0.00077503288755374051, 0.0006711508300522726, 0.00058119267441876239, 0.00050329212104487033, 0.00043583302105307329, 0.00037741584717419774, 0.00032682865872356992, 0.00028302195830623395, 0.00024508691862069854, 0.00021223652764777661, 0.00018378926105679666, 0.00015915494309189535, 0.00013782250260398286, 0.00011934937021124886, 0.00010335229661843406, 8.9499401608891018e-05, 7.7503288755374056e-05, 6.7115083005227254e-05, 5.8119267441876239e-05, 5.0329212104487035e-05, 4.3583302105307322e-05, 3.7741584717419777e-05, 3.2682865872356999e-05, 2.8302195830623396e-05, 2.4508691862069852e-05, 2.1223652764777659e-05, 1.8378926105679668e-05};
__device__ __forceinline__ float log2g(int h) { return h == 0 ? -0.0458036896f : (h == 1 ? -0.0227200765f : (h == 2 ? -0.0113153132f : -0.00564656314f)); }

struct Args { const float* in[18]; float* out; unsigned char* ws; int ph_lo, ph_hi; };
struct Frame { LAS unsigned char* lds; volatile LAS unsigned* MISC; gu32* ctl; int tid, lane, wave, vcu, G; };

__device__ __forceinline__ void p0_transpose_item(const float* W, int K, int N, bf16* WT, LAS float* scr, int item, int lane) {
    const int nblk = N / 32, kb = item / nblk, nb = item % nblk, k0 = 64 * kb, n0 = 32 * nb;
#pragma unroll 8
    for (int i = 0; i < 32; ++i) { const int kk = 2 * i + (lane >> 5); scr[kk * 33 + (lane & 31)] = W[(size_t)(k0 + kk) * N + n0 + (lane & 31)]; }
    LDS_WAIT(); asm volatile("" ::: "memory");
    const int c = lane & 7;
#pragma unroll
    for (int j = 0; j < 4; ++j) { const int n = (lane >> 3) + 8 * j; const LAS float* s = scr + (8 * c) * 33 + n;
        v4u o; o.x = pk2(s[0 * 33], s[1 * 33]); o.y = pk2(s[2 * 33], s[3 * 33]); o.z = pk2(s[4 * 33], s[5 * 33]); o.w = pk2(s[6 * 33], s[7 * 33]);
        *(GAS v4u*)(WT + (size_t)(n0 + n) * K + k0 + 8 * c) = o; }
    LDS_WAIT(); asm volatile("" ::: "memory");
}
__device__ __forceinline__ void p0_prologue(const Args& a, Frame& F) {
    const int gw = F.vcu * NWAVES + F.wave, NGW = F.G * NWAVES;
    { float2* rope = (float2*)(a.ws + WS_ROPE);
      for (int idx = F.vcu * NTHR + F.tid; idx < SEQ * 64; idx += F.G * NTHR) { const int pos = idx >> 6, i = idx & 63;
          double rev = (double)pos * ROPE_C[i]; rev -= __builtin_floor(rev); const float f = (float)rev;
          rope[idx] = make_float2(__builtin_amdgcn_cosf(f), __builtin_amdgcn_sinf(f)); } }
    if (F.vcu < 96) { float* mod = (float*)(a.ws + WS_CTL) + CW_MOD; const float* c = a.in[1]; const float* w_ada = a.in[2]; const float* b_ada = a.in[3];
      const int cg = F.vcu, col = cg * 64 + F.lane; LAS float* red = (LAS float*)(F.lds + 8 * 16384);
      float acc[4] = {0.f, 0.f, 0.f, 0.f};
      for (int kc = 0; kc < 2; ++kc) { const int k0 = F.wave * 128 + kc * 64; float cs[4];
#pragma unroll
          for (int b = 0; b < 4; ++b) { const float cv = c[b * DM + k0 + F.lane]; cs[b] = cv / (1.0f + __expf(-cv)); }
#pragma unroll 16
          for (int kk = 0; kk < 64; ++kk) { const float w = w_ada[(size_t)(k0 + kk) * 6144 + col];
#pragma unroll
              for (int b = 0; b < 4; ++b) acc[b] += __shfl(cs[b], kk) * w; } }
#pragma unroll
      for (int b = 0; b < 4; ++b) red[(F.wave * 4 + b) * 64 + F.lane] = acc[b];
      __syncthreads();
      if (F.tid < 256) { const int b = F.tid >> 6, ln = F.tid & 63; float s = b_ada[cg * 64 + ln];
#pragma unroll
          for (int w = 0; w < 8; ++w) s += red[(w * 4 + b) * 64 + ln];
          mod[b * 6144 + cg * 64 + ln] = s; }
      __syncthreads(); }
    { LAS float* scr = (LAS float*)(F.lds + F.wave * 16384);
      constexpr int I_IN = 16 * (INW / 32), I_RET = 16 * 32, I_ATT = 8 * 32, I_O = 16 * 32, I_1E = 16 * 64, I_2E = 16 * 32;
      constexpr int NITEMS = I_IN + I_RET + I_ATT + I_O + NEXP * (I_1E + I_2E);
      for (int it = gw; it < NITEMS; it += NGW) { int r = it;
          if (r < I_IN) { p0_transpose_item(a.in[5], 1024, INW, (bf16*)(a.ws + WS_WIN), scr, r, F.lane); continue; } r -= I_IN;
          if (r < I_RET) { p0_transpose_item(a.in[7], 1024, 1024, (bf16*)(a.ws + WS_WRET), scr, r, F.lane); continue; } r -= I_RET;
          if (r < I_ATT) { p0_transpose_item(a.in[8], 512, 1024, (bf16*)(a.ws + WS_WATT), scr, r, F.lane); continue; } r -= I_ATT;
          if (r < I_O) { p0_transpose_item(a.in[9], 1024, 1024, (bf16*)(a.ws + WS_WO), scr, r, F.lane); continue; } r -= I_O;
          if (r < NEXP * I_1E) { const int e = r / I_1E; p0_transpose_item(a.in[13] + (size_t)e * 1024 * FF2, 1024, FF2, (bf16*)(a.ws + WS_W1) + (size_t)e * FF2 * 1024, scr, r % I_1E, F.lane); continue; } r -= NEXP * I_1E;
          { const int e = r / I_2E; p0_transpose_item(a.in[15] + (size_t)e * FF * 1024, FF, 1024, (bf16*)(a.ws + WS_W2) + (size_t)e * 1024 * FF, scr, r % I_2E, F.lane); } } }
}
__device__ __forceinline__ void norm_mod_row(const float* xrow, const float* g, const float* sc, const float* sh, bf16* orow, int lane) {
    const GAS f32x4* xr = (const GAS f32x4*)xrow + lane; f32x4 v[4]; float s = 0.f;
#pragma unroll
    for (int j = 0; j < 4; ++j) { v[j] = xr[64 * j]; s += (v[j].x * v[j].x + v[j].y * v[j].y) + (v[j].z * v[j].z + v[j].w * v[j].w); }
    const float rstd = 1.0f / sqrtf(wave_sum(s) * (1.0f / DM) + RMS_EPS);
    GAS unsigned long long* o8 = (GAS unsigned long long*)orow + lane;
#pragma unroll
    for (int j = 0; j < 4; ++j) { const int c = 4 * (64 * j + lane); const f32x4 gg = *(const f32x4*)(g + c), ss = *(const f32x4*)(sc + c), hh = *(const f32x4*)(sh + c);
        const f32x4 o = v[j] * rstd * gg * (ss + 1.0f) + hh;
        o8[64 * j] = (unsigned long long)cvtpk(o.x, o.y) | ((unsigned long long)cvtpk(o.z, o.w) << 32); }
}
__device__ __forceinline__ void p1_norm1(const Args& a, Frame& F) {
    const int gw = F.vcu * NWAVES + F.wave, NGW = F.G * NWAVES; const float* mod = (const float*)(a.ws + WS_CTL) + CW_MOD;
    for (int m = gw; m < TOK; m += NGW) { const int b = m / SEQ;
        norm_mod_row(a.in[0] + (size_t)m * DM, a.in[4], mod + b * 6144 + 1024, mod + b * 6144, (bf16*)(a.ws + WS_H) + (size_t)m * DM, F.lane); }
}

#define MFMA16(a, b, c) __builtin_amdgcn_mfma_f32_16x16x32_bf16((a), (b), (c), 0, 0, 0)
__device__ __forceinline__ bf16x8 ldsfrag(const LAS bf16* base, int pitch, int row0, int k0, int lane) { return *(const LAS bf16x8*)(base + (row0 + (lane & 15)) * pitch + k0 + 8 * (lane >> 4)); }

constexpr int AT_KP = 136, AT_VP = 280, AT_PP = 168;
constexpr int AT_KS = 0, AT_VT = 256 * AT_KP * 2, AT_BIAS = AT_VT + 128 * AT_VP * 2;
__device__ __forceinline__ void attn_unit(const Args& a, Frame& F, int U) {
    const int ub = U & 31, hh = (U >> 5) & 3, g = (U >> 7) % 3, b = U / 384;
    const int rs = 2 * g, r = 1 << rs, ares = ub & (r - 1), blk = ub >> rs, i0 = blk * 128;
    const bf16* Ub = (const bf16*)(a.ws + WS_U) + (size_t)(b * SEQ + ares) * INW + (g * 4 + hh) * 128;
    const size_t rstride = (size_t)r * INW;
    LAS bf16* KS = (LAS bf16*)(F.lds + AT_KS); LAS bf16* VT = (LAS bf16*)(F.lds + AT_VT); LAS float* BIAS = (LAS float*)(F.lds + AT_BIAS);
    const int tid = F.tid, lane = F.lane, w = F.wave, q = lane >> 4, l15 = lane & 15;
#pragma unroll 2
    for (int it = 0; it < 8; ++it) { const int c = tid + NTHR * it, kk = c >> 4, ch = c & 15, i = i0 - 128 + kk;
        v4u kv = (v4u){0u, 0u, 0u, 0u}, vv = (v4u){0u, 0u, 0u, 0u};
        if (i >= 0) { const bf16* rowp = Ub + (size_t)i * rstride + ch * 8; kv = *(const GAS v4u*)(rowp + C_AK); vv = *(const GAS v4u*)(rowp + C_AV); }
        *(LAS v4u*)(KS + kk * AT_KP + ch * 8) = kv;
        LAS bf16* vt = VT + (ch * 8) * AT_VP + kk;
        vt[0 * AT_VP] = (bf16)(vv.x & 0xffffu); vt[1 * AT_VP] = (bf16)(vv.x >> 16); vt[2 * AT_VP] = (bf16)(vv.y & 0xffffu); vt[3 * AT_VP] = (bf16)(vv.y >> 16);
        vt[4 * AT_VP] = (bf16)(vv.z & 0xffffu); vt[5 * AT_VP] = (bf16)(vv.z >> 16); vt[6 * AT_VP] = (bf16)(vv.w & 0xffffu); vt[7 * AT_VP] = (bf16)(vv.w >> 16); }
    if (tid < 128) { LAS v4u* z = (LAS v4u*)(VT + tid * AT_VP + 256); z[0] = (v4u){0u, 0u, 0u, 0u}; z[1] = (v4u){0u, 0u, 0u, 0u}; z[2] = (v4u){0u, 0u, 0u, 0u}; }
    if (tid < 129) { const int dist = r * tid; int bk;
        if (dist < 16) bk = dist; else { bk = 16 + (int)(__log2f((float)dist * 0.0625f) * (16.0f / 7.0f)); bk = bk > 31 ? 31 : bk; }
        BIAS[tid] = a.in[6][bk * 12 + g * 4 + hh]; }
    bf16x8 qf[4];
    { const bf16* qrow = Ub + (size_t)(i0 + 16 * w + l15) * rstride + C_AQ + 8 * q;
#pragma unroll
      for (int ks = 0; ks < 4; ++ks) qf[ks] = *(const GAS bf16x8*)(qrow + 32 * ks); }
    __syncthreads();
    f32x4 s[9];
#pragma unroll
    for (int t9 = 0; t9 < 9; ++t9) { f32x4 acc = (f32x4){0.f, 0.f, 0.f, 0.f};
#pragma unroll
        for (int ks = 0; ks < 4; ++ks) acc = MFMA16(ldsfrag(KS, AT_KP, 16 * (w + t9), 32 * ks, lane), qf[ks], acc);
        s[t9] = acc; }
    const float scale = 0.08838834764831845f;
    float mx = -INFINITY;
#pragma unroll
    for (int t9 = 0; t9 < 9; ++t9)
#pragma unroll
        for (int rr = 0; rr < 4; ++rr) { const int krel = 16 * t9 + 4 * q + rr, dist = 128 + l15 - krel; const bool valid = (dist >= 0) && (dist <= 128) && (i0 - 128 + 16 * w + krel >= 0);
            const float v = valid ? s[t9][rr] * scale + BIAS[valid ? dist : 0] : -INFINITY; s[t9][rr] = v; mx = fmaxf(mx, v); }
    mx = fmaxf(mx, __shfl_xor(mx, 16)); mx = fmaxf(mx, __shfl_xor(mx, 32));
    float lsum = 0.f;
#pragma unroll
    for (int t9 = 0; t9 < 9; ++t9)
#pragma unroll
        for (int rr = 0; rr < 4; ++rr) { const float p = __expf(s[t9][rr] - mx); s[t9][rr] = p; lsum += p; }
    lsum += __shfl_xor(lsum, 16); lsum += __shfl_xor(lsum, 32);
    __syncthreads();
    LAS bf16* PS = KS + w * 16 * AT_PP;
    typedef unsigned u32x2 __attribute__((ext_vector_type(2)));
#pragma unroll
    for (int t9 = 0; t9 < 9; ++t9) *(LAS u32x2*)(PS + l15 * AT_PP + 16 * t9 + 4 * q) = (u32x2){cvtpk(s[t9][0], s[t9][1]), cvtpk(s[t9][2], s[t9][3])};
    *(LAS u32x2*)(PS + l15 * AT_PP + 144 + 4 * q) = (u32x2){0u, 0u};
    __syncthreads();
    bf16x8 pf[5];
#pragma unroll
    for (int ks = 0; ks < 5; ++ks) pf[ks] = ldsfrag(PS, AT_PP, 0, 32 * ks, lane);
    const float inv = 1.0f / lsum;
    const size_t tokrow = (size_t)(b * SEQ + ares) + (size_t)(i0 + 16 * w + l15) * r;
    bf16* og = (bf16*)(a.ws + WS_OG) + (size_t)g * TOK * 512 + tokrow * 512 + hh * 128 + 4 * q;
#pragma unroll
    for (int dt = 0; dt < 8; ++dt) { f32x4 acc = (f32x4){0.f, 0.f, 0.f, 0.f};
#pragma unroll
        for (int ks = 0; ks < 5; ++ks) acc = MFMA16(ldsfrag(VT, AT_VP, 16 * dt, 16 * w + 32 * ks, lane), pf[ks], acc);
        *(GAS u32x2*)(og + 16 * dt) = (u32x2){cvtpk(acc[0] * inv, acc[1] * inv), cvtpk(acc[2] * inv, acc[3] * inv)}; }
    if (q == 0) ((float*)(a.ws + WS_LSE))[(size_t)g * TOK * 4 + tokrow * 4 + hh] = mx + __logf(lsum);
    __syncthreads();
}

constexpr int RT_P = 136;
template <bool TRANS, bool ZETA>
__device__ __forceinline__ void ret_stage_rot(const Args& a, Frame& F, const bf16* src  , int pos0, float mul, float l2g, LAS bf16* dst) {
    const float2* rope = (const float2*)(a.ws + WS_ROPE);
#pragma unroll
    for (int it = 0; it < 2; ++it) { const int pc = F.tid + NTHR * it, j = pc >> 3, d0 = (pc & 7) * 8;
        const v4u lo = *(const GAS v4u*)(src + (size_t)j * INW + d0), hi = *(const GAS v4u*)(src + (size_t)j * INW + d0 + 64);
        const float2* rp = rope + (size_t)(pos0 + j) * 64 + d0;
        const float m = ZETA ? mul * exp2f((float)(127 - j) * l2g) : mul;
        float ol[8], oh[8];
#pragma unroll
        for (int i = 0; i < 8; ++i) { const unsigned wl = i < 2 ? lo.x : (i < 4 ? lo.y : (i < 6 ? lo.z : lo.w)), wh = i < 2 ? hi.x : (i < 4 ? hi.y : (i < 6 ? hi.z : hi.w));
            const float tl = (i & 1) ? bfhi(wl) : bflo(wl), th = (i & 1) ? bfhi(wh) : bflo(wh); const float2 cs = rp[i];
            ol[i] = (tl * cs.x - th * cs.y) * m; oh[i] = (tl * cs.y + th * cs.x) * m; }
        if (TRANS) {
#pragma unroll
            for (int i = 0; i < 8; ++i) { dst[(d0 + i) * RT_P + j] = (bf16)f2bf(ol[i]); dst[(d0 + 64 + i) * RT_P + j] = (bf16)f2bf(oh[i]); }
        } else {
            *(LAS v4u*)(dst + j * RT_P + d0) = (v4u){cvtpk(ol[0], ol[1]), cvtpk(ol[2], ol[3]), cvtpk(ol[4], ol[5]), cvtpk(ol[6], ol[7])};
            *(LAS v4u*)(dst + j * RT_P + d0 + 64) = (v4u){cvtpk(oh[0], oh[1]), cvtpk(oh[2], oh[3]), cvtpk(oh[4], oh[5]), cvtpk(oh[6], oh[7])};
        } }
}
__device__ __forceinline__ void ret_stage_vt(Frame& F, const bf16* src, LAS bf16* VT2) {
#pragma unroll 2
    for (int it = 0; it < 8; ++it) { const int c = F.tid + NTHR * it, j = c >> 5, e0 = (c & 31) * 8;
        const v4u vv = *(const GAS v4u*)(src + (size_t)j * INW + e0); LAS bf16* vt = VT2 + e0 * RT_P + j;
        vt[0 * RT_P] = (bf16)(vv.x & 0xffffu); vt[1 * RT_P] = (bf16)(vv.x >> 16); vt[2 * RT_P] = (bf16)(vv.y & 0xffffu); vt[3 * RT_P] = (bf16)(vv.y >> 16);
        vt[4 * RT_P] = (bf16)(vv.z & 0xffffu); vt[5 * RT_P] = (bf16)(vv.z >> 16); vt[6 * RT_P] = (bf16)(vv.w & 0xffffu); vt[7 * RT_P] = (bf16)(vv.w >> 16); }
}
__device__ __forceinline__ void ret_kv_item(const Args& a, Frame& F, int item) {
    const int h = item & 3, n = (item >> 2) & 31, b = item >> 7; const float l2g = log2g(h);
    const bf16* Ub = (const bf16*)(a.ws + WS_U) + (size_t)(b * SEQ + n * 128) * INW;
    LAS bf16* KT = (LAS bf16*)F.lds; LAS bf16* VT2 = (LAS bf16*)(F.lds + 128 * RT_P * 2);
    ret_stage_rot<true, true>(a, F, Ub + C_RK + h * 128, n * 128, 0.08838834764831845f, l2g, KT);
    ret_stage_vt(F, Ub + C_RV + h * 256, VT2);
    __syncthreads();
    const int lane = F.lane, w = F.wave, q = lane >> 4, l15 = lane & 15;
    f32x4 acc[2][8];
#pragma unroll
    for (int e2 = 0; e2 < 2; ++e2)
#pragma unroll
        for (int dt = 0; dt < 8; ++dt) acc[e2][dt] = (f32x4){0.f, 0.f, 0.f, 0.f};
#pragma unroll
    for (int ks = 0; ks < 4; ++ks) { const bf16x8 a0 = ldsfrag(VT2, RT_P, 32 * w, 32 * ks, lane), a1 = ldsfrag(VT2, RT_P, 32 * w + 16, 32 * ks, lane);
#pragma unroll
        for (int dt = 0; dt < 8; ++dt) { const bf16x8 bb = ldsfrag(KT, RT_P, 16 * dt, 32 * ks, lane); acc[0][dt] = MFMA16(a0, bb, acc[0][dt]); acc[1][dt] = MFMA16(a1, bb, acc[1][dt]); } }
    float* kv = (float*)(a.ws + WS_KV) + (size_t)item * 32768;
#pragma unroll
    for (int e2 = 0; e2 < 2; ++e2)
#pragma unroll
        for (int dt = 0; dt < 8; ++dt)
#pragma unroll
            for (int rr = 0; rr < 4; ++rr) kv[(32 * w + 16 * e2 + 4 * q + rr) * 128 + 16 * dt + l15] = acc[e2][dt][rr];
    __syncthreads();
}
__device__ __forceinline__ void p4_scan_merge(const Args& a, Frame& F) {
    const float* kv = (const float*)(a.ws + WS_KV); bf16* rt = (bf16*)(a.ws + WS_RT);
    for (int idx = F.vcu * NTHR + F.tid; idx < 16 * 8192; idx += F.G * NTHR) {
        const int bh = idx >> 13, el = (idx & 8191) * 4, b = bh >> 2, h = bh & 3; const float gch = exp2f(128.0f * log2g(h));
        f32x4 R = (f32x4){0.f, 0.f, 0.f, 0.f};
        for (int n = 0; n < 32; ++n) { const size_t off = (size_t)(((b * 32 + n) << 2) + h) * 32768 + el;
            *(GAS unsigned long long*)(rt + off) = (unsigned long long)cvtpk(R.x, R.y) | ((unsigned long long)cvtpk(R.z, R.w) << 32);
            if (n < 31) { const f32x4 k4 = *(const GAS f32x4*)(kv + off); R = R * gch + k4; } } }
    const int gw = F.vcu * NWAVES + F.wave, NGW = F.G * NWAVES;
    const bf16* og = (const bf16*)(a.ws + WS_OG); const float* lse = (const float*)(a.ws + WS_LSE); bf16* att = (bf16*)(a.ws + WS_ATT);
    for (int t = gw; t < TOK; t += NGW) { const int hh = F.lane >> 4;
        const float l0 = lse[(size_t)t * 4 + hh], l1 = lse[(size_t)TOK * 4 + (size_t)t * 4 + hh], l2 = lse[(size_t)2 * TOK * 4 + (size_t)t * 4 + hh];
        const float m = fmaxf(l0, fmaxf(l1, l2)); float a0 = __expf(l0 - m), a1 = __expf(l1 - m), a2 = __expf(l2 - m); const float is = 1.0f / (a0 + a1 + a2); a0 *= is; a1 *= is; a2 *= is;
        const size_t o = (size_t)t * 512 + F.lane * 8;
        const v4u x0 = *(const GAS v4u*)(og + o), x1 = *(const GAS v4u*)(og + (size_t)TOK * 512 + o), x2 = *(const GAS v4u*)(og + (size_t)2 * TOK * 512 + o);
        v4u r;
        r.x = cvtpk(a0 * bflo(x0.x) + a1 * bflo(x1.x) + a2 * bflo(x2.x), a0 * bfhi(x0.x) + a1 * bfhi(x1.x) + a2 * bfhi(x2.x));
        r.y = cvtpk(a0 * bflo(x0.y) + a1 * bflo(x1.y) + a2 * bflo(x2.y), a0 * bfhi(x0.y) + a1 * bfhi(x1.y) + a2 * bfhi(x2.y));
        r.z = cvtpk(a0 * bflo(x0.z) + a1 * bflo(x1.z) + a2 * bflo(x2.z), a0 * bfhi(x0.z) + a1 * bfhi(x1.z) + a2 * bfhi(x2.z));
        r.w = cvtpk(a0 * bflo(x0.w) + a1 * bflo(x1.w) + a2 * bflo(x2.w), a0 * bfhi(x0.w) + a1 * bfhi(x1.w) + a2 * bfhi(x2.w));
        *(GAS v4u*)(att + o) = r; }
}
__device__ __forceinline__ void ret_out_item(const Args& a, Frame& F, int item) {
    const int h = item & 3, n = (item >> 2) & 31, b = item >> 7; const float l2g = log2g(h);
    const bf16* Ub = (const bf16*)(a.ws + WS_U) + (size_t)(b * SEQ + n * 128) * INW;
    LAS bf16* QS = (LAS bf16*)F.lds; LAS bf16* KS = (LAS bf16*)(F.lds + 128 * RT_P * 2); LAS bf16* VT2 = (LAS bf16*)(F.lds + 2 * 128 * RT_P * 2);
    ret_stage_rot<false, false>(a, F, Ub + C_RQ + h * 128, n * 128, 1.0f, l2g, QS);
    ret_stage_rot<false, false>(a, F, Ub + C_RK + h * 128, n * 128, 0.08838834764831845f, l2g, KS);
    ret_stage_vt(F, Ub + C_RV + h * 256, VT2);
    __syncthreads();
    const int lane = F.lane, w = F.wave, q = lane >> 4, l15 = lane & 15;
    typedef unsigned u32x2 __attribute__((ext_vector_type(2)));
    bf16x8 qf[4];
#pragma unroll
    for (int ks = 0; ks < 4; ++ks) qf[ks] = ldsfrag(QS, RT_P, 16 * w, 32 * ks, lane);
    u32x2 pw[8];
#pragma unroll
    for (int jt = 0; jt < 8; ++jt) { f32x4 acc = (f32x4){0.f, 0.f, 0.f, 0.f};
        if (jt <= w) {
#pragma unroll
            for (int ks = 0; ks < 4; ++ks) acc = MFMA16(ldsfrag(KS, RT_P, 16 * jt, 32 * ks, lane), qf[ks], acc); }
        float p[4];
#pragma unroll
        for (int rr = 0; rr < 4; ++rr) { const int j = 16 * jt + 4 * q + rr, i = 16 * w + l15; p[rr] = (j <= i) ? acc[rr] * exp2f(-(float)(j + 1) * l2g) : 0.f; }
        pw[jt] = (u32x2){cvtpk(p[0], p[1]), cvtpk(p[2], p[3])}; }
    __syncthreads();
#pragma unroll
    for (int jt = 0; jt < 8; ++jt) *(LAS u32x2*)(KS + (16 * w + l15) * RT_P + 16 * jt + 4 * q) = pw[jt];
    __syncthreads();
    f32x4 acc[16];
#pragma unroll
    for (int et = 0; et < 16; ++et) acc[et] = (f32x4){0.f, 0.f, 0.f, 0.f};
    for (int ks = 0; ks <= (w >> 1); ++ks) { const bf16x8 pf = ldsfrag(KS, RT_P, 16 * w, 32 * ks, lane);
#pragma unroll
        for (int et = 0; et < 16; ++et) acc[et] = MFMA16(ldsfrag(VT2, RT_P, 16 * et, 32 * ks, lane), pf, acc[et]); }
    const bf16* rtg = (const bf16*)(a.ws + WS_RT) + (size_t)item * 32768 + l15 * 128 + 8 * q;
#pragma unroll
    for (int ks = 0; ks < 4; ++ks) {
#pragma unroll
        for (int et = 0; et < 16; ++et) { const bf16x8 rf = *(const GAS bf16x8*)(rtg + (16 * et) * 128 + 32 * ks); acc[et] = MFMA16(rf, qf[ks], acc[et]); } }
    const float xi = exp2f((float)(16 * w + l15 + 1) * l2g);
    float s1 = 0.f;
#pragma unroll
    for (int et = 0; et < 16; ++et) { acc[et] = acc[et] * xi; s1 += (acc[et][0] + acc[et][1]) + (acc[et][2] + acc[et][3]); }
    s1 += __shfl_xor(s1, 16); s1 += __shfl_xor(s1, 32);
    const float mean = s1 * (1.0f / 256.0f); float s2 = 0.f;
#pragma unroll
    for (int et = 0; et < 16; ++et) { acc[et] = acc[et] - mean; s2 += (acc[et][0] * acc[et][0] + acc[et][1] * acc[et][1]) + (acc[et][2] * acc[et][2] + acc[et][3] * acc[et][3]); }
    s2 += __shfl_xor(s2, 16); s2 += __shfl_xor(s2, 32);
    const float rstd = 1.0f / sqrtf(s2 * (1.0f / 256.0f) + GN_EPS);
    const size_t tok = (size_t)(b * SEQ + n * 128 + 16 * w + l15);
    const bf16* gp = (const bf16*)(a.ws + WS_U) + tok * INW + C_RG + h * 256 + 4 * q; bf16* op = (bf16*)(a.ws + WS_RET) + tok * 1024 + h * 256 + 4 * q;
#pragma unroll
    for (int et = 0; et < 16; ++et) { const u32x2 gg = *(const GAS u32x2*)(gp + 16 * et);
        const float g0 = bflo(gg.x), g1 = bfhi(gg.x), g2 = bflo(gg.y), g3 = bfhi(gg.y);
        const float o0 = g0 / (1.0f + __expf(-g0)) * acc[et][0] * rstd, o1 = g1 / (1.0f + __expf(-g1)) * acc[et][1] * rstd, o2 = g2 / (1.0f + __expf(-g2)) * acc[et][2] * rstd, o3 = g3 / (1.0f + __expf(-g3)) * acc[et][3] * rstd;
        *(GAS u32x2*)(op + 16 * et) = (u32x2){cvtpk(o0, o1), cvtpk(o2, o3)}; }
    __syncthreads();
}

constexpr int WR_P = 36;
constexpr int P8_SL = 1024 * WR_P * 4, P8_CNT = P8_SL + 1024;
__device__ __forceinline__ void p8_route(const Args& a, Frame& F) {
    LAS float* WRL = (LAS float*)F.lds; LAS float* SL = (LAS float*)(F.lds + P8_SL) + F.wave * 32; LAS int* CNT = (LAS int*)(F.lds + P8_CNT);
    const float* wr = a.in[11];
    for (int idx = F.tid; idx < 1024 * 32; idx += NTHR) { const int k = idx >> 5, e = idx & 31, j = k >> 8, ln = (k & 255) >> 2, cc = k & 3; WRL[((j * 4 + cc) * 64 + ln) * WR_P + e] = wr[idx]; }
    if (F.tid < 32) CNT[F.tid] = 0;
    __syncthreads();
    const float* mod = (const float*)(a.ws + WS_CTL) + CW_MOD; const int lane = F.lane;
    const float* xm = (const float*)(a.ws + WS_XMID); bf16* h2 = (bf16*)(a.ws + WS_H);
    int* TE = (int*)(a.ws + WS_TE); int* TP = (int*)(a.ws + WS_TP); float* TG = (float*)(a.ws + WS_TG);
    const int rows_per_blk = TOK / F.G, rows_per_wave = rows_per_blk / NWAVES;
    for (int ri = 0; ri < rows_per_wave; ++ri) { const int t = F.vcu * rows_per_blk + F.wave * rows_per_wave + ri, b = t / SEQ;
        const GAS f32x4* xr = (const GAS f32x4*)(xm + (size_t)t * DM) + lane; f32x4 v[4]; float s = 0.f;
#pragma unroll
        for (int j = 0; j < 4; ++j) { v[j] = xr[64 * j]; s += (v[j].x * v[j].x + v[j].y * v[j].y) + (v[j].z * v[j].z + v[j].w * v[j].w); }
        const float rstd = 1.0f / sqrtf(wave_sum(s) * (1.0f / DM) + RMS_EPS);
        float p[32];
#pragma unroll
        for (int e = 0; e < 32; ++e) p[e] = 0.f;
        GAS unsigned long long* o8 = (GAS unsigned long long*)(h2 + (size_t)t * DM) + lane;
#pragma unroll
        for (int j = 0; j < 4; ++j) { const int c = 4 * (64 * j + lane);
            const f32x4 gg = *(const f32x4*)(a.in[10] + c), ss = *(const f32x4*)(mod + b * 6144 + 4096 + c), hh = *(const f32x4*)(mod + b * 6144 + 3072 + c);
            const f32x4 o = v[j] * rstd * gg * (ss + 1.0f) + hh;
            o8[64 * j] = (unsigned long long)cvtpk(o.x, o.y) | ((unsigned long long)cvtpk(o.z, o.w) << 32);
#pragma unroll
            for (int cc = 0; cc < 4; ++cc) { const float hv = o[cc]; const LAS f32x4* wp = (const LAS f32x4*)(WRL + ((j * 4 + cc) * 64 + lane) * WR_P);
#pragma unroll
                for (int e4 = 0; e4 < 8; ++e4) { const f32x4 ww = wp[e4]; p[4 * e4] += hv * ww.x; p[4 * e4 + 1] += hv * ww.y; p[4 * e4 + 2] += hv * ww.z; p[4 * e4 + 3] += hv * ww.w; } } }
        float q16[16], q8[8], q4[4], q2[2], q1;
        { const bool hi = (lane & 32) != 0;
#pragma unroll
          for (int i = 0; i < 16; ++i) { const float send = hi ? p[i] : p[i + 16], keep = hi ? p[i + 16] : p[i]; q16[i] = keep + __shfl_xor(send, 32); } }
        { const bool hi = (lane & 16) != 0;
#pragma unroll
          for (int i = 0; i < 8; ++i) { const float send = hi ? q16[i] : q16[i + 8], keep = hi ? q16[i + 8] : q16[i]; q8[i] = keep + __shfl_xor(send, 16); } }
        { const bool hi = (lane & 8) != 0;
#pragma unroll
          for (int i = 0; i < 4; ++i) { const float send = hi ? q8[i] : q8[i + 4], keep = hi ? q8[i + 4] : q8[i]; q4[i] = keep + __shfl_xor(send, 8); } }
        { const bool hi = (lane & 4) != 0;
#pragma unroll
          for (int i = 0; i < 2; ++i) { const float send = hi ? q4[i] : q4[i + 2], keep = hi ? q4[i + 2] : q4[i]; q2[i] = keep + __shfl_xor(send, 4); } }
        { const bool hi = (lane & 2) != 0; const float send = hi ? q2[0] : q2[1], keep = hi ? q2[1] : q2[0]; q1 = keep + __shfl_xor(send, 2); }
        q1 += __shfl_xor(q1, 1);
        const int emine = ((lane >> 5) & 1) * 16 + ((lane >> 4) & 1) * 8 + ((lane >> 3) & 1) * 4 + ((lane >> 2) & 1) * 2 + ((lane >> 1) & 1);
        if ((lane & 1) == 0) SL[emine] = q1 + a.in[12][emine];
        LDS_WAIT(); asm volatile("" ::: "memory");
        float lg[32];
#pragma unroll
        for (int e4 = 0; e4 < 8; ++e4) { const f32x4 t4 = ((const LAS f32x4*)SL)[e4]; lg[4 * e4] = t4.x; lg[4 * e4 + 1] = t4.y; lg[4 * e4 + 2] = t4.z; lg[4 * e4 + 3] = t4.w; }
        LDS_WAIT(); asm volatile("" ::: "memory");
        unsigned taken = 0u; float tv[4]; int ti[4];
#pragma unroll
        for (int k = 0; k < 4; ++k) { float best = -INFINITY; int bi = 0;
#pragma unroll
            for (int e = 0; e < 32; ++e) { const bool ok = !((taken >> e) & 1u) && (lg[e] > best); best = ok ? lg[e] : best; bi = ok ? e : bi; }
            taken |= 1u << bi; tv[k] = best; ti[k] = bi; }
        const float e1 = __expf(tv[1] - tv[0]), e2 = __expf(tv[2] - tv[0]), e3 = __expf(tv[3] - tv[0]); const float is = 1.0f / (1.0f + e1 + e2 + e3);
        if (lane < 4) { const int k = lane; const int ek = k == 0 ? ti[0] : (k == 1 ? ti[1] : (k == 2 ? ti[2] : ti[3])); const float gk = (k == 0 ? 1.0f : (k == 1 ? e1 : (k == 2 ? e2 : e3))) * is;
            const int lp = atomicAdd((int*)&CNT[ek], 1);
            TE[t * 4 + k] = ek; TP[t * 4 + k] = lp; TG[t * 4 + k] = gk; }
    }
    __syncthreads();
    if (F.tid < 32) { const int cnt = CNT[F.tid]; const int base = (int)__hip_atomic_fetch_add(F.ctl + CW_CNT + F.tid, (unsigned)cnt, RLX_AGENT); ((int*)(a.ws + WS_BB))[F.vcu * 32 + F.tid] = base; }
    __syncthreads();
}
__device__ __forceinline__ void p9_dispatch(const Args& a, Frame& F) {
    LAS int* PST = (LAS int*)F.lds;
    if (F.tid == 0) { int acc = 0; int* tile = (int*)(a.ws + WS_TILE);
        for (int e = 0; e < 32; ++e) { const int cnt = (int)__hip_atomic_load(F.ctl + CW_CNT + e, RLX_AGENT); PST[e] = acc; const int nt = (cnt + 255) >> 8;
            if (blockIdx.x == 0) for (int i = 0; i < nt; ++i) tile[16 + (acc >> 8) + i] = e;
            acc += nt << 8; }
        if (blockIdx.x == 0) tile[0] = acc >> 8; }
    __syncthreads();
    const int* TE = (const int*)(a.ws + WS_TE); const int* TP = (const int*)(a.ws + WS_TP); int* SLOT = (int*)(a.ws + WS_SLOT); const int* BB = (const int*)(a.ws + WS_BB);
    const bf16* h2 = (const bf16*)(a.ws + WS_H); bf16* xin = (bf16*)(a.ws + WS_XIN);
    const int rows_per_blk = TOK / F.G, pairs_per_wave = rows_per_blk * 4 / NWAVES;
    for (int pi = 0; pi < pairs_per_wave; ++pi) { const int p = F.wave * pairs_per_wave + pi, t = F.vcu * rows_per_blk + (p >> 2), k = p & 3;
        const int e = TE[t * 4 + k]; const int row = PST[e] + BB[F.vcu * 32 + e] + TP[t * 4 + k];
        if (F.lane == 0) SLOT[t * 4 + k] = row;
        const GAS v4u* src = (const GAS v4u*)(h2 + (size_t)t * DM) + F.lane; GAS v4u* dst = (GAS v4u*)(xin + (size_t)row * DM) + F.lane;
        const v4u x0 = src[0], x1 = src[64]; dst[0] = x0; dst[64] = x1; }
    __syncthreads();
}
__device__ __forceinline__ void p12_final(const Args& a, Frame& F, bool with_moe) {
    const int gw = F.vcu * NWAVES + F.wave, NGW = F.G * NWAVES, lane = F.lane; const float* mod = (const float*)(a.ws + WS_CTL) + CW_MOD;
    const float* xm = (const float*)(a.ws + WS_XMID); const bf16* yb = (const bf16*)(a.ws + WS_YB); const int* SLOT = (const int*)(a.ws + WS_SLOT); const float* TG = (const float*)(a.ws + WS_TG);
    for (int t = gw; t < TOK; t += NGW) { const int b = t / SEQ;
        f32x4 v[4], m4[4];
#pragma unroll
        for (int j = 0; j < 4; ++j) { v[j] = ((const GAS f32x4*)(xm + (size_t)t * DM) + lane)[64 * j]; m4[j] = (f32x4){0.f, 0.f, 0.f, 0.f}; }
        if (with_moe) {
#pragma unroll
            for (int k = 0; k < 4; ++k) { const int row = SLOT[t * 4 + k]; const float gk = TG[t * 4 + k]; const GAS unsigned long long* yr = (const GAS unsigned long long*)(yb + (size_t)row * DM) + lane;
#pragma unroll
                for (int j = 0; j < 4; ++j) { const unsigned long long y8 = yr[64 * j]; const unsigned lo = (unsigned)y8, hi = (unsigned)(y8 >> 32);
                    m4[j].x += gk * bflo(lo); m4[j].y += gk * bfhi(lo); m4[j].z += gk * bflo(hi); m4[j].w += gk * bfhi(hi); } }
        }
        float s = 0.f;
#pragma unroll
        for (int j = 0; j < 4; ++j) { const f32x4 gt = *(const f32x4*)(mod + b * 6144 + 5120 + 4 * (64 * j + lane)); v[j] = v[j] + gt * m4[j]; s += (v[j].x * v[j].x + v[j].y * v[j].y) + (v[j].z * v[j].z + v[j].w * v[j].w); }
        const float rstd = 1.0f / sqrtf(wave_sum(s) * (1.0f / DM) + RMS_EPS);
#pragma unroll
        for (int j = 0; j < 4; ++j) { const f32x4 gf = *(const f32x4*)(a.in[17] + 4 * (64 * j + lane)); ((GAS f32x4*)(a.out + (size_t)t * DM) + lane)[64 * j] = v[j] * rstd * gf; } }
}

#ifndef ABL_NOMIX
#define ABL_NOMIX 0
#endif
#ifndef ABL_NOMOE
#define ABL_NOMOE 0
#endif
#ifndef ONE_LAUNCH
#define ONE_LAUNCH 1
#endif
constexpr int NPHASE = 13;
__global__ void __launch_bounds__(NTHR, 2) mk_fwd(Args args) {
    extern __shared__ __attribute__((aligned(16))) unsigned char lds[];
    Frame F;
    F.lds = (LAS unsigned char*)lds; F.MISC = (volatile LAS unsigned*)(F.lds + MISC_OFF);
    F.tid = threadIdx.x; F.lane = F.tid & 63; F.wave = __builtin_amdgcn_readfirstlane(F.tid >> 6);
    F.G = gridDim.x; { const int bx = blockIdx.x; F.vcu = (F.G % 8 == 0) ? (bx % 8) * (F.G / 8) + bx / 8 : bx; }
    unsigned char* ws = args.ws; F.ctl = (gu32*)(ws + WS_CTL);
    if (F.tid < 64) F.MISC[F.tid] = 0u;
    __syncthreads();
    XcdBarrier bar = xcd_barrier_post((unsigned*)(F.ctl + CW_BAR), F.MISC + 8);
    const int lo = args.ph_lo, hi = args.ph_hi;
#ifndef PHMASK
#define PHMASK 0x1fff
#endif
#define IN(k) (lo <= (k) && (k) < hi && ((PHMASK >> (k)) & 1))
#define SEAM(k) do { if (IN(k) && IN((k) + 1)) xcd_barrier(bar); } while (0)
    typedef pg8::bf16_t pb;
    if (IN(0)) { p0_prologue(args, F); } SEAM(0);
#if !ABL_NOMIX
    if (IN(1)) { p1_norm1(args, F); } SEAM(1);
    if (IN(2)) { pg8::Gemm g{(const pb*)(ws + WS_H), (const pb*)(ws + WS_WIN), TOK, INW, DM}; pg8::StaticOrder S; S.init(TOK, INW, F.G, (int)blockIdx.x);
        pg8::EpiBf16<0> E{(pb*)(ws + WS_U), INW, nullptr, 0, 0, 1.f};
        pg8::gemm_phase<pg8::EpiBf16<0>, pg8::StaticOrder, true, true>(F.lds, g, S, E); } SEAM(2);
    if (IN(3)) { for (int U = F.vcu; U < 1536; U += F.G) attn_unit(args, F, U);
        for (int it = (F.vcu + 128) % F.G; it < 512; it += F.G) ret_kv_item(args, F, it); } SEAM(3);
    if (IN(4)) { p4_scan_merge(args, F); } SEAM(4);
    if (IN(5)) { for (int it = F.vcu; it < 512; it += F.G) ret_out_item(args, F, it); } SEAM(5);
    if (IN(6)) {
        { pg8::Gemm g{(const pb*)(ws + WS_RET), (const pb*)(ws + WS_WRET), TOK, DM, 1024}; pg8::StaticOrder S; S.init(TOK, DM, F.G, (int)blockIdx.x);
          pg8::EpiGateF32 E{(float*)(ws + WS_MTMP), DM, (const pb*)(ws + WS_U) + C_GA, INW};
          pg8::gemm_phase<pg8::EpiGateF32, pg8::StaticOrder, true, true>(F.lds, g, S, E); }
        __syncthreads();
        { pg8::Gemm g{(const pb*)(ws + WS_ATT), (const pb*)(ws + WS_WATT), TOK, DM, 512}; pg8::StaticOrder S; S.init(TOK, DM, F.G, (int)blockIdx.x);
          pg8::EpiGateAddBf16 E{(pb*)(ws + WS_MERGED), DM, (const float*)(ws + WS_MTMP), DM, (const pb*)(ws + WS_U) + C_GB, INW};
          pg8::gemm_phase<pg8::EpiGateAddBf16, pg8::StaticOrder, true, true>(F.lds, g, S, E); } } SEAM(6);
    if (IN(7)) { pg8::Gemm g{(const pb*)(ws + WS_MERGED), (const pb*)(ws + WS_WO), TOK, DM, 1024}; pg8::StaticOrder S; S.init(TOK, DM, F.G, (int)blockIdx.x);
        pg8::EpiResid E{(float*)(ws + WS_XMID), args.in[0], DM, (const float*)(ws + WS_CTL) + CW_MOD + 2048, 6144, SEQ / 256};
        pg8::gemm_phase<pg8::EpiResid, pg8::StaticOrder, true, true>(F.lds, g, S, E); } SEAM(7);
#else
    if (IN(7)) { const f32x4* s = (const f32x4*)args.in[0]; f32x4* d = (f32x4*)(ws + WS_XMID); for (size_t i = (size_t)blockIdx.x * NTHR + F.tid; i < (size_t)TOK * DM / 4; i += (size_t)F.G * NTHR) d[i] = s[i]; } SEAM(7);
#endif
#if !ABL_NOMOE
    if (IN(8)) { p8_route(args, F); } SEAM(8);
    if (IN(9)) { p9_dispatch(args, F); } SEAM(9);
    if (IN(10)) { const int* tile = (const int*)(ws + WS_TILE); const int nt = __builtin_amdgcn_readfirstlane((int)__hip_atomic_load((const unsigned*)tile, RLX_AGENT));
        pg8::Gemm g{(const pb*)(ws + WS_XIN), (const pb*)(ws + WS_W1), nt * 256, NEXP * FF2, DM}; pg8::MoeOrder S{nt, FF2 / 256, F.G, (int)blockIdx.x, tile + 16};
        pg8::EpiSwiglu E{(pb*)(ws + WS_A), FF, args.in[14], FF2 / 256};
        pg8::gemm_phase<pg8::EpiSwiglu, pg8::MoeOrder, true, true>(F.lds, g, S, E); } SEAM(10);
    if (IN(11)) { const int* tile = (const int*)(ws + WS_TILE); const int nt = __builtin_amdgcn_readfirstlane((int)__hip_atomic_load((const unsigned*)tile, RLX_AGENT));
        pg8::Gemm g{(const pb*)(ws + WS_A), (const pb*)(ws + WS_W2), nt * 256, NEXP * DM, FF}; pg8::MoeOrder S{nt, DM / 256, F.G, (int)blockIdx.x, tile + 16};
        pg8::EpiBf16<0> E{(pb*)(ws + WS_YB), DM, args.in[16], DM, 0, 1.f};
        pg8::gemm_phase<pg8::EpiBf16<0>, pg8::MoeOrder, true, true>(F.lds, g, S, E); } SEAM(11);
#endif
    if (IN(12)) { p12_final(args, F, !ABL_NOMOE); }
#undef IN
#undef SEAM
}

extern "C" void kernel_launch(void* const* d_in, const int* in_sizes, int n_in, void* d_out, int out_size, void* d_ws, size_t ws_size, hipStream_t stream) {
    static int grid = 0;
    if (grid == 0) {
        if (n_in != 18 || in_sizes[0] != TOK * DM || out_size != TOK * DM || ws_size < WS_END) { fprintf(stderr, "kernel_launch: unexpected shapes n_in %d in0 %d out %d ws %zu\n", n_in, n_in > 0 ? in_sizes[0] : -1, out_size, ws_size); grid = -1; return; }
        int dev = 0, cus = 0, per_cu = 0;
        if (hipGetDevice(&dev) != hipSuccess || hipDeviceGetAttribute(&cus, hipDeviceAttributeMultiprocessorCount, dev) != hipSuccess) { grid = -1; return; }
        if (hipFuncSetAttribute((const void*)mk_fwd, hipFuncAttributeMaxDynamicSharedMemorySize, LDS_BYTES) != hipSuccess) { fprintf(stderr, "kernel_launch: hipFuncSetAttribute failed\n"); grid = -1; return; }
        if (hipOccupancyMaxActiveBlocksPerMultiprocessor(&per_cu, (const void*)mk_fwd, NTHR, LDS_BYTES) != hipSuccess || per_cu < 1) fprintf(stderr, "kernel_launch: occupancy query says %d\n", per_cu);
        (void)hipGetLastError();
        grid = cus;
        if (grid != 256) fprintf(stderr, "kernel_launch: %d CUs (built for 256)\n", grid);
    }
    if (grid < 0) return;
    (void)hipMemsetAsync((char*)d_ws + WS_CTL, 0, CTL_ZERO_BYTES, stream);
    Args a{};
    for (int i = 0; i < 18; ++i) a.in[i] = (const float*)d_in[i];
    a.out = (float*)d_out; a.ws = (unsigned char*)d_ws;
#if ONE_LAUNCH
    a.ph_lo = 0; a.ph_hi = NPHASE;
    hipLaunchKernelGGL(mk_fwd, dim3(grid), dim3(NTHR), LDS_BYTES, stream, a);
#else
    for (int p = 0; p < NPHASE; ++p) {
#if ABL_NOMIX
        if (p >= 1 && p <= 6) continue;
#endif
#if ABL_NOMOE
        if (p >= 8 && p <= 11) continue;
#endif
        a.ph_lo = p; a.ph_hi = p + 1;
        hipLaunchKernelGGL(mk_fwd, dim3(grid), dim3(NTHR), LDS_BYTES, stream, a);
    }
#endif
}
```

```cpp
#include <hip/hip_runtime.h>
#include <cstdio>
#include <cstdint>
namespace pg8 {
#define PG8_LAS __attribute__((address_space(3)))
typedef unsigned short bf16_t;
typedef short bf16x8 __attribute__((ext_vector_type(8)));
typedef float f32x4 __attribute__((ext_vector_type(4)));
typedef unsigned u32x4 __attribute__((ext_vector_type(4)));
constexpr int BM = 256, BK = 64, HALF = 128, HTB = HALF * BK * 2  , STAGE_BYTES = 8 * HTB, NXCD = 8, WGM = 4;

__host__ __device__ __forceinline__ int lds_byte(int r, int c) { const int st = (r >> 4) * 2 + (c >> 5), rr = r & 15, cc = c & 31, ob = rr * 64 + cc * 2; return st * 1024 + (ob ^ (((ob >> 9) & 1) << 5)); }
__host__ __device__ __forceinline__ void stage_rc(int b, int& R, int& C) { const int st = b / 1024, sb = b % 1024, swz = sb ^ (((sb >> 9) & 1) << 5); R = (st >> 1) * 16 + swz / 64; C = (st & 1) * 32 + (swz % 64) / 2; }
__host__ __device__ __forceinline__ int perm32(int rho) { const int n = rho >> 4, i = rho & 15; return 8 * (i >> 2) + 4 * n + (i & 3); }

struct Unit { int pm, pn, po; };
struct Gemm { const bf16_t* A; const bf16_t* Bt; int M, N, K; };

struct StaticOrder {
    int nM, nN, nwg, G, c;
    __host__ __device__ void init(int M, int N, int G_, int c_) { nM = M / BM; nN = N / BM; nwg = nM * nN; G = G_; c = c_; }
    __host__ __device__ bool next(int i, Unit& u) const {
        const long L = (long)i * G + c; if (L >= nwg) return false;
        int wgid = (int)L; { const int q = nwg / NXCD, r = nwg % NXCD, xcd = wgid % NXCD, off = wgid / NXCD; wgid = (xcd < r ? xcd * (q + 1) : r * (q + 1) + (xcd - r) * q) + off; }
        const int nig = WGM * nN, gid = wgid / nig, fm = gid * WGM, gsz = (nM - fm) < WGM ? (nM - fm) : WGM;
        u.pm = fm + ((wgid % nig) % gsz); u.pn = (wgid % nig) / gsz; u.po = u.pm; return true;
    }
    __device__ __forceinline__ void a_ready(const Unit&) const {}
    __device__ __forceinline__ void done(const Unit&) const {}
};

__device__ __forceinline__ unsigned cvt_pk_bf16(float lo, float hi) { unsigned r; asm volatile("v_cvt_pk_bf16_f32 %0, %1, %2" : "=v"(r) : "v"(lo), "v"(hi)); return r; }
typedef float f32x2 __attribute__((ext_vector_type(2)));
__device__ __forceinline__ f32x2 gelu_pk(f32x2 v) {
    const f32x2 av = __builtin_elementwise_abs(v), d = av * 0.2316418882f + 1.0f;
    f32x2 t; t.x = __builtin_amdgcn_rcpf(d.x); t.y = __builtin_amdgcn_rcpf(d.y);
    f32x2 q = t * 0.5307027145f + (-0.7265760135f); q = q * t + 0.7107068705f; q = q * t + (-0.142248368f); q = q * t + 0.127414796f; q = q * t;
    const f32x2 s = (v * v) * (-0.72134752044f);
    f32x2 e; e.x = __builtin_amdgcn_exp2f(s.x); e.y = __builtin_amdgcn_exp2f(s.y);
    const f32x2 m = v * (q * e), r = v - m;
    f32x2 o; o.x = v.x < 0.f ? m.x : r.x; o.y = v.y < 0.f ? m.y : r.y; return o;
}

template <int ACT  > struct EpiBf16 {
    static constexpr bool PERM = true, AFTER_DRAIN = false; static constexpr int MID_T = 0; static_assert(ACT == 0 || ACT == 1, "EpiBf16: ACT is 0 (none) or 1 (gelu_pk)");
    bf16_t* O; int ldc; const float* bias; int split_cols; size_t split_stride; float scale0;
    __device__ __forceinline__ void operator()(const f32x4 (&acc)[2][2][4][2], const Unit& u, int wr, int wc, int fr, int fq) const {
        const int row0 = u.pm * BM + wr * 64 + fr; int colt = u.pn * BM; bf16_t* base = O;
        float sc = 1.f; if (split_cols) { const int t = colt / split_cols; base += (size_t)t * split_stride; colt -= t * split_cols; if (t == 0) sc = scale0; }
        const int col0 = colt + wc * 32 + 8 * fq, bcol0 = u.pn * BM + wc * 32 + 8 * fq;
        f32x4 bv[2][2];
#pragma unroll
        for (int bj = 0; bj < 2; ++bj)
#pragma unroll
            for (int n = 0; n < 2; ++n) bv[bj][n] = bias ? *(const f32x4*)(bias + bcol0 + bj * HALF + 4 * n) : (f32x4){0.f, 0.f, 0.f, 0.f};
#pragma unroll
        for (int ai = 0; ai < 2; ++ai)
#pragma unroll
            for (int m = 0; m < 4; ++m) { bf16_t* rowp = base + (size_t)(row0 + ai * HALF + m * 16) * ldc + col0;
#pragma unroll
                for (int bj = 0; bj < 2; ++bj) { f32x4 v0 = acc[ai][bj][m][0] + bv[bj][0], v1 = acc[ai][bj][m][1] + bv[bj][1];
                    if (ACT == 1) { f32x2 a = gelu_pk((f32x2){v0[0], v0[1]}), b = gelu_pk((f32x2){v0[2], v0[3]}), c = gelu_pk((f32x2){v1[0], v1[1]}), d = gelu_pk((f32x2){v1[2], v1[3]});
                        v0 = (f32x4){a.x, a.y, b.x, b.y}; v1 = (f32x4){c.x, c.y, d.x, d.y}; }
                    v0 = v0 * sc; v1 = v1 * sc; u32x4 w; w.x = cvt_pk_bf16(v0[0], v0[1]); w.y = cvt_pk_bf16(v0[2], v0[3]); w.z = cvt_pk_bf16(v1[0], v1[1]); w.w = cvt_pk_bf16(v1[2], v1[3]);
                    *(u32x4*)(rowp + bj * HALF) = w; } }
    }
};
__device__ __forceinline__ float bf_lo(unsigned w) { return __uint_as_float(w << 16); }
__device__ __forceinline__ float bf_hi(unsigned w) { return __uint_as_float(w & 0xffff0000u); }
__device__ __forceinline__ float sigmf(float x) { return __builtin_amdgcn_rcpf(1.0f + __expf(-x)); }

template <int MIDT> struct EpiGate2 {
    static constexpr bool PERM = true, AFTER_DRAIN = false; static constexpr int MID_T = MIDT;
    bf16_t* O; int ldc; const unsigned char* Ga; const unsigned char* Gb; size_t gblk;
    __device__ __forceinline__ void mid(f32x4 (&acc)[2][2][4][2], const Unit& u, int wr, int wc, int fr, int fq) const {
        int row0 = u.pm * BM + wr * 64 + fr, col0 = wc * 32 + 8 * fq;
        asm volatile("" : "+v"(row0), "+v"(col0));
        const unsigned char* Gat = Ga + (size_t)u.pn * gblk; const unsigned char* Gbt = Gb + (size_t)u.pn * gblk;
        typedef int i32x2 __attribute__((ext_vector_type(2))); typedef float f32x2_ __attribute__((ext_vector_type(2)));
#pragma unroll
        for (int ai = 0; ai < 2; ++ai)
#pragma unroll
            for (int m = 0; m < 4; ++m) { const size_t row = (size_t)(row0 + ai * HALF + m * 16);
#pragma unroll
                for (int bj = 0; bj < 2; ++bj) { const int col = col0 + bj * HALF;
                    const i32x2 a = *(const i32x2*)(Gat + row * 256 + col), b = *(const i32x2*)(Gbt + row * 256 + col);
#define RAT_(x, y) ((1.0f + __expf(-(y))) * __builtin_amdgcn_rcpf(1.0f + __expf(-(x))))
                    const f32x2_ a0 = __builtin_amdgcn_cvt_pk_f32_fp8(a.x, false), a1 = __builtin_amdgcn_cvt_pk_f32_fp8(a.x, true), a2 = __builtin_amdgcn_cvt_pk_f32_fp8(a.y, false), a3 = __builtin_amdgcn_cvt_pk_f32_fp8(a.y, true);
                    const f32x2_ b0 = __builtin_amdgcn_cvt_pk_f32_fp8(b.x, false), b1 = __builtin_amdgcn_cvt_pk_f32_fp8(b.x, true), b2 = __builtin_amdgcn_cvt_pk_f32_fp8(b.y, false), b3 = __builtin_amdgcn_cvt_pk_f32_fp8(b.y, true);
                    f32x4 v0 = acc[ai][bj][m][0], v1 = acc[ai][bj][m][1];
                    v0[0] *= RAT_(a0.x, b0.x); v0[1] *= RAT_(a0.y, b0.y); v0[2] *= RAT_(a1.x, b1.x); v0[3] *= RAT_(a1.y, b1.y);
                    v1[0] *= RAT_(a2.x, b2.x); v1[1] *= RAT_(a2.y, b2.y); v1[2] *= RAT_(a3.x, b3.x); v1[3] *= RAT_(a3.y, b3.y);
#undef RAT_
                    acc[ai][bj][m][0] = v0; acc[ai][bj][m][1] = v1; }
                asm volatile("" ::: "memory"); }
    }
    __device__ __forceinline__ void operator()(const f32x4 (&acc)[2][2][4][2], const Unit& u, int wr, int wc, int fr, int fq) const {
        const int row0 = u.pm * BM + wr * 64 + fr, col0 = u.pn * BM + wc * 32 + 8 * fq;
#pragma unroll
        for (int ai = 0; ai < 2; ++ai)
#pragma unroll
            for (int m = 0; m < 4; ++m) { const size_t row = (size_t)(row0 + ai * HALF + m * 16);
#pragma unroll
                for (int bj = 0; bj < 2; ++bj) { const int col = col0 + bj * HALF;
                    typedef int i32x2 __attribute__((ext_vector_type(2))); typedef float f32x2_ __attribute__((ext_vector_type(2)));
                    const i32x2 g = *(const i32x2*)(Gb + (size_t)u.pn * gblk + row * 256 + (col - u.pn * BM));
                    const f32x2_ g0 = __builtin_amdgcn_cvt_pk_f32_fp8(g.x, false), g1 = __builtin_amdgcn_cvt_pk_f32_fp8(g.x, true), g2 = __builtin_amdgcn_cvt_pk_f32_fp8(g.y, false), g3 = __builtin_amdgcn_cvt_pk_f32_fp8(g.y, true);
                    f32x4 v0 = acc[ai][bj][m][0], v1 = acc[ai][bj][m][1];
                    v0[0] *= sigmf(g0.x); v0[1] *= sigmf(g0.y); v0[2] *= sigmf(g1.x); v0[3] *= sigmf(g1.y);
                    v1[0] *= sigmf(g2.x); v1[1] *= sigmf(g2.y); v1[2] *= sigmf(g3.x); v1[3] *= sigmf(g3.y);
                    u32x4 w; w.x = cvt_pk_bf16(v0[0], v0[1]); w.y = cvt_pk_bf16(v0[2], v0[3]); w.z = cvt_pk_bf16(v1[0], v1[1]); w.w = cvt_pk_bf16(v1[2], v1[3]);
                    *(u32x4*)(O + row * ldc + col) = w; } }
    }
};
struct EpiResid {
    static constexpr bool PERM = false, AFTER_DRAIN = false; static constexpr int MID_T = 0;
    float* O; const float* base; int ldc; const float* gvec; int gstride; int tiles_per_b;
    __device__ __forceinline__ void operator()(const f32x4 (&acc)[2][2][4][2], const Unit& u, int wr, int wc, int fr, int fq) const {
        const int row0 = u.pm * BM + wr * 64 + fr, col0 = u.pn * BM + wc * 32 + 4 * fq;
        const float* gv = gvec + (size_t)(u.pm / tiles_per_b) * gstride;
#pragma unroll
        for (int bj = 0; bj < 2; ++bj)
#pragma unroll
            for (int n = 0; n < 2; ++n) { const int col = col0 + bj * HALF + n * 16; const f32x4 gt = *(const f32x4*)(gv + col);
#pragma unroll
                for (int ai = 0; ai < 2; ++ai)
#pragma unroll
                    for (int m = 0; m < 4; ++m) { const size_t off = (size_t)(row0 + ai * HALF + m * 16) * ldc + col;
                        const f32x4 b = *(const f32x4*)(base + off); *(f32x4*)(O + off) = b + gt * acc[ai][bj][m][n]; } }
    }
};
struct EpiSwiglu {
    static constexpr bool PERM = true, AFTER_DRAIN = false; static constexpr int MID_T = 0;
    bf16_t* O; int lda; const float* bias; int nN;
    __device__ __forceinline__ int act4(const f32x4& v0, const f32x4& v1) const {
        f32x4 G = (f32x4){v0[0], v0[2], v1[0], v1[2]}, L = (f32x4){v0[1], v0[3], v1[1], v1[3]};
        G = __builtin_elementwise_min(G, (f32x4){7.f, 7.f, 7.f, 7.f});
        L = __builtin_elementwise_min(__builtin_elementwise_max(L, (f32x4){-7.f, -7.f, -7.f, -7.f}), (f32x4){7.f, 7.f, 7.f, 7.f}) + 1.0f;
        const f32x4 X = G * (-1.702f * 1.4426950408889634f);
        f32x4 S; S[0] = __builtin_amdgcn_exp2f(X[0]); S[1] = __builtin_amdgcn_exp2f(X[1]); S[2] = __builtin_amdgcn_exp2f(X[2]); S[3] = __builtin_amdgcn_exp2f(X[3]);
        S = S + 1.0f; S[0] = __builtin_amdgcn_rcpf(S[0]); S[1] = __builtin_amdgcn_rcpf(S[1]); S[2] = __builtin_amdgcn_rcpf(S[2]); S[3] = __builtin_amdgcn_rcpf(S[3]);
        const f32x4 A4 = G * S * L;
        int w8 = 0; w8 = __builtin_amdgcn_cvt_pk_fp8_f32(A4[0], A4[1], w8, false); w8 = __builtin_amdgcn_cvt_pk_fp8_f32(A4[2], A4[3], w8, true); return w8;
    }
    __device__ __forceinline__ void operator()(const f32x4 (&acc)[2][2][4][2], const Unit& u, int wr, int wc, int fr, int fq) const {
        const int row0 = u.po * BM + wr * 64 + fr; const int pnl = u.pn % nN;
        const int bcol0 = u.pn * BM + wc * 32 + 8 * fq; const bool odd = (fq & 1) != 0;
        const int bytecol = (pnl * BM + wc * 32 + 8 * (fq & ~1)) / 2 + (odd ? 64 : 0);
        f32x4 bv[2][2];
#pragma unroll
        for (int bj = 0; bj < 2; ++bj)
#pragma unroll
            for (int n = 0; n < 2; ++n) bv[bj][n] = *(const f32x4*)(bias + bcol0 + bj * HALF + 4 * n);
        typedef int i32x2 __attribute__((ext_vector_type(2)));
#pragma unroll
        for (int ai = 0; ai < 2; ++ai)
#pragma unroll
            for (int m = 0; m < 4; ++m) {
                const int wA = act4(acc[ai][0][m][0] + bv[0][0], acc[ai][0][m][1] + bv[0][1]), wB = act4(acc[ai][1][m][0] + bv[1][0], acc[ai][1][m][1] + bv[1][1]);
                const int recv = __shfl_xor(odd ? wA : wB, 16);
                *(i32x2*)((unsigned char*)O + (size_t)(row0 + ai * HALF + m * 16) * lda + bytecol) = odd ? (i32x2){recv, wB} : (i32x2){wA, recv}; }
    }
};
struct EpiFp8Blk {
    static constexpr bool PERM = true, AFTER_DRAIN = false; static constexpr int MID_T = 0;
    unsigned char* O; size_t blk;
    __device__ __forceinline__ void operator()(const f32x4 (&acc)[2][2][4][2], const Unit& u, int wr, int wc, int fr, int fq) const {
        const bool odd = (fq & 1) != 0;
        const int row0 = u.pm * BM + wr * 64 + fr, col0 = wc * 32 + 8 * (fq & ~1) + (odd ? HALF : 0); unsigned char* base = O + (size_t)u.pn * blk;
#pragma unroll
        for (int ai = 0; ai < 2; ++ai)
#pragma unroll
            for (int m = 0; m < 4; ++m) { unsigned char* rowp = base + (size_t)(row0 + ai * HALF + m * 16) * 256 + col0; int w[2][2];
#pragma unroll
                for (int bj = 0; bj < 2; ++bj) { const f32x4 v0 = acc[ai][bj][m][0], v1 = acc[ai][bj][m][1]; int w0 = 0, w1 = 0;
                    w0 = __builtin_amdgcn_cvt_pk_fp8_f32(v0[0], v0[1], w0, false); w0 = __builtin_amdgcn_cvt_pk_fp8_f32(v0[2], v0[3], w0, true);
                    w1 = __builtin_amdgcn_cvt_pk_fp8_f32(v1[0], v1[1], w1, false); w1 = __builtin_amdgcn_cvt_pk_fp8_f32(v1[2], v1[3], w1, true); w[bj][0] = w0; w[bj][1] = w1; }
                const int r0 = __shfl_xor(odd ? w[0][0] : w[1][0], 16), r1 = __shfl_xor(odd ? w[0][1] : w[1][1], 16);
                *(u32x4*)rowp = odd ? (u32x4){(unsigned)r0, (unsigned)r1, (unsigned)w[1][0], (unsigned)w[1][1]} : (u32x4){(unsigned)w[0][0], (unsigned)w[0][1], (unsigned)r0, (unsigned)r1}; }
    }
};
struct EpiFp8Row {
    static constexpr bool PERM = true, AFTER_DRAIN = false; static constexpr int MID_T = 0;
    unsigned char* O; int ldc; const float* bias; int nN;
    __device__ __forceinline__ void operator()(const f32x4 (&acc)[2][2][4][2], const Unit& u, int wr, int wc, int fr, int fq) const {
        const bool odd = (fq & 1) != 0;
        const int row0 = u.po * BM + wr * 64 + fr, col0 = (u.pn % nN) * BM + wc * 32 + 8 * (fq & ~1) + (odd ? HALF : 0), bcol0 = u.pn * BM + wc * 32 + 8 * fq;
        f32x4 bv[2][2];
#pragma unroll
        for (int bj = 0; bj < 2; ++bj)
#pragma unroll
            for (int n = 0; n < 2; ++n) bv[bj][n] = *(const f32x4*)(bias + bcol0 + bj * HALF + 4 * n);
#pragma unroll
        for (int ai = 0; ai < 2; ++ai)
#pragma unroll
            for (int m = 0; m < 4; ++m) { unsigned char* rowp = O + (size_t)(row0 + ai * HALF + m * 16) * ldc + col0; int w[2][2];
#pragma unroll
                for (int bj = 0; bj < 2; ++bj) { const f32x4 v0 = acc[ai][bj][m][0] + bv[bj][0], v1 = acc[ai][bj][m][1] + bv[bj][1]; int w0 = 0, w1 = 0;
                    w0 = __builtin_amdgcn_cvt_pk_fp8_f32(v0[0], v0[1], w0, false); w0 = __builtin_amdgcn_cvt_pk_fp8_f32(v0[2], v0[3], w0, true);
                    w1 = __builtin_amdgcn_cvt_pk_fp8_f32(v1[0], v1[1], w1, false); w1 = __builtin_amdgcn_cvt_pk_fp8_f32(v1[2], v1[3], w1, true); w[bj][0] = w0; w[bj][1] = w1; }
                const int r0 = __shfl_xor(odd ? w[0][0] : w[1][0], 16), r1 = __shfl_xor(odd ? w[0][1] : w[1][1], 16);
                *(u32x4*)rowp = odd ? (u32x4){(unsigned)r0, (unsigned)r1, (unsigned)w[1][0], (unsigned)w[1][1]} : (u32x4){(unsigned)w[0][0], (unsigned)w[0][1], (unsigned)r0, (unsigned)r1}; }
    }
};
struct MoeOrder {
    int ntiles, nN, G, c; const PG8_LAS int* tpm; const PG8_LAS int* te;
    __device__ bool next(int i, Unit& u) const {
        const long L = (long)i * G + c; if (L >= (long)ntiles * nN) return false;
        const int t = (int)(L / nN), pnl = (int)(L % nN);
        u.pm = __builtin_amdgcn_readfirstlane(tpm[t]); u.po = t; u.pn = __builtin_amdgcn_readfirstlane(te[t]) * nN + pnl; return true;
    }
    __device__ __forceinline__ void a_ready(const Unit&) const {}
    __device__ __forceinline__ void done(const Unit&) const {}
};

struct SplitOrder : StaticOrder {
    int nx, ny;
    __device__ bool next(int i, Unit& u) const {
        const int half = G >> 1, grp = (c >> 3) & 1, ci = ((c >> 4) << 3) | (c & 7);
        long L; if (grp == 0) { if (i >= nx) return false; L = (long)i * half + ci; } else { if (i >= ny) return false; L = (long)nx * half + (long)i * half + ci; }
        if (L >= nwg) return false;
        int wgid = (int)L; { const int q = nwg / NXCD, r = nwg % NXCD, xcd = wgid % NXCD, off = wgid / NXCD; wgid = (xcd < r ? xcd * (q + 1) : r * (q + 1) + (xcd - r) * q) + off; }
        const int nig = WGM * nN, gid = wgid / nig, fm = gid * WGM, gsz = (nM - fm) < WGM ? (nM - fm) : WGM;
        u.pm = fm + ((wgid % nig) % gsz); u.pn = (wgid % nig) / gsz; u.po = u.pm; return true;
    }
};
typedef int v4i_ __attribute__((ext_vector_type(4))); typedef int v8i_ __attribute__((ext_vector_type(8)));
template <bool F8> struct FragT { bf16x8 h[2]; __device__ __forceinline__ void set(int k, bf16x8 v) { h[k] = v; } };
template <> struct FragT<true> { v8i_ w; __device__ __forceinline__ void set(int k, bf16x8 v) { if (k == 0) w.lo = __builtin_bit_cast(v4i_, v); else w.hi = __builtin_bit_cast(v4i_, v); } };
template <class Epi, class Sched, bool ALIGN_EPI = false, bool SP2 = false, bool F8 = false>
__device__ __forceinline__ void gemm_phase(PG8_LAS unsigned char* lds, const Gemm g, const Sched& S, const Epi& E) {
    const int tid = threadIdx.x, wid = __builtin_amdgcn_readfirstlane(tid >> 6), lane = tid & 63, wr = wid >> 2, wc = wid & 3, fr = lane & 15, fq = lane >> 4;
    const int K = g.K, nt = K / BK;
    unsigned voffA[2], voffB[2];
#pragma unroll
    for (int i = 0; i < 2; ++i) { int R, C; stage_rc(tid * 16 + i * 8192, R, C); const int Rb = Epi::PERM ? ((R & ~31) + perm32(R & 31)) : R;
        voffA[i] = (unsigned)(R * K + C) * 2u; voffB[i] = (unsigned)(Rb * K + C) * 2u; }
    const size_t kstep = (size_t)(BK * 2);
    const size_t hstep = (size_t)HALF * K * 2;
    const size_t tstep = 2 * hstep;
    const unsigned ldsw = (unsigned)wid * 1024u;
    const int aoff = lds_byte(wr * 64 + fr, fq * 8), boff = lds_byte(wc * 32 + fr, fq * 8);
#define PG8_SA(b, h) (((b) * 2 + (h)) * HTB)
#define PG8_SB(b, h) ((4 + (b) * 2 + (h)) * HTB)
#define PG8_STAGE(bufoff, gbase, voff) do { _Pragma("unroll") for (int _i = 0; _i < 2; ++_i) \
        __builtin_amdgcn_global_load_lds((const unsigned*)((const char*)(gbase) + (voff)[_i]), (PG8_LAS unsigned*)(lds + (bufoff) + ldsw + _i * 8192), 16, 0, 0); } while (0)
#define PG8_LDA(dst, b, h) do { _Pragma("unroll") for (int m = 0; m < 4; ++m) _Pragma("unroll") for (int k = 0; k < 2; ++k) dst[m].set(k, *(const PG8_LAS bf16x8*)(lds + PG8_SA(b, h) + aoff + m * 2048 + k * 1024)); } while (0)
#define PG8_LDB(dst, b, h) do { _Pragma("unroll") for (int n = 0; n < 2; ++n) _Pragma("unroll") for (int k = 0; k < 2; ++k) dst[n].set(k, *(const PG8_LAS bf16x8*)(lds + PG8_SB(b, h) + boff + n * 2048 + k * 1024)); } while (0)
#define PG8_MMA(ai, bj, At, Bt) do { __builtin_amdgcn_s_setprio(1); _Pragma("unroll") for (int m = 0; m < 4; ++m) _Pragma("unroll") for (int n = 0; n < 2; ++n) { \
        if constexpr (F8) { asm volatile("v_mfma_scale_f32_16x16x128_f8f6f4 %0, %1, %2, %0, %3, %4 op_sel_hi:[0,0,0]" : "+v"(acc[ai][bj][m][n]) : "v"(Bt[n].w), "v"(At[m].w), "v"(sc_w), "v"(sc_x)); \
        } else { _Pragma("unroll") for (int k = 0; k < 2; ++k) \
        acc[ai][bj][m][n] = __builtin_amdgcn_mfma_f32_16x16x32_bf16(Bt[n].h[k], At[m].h[k], acc[ai][bj][m][n], 0, 0, 0); } } __builtin_amdgcn_s_setprio(0); } while (0)
#define PG8_WAIT_V(n) asm volatile("s_waitcnt vmcnt(" #n ")" ::: "memory")
#define PG8_WAIT_L(n) asm volatile("s_waitcnt lgkmcnt(" #n ")" ::: "memory")
#define PG8_BAR __builtin_amdgcn_s_barrier()
#define PG8_SCHED __builtin_amdgcn_sched_barrier(0)
    Unit cur, nxt; int ui = 0;
    if (!S.next(0, cur)) return;
    f32x4 acc[2][2][4][2];
#pragma unroll
    for (int a = 0; a < 2; ++a)
#pragma unroll
        for (int b = 0; b < 2; ++b)
#pragma unroll
            for (int m = 0; m < 4; ++m)
#pragma unroll
                for (int n = 0; n < 2; ++n) acc[a][b][m][n] = (f32x4){0.f, 0.f, 0.f, 0.f};
    FragT<F8> At[4], B0[2], B1[2];
    int sc_w = 0x7a7a7a7a, sc_x = 0x7f7f7f7f;
    if constexpr (F8) { asm volatile("" : "+v"(sc_w), "+v"(sc_x)); }
    const char* cA = (const char*)g.A + (size_t)cur.pm * tstep; const char* cB = (const char*)g.Bt + (size_t)cur.pn * tstep;
    S.a_ready(cur);
    if constexpr (SP2) {
        PG8_STAGE(PG8_SB(0, 0), cB, voffB); PG8_STAGE(PG8_SB(0, 1), cB + hstep, voffB); PG8_STAGE(PG8_SA(0, 0), cA, voffA); PG8_STAGE(PG8_SA(0, 1), cA + hstep, voffA);
        if (wr == 1) PG8_BAR;
        PG8_WAIT_V(2); PG8_BAR;
        PG8_STAGE(PG8_SB(1, 0), cB + kstep, voffB); PG8_STAGE(PG8_SA(1, 0), cA + kstep, voffA); PG8_STAGE(PG8_SB(1, 1), cB + hstep + kstep, voffB);
        PG8_WAIT_V(6); PG8_BAR;
    } else {
        PG8_STAGE(PG8_SB(0, 0), cB, voffB); PG8_STAGE(PG8_SA(0, 0), cA, voffA); PG8_STAGE(PG8_SB(0, 1), cB + hstep, voffB); PG8_STAGE(PG8_SA(0, 1), cA + hstep, voffA);
        if (wr == 1) PG8_BAR;
        PG8_WAIT_V(4); PG8_BAR;
        PG8_STAGE(PG8_SB(1, 0), cB + kstep, voffB); PG8_STAGE(PG8_SA(1, 0), cA + kstep, voffA); PG8_STAGE(PG8_SB(1, 1), cB + hstep + kstep, voffB);
        PG8_WAIT_V(6); PG8_BAR;
    }
    for (;;) {
        const bool has_next = S.next(ui + 1, nxt);
        const char* nA = has_next ? (const char*)g.A + (size_t)nxt.pm * tstep : cA; const char* nB = has_next ? (const char*)g.Bt + (size_t)nxt.pn * tstep : cB;
        for (int t = 0; t < nt; t += 2) {
            if constexpr (Epi::MID_T > 0) { if (t == Epi::MID_T) { if constexpr (F8) asm volatile("s_nop 15\n\ts_nop 3" ::: "memory"); E.mid(acc, cur, wr, wc, fr, fq); if constexpr (F8) asm volatile("s_nop 7" ::: "memory"); } }
            const bool last = (t == nt - 2);
            const char* a1 = cA + (size_t)(t + 1) * kstep;
            const char* a2 = last ? nA : cA + (size_t)(t + 2) * kstep; const char* b2 = last ? nB : cB + (size_t)(t + 2) * kstep;
            const char* a3 = a2 + kstep; const char* b3 = b2 + kstep;
            if (last && has_next) S.a_ready(nxt);
            if constexpr (SP2) {
            PG8_LDB(B0, 0, 0); PG8_LDB(B1, 0, 1); PG8_SCHED; PG8_LDA(At, 0, 0); PG8_STAGE(PG8_SA(1, 1), a1 + hstep, voffA);
            PG8_WAIT_V(8); PG8_WAIT_L(0); PG8_BAR; PG8_MMA(0, 0, At, B0); PG8_MMA(0, 1, At, B1); PG8_BAR; PG8_SCHED;
            PG8_LDA(At, 0, 1); PG8_STAGE(PG8_SB(0, 0), b2, voffB); PG8_STAGE(PG8_SB(0, 1), b2 + hstep, voffB); PG8_STAGE(PG8_SA(0, 0), a2, voffA);
            PG8_WAIT_V(8); PG8_WAIT_L(0); PG8_BAR; PG8_MMA(1, 0, At, B0); PG8_MMA(1, 1, At, B1); PG8_BAR; PG8_SCHED;
            PG8_LDB(B0, 1, 0); PG8_LDB(B1, 1, 1); PG8_SCHED; PG8_LDA(At, 1, 0); PG8_STAGE(PG8_SA(0, 1), a2 + hstep, voffA);
            PG8_WAIT_V(8); PG8_WAIT_L(0); PG8_BAR; PG8_MMA(0, 0, At, B0); PG8_MMA(0, 1, At, B1); PG8_BAR; PG8_SCHED;
            PG8_LDA(At, 1, 1); PG8_STAGE(PG8_SB(1, 0), b3, voffB); PG8_STAGE(PG8_SB(1, 1), b3 + hstep, voffB); PG8_STAGE(PG8_SA(1, 0), a3, voffA);
            PG8_WAIT_V(8); PG8_WAIT_L(0); PG8_BAR; PG8_MMA(1, 0, At, B0); PG8_MMA(1, 1, At, B1); PG8_BAR; PG8_SCHED;
            } else {
            PG8_LDB(B0, 0, 0); PG8_SCHED; PG8_LDA(At, 0, 0); PG8_STAGE(PG8_SA(1, 1), a1 + hstep, voffA);
            PG8_WAIT_L(8); PG8_BAR; PG8_WAIT_L(0); PG8_MMA(0, 0, At, B0); PG8_BAR; PG8_SCHED;
            PG8_LDB(B1, 0, 1); PG8_STAGE(PG8_SB(0, 0), b2, voffB);
            PG8_BAR; PG8_WAIT_L(0); PG8_MMA(0, 1, At, B1); PG8_BAR;
            PG8_LDA(At, 0, 1); PG8_STAGE(PG8_SA(0, 0), a2, voffA);
            PG8_BAR; PG8_WAIT_L(0); PG8_MMA(1, 0, At, B0); PG8_BAR; PG8_SCHED;
            PG8_STAGE(PG8_SB(0, 1), b2 + hstep, voffB);
            PG8_WAIT_V(6); PG8_BAR; PG8_MMA(1, 1, At, B1); PG8_BAR;
            PG8_LDB(B0, 1, 0); PG8_SCHED; PG8_LDA(At, 1, 0); PG8_STAGE(PG8_SA(0, 1), a2 + hstep, voffA);
            PG8_WAIT_L(8); PG8_BAR; PG8_WAIT_L(0); PG8_MMA(0, 0, At, B0); PG8_BAR; PG8_SCHED;
            PG8_LDB(B1, 1, 1); PG8_STAGE(PG8_SB(1, 0), b3, voffB);
            PG8_BAR; PG8_WAIT_L(0); PG8_MMA(0, 1, At, B1); PG8_BAR;
            PG8_LDA(At, 1, 1); PG8_STAGE(PG8_SA(1, 0), a3, voffA);
            PG8_BAR; PG8_WAIT_L(0); PG8_MMA(1, 0, At, B0); PG8_BAR; PG8_SCHED;
            PG8_STAGE(PG8_SB(1, 1), b3 + hstep, voffB);
            PG8_WAIT_V(6); PG8_BAR; PG8_MMA(1, 1, At, B1); PG8_BAR;
            }
        }
        if constexpr (F8) { asm volatile("s_nop 15\n\ts_nop 3" ::: "memory"); }
        if constexpr (ALIGN_EPI) { if (wr == 0) PG8_BAR; }
        if constexpr (!Epi::AFTER_DRAIN) { E(acc, cur, wr, wc, fr, fq); S.done(cur); }
        if (!has_next) break;
#pragma unroll
        for (int a = 0; a < 2; ++a)
#pragma unroll
            for (int b = 0; b < 2; ++b)
#pragma unroll
                for (int m = 0; m < 4; ++m)
#pragma unroll
                    for (int n = 0; n < 2; ++n) acc[a][b][m][n] = (f32x4){0.f, 0.f, 0.f, 0.f};
        cur = nxt; cA = nA; cB = nB; ++ui;
        if constexpr (ALIGN_EPI) { if (wr == 1) PG8_BAR; }
    }
    PG8_WAIT_V(0);
    if constexpr (!ALIGN_EPI) { if (wr == 0) PG8_BAR; }
    PG8_BAR;
    if constexpr (Epi::AFTER_DRAIN) { E.fused(acc, cur, wr, wc, fr, fq, lds, wid, lane); S.done(cur); }
#undef PG8_SA
#undef PG8_SB
#undef PG8_STAGE
#undef PG8_LDA
#undef PG8_LDB
#undef PG8_MMA
#undef PG8_WAIT_V
#undef PG8_WAIT_L
#undef PG8_BAR
#undef PG8_SCHED
}
}
#define GAS __attribute__((address_space(1)))
#define LAS __attribute__((address_space(3)))
typedef unsigned short bf16;
typedef unsigned v4u __attribute__((ext_vector_type(4)));
typedef float f32x4 __attribute__((ext_vector_type(4)));
typedef short bf16x8 __attribute__((ext_vector_type(8)));
typedef GAS unsigned gu32;
typedef GAS unsigned long long gu64;
#define RLX_AGENT __ATOMIC_RELAXED, __HIP_MEMORY_SCOPE_AGENT
#define LDS_WAIT() asm volatile("s_waitcnt lgkmcnt(0)" ::: "memory")
#define VM_WAIT() asm volatile("s_waitcnt vmcnt(0)" ::: "memory")
__device__ __forceinline__ unsigned long long rt() { return __builtin_amdgcn_s_memrealtime(); }
__device__ __forceinline__ unsigned f2bf(float f) { unsigned u = __builtin_bit_cast(unsigned, f); return (u + 0x7fffu + ((u >> 16) & 1u)) >> 16; }
__device__ __forceinline__ unsigned pk2(float lo, float hi) { return f2bf(lo) | (f2bf(hi) << 16); }

#define XB_TMO      128
#define XB_XCNT(j)  (256  + 64 * (j))
#define XB_XSUB(j)  (1280 + 64 * (j))
#define XB_XGEN(j)  (2304 + 64 * (j))
#define XB_TOP      3328
#define XB_TOPGEN   3392
#define XCD_BAR_WORDS 3456
#define XB_SPIN_CAP (1u << 18)

__device__ __forceinline__ unsigned xb_ld(unsigned* p)              { return __hip_atomic_load(p, __ATOMIC_RELAXED, __HIP_MEMORY_SCOPE_AGENT); }
__device__ __forceinline__ unsigned xb_add(unsigned* p, unsigned v) { return __hip_atomic_fetch_add(p, v, __ATOMIC_RELAXED, __HIP_MEMORY_SCOPE_AGENT); }
__device__ __forceinline__ unsigned xb_xcc_id() { return (unsigned)__builtin_amdgcn_s_getreg((3 << 11) | 20) & 0xFu; }
#define XB_SPIN(cond, bar) do { unsigned _sp = 0; while (cond) { __builtin_amdgcn_s_sleep(1); \
    if ((++_sp & 255u) == 0u) { if (xb_ld(&(bar)[XB_TMO])) break; if (_sp > XB_SPIN_CAP) { atomicAdd(&(bar)[XB_TMO], 1u); break; } } } } while (0)

struct XcdBarrier {
    unsigned* bar; unsigned x;
    volatile LAS unsigned* st;
};

__device__ __forceinline__ XcdBarrier xcd_barrier_post(unsigned* bar, volatile LAS unsigned* st) {
    XcdBarrier b; b.bar = bar; b.x = xb_xcc_id(); b.st = st;
    if (threadIdx.x == 0) (void)xb_add(&bar[XB_XCNT(b.x)], 1u);
    return b;
}
__device__ __forceinline__ void xcd_barrier_complete(unsigned* bar, unsigned x, unsigned& nloc, unsigned& nx) {
    const unsigned G = gridDim.x * gridDim.y * gridDim.z;
    unsigned sum, cnt, mine, sp = 0u;
    for (;;) {
        sum = 0u; cnt = 0u; mine = 0u;
#pragma unroll
        for (unsigned j = 0; j < 16; ++j) { const unsigned c = xb_ld(&bar[XB_XCNT(j)]); sum += c; cnt += (c > 0u) ? 1u : 0u; mine = (j == x) ? c : mine; }
        if (sum == G) break;
        __builtin_amdgcn_s_sleep(1);
        if ((++sp & 255u) == 0u) { if (xb_ld(&bar[XB_TMO])) break; if (sp > XB_SPIN_CAP) { atomicAdd(&bar[XB_TMO], 1u); break; } }
    }
    nloc = mine > 0u ? mine : 1u; nx = cnt > 0u ? cnt : 1u;
}

__device__ __forceinline__ void xcd_barrier(const XcdBarrier& b) {
    asm volatile("s_waitcnt vmcnt(0)" ::: "memory");
    __syncthreads();
    if (threadIdx.x == 0) {
        unsigned* bar = b.bar;
        __builtin_amdgcn_s_waitcnt(0);
        unsigned nloc = b.st[0], nx = b.st[1];
        if (nloc == 0u) { xcd_barrier_complete(bar, b.x, nloc, nx); b.st[0] = nloc; b.st[1] = nx; }
        const unsigned old = xb_add(&bar[XB_XSUB(b.x)], 1u);
        const unsigned gen = old / nloc;
        if (old + 1u == (gen + 1u) * nloc) {
            __builtin_amdgcn_fence(__ATOMIC_RELEASE, "agent");
            asm volatile("s_waitcnt vmcnt(0)" ::: "memory");
            const unsigned og = xb_add(&bar[XB_TOP], 1u);
            const unsigned tg = og / nx;
            if (og + 1u == (tg + 1u) * nx) xb_add(&bar[XB_TOPGEN], 1u);
            else XB_SPIN(xb_ld(&bar[XB_TOPGEN]) == tg, bar);
            __builtin_amdgcn_fence(__ATOMIC_ACQUIRE, "agent");
            xb_add(&bar[XB_XGEN(b.x)], 1u);
            asm volatile("s_waitcnt vmcnt(0)" ::: "memory");
        } else {
            XB_SPIN(xb_ld(&bar[XB_XGEN(b.x)]) == gen, bar);
            __builtin_amdgcn_fence(__ATOMIC_ACQUIRE, "agent");
            asm volatile("s_waitcnt vmcnt(0)" ::: "memory");
        }
    }
    __syncthreads();
}

constexpr int NWAVES = 8, NTHR = 512;
constexpr int BATCH = 4, SEQ = 4096, DM = 1024, TOK = BATCH * SEQ;
constexpr int INW = 9728;
constexpr int C_RQ = 0, C_RK = 512, C_RV = 1024, C_RG = 2048, C_AQ = 3072, C_AK = 4608, C_AV = 6144, C_GA = 7680, C_GB = 8704;
constexpr int NEXP = 32, FF = 1024, FF2 = 2048;
constexpr int MAXROWS = TOK * 4 + NEXP * 256;
constexpr float RMS_EPS = 1e-6f, GN_EPS = 1e-5f;
constexpr size_t MiB = 1u << 20;
constexpr size_t WS_CTL = 0, CTL_ZERO_BYTES = 32 * 1024;
constexpr size_t WS_ROPE = 1 * MiB;
constexpr size_t WS_WRT = 3 * MiB;
constexpr int N16 = 3072;
constexpr size_t WS_WIN8 = 12 * MiB;
constexpr size_t WS_WIN = 4 * MiB, WS_WRET = 24 * MiB  , WS_WO = 27 * MiB;
constexpr size_t WS_W1 = 32 * MiB, WS_W2 = 160 * MiB;
constexpr size_t WS_H8 = 208 * MiB;
constexpr size_t WS_H = 224 * MiB;
constexpr size_t WS_U = 256 * MiB;
constexpr size_t WS_KV = 560 * MiB;
constexpr size_t WS_RT = 624 * MiB;
constexpr size_t WS_RET = 656 * MiB;
constexpr int RA_LD = 1536;
constexpr size_t WS_OG = 704 * MiB;
constexpr size_t WS_LSE = 752 * MiB;
constexpr size_t WS_MERGED = 753 * MiB;
constexpr size_t WS_XMID = 849 * MiB;
constexpr size_t WS_XIN = 256 * MiB;
constexpr int XCAP = 16384;
constexpr size_t WS_A = 768 * MiB;
constexpr size_t WS_YB = 913 * MiB;
constexpr size_t WS_TE = 1000 * MiB, WS_TP = WS_TE + 256 * 1024, WS_TG = WS_TP + 256 * 1024;
constexpr size_t WS_END = 1002 * MiB;
static_assert(WS_XIN + (size_t)NEXP * XCAP * 1024 <= WS_A && WS_A + (size_t)MAXROWS * 1024 <= WS_XMID && WS_XMID + (size_t)TOK * DM * 4 <= WS_YB && WS_YB + (size_t)MAXROWS * 1024 <= WS_TE, "MoE map");
constexpr int CW_BAR = 4096;
constexpr int CW_MOD = 8192;
constexpr int CW_CNT = 7680;
constexpr int CW_MODRDY = 7744;
static_assert(CW_BAR + 3456 <= CW_CNT && (CW_MODRDY + 64) * 4 <= (int)CTL_ZERO_BYTES && CW_MODRDY + 64 <= CW_MOD, "ctl");
constexpr int LDS_BYTES = 160 * 1024 - 512, MISC_OFF = LDS_BYTES - 256;

__device__ __forceinline__ float bflo(unsigned w) { return __uint_as_float(w << 16); }
__device__ __forceinline__ float bfhi(unsigned w) { return __uint_as_float(w & 0xffff0000u); }
typedef float f32x2_t_ __attribute__((ext_vector_type(2))); typedef __bf16 bf16x2_t_ __attribute__((ext_vector_type(2)));
__device__ __forceinline__ unsigned cvtpk(float lo, float hi) { const f32x2_t_ v = {lo, hi}; const bf16x2_t_ b = __builtin_convertvector(v, bf16x2_t_); return __builtin_bit_cast(unsigned, b); }
__device__ __forceinline__ unsigned f8x2bf(unsigned w, bool hi) { typedef float f32x2_ __attribute__((ext_vector_type(2))); const f32x2_ f = hi ? __builtin_amdgcn_cvt_pk_f32_fp8((int)w, true) : __builtin_amdgcn_cvt_pk_f32_fp8((int)w, false); return cvtpk(f.x, f.y); }
__device__ __forceinline__ float wave_sum(float v) {
#pragma unroll
    for (int o = 1; o < 64; o <<= 1) v += __shfl_xor(v, o);
    return v;
}
static __device__ const double ROPE_C[64] = {0.15915494309189535, 0.13782250260398285, 0.11934937021124886, 0.10335229661843406, 0.089499401608891013, 0.077503288755374058, 0.067115083005227255, 0.058119267441876246, 0.050329212104487035, 0.04358330210530733, 0.037741584717419771, 0.032682865872356998, 0.028302195830623399, 0.024508691862069852, 0.02122365276477766, 0.018378926105679667, 0.015915494309189534, 0.013782250260398284, 0.011934937021124886, 0.010335229661843406, 0.0089499401608891024, 0.0077503288755374055, 0.0067115083005227253, 0.0058119267441876241, 0.0050329212104487037, 0.0043583302105307331, 0.0037741584717419772, 0.0032682865872356993, 0.0028302195830623399, 0.0024508691862069852, 0.0021223652764777662, 0.0018378926105679667, 0.0015915494309189536, 0.0013782250260398288, 0.0011934937021124885, 0.0010335229661843405, 0.00089499401608891024, 0.00077503288755374051, 0.0006711508300522726, 0.00058119267441876239, 0.00050329212104487033, 0.00043583302105307329, 0.00037741584717419774, 0.00032682865872356992, 0.00028302195830623395, 0.00024508691862069854, 0.00021223652764777661, 0.00018378926105679666, 0.00015915494309189535, 0.00013782250260398286, 0.00011934937021124886, 0.00010335229661843406, 8.9499401608891018e-05, 7.7503288755374056e-05, 6.7115083005227254e-05, 5.8119267441876239e-05, 5.0329212104487035e-05, 4.3583302105307322e-05, 3.7741584717419777e-05, 3.2682865872356999e-05, 2.8302195830623396e-05, 2.4508691862069852e-05, 2.1223652764777659e-05, 1.8378926105679668e-05};
__device__ __forceinline__ float log2g(int h) { return h == 0 ? -0.0458036896f : (h == 1 ? -0.0227200765f : (h == 2 ? -0.0113153132f : -0.00564656314f)); }

constexpr size_t UBLK = (size_t)TOK * 256; constexpr int ULD = 256;
__device__ __forceinline__ const bf16* ucol(const unsigned char* ws, int col) { return (const bf16*)(ws + WS_U) + (size_t)(col >> 8) * UBLK + (col & 255); }
__device__ __forceinline__ const unsigned char* ucol8(const unsigned char* ws, int col) { return ws + WS_U + (size_t)(N16 / 256) * UBLK * 2 + (size_t)((col >> 8) - N16 / 256) * UBLK + (col & 255); }
typedef short v4i16_t __attribute__((ext_vector_type(4)));
struct Args { const float* in[18]; float* out; unsigned char* ws; int ph_lo, ph_hi; };
struct Frame { LAS unsigned char* lds; volatile LAS unsigned* MISC; gu32* ctl; int tid, lane, wave, vcu, G; };

template <bool F8, int NB = 32>
__device__ __forceinline__ void p0_transpose_item(const float* W, int K, int N, bf16* WT, LAS float* scr, int item, int lane, int ldk = 0) {
    if (ldk == 0) ldk = K;
    const int nblk = N / 32, kb = item / nblk, nb = item % nblk, k0 = 64 * kb, n0 = 32 * nb;
#pragma unroll
    for (int hb = 0; hb < 32 / NB; ++hb) { float t[NB];
      const float* wp = W + (size_t)(k0 + 2 * NB * hb + (lane >> 5)) * N + n0 + (lane & 31);
#pragma unroll
      for (int i = 0; i < NB; ++i) t[i] = __builtin_nontemporal_load(wp + (size_t)(2 * i) * N);
#pragma unroll
      for (int i = 0; i < NB; ++i) scr[(2 * (NB * hb + i) + (lane >> 5)) * 33 + (lane & 31)] = t[i]; }
    LDS_WAIT(); asm volatile("" ::: "memory");
    const int c = lane & 7;
#pragma unroll
    for (int j = 0; j < 4; ++j) { const int n = (lane >> 3) + 8 * j; const LAS float* s = scr + (8 * c) * 33 + n;
        if (F8) { int w0 = 0, w1 = 0;
            w0 = __builtin_amdgcn_cvt_pk_fp8_f32(s[0 * 33] * 32.f, s[1 * 33] * 32.f, w0, false); w0 = __builtin_amdgcn_cvt_pk_fp8_f32(s[2 * 33] * 32.f, s[3 * 33] * 32.f, w0, true);
            w1 = __builtin_amdgcn_cvt_pk_fp8_f32(s[4 * 33] * 32.f, s[5 * 33] * 32.f, w1, false); w1 = __builtin_amdgcn_cvt_pk_fp8_f32(s[6 * 33] * 32.f, s[7 * 33] * 32.f, w1, true);
            typedef int i32x2 __attribute__((ext_vector_type(2)));
            *(GAS i32x2*)((unsigned char*)WT + (size_t)(n0 + n) * ldk + k0 + 8 * c) = (i32x2){w0, w1};
        } else { v4u o; o.x = pk2(s[0 * 33], s[1 * 33]); o.y = pk2(s[2 * 33], s[3 * 33]); o.z = pk2(s[4 * 33], s[5 * 33]); o.w = pk2(s[6 * 33], s[7 * 33]);
            *(GAS v4u*)(WT + (size_t)(n0 + n) * ldk + k0 + 8 * c) = o; } }
    LDS_WAIT(); asm volatile("" ::: "memory");
}
__device__ __forceinline__ void p0_prologue(const Args& a, Frame& F) {
    const int gw = F.vcu * NWAVES + F.wave, NGW = F.G * NWAVES;
    { float2* rope = (float2*)(a.ws + WS_ROPE);
      for (int idx = F.vcu * NTHR + F.tid; idx < SEQ * 64; idx += F.G * NTHR) { const int pos = idx >> 6, i = idx & 63;
          double rev = (double)pos * ROPE_C[i]; rev -= __builtin_floor(rev); const float f = (float)rev;
          rope[idx] = make_float2(__builtin_amdgcn_cosf(f), __builtin_amdgcn_sinf(f)); } }
    { bf16* wrt = (bf16*)(a.ws + WS_WRT); const float* wr = a.in[11];
      for (int idx = F.vcu * NTHR + F.tid; idx < 1024 * 32; idx += F.G * NTHR) { const int k = idx >> 5, e = idx & 31; const float w = wr[idx];
          const unsigned hi = f2bf(w); const float lo = w - __uint_as_float(hi << 16); wrt[e * 1024 + k] = (bf16)hi; wrt[32768 + e * 1024 + k] = (bf16)f2bf(lo); } }
    if (F.vcu < 96) { float* mod = (float*)(a.ws + WS_CTL) + CW_MOD; const float* c = a.in[1]; const float* w_ada = a.in[2]; const float* b_ada = a.in[3];
      const int cg = F.vcu, col = cg * 64 + F.lane; LAS float* red = (LAS float*)(F.lds + 8 * 16384);
      float acc[4] = {0.f, 0.f, 0.f, 0.f};
      for (int kc = 0; kc < 2; ++kc) { const int k0 = F.wave * 128 + kc * 64; float cs[4];
#pragma unroll
          for (int b = 0; b < 4; ++b) { const float cv = c[b * DM + k0 + F.lane]; cs[b] = cv / (1.0f + __expf(-cv)); }
#pragma unroll 16
          for (int kk = 0; kk < 64; ++kk) { const float w = w_ada[(size_t)(k0 + kk) * 6144 + col];
#pragma unroll
              for (int b = 0; b < 4; ++b) acc[b] += __shfl(cs[b], kk) * w; } }
#pragma unroll
      for (int b = 0; b < 4; ++b) red[(F.wave * 4 + b) * 64 + F.lane] = acc[b];
      __syncthreads();
      if (F.tid < 256) { const int b = F.tid >> 6, ln = F.tid & 63; float s = b_ada[cg * 64 + ln];
#pragma unroll
          for (int w = 0; w < 8; ++w) s += red[(w * 4 + b) * 64 + ln];
          mod[b * 6144 + cg * 64 + ln] = s; }
      asm volatile("s_waitcnt vmcnt(0)" ::: "memory"); __syncthreads();
      if (F.tid == 0) { __builtin_amdgcn_fence(__ATOMIC_RELEASE, "agent"); asm volatile("s_waitcnt vmcnt(0)" ::: "memory"); __hip_atomic_fetch_add(F.ctl + CW_MODRDY, 1u, RLX_AGENT); } }
    { LAS float* scr = (LAS float*)(F.lds + F.wave * 16384);
      constexpr int I_IN = 16 * (INW / 32), I_RET = 16 * 32, I_ATT = 8 * 32, I_O = 16 * 32, I_1E = 16 * 64, I_2E = 16 * 32;
      constexpr int NITEMS = I_IN + I_RET + I_ATT + I_O;
      if (F.vcu >= 96 || F.G <= 96)
      for (int it = (F.G > 96 ? gw - 96 * NWAVES : gw); it < NITEMS; it += (F.G > 96 ? NGW - 96 * NWAVES : NGW)) { int r = it;
          if (r < I_IN) { const int nb = r % (INW / 32);
              if (nb < N16 / 32) p0_transpose_item<false>(a.in[5], 1024, INW, (bf16*)(a.ws + WS_WIN), scr, r, F.lane);
              else p0_transpose_item<true>(a.in[5], 1024, INW, (bf16*)(a.ws + WS_WIN8 - (size_t)N16 * 1024), scr, r, F.lane);
              continue; } r -= I_IN;
          if (r < I_RET) { p0_transpose_item<true>(a.in[7], 1024, 1024, (bf16*)(a.ws + WS_WRET), scr, r, F.lane, RA_LD); continue; } r -= I_RET;
          if (r < I_ATT) { p0_transpose_item<true>(a.in[8], 512, 1024, (bf16*)(a.ws + WS_WRET + 1024), scr, r, F.lane, RA_LD); continue; } r -= I_ATT;
          p0_transpose_item<false>(a.in[9], 1024, 1024, (bf16*)(a.ws + WS_WO), scr, r, F.lane); } }
}
__device__ __forceinline__ void moe_item8(const float* W, int N, unsigned char* WT8, LAS bf16* scr, int item, int lane) {
    const int nblk = N / 32, kb = item / nblk, nb = item % nblk, k0 = 128 * kb, n0 = 32 * nb, rr = lane >> 3, cq = lane & 7;
    typedef unsigned u32x2 __attribute__((ext_vector_type(2)));
    f32x4 t[16];
    { const float* wp = W + (size_t)(k0 + rr) * N + n0 + 4 * cq;
#pragma unroll
      for (int i = 0; i < 16; ++i) t[i] = __builtin_nontemporal_load((const GAS f32x4*)(wp + (size_t)(8 * i) * N)); }
#pragma unroll
    for (int i = 0; i < 16; ++i) *(LAS u32x2*)(scr + (8 * i + rr) * 40 + 4 * cq) = (u32x2){cvtpk(t[i].x, t[i].y), cvtpk(t[i].z, t[i].w)};
    LDS_WAIT(); asm volatile("" ::: "memory");
    const int g = lane >> 4, i15 = lane & 15, qq = i15 >> 2, p = i15 & 3;
#pragma unroll
    for (int c0 = 0; c0 < 32; c0 += 16)
#pragma unroll
        for (int kh = 0; kh < 2; ++kh) { const LAS bf16* a0 = scr + (64 * kh + 16 * g + qq) * 40 + c0 + 4 * p; v4u o;
#pragma unroll
            for (int sb = 0; sb < 4; ++sb) { const v4i16_t v = __builtin_amdgcn_ds_read_tr16_b64_v4i16((LAS v4i16_t*)(a0 + 4 * sb * 40)); const u32x2 w2 = __builtin_bit_cast(u32x2, v);
                int w8 = 0; w8 = __builtin_amdgcn_cvt_pk_fp8_f32(bflo(w2.x) * 32.f, bfhi(w2.x) * 32.f, w8, false); w8 = __builtin_amdgcn_cvt_pk_fp8_f32(bflo(w2.y) * 32.f, bfhi(w2.y) * 32.f, w8, true);
                if (sb == 0) o.x = (unsigned)w8; else if (sb == 1) o.y = (unsigned)w8; else if (sb == 2) o.z = (unsigned)w8; else o.w = (unsigned)w8; }
            *(GAS v4u*)(WT8 + (size_t)(n0 + c0 + i15) * 1024 + k0 + 64 * kh + 16 * g) = o; }
    LDS_WAIT(); asm volatile("" ::: "memory");
}
__device__ __forceinline__ void moe_convert(const Args& a, Frame& F, int k0, int nk) {
    LAS bf16* scr = (LAS bf16*)(F.lds + F.wave * 16384); const int gw = F.vcu * NWAVES + F.wave, NGW = F.G * NWAVES;
    constexpr int I_1E = 8 * 64, I_2E = 8 * 32;
    for (int k = k0; k < k0 + nk; ++k) { int r = gw + NGW * k;
        if (r < NEXP * I_1E) { const int e = r / I_1E; moe_item8(a.in[13] + (size_t)e * 1024 * FF2, FF2, a.ws + WS_W1 + (size_t)e * FF2 * 1024, scr, r % I_1E, F.lane); continue; } r -= NEXP * I_1E;
        if (r < NEXP * I_2E) { const int e = r / I_2E; moe_item8(a.in[15] + (size_t)e * FF * 1024, 1024, a.ws + WS_W2 + (size_t)e * 1024 * FF, scr, r % I_2E, F.lane); } }
}
__device__ __forceinline__ void norm_mod_row(const float* xrow, const float* g, const float* sc, const float* sh, bf16* orow, unsigned char* orow8, int lane) {
    const GAS f32x4* xr = (const GAS f32x4*)xrow + lane; f32x4 v[4]; float s = 0.f;
#pragma unroll
    for (int j = 0; j < 4; ++j) { v[j] = __builtin_nontemporal_load(xr + 64 * j); s += (v[j].x * v[j].x + v[j].y * v[j].y) + (v[j].z * v[j].z + v[j].w * v[j].w); }
    const float rstd = 1.0f / sqrtf(wave_sum(s) * (1.0f / DM) + RMS_EPS);
    GAS int* o4 = (GAS int*)orow8 + lane; GAS unsigned long long* o8 = (GAS unsigned long long*)orow + lane;
#pragma unroll
    for (int j = 0; j < 4; ++j) { const int c = 4 * (64 * j + lane); const f32x4 gg = *(const f32x4*)(g + c), ss = *(const f32x4*)(sc + c), hh = *(const f32x4*)(sh + c);
        const f32x4 o = v[j] * rstd * gg * (ss + 1.0f) + hh;
        int w8 = 0; w8 = __builtin_amdgcn_cvt_pk_fp8_f32(o.x, o.y, w8, false); w8 = __builtin_amdgcn_cvt_pk_fp8_f32(o.z, o.w, w8, true);
        o4[64 * j] = w8; o8[64 * j] = (unsigned long long)cvtpk(o.x, o.y) | ((unsigned long long)cvtpk(o.z, o.w) << 32); }
}
__device__ __forceinline__ void p1_norm1(const Args& a, Frame& F) {
    const int gw = F.vcu * NWAVES + F.wave, NGW = F.G * NWAVES, lane = F.lane; const float* mod = (const float*)(a.ws + WS_CTL) + CW_MOD;
    bool waited = false;
    for (int m0 = gw; m0 < TOK; m0 += 4 * NGW) {
        f32x4 v[4][4]; float rstd[4];
#pragma unroll
        for (int r = 0; r < 4; ++r) { const int m = m0 + r * NGW; const GAS f32x4* xr = (const GAS f32x4*)(a.in[0] + (size_t)(m < TOK ? m : m0) * DM) + lane;
#pragma unroll
            for (int j = 0; j < 4; ++j) v[r][j] = __builtin_nontemporal_load(xr + 64 * j); }
#pragma unroll
        for (int r = 0; r < 4; ++r) { float s = 0.f;
#pragma unroll
            for (int j = 0; j < 4; ++j) s += (v[r][j].x * v[r][j].x + v[r][j].y * v[r][j].y) + (v[r][j].z * v[r][j].z + v[r][j].w * v[r][j].w);
            rstd[r] = 1.0f / sqrtf(wave_sum(s) * (1.0f / DM) + RMS_EPS); }
        if (!waited) { waited = true;
            if (F.tid == 0) { unsigned sp = 0;
                while (__hip_atomic_load(F.ctl + CW_MODRDY, RLX_AGENT) < 96u && ++sp < (1u << 22)) __builtin_amdgcn_s_sleep(2);
                __builtin_amdgcn_fence(__ATOMIC_ACQUIRE, "agent"); asm volatile("s_waitcnt vmcnt(0)" ::: "memory"); }
            __syncthreads(); }
#pragma unroll
        for (int r = 0; r < 4; ++r) { const int m = m0 + r * NGW; if (m < TOK) { const int b = m / SEQ; const float* g = a.in[4]; const float* sc = mod + b * 6144 + 1024; const float* sh = mod + b * 6144;
            GAS int* o4 = (GAS int*)(a.ws + WS_H8 + (size_t)m * DM) + lane; GAS unsigned long long* o8 = (GAS unsigned long long*)((bf16*)(a.ws + WS_H) + (size_t)m * DM) + lane;
#pragma unroll
            for (int j = 0; j < 4; ++j) { const int c = 4 * (64 * j + lane); const f32x4 gg = *(const f32x4*)(g + c), ss = *(const f32x4*)(sc + c), hh = *(const f32x4*)(sh + c);
                const f32x4 o = v[r][j] * rstd[r] * gg * (ss + 1.0f) + hh;
                int w8 = 0; w8 = __builtin_amdgcn_cvt_pk_fp8_f32(o.x, o.y, w8, false); w8 = __builtin_amdgcn_cvt_pk_fp8_f32(o.z, o.w, w8, true);
                o4[64 * j] = w8; o8[64 * j] = (unsigned long long)cvtpk(o.x, o.y) | ((unsigned long long)cvtpk(o.z, o.w) << 32); } } }
    }
    if (!waited) { __syncthreads(); }
}

#define MFMA16(a, b, c) __builtin_amdgcn_mfma_f32_16x16x32_bf16((a), (b), (c), 0, 0, 0)
__device__ __forceinline__ bf16x8 ldsfrag(const LAS bf16* base, int pitch, int row0, int k0, int lane) { return *(const LAS bf16x8*)(base + (row0 + (lane & 15)) * pitch + k0 + 8 * (lane >> 4)); }

__device__ __forceinline__ bf16x8 ldsfrag_tr(const LAS bf16* M, int pitch, int k0, int c0, int lane) {
    const int g = lane >> 4, i = lane & 15, qq = i >> 2, p = i & 3;
    const LAS bf16* a0 = M + (k0 + 8 * g + qq) * pitch + c0 + 4 * p;
    const v4i16_t lo = __builtin_amdgcn_ds_read_tr16_b64_v4i16((LAS v4i16_t*)a0), hi = __builtin_amdgcn_ds_read_tr16_b64_v4i16((LAS v4i16_t*)(a0 + 4 * pitch));
    return (bf16x8){lo[0], lo[1], lo[2], lo[3], hi[0], hi[1], hi[2], hi[3]};
}
constexpr int AT_KP = 136, AT_PP = 168;
constexpr int AT_KS = 0, AT_VS = 256 * AT_KP * 2, AT_BIAS = AT_VS + 272 * AT_KP * 2;
struct AttnU { const unsigned char *Qb, *Kb, *Vb; size_t rstride; int i0, r, g, hh; size_t tok0; };
__device__ __forceinline__ AttnU attn_decode(const Args& a, int U) {
    AttnU u; const int ub = U & 31; u.hh = (U >> 5) & 3; u.g = (U >> 7) % 3; const int b = U / 384;
    const int rs = 2 * u.g; u.r = 1 << rs; const int ares = ub & (u.r - 1), blk = ub >> rs; u.i0 = blk * 128;
    u.tok0 = (size_t)(b * SEQ + ares); u.rstride = (size_t)u.r * ULD; const int hc = (u.g * 4 + u.hh) * 128;
    u.Qb = ucol8(a.ws, C_AQ + hc) + u.tok0 * ULD; u.Kb = ucol8(a.ws, C_AK + hc) + u.tok0 * ULD; u.Vb = ucol8(a.ws, C_AV + hc) + u.tok0 * ULD;
    return u;
}
__device__ __forceinline__ void attn_phase(const Args& a, Frame& F) {
    LAS bf16* KS = (LAS bf16*)(F.lds + AT_KS); LAS bf16* VS = (LAS bf16*)(F.lds + AT_VS); LAS float* BIAS = (LAS float*)(F.lds + AT_BIAS);
    const int tid = F.tid, lane = F.lane, w = F.wave, q = lane >> 4, l15 = lane & 15;
    typedef unsigned u32x2 __attribute__((ext_vector_type(2)));
    int U = F.vcu; if (U >= 1536) return;
    v4u kreg[4], vreg[4];
    { const AttnU u = attn_decode(a, U);
#pragma unroll
      for (int it = 0; it < 4; ++it) { const int c = tid + NTHR * it, kk = c >> 3, ch = c & 7; int i = u.i0 - 128 + kk; i = i < 0 ? 0 : i;
          const size_t ro = (size_t)i * u.rstride + ch * 16; kreg[it] = *(const GAS v4u*)(u.Kb + ro); vreg[it] = *(const GAS v4u*)(u.Vb + ro); }
    }
    if (tid < 256) { LAS v4u* z = (LAS v4u*)(VS + (256 + (tid >> 4)) * AT_KP + (tid & 15) * 8); z[0] = (v4u){0u, 0u, 0u, 0u}; }
    const bool bg_pre = (F.vcu & 1) != 0; int slot = 0;
    for (; U < 1536; U += F.G, ++slot) {
        if (bg_pre) { moe_convert(a, F, 2 * slot, 2); __syncthreads(); }
        const AttnU u = attn_decode(a, U);
        bf16x8 qf[4];
        { const unsigned char* qrow = u.Qb + (size_t)(u.i0 + 16 * w + l15) * u.rstride + 8 * q; typedef unsigned u32x2q __attribute__((ext_vector_type(2)));
          u32x2q qb[4];
#pragma unroll
          for (int ks = 0; ks < 4; ++ks) qb[ks] = *(const GAS u32x2q*)(qrow + 32 * ks);
#pragma unroll
          for (int ks = 0; ks < 4; ++ks) qf[ks] = __builtin_bit_cast(bf16x8, (v4u){f8x2bf(qb[ks].x, false), f8x2bf(qb[ks].x, true), f8x2bf(qb[ks].y, false), f8x2bf(qb[ks].y, true)}); }
#pragma unroll
        for (int it = 0; it < 4; ++it) { const int c = tid + NTHR * it, kk = c >> 3, ch = c & 7; const bool ok = (u.i0 - 128 + kk) >= 0;
            const v4u kz = ok ? kreg[it] : (v4u){0u, 0u, 0u, 0u}, vz = ok ? vreg[it] : (v4u){0u, 0u, 0u, 0u};
            *(LAS v4u*)(KS + kk * AT_KP + ch * 16) = (v4u){f8x2bf(kz.x, false), f8x2bf(kz.x, true), f8x2bf(kz.y, false), f8x2bf(kz.y, true)};
            *(LAS v4u*)(KS + kk * AT_KP + ch * 16 + 8) = (v4u){f8x2bf(kz.z, false), f8x2bf(kz.z, true), f8x2bf(kz.w, false), f8x2bf(kz.w, true)};
            *(LAS v4u*)(VS + kk * AT_KP + ch * 16) = (v4u){f8x2bf(vz.x, false), f8x2bf(vz.x, true), f8x2bf(vz.y, false), f8x2bf(vz.y, true)};
            *(LAS v4u*)(VS + kk * AT_KP + ch * 16 + 8) = (v4u){f8x2bf(vz.z, false), f8x2bf(vz.z, true), f8x2bf(vz.w, false), f8x2bf(vz.w, true)}; }
        if (tid < 129) { const int dist = u.r * tid; int bk;
            if (dist < 16) bk = dist; else { bk = 16 + (int)(__log2f((float)dist * 0.0625f) * (16.0f / 7.0f)); bk = bk > 31 ? 31 : bk; }
            BIAS[tid] = a.in[6][bk * 12 + u.g * 4 + u.hh]; }
        __syncthreads();
        if (U + F.G < 1536) { const AttnU n = attn_decode(a, U + F.G);
#pragma unroll
            for (int it = 0; it < 4; ++it) { const int c = tid + NTHR * it, kk = c >> 3, ch = c & 7; int i = n.i0 - 128 + kk; i = i < 0 ? 0 : i;
                const size_t ro = (size_t)i * n.rstride + ch * 16; kreg[it] = *(const GAS v4u*)(n.Kb + ro); vreg[it] = *(const GAS v4u*)(n.Vb + ro); } }
        f32x4 s[9];
#pragma unroll
        for (int t9 = 0; t9 < 9; ++t9) { f32x4 acc = (f32x4){0.f, 0.f, 0.f, 0.f};
#pragma unroll
            for (int ks = 0; ks < 4; ++ks) acc = MFMA16(ldsfrag(KS, AT_KP, 16 * (w + t9), 32 * ks, lane), qf[ks], acc);
            s[t9] = acc; }
        const float scale = 0.08838834764831845f;
        float mx = -INFINITY;
#pragma unroll
        for (int t9 = 0; t9 < 9; ++t9)
#pragma unroll
            for (int rr = 0; rr < 4; ++rr) { const int krel = 16 * t9 + 4 * q + rr, dist = 128 + l15 - krel; const bool valid = (dist >= 0) && (dist <= 128) && (u.i0 - 128 + 16 * w + krel >= 0);
                const float v = valid ? s[t9][rr] * scale + BIAS[valid ? dist : 0] : -INFINITY; s[t9][rr] = v; mx = fmaxf(mx, v); }
        mx = fmaxf(mx, __shfl_xor(mx, 16)); mx = fmaxf(mx, __shfl_xor(mx, 32));
        float lsum = 0.f;
#pragma unroll
        for (int t9 = 0; t9 < 9; ++t9)
#pragma unroll
            for (int rr = 0; rr < 4; ++rr) { const float p = __expf(s[t9][rr] - mx); s[t9][rr] = p; lsum += p; }
        lsum += __shfl_xor(lsum, 16); lsum += __shfl_xor(lsum, 32);
        __syncthreads();
        LAS bf16* PS = KS + w * 16 * AT_PP;
#pragma unroll
        for (int t9 = 0; t9 < 9; ++t9) *(LAS u32x2*)(PS + l15 * AT_PP + 16 * t9 + 4 * q) = (u32x2){cvtpk(s[t9][0], s[t9][1]), cvtpk(s[t9][2], s[t9][3])};
        *(LAS u32x2*)(PS + l15 * AT_PP + 144 + 4 * q) = (u32x2){0u, 0u};
        __syncthreads();
        bf16x8 pf[5];
#pragma unroll
        for (int ks = 0; ks < 5; ++ks) pf[ks] = ldsfrag(PS, AT_PP, 0, 32 * ks, lane);
        const float inv = 1.0f / lsum;
        const size_t tokrow = u.tok0 + (size_t)(u.i0 + 16 * w + l15) * u.r;
        bf16* og = (bf16*)(a.ws + WS_OG) + (size_t)u.g * TOK * 512 + tokrow * 512 + u.hh * 128 + 4 * q;
#pragma unroll
        for (int dp = 0; dp < 8; dp += 2) { u32x2 pc[2];
#pragma unroll
            for (int d2 = 0; d2 < 2; ++d2) { f32x4 acc = (f32x4){0.f, 0.f, 0.f, 0.f};
#pragma unroll
                for (int ks = 0; ks < 5; ++ks) acc = MFMA16(ldsfrag_tr(VS, AT_KP, 16 * w + 32 * ks, 16 * (dp + d2), lane), pf[ks], acc);
                pc[d2] = (u32x2){cvtpk(acc[0] * inv, acc[1] * inv), cvtpk(acc[2] * inv, acc[3] * inv)}; }
            const bool odd = (q & 1) != 0;
            const unsigned r0 = (unsigned)__shfl_xor((int)(odd ? pc[0].x : pc[1].x), 16), r1 = (unsigned)__shfl_xor((int)(odd ? pc[0].y : pc[1].y), 16);
            *(GAS v4u*)(og - 4 * (q & 1) + 16 * (dp + (odd ? 1 : 0))) = odd ? (v4u){r0, r1, pc[1].x, pc[1].y} : (v4u){pc[0].x, pc[0].y, r0, r1}; }
        if (q == 0) ((float*)(a.ws + WS_LSE))[(size_t)u.g * TOK * 4 + tokrow * 4 + u.hh] = mx + __logf(lsum);
        __syncthreads();
        if (!bg_pre) { moe_convert(a, F, 2 * slot, 2); __syncthreads(); }
    }
}

constexpr int RT_P = 136, RV_P = 264;
struct RotRegs { v4u lo[2], hi[2]; };
__device__ __forceinline__ void rot_issue(Frame& F, const bf16* src, RotRegs& r) {
#pragma unroll
    for (int it = 0; it < 2; ++it) { const int pc = F.tid + NTHR * it, j = pc >> 3, d0 = (pc & 7) * 8; r.lo[it] = *(const GAS v4u*)(src + (size_t)j * ULD + d0); r.hi[it] = *(const GAS v4u*)(src + (size_t)j * ULD + d0 + 64); }
}
__device__ __forceinline__ void rope_issue(const Args& a, Frame& F, int pos0, f32x4 (&cs)[2][4]) {
    const float* rope = (const float*)(a.ws + WS_ROPE);
#pragma unroll
    for (int it = 0; it < 2; ++it) { const int pc = F.tid + NTHR * it, j = pc >> 3, d0 = (pc & 7) * 8; const GAS f32x4* rp = (const GAS f32x4*)(rope + ((size_t)(pos0 + j) * 64 + d0) * 2);
#pragma unroll
        for (int i = 0; i < 4; ++i) cs[it][i] = rp[i]; }
}
template <bool ZETA>
__device__ __forceinline__ void rot_finish(Frame& F, const RotRegs& r, const f32x4 (&cs)[2][4], float mul, float l2g, LAS bf16* dst) {
#pragma unroll
    for (int it = 0; it < 2; ++it) { const int pc = F.tid + NTHR * it, j = pc >> 3, d0 = (pc & 7) * 8;
        const float m = ZETA ? mul * __builtin_amdgcn_exp2f((float)(127 - j) * l2g) : mul;
        float ol[8], oh[8];
#pragma unroll
        for (int i = 0; i < 8; ++i) { const unsigned wl = i < 2 ? r.lo[it].x : (i < 4 ? r.lo[it].y : (i < 6 ? r.lo[it].z : r.lo[it].w)), wh = i < 2 ? r.hi[it].x : (i < 4 ? r.hi[it].y : (i < 6 ? r.hi[it].z : r.hi[it].w));
            const float tl = (i & 1) ? bfhi(wl) : bflo(wl), th = (i & 1) ? bfhi(wh) : bflo(wh); const float c = (i & 1) ? cs[it][i >> 1].z : cs[it][i >> 1].x, sn = (i & 1) ? cs[it][i >> 1].w : cs[it][i >> 1].y;
            ol[i] = (tl * c - th * sn) * m; oh[i] = (tl * sn + th * c) * m; }
        *(LAS v4u*)(dst + j * RT_P + d0) = (v4u){cvtpk(ol[0], ol[1]), cvtpk(ol[2], ol[3]), cvtpk(ol[4], ol[5]), cvtpk(ol[6], ol[7])};
        *(LAS v4u*)(dst + j * RT_P + d0 + 64) = (v4u){cvtpk(oh[0], oh[1]), cvtpk(oh[2], oh[3]), cvtpk(oh[4], oh[5]), cvtpk(oh[6], oh[7])}; }
}
__device__ __forceinline__ void v_issue(Frame& F, const bf16* src, v4u (&t)[8]) {
#pragma unroll
    for (int it = 0; it < 8; ++it) { const int c = F.tid + NTHR * it, j = c >> 5, ch = c & 31; t[it] = *(const GAS v4u*)(src + (size_t)j * ULD + ch * 8); }
}
__device__ __forceinline__ void v_finish(Frame& F, const v4u (&t)[8], LAS bf16* VS) {
#pragma unroll
    for (int it = 0; it < 8; ++it) { const int c = F.tid + NTHR * it, j = c >> 5, ch = c & 31; *(LAS v4u*)(VS + j * RV_P + ch * 8) = t[it]; }
}
__device__ __forceinline__ void ret_kv_item(const Args& a, Frame& F, int item) {
    const int h = item & 3, n = (item >> 2) & 31, b = item >> 7; const float l2g = log2g(h);
    const size_t r0 = (size_t)(b * SEQ + n * 128) * ULD;
    LAS bf16* KZ = (LAS bf16*)F.lds; LAS bf16* VS = (LAS bf16*)(F.lds + 128 * RT_P * 2);
    { RotRegs kr; f32x4 cs[2][4]; v4u vt[8];
      rot_issue(F, ucol(a.ws, C_RK + h * 128) + r0, kr); rope_issue(a, F, n * 128, cs); v_issue(F, ucol(a.ws, C_RV + h * 256) + r0, vt);
      rot_finish<true>(F, kr, cs, 0.08838834764831845f, l2g, KZ); v_finish(F, vt, VS); }
    __syncthreads();
    const int lane = F.lane, w = F.wave, q = lane >> 4, l15 = lane & 15;
    f32x4 acc[2][8];
#pragma unroll
    for (int e2 = 0; e2 < 2; ++e2)
#pragma unroll
        for (int dt = 0; dt < 8; ++dt) acc[e2][dt] = (f32x4){0.f, 0.f, 0.f, 0.f};
#pragma unroll
    for (int ks = 0; ks < 4; ++ks) { const bf16x8 v0 = ldsfrag_tr(VS, RV_P, 32 * ks, 32 * w, lane), v1 = ldsfrag_tr(VS, RV_P, 32 * ks, 32 * w + 16, lane);
#pragma unroll
        for (int dt = 0; dt < 8; ++dt) { const bf16x8 kk = ldsfrag_tr(KZ, RT_P, 32 * ks, 16 * dt, lane); acc[0][dt] = MFMA16(kk, v0, acc[0][dt]); acc[1][dt] = MFMA16(kk, v1, acc[1][dt]); } }
    bf16* kv = (bf16*)(a.ws + WS_KV) + (size_t)item * 32768; typedef unsigned u32x2 __attribute__((ext_vector_type(2)));
#pragma unroll
    for (int e2 = 0; e2 < 2; ++e2)
#pragma unroll
        for (int dt = 0; dt < 8; ++dt) *(GAS u32x2*)(kv + (32 * w + 16 * e2 + l15) * 128 + 16 * dt + 4 * q) = (u32x2){cvtpk(acc[e2][dt][0], acc[e2][dt][1]), cvtpk(acc[e2][dt][2], acc[e2][dt][3])};
    __syncthreads();
}
__device__ __forceinline__ void p4_scan_merge(const Args& a, Frame& F) {
    const bf16* kv = (const bf16*)(a.ws + WS_KV); bf16* rt = (bf16*)(a.ws + WS_RT);
    for (int idx = F.vcu * NTHR + F.tid; idx < 16 * 8192; idx += F.G * NTHR) {
        const int bh = idx >> 13, el = (idx & 8191) * 4, b = bh >> 2, h = bh & 3; const float gch = exp2f(128.0f * log2g(h));
        f32x4 R = (f32x4){0.f, 0.f, 0.f, 0.f};
        for (int n0 = 0; n0 < 32; n0 += 8) { unsigned long long k8[8];
#pragma unroll
            for (int i = 0; i < 8; ++i) k8[i] = __builtin_nontemporal_load((const GAS unsigned long long*)(kv + (size_t)(((b * 32 + n0 + i) << 2) + h) * 32768 + el));
#pragma unroll
            for (int i = 0; i < 8; ++i) { const size_t off = (size_t)(((b * 32 + n0 + i) << 2) + h) * 32768 + el;
                *(GAS unsigned long long*)(rt + off) = (unsigned long long)cvtpk(R.x, R.y) | ((unsigned long long)cvtpk(R.z, R.w) << 32);
                const unsigned lo = (unsigned)k8[i], hi = (unsigned)(k8[i] >> 32); R = R * gch + (f32x4){bflo(lo), bfhi(lo), bflo(hi), bfhi(hi)}; } } }
    const int gw = F.vcu * NWAVES + F.wave, NGW = F.G * NWAVES;
    const bf16* og = (const bf16*)(a.ws + WS_OG); const float* lse = (const float*)(a.ws + WS_LSE); bf16* att = (bf16*)(a.ws + WS_RET) + 1024;
    for (int t0 = gw; t0 < TOK; t0 += 4 * NGW) { const int hh = F.lane >> 4;
        v4u x0[4], x1[4], x2[4]; float l0[4], l1[4], l2[4];
#pragma unroll
        for (int u = 0; u < 4; ++u) { const int t = (t0 + u * NGW) < TOK ? t0 + u * NGW : t0; const size_t o = (size_t)t * 512 + F.lane * 8;
            l0[u] = lse[(size_t)t * 4 + hh]; l1[u] = lse[(size_t)TOK * 4 + (size_t)t * 4 + hh]; l2[u] = lse[(size_t)2 * TOK * 4 + (size_t)t * 4 + hh];
            x0[u] = *(const GAS v4u*)(og + o); x1[u] = *(const GAS v4u*)(og + (size_t)TOK * 512 + o); x2[u] = *(const GAS v4u*)(og + (size_t)2 * TOK * 512 + o); }
#pragma unroll
        for (int u = 0; u < 4; ++u) { const int t = t0 + u * NGW; if (t >= TOK) continue;
            const float m = fmaxf(l0[u], fmaxf(l1[u], l2[u])); float a0 = __expf(l0[u] - m), a1 = __expf(l1[u] - m), a2 = __expf(l2[u] - m); const float is = __builtin_amdgcn_rcpf(a0 + a1 + a2); a0 *= is; a1 *= is; a2 *= is;
            v4u r;
            r.x = cvtpk(a0 * bflo(x0[u].x) + a1 * bflo(x1[u].x) + a2 * bflo(x2[u].x), a0 * bfhi(x0[u].x) + a1 * bfhi(x1[u].x) + a2 * bfhi(x2[u].x));
            r.y = cvtpk(a0 * bflo(x0[u].y) + a1 * bflo(x1[u].y) + a2 * bflo(x2[u].y), a0 * bfhi(x0[u].y) + a1 * bfhi(x1[u].y) + a2 * bfhi(x2[u].y));
            r.z = cvtpk(a0 * bflo(x0[u].z) + a1 * bflo(x1[u].z) + a2 * bflo(x2[u].z), a0 * bfhi(x0[u].z) + a1 * bfhi(x1[u].z) + a2 * bfhi(x2[u].z));
            r.w = cvtpk(a0 * bflo(x0[u].w) + a1 * bflo(x1[u].w) + a2 * bflo(x2[u].w), a0 * bfhi(x0[u].w) + a1 * bfhi(x1[u].w) + a2 * bfhi(x2[u].w));
            typedef int i32x2 __attribute__((ext_vector_type(2))); int w0 = 0, w1 = 0;
            w0 = __builtin_amdgcn_cvt_pk_fp8_f32(bflo(r.x), bfhi(r.x), w0, false); w0 = __builtin_amdgcn_cvt_pk_fp8_f32(bflo(r.y), bfhi(r.y), w0, true);
            w1 = __builtin_amdgcn_cvt_pk_fp8_f32(bflo(r.z), bfhi(r.z), w1, false); w1 = __builtin_amdgcn_cvt_pk_fp8_f32(bflo(r.w), bfhi(r.w), w1, true);
            *(GAS i32x2*)(a.ws + WS_RET + (size_t)t * RA_LD + 1024 + F.lane * 8) = (i32x2){w0, w1}; } }
}
__device__ __forceinline__ void ret_out_item(const Args& a, Frame& F, int item) {
    const int h = item & 3, n = (item >> 2) & 31, b = item >> 7; const float l2g = log2g(h);
    const size_t r0 = (size_t)(b * SEQ + n * 128) * ULD;
    LAS bf16* QS = (LAS bf16*)F.lds; LAS bf16* KS = (LAS bf16*)(F.lds + 128 * RT_P * 2); LAS bf16* VS = (LAS bf16*)(F.lds + 2 * 128 * RT_P * 2);
    LAS float* RED = (LAS float*)(F.lds + 2 * 128 * RT_P * 2 + 128 * RV_P * 2);
    { RotRegs qr, kr; f32x4 cs[2][4]; v4u vt[8];
      rot_issue(F, ucol(a.ws, C_RQ + h * 128) + r0, qr); rot_issue(F, ucol(a.ws, C_RK + h * 128) + r0, kr); rope_issue(a, F, n * 128, cs); v_issue(F, ucol(a.ws, C_RV + h * 256) + r0, vt);
      rot_finish<false>(F, qr, cs, 1.0f, l2g, QS); rot_finish<false>(F, kr, cs, 0.08838834764831845f, l2g, KS); v_finish(F, vt, VS); }
    __syncthreads();
    const int lane = F.lane, w = F.wave, q = lane >> 4, l15 = lane & 15;
    typedef unsigned u32x2 __attribute__((ext_vector_type(2)));
    u32x2 pw[8];
    bf16x8 rf0[4], rf1[4];
    { const bf16* rtg = (const bf16*)(a.ws + WS_RT) + (size_t)item * 32768 + (size_t)(32 * w + l15) * 128 + 8 * q;
#pragma unroll
      for (int ks = 0; ks < 4; ++ks) { rf0[ks] = *(const GAS bf16x8*)(rtg + 32 * ks); rf1[ks] = *(const GAS bf16x8*)(rtg + 16 * 128 + 32 * ks); } }
    { bf16x8 qf[4];
#pragma unroll
      for (int ks = 0; ks < 4; ++ks) qf[ks] = ldsfrag(QS, RT_P, 16 * w, 32 * ks, lane);
#pragma unroll
      for (int jt = 0; jt < 8; ++jt) { f32x4 acc = (f32x4){0.f, 0.f, 0.f, 0.f};
          if (jt <= w) {
#pragma unroll
              for (int ks = 0; ks < 4; ++ks) acc = MFMA16(ldsfrag(KS, RT_P, 16 * jt, 32 * ks, lane), qf[ks], acc); }
          float p[4];
#pragma unroll
          for (int rr = 0; rr < 4; ++rr) { const int j = 16 * jt + 4 * q + rr, i = 16 * w + l15; p[rr] = (j <= i) ? acc[rr] * __builtin_amdgcn_exp2f(-(float)(j + 1) * l2g) : 0.f; }
          pw[jt] = (u32x2){cvtpk(p[0], p[1]), cvtpk(p[2], p[3])}; } }
    __syncthreads();
#pragma unroll
    for (int jt = 0; jt < 8; ++jt) *(LAS u32x2*)(KS + (16 * w + l15) * RT_P + 16 * jt + 4 * q) = pw[jt];
    __syncthreads();
    f32x4 acc[2][8];
#pragma unroll
    for (int e2 = 0; e2 < 2; ++e2)
#pragma unroll
        for (int it = 0; it < 8; ++it) acc[e2][it] = (f32x4){0.f, 0.f, 0.f, 0.f};
#pragma unroll
    for (int ks = 0; ks < 4; ++ks) { const bf16x8 a0 = ldsfrag_tr(VS, RV_P, 32 * ks, 32 * w, lane), a1 = ldsfrag_tr(VS, RV_P, 32 * ks, 32 * w + 16, lane);
#pragma unroll
        for (int it = 2 * ks; it < 8; ++it) { const bf16x8 pf = ldsfrag(KS, RT_P, 16 * it, 32 * ks, lane); acc[0][it] = MFMA16(a0, pf, acc[0][it]); acc[1][it] = MFMA16(a1, pf, acc[1][it]); } }
#pragma unroll
    for (int ks = 0; ks < 4; ++ks) {
#pragma unroll
        for (int it = 0; it < 8; ++it) { const bf16x8 qf = ldsfrag(QS, RT_P, 16 * it, 32 * ks, lane); acc[0][it] = MFMA16(rf0[ks], qf, acc[0][it]); acc[1][it] = MFMA16(rf1[ks], qf, acc[1][it]); } }
#pragma unroll
    for (int it = 0; it < 8; ++it) { const float xi = __builtin_amdgcn_exp2f((float)(16 * it + l15 + 1) * l2g); acc[0][it] = acc[0][it] * xi; acc[1][it] = acc[1][it] * xi;
        float s1 = (acc[0][it][0] + acc[0][it][1]) + (acc[0][it][2] + acc[0][it][3]) + (acc[1][it][0] + acc[1][it][1]) + (acc[1][it][2] + acc[1][it][3]);
        float s2 = (acc[0][it][0] * acc[0][it][0] + acc[0][it][1] * acc[0][it][1]) + (acc[0][it][2] * acc[0][it][2] + acc[0][it][3] * acc[0][it][3]) + (acc[1][it][0] * acc[1][it][0] + acc[1][it][1] * acc[1][it][1]) + (acc[1][it][2] * acc[1][it][2] + acc[1][it][3] * acc[1][it][3]);
        s1 += __shfl_xor(s1, 16); s1 += __shfl_xor(s1, 32); s2 += __shfl_xor(s2, 16); s2 += __shfl_xor(s2, 32);
        if (q == 0) *(LAS u32x2*)(RED + (16 * it + l15) * 16 + 2 * w) = (u32x2){__float_as_uint(s1), __float_as_uint(s2)}; }
    __syncthreads();
#pragma unroll
    for (int it = 0; it < 8; ++it) { const LAS f32x4* rp = (const LAS f32x4*)(RED + (16 * it + l15) * 16); const f32x4 r0 = rp[0], r1 = rp[1], r2 = rp[2], r3 = rp[3];
        const float s1 = (r0[0] + r0[2]) + (r1[0] + r1[2]) + (r2[0] + r2[2]) + (r3[0] + r3[2]), s2 = (r0[1] + r0[3]) + (r1[1] + r1[3]) + (r2[1] + r2[3]) + (r3[1] + r3[3]);
        const float mean = s1 * (1.0f / 256.0f), var = fmaxf(s2 * (1.0f / 256.0f) - mean * mean, 0.f), rstd = 1.0f / sqrtf(var + GN_EPS);
        const size_t tok = (size_t)(b * SEQ + n * 128 + 16 * it + l15);
        const bf16* gp = ucol(a.ws, C_RG + h * 256) + tok * ULD + 32 * w + 4 * q; unsigned char* op = a.ws + WS_RET + tok * RA_LD + h * 256 + 32 * w + 4 * q;
        int w8p[2];
#pragma unroll
        for (int e2 = 0; e2 < 2; ++e2) { const u32x2 gg = *(const GAS u32x2*)(gp + 16 * e2);
            const float g0 = bflo(gg.x), g1 = bfhi(gg.x), g2 = bflo(gg.y), g3 = bfhi(gg.y);
#define SILU_(x) ((x) * __builtin_amdgcn_rcpf(1.0f + __expf(-(x))))
            const float o0 = SILU_(g0) * (acc[e2][it][0] - mean) * rstd, o1 = SILU_(g1) * (acc[e2][it][1] - mean) * rstd, o2 = SILU_(g2) * (acc[e2][it][2] - mean) * rstd, o3 = SILU_(g3) * (acc[e2][it][3] - mean) * rstd;
#undef SILU_
            int w8 = 0; w8 = __builtin_amdgcn_cvt_pk_fp8_f32(o0, o1, w8, false); w8 = __builtin_amdgcn_cvt_pk_fp8_f32(o2, o3, w8, true); w8p[e2] = w8; }
        { const bool odd = (q & 1) != 0; const int recv = __shfl_xor(odd ? w8p[0] : w8p[1], 16);
          *(GAS u32x2*)(op - 4 * (q & 1) + (odd ? 16 : 0)) = odd ? (u32x2){(unsigned)recv, (unsigned)w8p[1]} : (u32x2){(unsigned)w8p[0], (unsigned)recv}; } }
    __syncthreads();
}

constexpr int P8_RSTD = 0, P8_LG = 1024, P8_CNT = P8_LG + 2 * 64 * 32 * 4, P8_LB = P8_CNT + 128, P8_LTE = P8_LB + 128, P8_LTP = P8_LTE + 1024, P8_H2 = P8_LTP + 1024;
__device__ __forceinline__ void p8_route(const Args& a, Frame& F) {
    LAS float* RSTD = (LAS float*)(F.lds + P8_RSTD); LAS float* LG = (LAS float*)(F.lds + P8_LG); LAS int* CNT = (LAS int*)(F.lds + P8_CNT);
    if (F.tid < 32) CNT[F.tid] = 0;
    const float* mod = (const float*)(a.ws + WS_CTL) + CW_MOD; const int lane = F.lane, w = F.wave, q = lane >> 4, l15 = lane & 15;
    const float* xm = (const float*)(a.ws + WS_XMID); LAS unsigned char* H2L = F.lds + P8_H2;
    LAS int* LB = (LAS int*)(F.lds + P8_LB); LAS int* LTE = (LAS int*)(F.lds + P8_LTE); LAS int* LTP = (LAS int*)(F.lds + P8_LTP);
    int* TE = (int*)(a.ws + WS_TE); int* TP = (int*)(a.ws + WS_TP); float* TG = (float*)(a.ws + WS_TG);
    const int t0 = F.vcu * 64, b = t0 / SEQ;
    const float* gf = a.in[10]; const float* scf = mod + b * 6144 + 4096; const float* shf = mod + b * 6144 + 3072;
#pragma unroll
    for (int hb = 0; hb < 2; ++hb) { f32x4 v[4][4];
#pragma unroll
        for (int ri = 0; ri < 4; ++ri) { const GAS f32x4* xr = (const GAS f32x4*)(xm + (size_t)(t0 + 8 * w + 4 * hb + ri) * DM) + lane;
#pragma unroll
            for (int j = 0; j < 4; ++j) v[ri][j] = xr[64 * j]; }
#pragma unroll
        for (int ri = 0; ri < 4; ++ri) { float s = 0.f;
#pragma unroll
            for (int j = 0; j < 4; ++j) s += (v[ri][j].x * v[ri][j].x + v[ri][j].y * v[ri][j].y) + (v[ri][j].z * v[ri][j].z + v[ri][j].w * v[ri][j].w);
            const float rstd = 1.0f / sqrtf(wave_sum(s) * (1.0f / DM) + RMS_EPS);
            if (lane == 0) RSTD[8 * w + 4 * hb + ri] = rstd;
            LAS int* o4 = (LAS int*)(H2L + (8 * w + 4 * hb + ri) * DM) + lane;
#pragma unroll
            for (int j = 0; j < 4; ++j) { const int c = 4 * (64 * j + lane); const f32x4 gg = *(const f32x4*)(gf + c), ss = *(const f32x4*)(scf + c), hh = *(const f32x4*)(shf + c);
                const f32x4 o = v[ri][j] * rstd * gg * (ss + 1.0f) + hh;
                int w8 = 0; w8 = __builtin_amdgcn_cvt_pk_fp8_f32(o.x, o.y, w8, false); w8 = __builtin_amdgcn_cvt_pk_fp8_f32(o.z, o.w, w8, true); o4[64 * j] = w8; } } }
    __syncthreads();
    { const int rt = w & 3, kh = w >> 2; const float rstd = RSTD[16 * rt + l15];
      const float* xrow = xm + (size_t)(t0 + 16 * rt + l15) * DM + 512 * kh + 8 * q;
      const bf16* wh = (const bf16*)(a.ws + WS_WRT) + (size_t)l15 * 1024 + 512 * kh + 8 * q; const bf16* wl = wh + 32768;
      f32x4 acc0 = (f32x4){0.f, 0.f, 0.f, 0.f}, acc1 = (f32x4){0.f, 0.f, 0.f, 0.f};
#pragma unroll 4
      for (int ks = 0; ks < 16; ++ks) { const int kc = 512 * kh + 32 * ks + 8 * q;
          const f32x4 x0 = *(const GAS f32x4*)(xrow + 32 * ks), x1 = *(const GAS f32x4*)(xrow + 32 * ks + 4);
          const f32x4 g0 = *(const f32x4*)(gf + kc), g1 = *(const f32x4*)(gf + kc + 4), s0 = *(const f32x4*)(scf + kc), s1 = *(const f32x4*)(scf + kc + 4), h0 = *(const f32x4*)(shf + kc), h1 = *(const f32x4*)(shf + kc + 4);
          const f32x4 o0 = x0 * rstd * g0 * (s0 + 1.0f) + h0, o1 = x1 * rstd * g1 * (s1 + 1.0f) + h1;
          v4u hi; hi.x = cvtpk(o0.x, o0.y); hi.y = cvtpk(o0.z, o0.w); hi.z = cvtpk(o1.x, o1.y); hi.w = cvtpk(o1.z, o1.w);
          v4u lo; lo.x = cvtpk(o0.x - bflo(hi.x), o0.y - bfhi(hi.x)); lo.y = cvtpk(o0.z - bflo(hi.y), o0.w - bfhi(hi.y)); lo.z = cvtpk(o1.x - bflo(hi.z), o1.y - bfhi(hi.z)); lo.w = cvtpk(o1.z - bflo(hi.w), o1.w - bfhi(hi.w));
          const bf16x8 ah = __builtin_bit_cast(bf16x8, hi), al = __builtin_bit_cast(bf16x8, lo);
          const bf16x8 wh0 = *(const GAS bf16x8*)(wh + 32 * ks), wh1 = *(const GAS bf16x8*)(wh + 16 * 1024 + 32 * ks), wl0 = *(const GAS bf16x8*)(wl + 32 * ks), wl1 = *(const GAS bf16x8*)(wl + 16 * 1024 + 32 * ks);
          acc0 = MFMA16(ah, wh0, acc0); acc0 = MFMA16(al, wh0, acc0); acc0 = MFMA16(ah, wl0, acc0);
          acc1 = MFMA16(ah, wh1, acc1); acc1 = MFMA16(al, wh1, acc1); acc1 = MFMA16(ah, wl1, acc1); }
#pragma unroll
      for (int rr = 0; rr < 4; ++rr) { LG[(kh * 64 + 16 * rt + 4 * q + rr) * 32 + l15] = acc0[rr]; LG[(kh * 64 + 16 * rt + 4 * q + rr) * 32 + 16 + l15] = acc1[rr]; } }
    __syncthreads();
    { const int e = lane & 31; const float br = a.in[12][e];
      for (int ri = 0; ri < 8; ++ri) { const int row = 8 * w + ri, t = t0 + row;
          float v = LG[row * 32 + e] + LG[(64 + row) * 32 + e] + br; float tv[4]; int ti[4];
#pragma unroll
          for (int k = 0; k < 4; ++k) { float m = v;
#pragma unroll
              for (int o = 1; o < 32; o <<= 1) m = fmaxf(m, __shfl_xor(m, o));
              const unsigned long long bal = __ballot(v == m); const int idx = __ffsll((long long)(bal & 0xffffffffull)) - 1;
              tv[k] = m; ti[k] = idx; if (e == idx) v = -INFINITY; }
          const float e1 = __expf(tv[1] - tv[0]), e2 = __expf(tv[2] - tv[0]), e3 = __expf(tv[3] - tv[0]); const float is = 1.0f / (1.0f + e1 + e2 + e3);
          if (lane < 4) { const int k = lane; const int ek = k == 0 ? ti[0] : (k == 1 ? ti[1] : (k == 2 ? ti[2] : ti[3])); const float gk = (k == 0 ? 1.0f : (k == 1 ? e1 : (k == 2 ? e2 : e3))) * is;
              const int lp = __hip_atomic_fetch_add(&CNT[ek], 1, __ATOMIC_RELAXED, __HIP_MEMORY_SCOPE_WORKGROUP);
              LTE[row * 4 + k] = ek; LTP[row * 4 + k] = lp; TE[t * 4 + k] = ek; TG[t * 4 + k] = gk; } } }
    __syncthreads();
    if (F.tid < 32) { const int cnt = CNT[F.tid]; LB[F.tid] = (int)__hip_atomic_fetch_add(F.ctl + CW_CNT + F.tid, (unsigned)cnt, RLX_AGENT); }
    __syncthreads();
    for (int pi = 0; pi < 32; ++pi) { const int p = w * 32 + pi, row = p >> 2; const int ek = LTE[p], pos = LB[ek] + LTP[p];
        if (lane == 0) TP[(t0 + row) * 4 + (p & 3)] = pos;
        *((GAS v4u*)(a.ws + WS_XIN + ((size_t)ek * XCAP + pos) * DM) + lane) = *((const LAS v4u*)(H2L + row * DM) + lane); }
    __syncthreads();
}
constexpr int MT_CS = 131072, MT_PM = MT_CS + 128, MT_E = MT_PM + 1280, MT_NT = MT_E + 1280;
__device__ __forceinline__ int moe_tables(Frame& F, bool sparse_a) {
    LAS int* CS = (LAS int*)(F.lds + MT_CS); LAS int* TPM = (LAS int*)(F.lds + MT_PM); LAS int* TEX = (LAS int*)(F.lds + MT_E); LAS int* NT = (LAS int*)(F.lds + MT_NT);
    if (F.tid < 64) { const int e = F.tid & 31; const int cnt = (int)__hip_atomic_load(F.ctl + CW_CNT + e, RLX_AGENT), n = (cnt + 255) >> 8;
        int incl = n;
#pragma unroll
        for (int o = 1; o < 32; o <<= 1) { const int v = __shfl_up(incl, o, 32); if (e >= o) incl += v; }
        const int t = incl - n;
        if (F.tid < 32) { CS[e] = t << 8;
            for (int j = 0; j < n; ++j) { TPM[t + j] = sparse_a ? e * (XCAP / 256) + j : t + j; TEX[t + j] = e; }
            if (e == 31) NT[0] = incl; } }
    __syncthreads();
    return __builtin_amdgcn_readfirstlane(NT[0]);
}
__device__ __forceinline__ void p12_final(const Args& a, Frame& F, bool with_moe) {
    LAS int* CS = (LAS int*)(F.lds + MT_CS); if (with_moe) (void)moe_tables(F, false);
    const int gw = F.vcu * NWAVES + F.wave, NGW = F.G * NWAVES, lane = F.lane; const float* mod = (const float*)(a.ws + WS_CTL) + CW_MOD;
    const float* xm = (const float*)(a.ws + WS_XMID); const unsigned char* yb = a.ws + WS_YB; const int* TE = (const int*)(a.ws + WS_TE); const int* TP = (const int*)(a.ws + WS_TP); const float* TG = (const float*)(a.ws + WS_TG);
    for (int t = gw; t < TOK; t += NGW) { const int b = t / SEQ;
        f32x4 v[4], m4[4];
#pragma unroll
        for (int j = 0; j < 4; ++j) { v[j] = __builtin_nontemporal_load((const GAS f32x4*)(xm + (size_t)t * DM) + lane + 64 * j); m4[j] = (f32x4){0.f, 0.f, 0.f, 0.f}; }
        if (with_moe) {
#pragma unroll
            for (int k = 0; k < 4; ++k) { const int row = CS[TE[t * 4 + k]] + TP[t * 4 + k]; const float gk = TG[t * 4 + k]; const GAS int* yr = (const GAS int*)(yb + (size_t)row * DM) + lane;
#pragma unroll
                for (int j = 0; j < 4; ++j) { const int y4 = __builtin_nontemporal_load(yr + 64 * j); typedef float f32x2_ __attribute__((ext_vector_type(2)));
                    const f32x2_ lo = __builtin_amdgcn_cvt_pk_f32_fp8(y4, false), hi = __builtin_amdgcn_cvt_pk_f32_fp8(y4, true);
                    m4[j].x += gk * lo.x; m4[j].y += gk * lo.y; m4[j].z += gk * hi.x; m4[j].w += gk * hi.y; } }
        }
        float s = 0.f;
#pragma unroll
        for (int j = 0; j < 4; ++j) { const f32x4 gt = *(const f32x4*)(mod + b * 6144 + 5120 + 4 * (64 * j + lane)); v[j] = v[j] + gt * m4[j]; s += (v[j].x * v[j].x + v[j].y * v[j].y) + (v[j].z * v[j].z + v[j].w * v[j].w); }
        const float rstd = 1.0f / sqrtf(wave_sum(s) * (1.0f / DM) + RMS_EPS);
#pragma unroll
        for (int j = 0; j < 4; ++j) { const f32x4 gf = *(const f32x4*)(a.in[17] + 4 * (64 * j + lane)); __builtin_nontemporal_store(v[j] * rstd * gf, (GAS f32x4*)(a.out + (size_t)t * DM) + lane + 64 * j); } }
}

#ifndef ABL_NOMIX
#define ABL_NOMIX 0
#endif
#ifndef ABL_NOMOE
#define ABL_NOMOE 0
#endif
#ifndef ONE_LAUNCH
#define ONE_LAUNCH 1
#endif
constexpr int NPHASE = 13;
__global__ void __launch_bounds__(NTHR, 2) mk_fwd(Args args) {
    extern __shared__ __attribute__((aligned(16))) unsigned char lds[];
    Frame F;
    F.lds = (LAS unsigned char*)lds; F.MISC = (volatile LAS unsigned*)(F.lds + MISC_OFF);
    F.tid = threadIdx.x; F.lane = F.tid & 63; F.wave = __builtin_amdgcn_readfirstlane(F.tid >> 6);
    F.G = gridDim.x; { const int bx = blockIdx.x; F.vcu = (F.G % 8 == 0) ? (bx % 8) * (F.G / 8) + bx / 8 : bx; }
    unsigned char* ws = args.ws; F.ctl = (gu32*)(ws + WS_CTL);
    if (F.tid < 64) F.MISC[F.tid] = 0u;
    __syncthreads();
    XcdBarrier bar = xcd_barrier_post((unsigned*)(F.ctl + CW_BAR), F.MISC + 8);
    const int lo = args.ph_lo, hi = args.ph_hi;
#ifndef PHMASK
#define PHMASK 0x1fff
#endif
#define IN(k) (lo <= (k) && (k) < hi && ((PHMASK >> (k)) & 1))
#ifndef REPMASK
#define REPMASK 0
#endif
#define REP(k) for (int rep_ = 0; rep_ < ((((REPMASK) >> (k)) & 1) ? 2 : 1); ++rep_)
#ifndef XBAR
#define XBAR 0
#endif
#define SEAM(k) do { if (IN(k) && IN((k) + 1)) { xcd_barrier(bar); if ((XBAR >> (k)) & 1) { xcd_barrier(bar); xcd_barrier(bar); } } } while (0)
    typedef pg8::bf16_t pb;
    if (IN(0)) REP(0) { p0_prologue(args, F); }
#if !ABL_NOMIX
    if (IN(1)) REP(1) { p1_norm1(args, F); } SEAM(1);
    if (IN(2)) REP(2) {
        { pg8::Gemm g{(const pb*)(ws + WS_H), (const pb*)(ws + WS_WIN), TOK, N16, DM}; pg8::SplitOrder S; S.init(TOK, N16, F.G, (int)blockIdx.x); S.nx = 4; S.ny = 2;
          pg8::EpiBf16<0> E{(pb*)(ws + WS_U), ULD, nullptr, 256, UBLK, 1.f};
          pg8::gemm_phase<pg8::EpiBf16<0>, pg8::SplitOrder, true, true>(F.lds, g, S, E); }
        __syncthreads();
        { pg8::Gemm g{(const pb*)(ws + WS_H8), (const pb*)(ws + WS_WIN8), TOK, INW - N16, DM / 2}; pg8::SplitOrder S; S.init(TOK, INW - N16, F.G, (int)blockIdx.x); S.nx = 5; S.ny = 8;
          pg8::EpiFp8Blk E{ws + WS_U + (size_t)(N16 / 256) * UBLK * 2, UBLK};
          pg8::gemm_phase<pg8::EpiFp8Blk, pg8::SplitOrder, true, true, true>(F.lds, g, S, E); } } SEAM(2);
    if (IN(3)) { REP(3) { attn_phase(args, F); }
        REP(13) { for (int it = (F.vcu + 128) % F.G; it < 512; it += F.G) ret_kv_item(args, F, it); } } SEAM(3);
    if (IN(4)) REP(4) { p4_scan_merge(args, F); } SEAM(4);
    if (IN(5)) REP(5) { for (int it = F.vcu; it < 512; it += F.G) ret_out_item(args, F, it); } SEAM(5);
    if (IN(6)) REP(6) { pg8::Gemm g{(const pb*)(ws + WS_RET), (const pb*)(ws + WS_WRET), TOK, DM, RA_LD / 2}; pg8::StaticOrder S; S.init(TOK, DM, F.G, (int)blockIdx.x);
        pg8::EpiGate2<8> E{(pb*)(ws + WS_MERGED), DM, ucol8(ws, C_GA), ucol8(ws, C_GB), UBLK};
        pg8::gemm_phase<pg8::EpiGate2<8>, pg8::StaticOrder, true, true, true>(F.lds, g, S, E); } SEAM(6);
    if (IN(7)) REP(7) { pg8::Gemm g{(const pb*)(ws + WS_MERGED), (const pb*)(ws + WS_WO), TOK, DM, 1024}; pg8::StaticOrder S; S.init(TOK, DM, F.G, (int)blockIdx.x);
        pg8::EpiResid E{(float*)(ws + WS_XMID), args.in[0], DM, (const float*)(ws + WS_CTL) + CW_MOD + 2048, 6144, SEQ / 256};
        pg8::gemm_phase<pg8::EpiResid, pg8::StaticOrder, true, true>(F.lds, g, S, E); } SEAM(7);
#else
    if (IN(7)) { const f32x4* s = (const f32x4*)args.in[0]; f32x4* d = (f32x4*)(ws + WS_XMID); for (size_t i = (size_t)blockIdx.x * NTHR + F.tid; i < (size_t)TOK * DM / 4; i += (size_t)F.G * NTHR) d[i] = s[i]; } SEAM(7);
#endif
#if !ABL_NOMOE
    if (IN(8)) { p8_route(args, F); } if (IN(8) && IN(10)) xcd_barrier(bar);
    if (IN(10)) REP(10) { const int nt = moe_tables(F, true);
        pg8::Gemm g{(const pb*)(ws + WS_XIN), (const pb*)(ws + WS_W1), nt * 256, NEXP * FF2, DM / 2}; pg8::MoeOrder S{nt, FF2 / 256, F.G, F.vcu  , (const LAS int*)(F.lds + MT_PM), (const LAS int*)(F.lds + MT_E)};
        pg8::EpiSwiglu E{(pb*)(ws + WS_A), FF, args.in[14], FF2 / 256};
        pg8::gemm_phase<pg8::EpiSwiglu, pg8::MoeOrder, true, true, true>(F.lds, g, S, E); } SEAM(10);
    if (IN(11)) REP(11) { const int nt = moe_tables(F, false);
        pg8::Gemm g{(const pb*)(ws + WS_A), (const pb*)(ws + WS_W2), nt * 256, NEXP * DM, FF / 2}; pg8::MoeOrder S{nt, DM / 256, F.G, F.vcu, (const LAS int*)(F.lds + MT_PM), (const LAS int*)(F.lds + MT_E)};
        pg8::EpiFp8Row E{ws + WS_YB, DM, args.in[16], DM / 256};
        pg8::gemm_phase<pg8::EpiFp8Row, pg8::MoeOrder, true, true, true>(F.lds, g, S, E); } SEAM(11);
#endif
    if (IN(12)) REP(12) { p12_final(args, F, !ABL_NOMOE); }
#undef IN
#undef SEAM
}

extern "C" void kernel_launch(void* const* d_in, const int* in_sizes, int n_in, void* d_out, int out_size, void* d_ws, size_t ws_size, hipStream_t stream) {
    static int grid = 0;
    if (grid == 0) {
        if (n_in != 18 || in_sizes[0] != TOK * DM || out_size != TOK * DM || ws_size < WS_END) { fprintf(stderr, "kernel_launch: unexpected shapes n_in %d in0 %d out %d ws %zu\n", n_in, n_in > 0 ? in_sizes[0] : -1, out_size, ws_size); grid = -1; return; }
        int dev = 0, cus = 0, per_cu = 0;
        if (hipGetDevice(&dev) != hipSuccess || hipDeviceGetAttribute(&cus, hipDeviceAttributeMultiprocessorCount, dev) != hipSuccess) { grid = -1; return; }
        if (hipFuncSetAttribute((const void*)mk_fwd, hipFuncAttributeMaxDynamicSharedMemorySize, LDS_BYTES) != hipSuccess) { fprintf(stderr, "kernel_launch: hipFuncSetAttribute failed\n"); grid = -1; return; }
        if (hipOccupancyMaxActiveBlocksPerMultiprocessor(&per_cu, (const void*)mk_fwd, NTHR, LDS_BYTES) != hipSuccess || per_cu < 1) fprintf(stderr, "kernel_launch: occupancy query says %d\n", per_cu);
        (void)hipGetLastError();
        grid = cus;
        if (grid != 256) fprintf(stderr, "kernel_launch: %d CUs (built for 256)\n", grid);
    }
    if (grid < 0) return;
    (void)hipMemsetAsync((char*)d_ws + WS_CTL, 0, CTL_ZERO_BYTES, stream);
    Args a{};
    for (int i = 0; i < 18; ++i) a.in[i] = (const float*)d_in[i];
    a.out = (float*)d_out; a.ws = (unsigned char*)d_ws;
#if ONE_LAUNCH
    a.ph_lo = 0; a.ph_hi = NPHASE;
    hipLaunchKernelGGL(mk_fwd, dim3(grid), dim3(NTHR), LDS_BYTES, stream, a);
#else
    for (int p = 0; p < NPHASE; ++p) {
#if ABL_NOMIX
        if (p >= 1 && p <= 6) continue;
#endif
#if ABL_NOMOE
        if (p >= 8 && p <= 11) continue;
#endif
        a.ph_lo = p; a.ph_hi = p + 1;
        hipLaunchKernelGGL(mk_fwd, dim3(grid), dim3(NTHR), LDS_BYTES, stream, a);
    }
#endif
}
```

```cpp
#include <hip/hip_runtime.h>
#include <cstdio>
#include <cstdint>
namespace pg8 {
#define PG8_LAS __attribute__((address_space(3)))
typedef unsigned short bf16_t;
typedef short bf16x8 __attribute__((ext_vector_type(8)));
typedef float f32x4 __attribute__((ext_vector_type(4)));
typedef unsigned u32x4 __attribute__((ext_vector_type(4)));
constexpr int BM = 256, BK = 64, HALF = 128, HTB = HALF * BK * 2  , STAGE_BYTES = 8 * HTB, NXCD = 8, WGM = 4;

__host__ __device__ __forceinline__ int lds_byte(int r, int c) { const int st = (r >> 4) * 2 + (c >> 5), rr = r & 15, cc = c & 31, ob = rr * 64 + cc * 2; return st * 1024 + (ob ^ (((ob >> 9) & 1) << 5)); }
__host__ __device__ __forceinline__ void stage_rc(int b, int& R, int& C) { const int st = b / 1024, sb = b % 1024, swz = sb ^ (((sb >> 9) & 1) << 5); R = (st >> 1) * 16 + swz / 64; C = (st & 1) * 32 + (swz % 64) / 2; }
__host__ __device__ __forceinline__ int perm32(int rho) { const int n = rho >> 4, i = rho & 15; return 8 * (i >> 2) + 4 * n + (i & 3); }

struct Unit { int pm, pn, po; };
struct Gemm { const bf16_t* A; const bf16_t* Bt; int M, N, K; };

struct StaticOrder {
    int nM, nN, nwg, G, c;
    __host__ __device__ void init(int M, int N, int G_, int c_) { nM = M / BM; nN = N / BM; nwg = nM * nN; G = G_; c = c_; }
    __host__ __device__ bool next(int i, Unit& u) const {
        const long L = (long)i * G + c; if (L >= nwg) return false;
        int wgid = (int)L; { const int q = nwg / NXCD, r = nwg % NXCD, xcd = wgid % NXCD, off = wgid / NXCD; wgid = (xcd < r ? xcd * (q + 1) : r * (q + 1) + (xcd - r) * q) + off; }
        const int nig = WGM * nN, gid = wgid / nig, fm = gid * WGM, gsz = (nM - fm) < WGM ? (nM - fm) : WGM;
        u.pm = fm + ((wgid % nig) % gsz); u.pn = (wgid % nig) / gsz; u.po = u.pm; return true;
    }
    __device__ __forceinline__ void a_ready(const Unit&) const {}
    __device__ __forceinline__ void done(const Unit&) const {}
};

__device__ __forceinline__ unsigned cvt_pk_bf16(float lo, float hi) { unsigned r; asm volatile("v_cvt_pk_bf16_f32 %0, %1, %2" : "=v"(r) : "v"(lo), "v"(hi)); return r; }
typedef float f32x2 __attribute__((ext_vector_type(2)));
__device__ __forceinline__ f32x2 gelu_pk(f32x2 v) {
    const f32x2 av = __builtin_elementwise_abs(v), d = av * 0.2316418882f + 1.0f;
    f32x2 t; t.x = __builtin_amdgcn_rcpf(d.x); t.y = __builtin_amdgcn_rcpf(d.y);
    f32x2 q = t * 0.5307027145f + (-0.7265760135f); q = q * t + 0.7107068705f; q = q * t + (-0.142248368f); q = q * t + 0.127414796f; q = q * t;
    const f32x2 s = (v * v) * (-0.72134752044f);
    f32x2 e; e.x = __builtin_amdgcn_exp2f(s.x); e.y = __builtin_amdgcn_exp2f(s.y);
    const f32x2 m = v * (q * e), r = v - m;
    f32x2 o; o.x = v.x < 0.f ? m.x : r.x; o.y = v.y < 0.f ? m.y : r.y; return o;
}

template <int ACT  > struct EpiBf16 {
    static constexpr bool PERM = true, AFTER_DRAIN = false; static constexpr int MID_T = 0; static_assert(ACT == 0 || ACT == 1, "EpiBf16: ACT is 0 (none) or 1 (gelu_pk)");
    bf16_t* O; int ldc; const float* bias; int split_cols; size_t split_stride; float scale0;
    __device__ __forceinline__ void operator()(const f32x4 (&acc)[2][2][4][2], const Unit& u, int wr, int wc, int fr, int fq) const {
        const int row0 = u.pm * BM + wr * 64 + fr; int colt = u.pn * BM; bf16_t* base = O;
        float sc = 1.f; if (split_cols) { const int t = colt / split_cols; base += (size_t)t * split_stride; colt -= t * split_cols; if (t == 0) sc = scale0; }
        const int col0 = colt + wc * 32 + 8 * fq, bcol0 = u.pn * BM + wc * 32 + 8 * fq;
        f32x4 bv[2][2];
#pragma unroll
        for (int bj = 0; bj < 2; ++bj)
#pragma unroll
            for (int n = 0; n < 2; ++n) bv[bj][n] = bias ? *(const f32x4*)(bias + bcol0 + bj * HALF + 4 * n) : (f32x4){0.f, 0.f, 0.f, 0.f};
#pragma unroll
        for (int ai = 0; ai < 2; ++ai)
#pragma unroll
            for (int m = 0; m < 4; ++m) { bf16_t* rowp = base + (size_t)(row0 + ai * HALF + m * 16) * ldc + col0;
#pragma unroll
                for (int bj = 0; bj < 2; ++bj) { f32x4 v0 = acc[ai][bj][m][0] + bv[bj][0], v1 = acc[ai][bj][m][1] + bv[bj][1];
                    if (ACT == 1) { f32x2 a = gelu_pk((f32x2){v0[0], v0[1]}), b = gelu_pk((f32x2){v0[2], v0[3]}), c = gelu_pk((f32x2){v1[0], v1[1]}), d = gelu_pk((f32x2){v1[2], v1[3]});
                        v0 = (f32x4){a.x, a.y, b.x, b.y}; v1 = (f32x4){c.x, c.y, d.x, d.y}; }
                    v0 = v0 * sc; v1 = v1 * sc; u32x4 w; w.x = cvt_pk_bf16(v0[0], v0[1]); w.y = cvt_pk_bf16(v0[2], v0[3]); w.z = cvt_pk_bf16(v1[0], v1[1]); w.w = cvt_pk_bf16(v1[2], v1[3]);
                    *(u32x4*)(rowp + bj * HALF) = w; } }
    }
};
__device__ __forceinline__ float bf_lo(unsigned w) { return __uint_as_float(w << 16); }
__device__ __forceinline__ float bf_hi(unsigned w) { return __uint_as_float(w & 0xffff0000u); }
__device__ __forceinline__ float sigmf(float x) { return __builtin_amdgcn_rcpf(1.0f + __expf(-x)); }

template <int MIDT> struct EpiGate2 {
    static constexpr bool PERM = true, AFTER_DRAIN = false; static constexpr int MID_T = MIDT;
    bf16_t* O; int ldc; const unsigned char* Ga; const unsigned char* Gb; size_t gblk;
    __device__ __forceinline__ void mid(f32x4 (&acc)[2][2][4][2], const Unit& u, int wr, int wc, int fr, int fq) const {
        int row0 = u.pm * BM + wr * 64 + fr, col0 = wc * 32 + 8 * fq;
        asm volatile("" : "+v"(row0), "+v"(col0));
        const unsigned char* Gat = Ga + (size_t)u.pn * gblk; const unsigned char* Gbt = Gb + (size_t)u.pn * gblk;
        typedef int i32x2 __attribute__((ext_vector_type(2))); typedef float f32x2_ __attribute__((ext_vector_type(2)));
#pragma unroll
        for (int ai = 0; ai < 2; ++ai)
#pragma unroll
            for (int m = 0; m < 4; ++m) { const size_t row = (size_t)(row0 + ai * HALF + m * 16);
#pragma unroll
                for (int bj = 0; bj < 2; ++bj) { const int col = col0 + bj * HALF;
                    const i32x2 a = *(const i32x2*)(Gat + row * 256 + col), b = *(const i32x2*)(Gbt + row * 256 + col);
#define RAT_(x, y) ((1.0f + __expf(-(y))) * __builtin_amdgcn_rcpf(1.0f + __expf(-(x))))
                    const f32x2_ a0 = __builtin_amdgcn_cvt_pk_f32_fp8(a.x, false), a1 = __builtin_amdgcn_cvt_pk_f32_fp8(a.x, true), a2 = __builtin_amdgcn_cvt_pk_f32_fp8(a.y, false), a3 = __builtin_amdgcn_cvt_pk_f32_fp8(a.y, true);
                    const f32x2_ b0 = __builtin_amdgcn_cvt_pk_f32_fp8(b.x, false), b1 = __builtin_amdgcn_cvt_pk_f32_fp8(b.x, true), b2 = __builtin_amdgcn_cvt_pk_f32_fp8(b.y, false), b3 = __builtin_amdgcn_cvt_pk_f32_fp8(b.y, true);
                    f32x4 v0 = acc[ai][bj][m][0], v1 = acc[ai][bj][m][1];
                    v0[0] *= RAT_(a0.x, b0.x); v0[1] *= RAT_(a0.y, b0.y); v0[2] *= RAT_(a1.x, b1.x); v0[3] *= RAT_(a1.y, b1.y);
                    v1[0] *= RAT_(a2.x, b2.x); v1[1] *= RAT_(a2.y, b2.y); v1[2] *= RAT_(a3.x, b3.x); v1[3] *= RAT_(a3.y, b3.y);
#undef RAT_
                    acc[ai][bj][m][0] = v0; acc[ai][bj][m][1] = v1; }
                asm volatile("" ::: "memory"); }
    }
    __device__ __forceinline__ void operator()(const f32x4 (&acc)[2][2][4][2], const Unit& u, int wr, int wc, int fr, int fq) const {
        const int row0 = u.pm * BM + wr * 64 + fr, col0 = u.pn * BM + wc * 32 + 8 * fq;
#pragma unroll
        for (int ai = 0; ai < 2; ++ai)
#pragma unroll
            for (int m = 0; m < 4; ++m) { const size_t row = (size_t)(row0 + ai * HALF + m * 16);
#pragma unroll
                for (int bj = 0; bj < 2; ++bj) { const int col = col0 + bj * HALF;
                    typedef int i32x2 __attribute__((ext_vector_type(2))); typedef float f32x2_ __attribute__((ext_vector_type(2)));
                    const i32x2 g = *(const i32x2*)(Gb + (size_t)u.pn * gblk + row * 256 + (col - u.pn * BM));
                    const f32x2_ g0 = __builtin_amdgcn_cvt_pk_f32_fp8(g.x, false), g1 = __builtin_amdgcn_cvt_pk_f32_fp8(g.x, true), g2 = __builtin_amdgcn_cvt_pk_f32_fp8(g.y, false), g3 = __builtin_amdgcn_cvt_pk_f32_fp8(g.y, true);
                    f32x4 v0 = acc[ai][bj][m][0], v1 = acc[ai][bj][m][1];
                    v0[0] *= sigmf(g0.x); v0[1] *= sigmf(g0.y); v0[2] *= sigmf(g1.x); v0[3] *= sigmf(g1.y);
                    v1[0] *= sigmf(g2.x); v1[1] *= sigmf(g2.y); v1[2] *= sigmf(g3.x); v1[3] *= sigmf(g3.y);
                    u32x4 w; w.x = cvt_pk_bf16(v0[0], v0[1]); w.y = cvt_pk_bf16(v0[2], v0[3]); w.z = cvt_pk_bf16(v1[0], v1[1]); w.w = cvt_pk_bf16(v1[2], v1[3]);
                    *(u32x4*)(O + row * ldc + col) = w; } }
    }
};
struct EpiResid {
    static constexpr bool PERM = false, AFTER_DRAIN = false; static constexpr int MID_T = 0;
    float* O; const float* base; int ldc; const float* gvec; int gstride; int tiles_per_b;
    __device__ __forceinline__ void operator()(const f32x4 (&acc)[2][2][4][2], const Unit& u, int wr, int wc, int fr, int fq) const {
        const int row0 = u.pm * BM + wr * 64 + fr, col0 = u.pn * BM + wc * 32 + 4 * fq;
        const float* gv = gvec + (size_t)(u.pm / tiles_per_b) * gstride;
#pragma unroll
        for (int bj = 0; bj < 2; ++bj)
#pragma unroll
            for (int n = 0; n < 2; ++n) { const int col = col0 + bj * HALF + n * 16; const f32x4 gt = *(const f32x4*)(gv + col);
#pragma unroll
                for (int ai = 0; ai < 2; ++ai)
#pragma unroll
                    for (int m = 0; m < 4; ++m) { const size_t off = (size_t)(row0 + ai * HALF + m * 16) * ldc + col;
                        const f32x4 b = *(const f32x4*)(base + off); *(f32x4*)(O + off) = b + gt * acc[ai][bj][m][n]; } }
    }
};
struct EpiSwiglu {
    static constexpr bool PERM = true, AFTER_DRAIN = false; static constexpr int MID_T = 0;
    bf16_t* O; int lda; const float* bias; int nN;
    __device__ __forceinline__ int act4(const f32x4& v0, const f32x4& v1) const {
        f32x4 G = (f32x4){v0[0], v0[2], v1[0], v1[2]}, L = (f32x4){v0[1], v0[3], v1[1], v1[3]};
        G = __builtin_elementwise_min(G, (f32x4){7.f, 7.f, 7.f, 7.f});
        L = __builtin_elementwise_min(__builtin_elementwise_max(L, (f32x4){-7.f, -7.f, -7.f, -7.f}), (f32x4){7.f, 7.f, 7.f, 7.f}) + 1.0f;
        const f32x4 X = G * (-1.702f * 1.4426950408889634f);
        f32x4 S; S[0] = __builtin_amdgcn_exp2f(X[0]); S[1] = __builtin_amdgcn_exp2f(X[1]); S[2] = __builtin_amdgcn_exp2f(X[2]); S[3] = __builtin_amdgcn_exp2f(X[3]);
        S = S + 1.0f; S[0] = __builtin_amdgcn_rcpf(S[0]); S[1] = __builtin_amdgcn_rcpf(S[1]); S[2] = __builtin_amdgcn_rcpf(S[2]); S[3] = __builtin_amdgcn_rcpf(S[3]);
        const f32x4 A4 = G * S * L;
        int w8 = 0; w8 = __builtin_amdgcn_cvt_pk_fp8_f32(A4[0], A4[1], w8, false); w8 = __builtin_amdgcn_cvt_pk_fp8_f32(A4[2], A4[3], w8, true); return w8;
    }
    __device__ __forceinline__ void operator()(const f32x4 (&acc)[2][2][4][2], const Unit& u, int wr, int wc, int fr, int fq) const {
        const int row0 = u.po * BM + wr * 64 + fr; const int pnl = u.pn % nN;
        const int bcol0 = u.pn * BM + wc * 32 + 8 * fq; const bool odd = (fq & 1) != 0;
        const int bytecol = (pnl * BM + wc * 32 + 8 * (fq & ~1)) / 2 + (odd ? 64 : 0);
        f32x4 bv[2][2];
#pragma unroll
        for (int bj = 0; bj < 2; ++bj)
#pragma unroll
            for (int n = 0; n < 2; ++n) bv[bj][n] = *(const f32x4*)(bias + bcol0 + bj * HALF + 4 * n);
        typedef int i32x2 __attribute__((ext_vector_type(2)));
#pragma unroll
        for (int ai = 0; ai < 2; ++ai)
#pragma unroll
            for (int m = 0; m < 4; ++m) {
                const int wA = act4(acc[ai][0][m][0] + bv[0][0], acc[ai][0][m][1] + bv[0][1]), wB = act4(acc[ai][1][m][0] + bv[1][0], acc[ai][1][m][1] + bv[1][1]);
                const int recv = __shfl_xor(odd ? wA : wB, 16);
                *(i32x2*)((unsigned char*)O + (size_t)(row0 + ai * HALF + m * 16) * lda + bytecol) = odd ? (i32x2){recv, wB} : (i32x2){wA, recv}; }
    }
};
struct EpiFp8Blk {
    static constexpr bool PERM = true, AFTER_DRAIN = false; static constexpr int MID_T = 0;
    unsigned char* O; size_t blk;
    __device__ __forceinline__ void operator()(const f32x4 (&acc)[2][2][4][2], const Unit& u, int wr, int wc, int fr, int fq) const {
        const bool odd = (fq & 1) != 0;
        const int row0 = u.pm * BM + wr * 64 + fr, col0 = wc * 32 + 8 * (fq & ~1) + (odd ? HALF : 0); unsigned char* base = O + (size_t)u.pn * blk;
#pragma unroll
        for (int ai = 0; ai < 2; ++ai)
#pragma unroll
            for (int m = 0; m < 4; ++m) { unsigned char* rowp = base + (size_t)(row0 + ai * HALF + m * 16) * 256 + col0; int w[2][2];
#pragma unroll
                for (int bj = 0; bj < 2; ++bj) { const f32x4 v0 = acc[ai][bj][m][0], v1 = acc[ai][bj][m][1]; int w0 = 0, w1 = 0;
                    w0 = __builtin_amdgcn_cvt_pk_fp8_f32(v0[0], v0[1], w0, false); w0 = __builtin_amdgcn_cvt_pk_fp8_f32(v0[2], v0[3], w0, true);
                    w1 = __builtin_amdgcn_cvt_pk_fp8_f32(v1[0], v1[1], w1, false); w1 = __builtin_amdgcn_cvt_pk_fp8_f32(v1[2], v1[3], w1, true); w[bj][0] = w0; w[bj][1] = w1; }
                const int r0 = __shfl_xor(odd ? w[0][0] : w[1][0], 16), r1 = __shfl_xor(odd ? w[0][1] : w[1][1], 16);
                *(u32x4*)rowp = odd ? (u32x4){(unsigned)r0, (unsigned)r1, (unsigned)w[1][0], (unsigned)w[1][1]} : (u32x4){(unsigned)w[0][0], (unsigned)w[0][1], (unsigned)r0, (unsigned)r1}; }
    }
};
struct EpiFp8Row {
    static constexpr bool PERM = true, AFTER_DRAIN = false; static constexpr int MID_T = 0;
    unsigned char* O; int ldc; const float* bias; int nN;
    __device__ __forceinline__ void operator()(const f32x4 (&acc)[2][2][4][2], const Unit& u, int wr, int wc, int fr, int fq) const {
        const bool odd = (fq & 1) != 0;
        const int row0 = u.po * BM + wr * 64 + fr, col0 = (u.pn % nN) * BM + wc * 32 + 8 * (fq & ~1) + (odd ? HALF : 0), bcol0 = u.pn * BM + wc * 32 + 8 * fq;
        f32x4 bv[2][2];
#pragma unroll
        for (int bj = 0; bj < 2; ++bj)
#pragma unroll
            for (int n = 0; n < 2; ++n) bv[bj][n] = *(const f32x4*)(bias + bcol0 + bj * HALF + 4 * n);
#pragma unroll
        for (int ai = 0; ai < 2; ++ai)
#pragma unroll
            for (int m = 0; m < 4; ++m) { unsigned char* rowp = O + (size_t)(row0 + ai * HALF + m * 16) * ldc + col0; int w[2][2];
#pragma unroll
                for (int bj = 0; bj < 2; ++bj) { const f32x4 v0 = acc[ai][bj][m][0] + bv[bj][0], v1 = acc[ai][bj][m][1] + bv[bj][1]; int w0 = 0, w1 = 0;
                    w0 = __builtin_amdgcn_cvt_pk_fp8_f32(v0[0], v0[1], w0, false); w0 = __builtin_amdgcn_cvt_pk_fp8_f32(v0[2], v0[3], w0, true);
                    w1 = __builtin_amdgcn_cvt_pk_fp8_f32(v1[0], v1[1], w1, false); w1 = __builtin_amdgcn_cvt_pk_fp8_f32(v1[2], v1[3], w1, true); w[bj][0] = w0; w[bj][1] = w1; }
                const int r0 = __shfl_xor(odd ? w[0][0] : w[1][0], 16), r1 = __shfl_xor(odd ? w[0][1] : w[1][1], 16);
                *(u32x4*)rowp = odd ? (u32x4){(unsigned)r0, (unsigned)r1, (unsigned)w[1][0], (unsigned)w[1][1]} : (u32x4){(unsigned)w[0][0], (unsigned)w[0][1], (unsigned)r0, (unsigned)r1}; }
    }
};
struct MoeOrder {
    int ntiles, nN, G, c; const PG8_LAS int* tpm; const PG8_LAS int* te;
    __device__ bool next(int i, Unit& u) const {
        const long L = (long)i * G + c; if (L >= (long)ntiles * nN) return false;
        const int t = (int)(L / nN), pnl = (int)(L % nN);
        u.pm = tpm ? __builtin_amdgcn_readfirstlane(tpm[t]) : t; u.po = t; u.pn = __builtin_amdgcn_readfirstlane(te[t]) * nN + pnl; return true;
    }
    __device__ __forceinline__ void a_ready(const Unit&) const {}
    __device__ __forceinline__ void done(const Unit&) const {}
};

struct SplitOrder : StaticOrder {
    int nx, ny;
    __device__ bool next(int i, Unit& u) const {
        const int half = G >> 1, grp = (c >> 3) & 1, ci = ((c >> 4) << 3) | (c & 7);
        long L; if (grp == 0) { if (i >= nx) return false; L = (long)i * half + ci; } else { if (i >= ny) return false; L = (long)nx * half + (long)i * half + ci; }
        if (L >= nwg) return false;
        int wgid = (int)L; { const int q = nwg / NXCD, r = nwg % NXCD, xcd = wgid % NXCD, off = wgid / NXCD; wgid = (xcd < r ? xcd * (q + 1) : r * (q + 1) + (xcd - r) * q) + off; }
        const int nig = WGM * nN, gid = wgid / nig, fm = gid * WGM, gsz = (nM - fm) < WGM ? (nM - fm) : WGM;
        u.pm = fm + ((wgid % nig) % gsz); u.pn = (wgid % nig) / gsz; u.po = u.pm; return true;
    }
};
typedef int v4i_ __attribute__((ext_vector_type(4))); typedef int v8i_ __attribute__((ext_vector_type(8)));
template <bool F8> struct FragT { bf16x8 h[2]; __device__ __forceinline__ void set(int k, bf16x8 v) { h[k] = v; } };
template <> struct FragT<true> { v8i_ w; __device__ __forceinline__ void set(int k, bf16x8 v) { if (k == 0) w.lo = __builtin_bit_cast(v4i_, v); else w.hi = __builtin_bit_cast(v4i_, v); } };
template <class Epi, class Sched, bool ALIGN_EPI = false, bool SP2 = false, bool F8 = false>
__device__ __forceinline__ void gemm_phase(PG8_LAS unsigned char* lds, const Gemm g, const Sched& S, const Epi& E) {
    const int tid = threadIdx.x, wid = __builtin_amdgcn_readfirstlane(tid >> 6), lane = tid & 63, wr = wid >> 2, wc = wid & 3, fr = lane & 15, fq = lane >> 4;
    const int K = g.K, nt = K / BK;
    unsigned voffA[2], voffB[2];
#pragma unroll
    for (int i = 0; i < 2; ++i) { int R, C; stage_rc(tid * 16 + i * 8192, R, C); const int Rb = Epi::PERM ? ((R & ~31) + perm32(R & 31)) : R;
        voffA[i] = (unsigned)(R * K + C) * 2u; voffB[i] = (unsigned)(Rb * K + C) * 2u; }
    const size_t kstep = (size_t)(BK * 2);
    const size_t hstep = (size_t)HALF * K * 2;
    const size_t tstep = 2 * hstep;
    const unsigned ldsw = (unsigned)wid * 1024u;
    const int aoff = lds_byte(wr * 64 + fr, fq * 8), boff = lds_byte(wc * 32 + fr, fq * 8);
#define PG8_SA(b, h) (((b) * 2 + (h)) * HTB)
#define PG8_SB(b, h) ((4 + (b) * 2 + (h)) * HTB)
#define PG8_STAGE(bufoff, gbase, voff) do { _Pragma("unroll") for (int _i = 0; _i < 2; ++_i) \
        __builtin_amdgcn_global_load_lds((const unsigned*)((const char*)(gbase) + (voff)[_i]), (PG8_LAS unsigned*)(lds + (bufoff) + ldsw + _i * 8192), 16, 0, 0); } while (0)
#define PG8_LDA(dst, b, h) do { _Pragma("unroll") for (int m = 0; m < 4; ++m) _Pragma("unroll") for (int k = 0; k < 2; ++k) dst[m].set(k, *(const PG8_LAS bf16x8*)(lds + PG8_SA(b, h) + aoff + m * 2048 + k * 1024)); } while (0)
#define PG8_LDB(dst, b, h) do { _Pragma("unroll") for (int n = 0; n < 2; ++n) _Pragma("unroll") for (int k = 0; k < 2; ++k) dst[n].set(k, *(const PG8_LAS bf16x8*)(lds + PG8_SB(b, h) + boff + n * 2048 + k * 1024)); } while (0)
#define PG8_MMA(ai, bj, At, Bt) do { __builtin_amdgcn_s_setprio(1); _Pragma("unroll") for (int m = 0; m < 4; ++m) _Pragma("unroll") for (int n = 0; n < 2; ++n) { \
        if constexpr (F8) { asm volatile("v_mfma_scale_f32_16x16x128_f8f6f4 %0, %1, %2, %0, %3, %4 op_sel_hi:[0,0,0]" : "+v"(acc[ai][bj][m][n]) : "v"(Bt[n].w), "v"(At[m].w), "v"(sc_w), "v"(sc_x)); \
        } else { _Pragma("unroll") for (int k = 0; k < 2; ++k) \
        acc[ai][bj][m][n] = __builtin_amdgcn_mfma_f32_16x16x32_bf16(Bt[n].h[k], At[m].h[k], acc[ai][bj][m][n], 0, 0, 0); } } __builtin_amdgcn_s_setprio(0); } while (0)
#define PG8_WAIT_V(n) asm volatile("s_waitcnt vmcnt(" #n ")" ::: "memory")
#define PG8_WAIT_L(n) asm volatile("s_waitcnt lgkmcnt(" #n ")" ::: "memory")
#define PG8_BAR __builtin_amdgcn_s_barrier()
#define PG8_SCHED __builtin_amdgcn_sched_barrier(0)
    Unit cur, nxt; int ui = 0;
    if (!S.next(0, cur)) return;
    f32x4 acc[2][2][4][2];
#pragma unroll
    for (int a = 0; a < 2; ++a)
#pragma unroll
        for (int b = 0; b < 2; ++b)
#pragma unroll
            for (int m = 0; m < 4; ++m)
#pragma unroll
                for (int n = 0; n < 2; ++n) acc[a][b][m][n] = (f32x4){0.f, 0.f, 0.f, 0.f};
    FragT<F8> At[4], B0[2], B1[2];
    int sc_w = 0x7a7a7a7a, sc_x = 0x7f7f7f7f;
    if constexpr (F8) { asm volatile("" : "+v"(sc_w), "+v"(sc_x)); }
    const char* cA = (const char*)g.A + (size_t)cur.pm * tstep; const char* cB = (const char*)g.Bt + (size_t)cur.pn * tstep;
    S.a_ready(cur);
    if constexpr (SP2) {
        PG8_STAGE(PG8_SB(0, 0), cB, voffB); PG8_STAGE(PG8_SB(0, 1), cB + hstep, voffB); PG8_STAGE(PG8_SA(0, 0), cA, voffA); PG8_STAGE(PG8_SA(0, 1), cA + hstep, voffA);
        if (wr == 1) PG8_BAR;
        PG8_WAIT_V(2); PG8_BAR;
        PG8_STAGE(PG8_SB(1, 0), cB + kstep, voffB); PG8_STAGE(PG8_SA(1, 0), cA + kstep, voffA); PG8_STAGE(PG8_SB(1, 1), cB + hstep + kstep, voffB);
        PG8_WAIT_V(6); PG8_BAR;
    } else {
        PG8_STAGE(PG8_SB(0, 0), cB, voffB); PG8_STAGE(PG8_SA(0, 0), cA, voffA); PG8_STAGE(PG8_SB(0, 1), cB + hstep, voffB); PG8_STAGE(PG8_SA(0, 1), cA + hstep, voffA);
        if (wr == 1) PG8_BAR;
        PG8_WAIT_V(4); PG8_BAR;
        PG8_STAGE(PG8_SB(1, 0), cB + kstep, voffB); PG8_STAGE(PG8_SA(1, 0), cA + kstep, voffA); PG8_STAGE(PG8_SB(1, 1), cB + hstep + kstep, voffB);
        PG8_WAIT_V(6); PG8_BAR;
    }
    for (;;) {
        const bool has_next = S.next(ui + 1, nxt);
        const char* nA = has_next ? (const char*)g.A + (size_t)nxt.pm * tstep : cA; const char* nB = has_next ? (const char*)g.Bt + (size_t)nxt.pn * tstep : cB;
        for (int t = 0; t < nt; t += 2) {
            if constexpr (Epi::MID_T > 0) { if (t == Epi::MID_T) { if constexpr (F8) asm volatile("s_nop 15\n\ts_nop 3" ::: "memory"); E.mid(acc, cur, wr, wc, fr, fq); if constexpr (F8) asm volatile("s_nop 7" ::: "memory"); } }
            const bool last = (t == nt - 2);
            const char* a1 = cA + (size_t)(t + 1) * kstep;
            const char* a2 = last ? nA : cA + (size_t)(t + 2) * kstep; const char* b2 = last ? nB : cB + (size_t)(t + 2) * kstep;
            const char* a3 = a2 + kstep; const char* b3 = b2 + kstep;
            if (last && has_next) S.a_ready(nxt);
            if constexpr (SP2) {
            PG8_LDB(B0, 0, 0); PG8_LDB(B1, 0, 1); PG8_SCHED; PG8_LDA(At, 0, 0); PG8_STAGE(PG8_SA(1, 1), a1 + hstep, voffA);
            PG8_WAIT_V(8); PG8_WAIT_L(0); PG8_BAR; PG8_MMA(0, 0, At, B0); PG8_MMA(0, 1, At, B1); PG8_BAR; PG8_SCHED;
            PG8_LDA(At, 0, 1); PG8_STAGE(PG8_SB(0, 0), b2, voffB); PG8_STAGE(PG8_SB(0, 1), b2 + hstep, voffB); PG8_STAGE(PG8_SA(0, 0), a2, voffA);
            PG8_WAIT_V(8); PG8_WAIT_L(0); PG8_BAR; PG8_MMA(1, 0, At, B0); PG8_MMA(1, 1, At, B1); PG8_BAR; PG8_SCHED;
            PG8_LDB(B0, 1, 0); PG8_LDB(B1, 1, 1); PG8_SCHED; PG8_LDA(At, 1, 0); PG8_STAGE(PG8_SA(0, 1), a2 + hstep, voffA);
            PG8_WAIT_V(8); PG8_WAIT_L(0); PG8_BAR; PG8_MMA(0, 0, At, B0); PG8_MMA(0, 1, At, B1); PG8_BAR; PG8_SCHED;
            PG8_LDA(At, 1, 1); PG8_STAGE(PG8_SB(1, 0), b3, voffB); PG8_STAGE(PG8_SB(1, 1), b3 + hstep, voffB); PG8_STAGE(PG8_SA(1, 0), a3, voffA);
            PG8_WAIT_V(8); PG8_WAIT_L(0); PG8_BAR; PG8_MMA(1, 0, At, B0); PG8_MMA(1, 1, At, B1); PG8_BAR; PG8_SCHED;
            } else {
            PG8_LDB(B0, 0, 0); PG8_SCHED; PG8_LDA(At, 0, 0); PG8_STAGE(PG8_SA(1, 1), a1 + hstep, voffA);
            PG8_WAIT_L(8); PG8_BAR; PG8_WAIT_L(0); PG8_MMA(0, 0, At, B0); PG8_BAR; PG8_SCHED;
            PG8_LDB(B1, 0, 1); PG8_STAGE(PG8_SB(0, 0), b2, voffB);
            PG8_BAR; PG8_WAIT_L(0); PG8_MMA(0, 1, At, B1); PG8_BAR;
            PG8_LDA(At, 0, 1); PG8_STAGE(PG8_SA(0, 0), a2, voffA);
            PG8_BAR; PG8_WAIT_L(0); PG8_MMA(1, 0, At, B0); PG8_BAR; PG8_SCHED;
            PG8_STAGE(PG8_SB(0, 1), b2 + hstep, voffB);
            PG8_WAIT_V(6); PG8_BAR; PG8_MMA(1, 1, At, B1); PG8_BAR;
            PG8_LDB(B0, 1, 0); PG8_SCHED; PG8_LDA(At, 1, 0); PG8_STAGE(PG8_SA(0, 1), a2 + hstep, voffA);
            PG8_WAIT_L(8); PG8_BAR; PG8_WAIT_L(0); PG8_MMA(0, 0, At, B0); PG8_BAR; PG8_SCHED;
            PG8_LDB(B1, 1, 1); PG8_STAGE(PG8_SB(1, 0), b3, voffB);
            PG8_BAR; PG8_WAIT_L(0); PG8_MMA(0, 1, At, B1); PG8_BAR;
            PG8_LDA(At, 1, 1); PG8_STAGE(PG8_SA(1, 0), a3, voffA);
            PG8_BAR; PG8_WAIT_L(0); PG8_MMA(1, 0, At, B0); PG8_BAR; PG8_SCHED;
            PG8_STAGE(PG8_SB(1, 1), b3 + hstep, voffB);
            PG8_WAIT_V(6); PG8_BAR; PG8_MMA(1, 1, At, B1); PG8_BAR;
            }
        }
        if constexpr (F8) { asm volatile("s_nop 15\n\ts_nop 3" ::: "memory"); }
        if constexpr (ALIGN_EPI) { if (wr == 0) PG8_BAR; }
        if constexpr (!Epi::AFTER_DRAIN) { E(acc, cur, wr, wc, fr, fq); S.done(cur); }
        if (!has_next) break;
#pragma unroll
        for (int a = 0; a < 2; ++a)
#pragma unroll
            for (int b = 0; b < 2; ++b)
#pragma unroll
                for (int m = 0; m < 4; ++m)
#pragma unroll
                    for (int n = 0; n < 2; ++n) acc[a][b][m][n] = (f32x4){0.f, 0.f, 0.f, 0.f};
        cur = nxt; cA = nA; cB = nB; ++ui;
        if constexpr (ALIGN_EPI) { if (wr == 1) PG8_BAR; }
    }
    PG8_WAIT_V(0);
    if constexpr (!ALIGN_EPI) { if (wr == 0) PG8_BAR; }
    PG8_BAR;
    if constexpr (Epi::AFTER_DRAIN) { E.fused(acc, cur, wr, wc, fr, fq, lds, wid, lane); S.done(cur); }
#undef PG8_SA
#undef PG8_SB
#undef PG8_STAGE
#undef PG8_LDA
#undef PG8_LDB
#undef PG8_MMA
#undef PG8_WAIT_V
#undef PG8_WAIT_L
#undef PG8_BAR
#undef PG8_SCHED
}
}
#define GAS __attribute__((address_space(1)))
#define LAS __attribute__((address_space(3)))
typedef unsigned short bf16;
typedef unsigned v4u __attribute__((ext_vector_type(4)));
typedef float f32x4 __attribute__((ext_vector_type(4)));
typedef short bf16x8 __attribute__((ext_vector_type(8)));
typedef GAS unsigned gu32;
typedef GAS unsigned long long gu64;
#define RLX_AGENT __ATOMIC_RELAXED, __HIP_MEMORY_SCOPE_AGENT
#define LDS_WAIT() asm volatile("s_waitcnt lgkmcnt(0)" ::: "memory")
#define VM_WAIT() asm volatile("s_waitcnt vmcnt(0)" ::: "memory")
__device__ __forceinline__ unsigned long long rt() { return __builtin_amdgcn_s_memrealtime(); }
__device__ __forceinline__ unsigned f2bf(float f) { unsigned u = __builtin_bit_cast(unsigned, f); return (u + 0x7fffu + ((u >> 16) & 1u)) >> 16; }
__device__ __forceinline__ unsigned pk2(float lo, float hi) { return f2bf(lo) | (f2bf(hi) << 16); }

#define XB_TMO      128
#define XB_XCNT(j)  (256  + 64 * (j))
#define XB_XSUB(j)  (1280 + 64 * (j))
#define XB_XGEN(j)  (2304 + 64 * (j))
#define XB_TOP      3328
#define XB_TOPGEN   3392
#define XCD_BAR_WORDS 3456
#define XB_SPIN_CAP (1u << 18)

__device__ __forceinline__ unsigned xb_ld(unsigned* p)              { return __hip_atomic_load(p, __ATOMIC_RELAXED, __HIP_MEMORY_SCOPE_AGENT); }
__device__ __forceinline__ unsigned xb_add(unsigned* p, unsigned v) { return __hip_atomic_fetch_add(p, v, __ATOMIC_RELAXED, __HIP_MEMORY_SCOPE_AGENT); }
__device__ __forceinline__ unsigned xb_xcc_id() { return (unsigned)__builtin_amdgcn_s_getreg((3 << 11) | 20) & 0xFu; }
#define XB_SPIN(cond, bar) do { unsigned _sp = 0; while (cond) { __builtin_amdgcn_s_sleep(1); \
    if ((++_sp & 255u) == 0u) { if (xb_ld(&(bar)[XB_TMO])) break; if (_sp > XB_SPIN_CAP) { atomicAdd(&(bar)[XB_TMO], 1u); break; } } } } while (0)

struct XcdBarrier {
    unsigned* bar; unsigned x;
    volatile LAS unsigned* st;
};

__device__ __forceinline__ XcdBarrier xcd_barrier_post(unsigned* bar, volatile LAS unsigned* st) {
    XcdBarrier b; b.bar = bar; b.x = xb_xcc_id(); b.st = st;
    if (threadIdx.x == 0) (void)xb_add(&bar[XB_XCNT(b.x)], 1u);
    return b;
}
__device__ __forceinline__ void xcd_barrier_complete(unsigned* bar, unsigned x, unsigned& nloc, unsigned& nx) {
    const unsigned G = gridDim.x * gridDim.y * gridDim.z;
    unsigned sum, cnt, mine, sp = 0u;
    for (;;) {
        sum = 0u; cnt = 0u; mine = 0u;
#pragma unroll
        for (unsigned j = 0; j < 16; ++j) { const unsigned c = xb_ld(&bar[XB_XCNT(j)]); sum += c; cnt += (c > 0u) ? 1u : 0u; mine = (j == x) ? c : mine; }
        if (sum == G) break;
        __builtin_amdgcn_s_sleep(1);
        if ((++sp & 255u) == 0u) { if (xb_ld(&bar[XB_TMO])) break; if (sp > XB_SPIN_CAP) { atomicAdd(&bar[XB_TMO], 1u); break; } }
    }
    nloc = mine > 0u ? mine : 1u; nx = cnt > 0u ? cnt : 1u;
}

__device__ __forceinline__ void xcd_barrier(const XcdBarrier& b) {
    asm volatile("s_waitcnt vmcnt(0)" ::: "memory");
    __syncthreads();
    if (threadIdx.x == 0) {
        unsigned* bar = b.bar;
        __builtin_amdgcn_s_waitcnt(0);
        unsigned nloc = b.st[0], nx = b.st[1];
        if (nloc == 0u) { xcd_barrier_complete(bar, b.x, nloc, nx); b.st[0] = nloc; b.st[1] = nx; }
        const unsigned old = xb_add(&bar[XB_XSUB(b.x)], 1u);
        const unsigned gen = old / nloc;
        if (old + 1u == (gen + 1u) * nloc) {
            __builtin_amdgcn_fence(__ATOMIC_RELEASE, "agent");
            asm volatile("s_waitcnt vmcnt(0)" ::: "memory");
            const unsigned og = xb_add(&bar[XB_TOP], 1u);
            const unsigned tg = og / nx;
            if (og + 1u == (tg + 1u) * nx) xb_add(&bar[XB_TOPGEN], 1u);
            else XB_SPIN(xb_ld(&bar[XB_TOPGEN]) == tg, bar);
            __builtin_amdgcn_fence(__ATOMIC_ACQUIRE, "agent");
            xb_add(&bar[XB_XGEN(b.x)], 1u);
            asm volatile("s_waitcnt vmcnt(0)" ::: "memory");
        } else {
            XB_SPIN(xb_ld(&bar[XB_XGEN(b.x)]) == gen, bar);
            __builtin_amdgcn_fence(__ATOMIC_ACQUIRE, "agent");
            asm volatile("s_waitcnt vmcnt(0)" ::: "memory");
        }
    }
    __syncthreads();
}

constexpr int NWAVES = 8, NTHR = 512;
constexpr int BATCH = 4, SEQ = 4096, DM = 1024, TOK = BATCH * SEQ;
constexpr int INW = 9728;
constexpr int C_RQ = 0, C_RK = 512, C_RV = 1024, C_RG = 2048, C_AQ = 3072, C_AK = 4608, C_AV = 6144, C_GA = 7680, C_GB = 8704;
constexpr int NEXP = 32, FF = 1024, FF2 = 2048;
constexpr int MAXROWS = TOK * 4 + NEXP * 256;
constexpr float RMS_EPS = 1e-6f, GN_EPS = 1e-5f;
constexpr size_t MiB = 1u << 20;
constexpr size_t WS_CTL = 0, CTL_ZERO_BYTES = 32 * 1024;
constexpr size_t WS_ROPE = 1 * MiB;
constexpr size_t WS_WRT = 3 * MiB;
constexpr int N16 = 3072;
constexpr size_t WS_WIN8 = 12 * MiB;
constexpr size_t WS_WIN = 4 * MiB, WS_WRET = 24 * MiB  , WS_WO = 27 * MiB;
constexpr size_t WS_W1 = 32 * MiB, WS_W2 = 160 * MiB;
constexpr size_t WS_H8 = 208 * MiB;
constexpr size_t WS_H = 224 * MiB;
constexpr size_t WS_U = 256 * MiB;
constexpr size_t WS_KV = 560 * MiB;
constexpr size_t WS_RT = 624 * MiB;
constexpr size_t WS_RET = 656 * MiB;
constexpr int RA_LD = 1536;
constexpr size_t WS_OG = 704 * MiB;
constexpr size_t WS_LSE = 752 * MiB;
constexpr size_t WS_MERGED = 753 * MiB;
constexpr size_t WS_XMID = 849 * MiB;
constexpr size_t WS_XIN = 256 * MiB;
constexpr int XCAP = 16384;
constexpr size_t WS_A = 768 * MiB;
constexpr size_t WS_YB = 913 * MiB;
constexpr size_t WS_TE = 1000 * MiB, WS_TP = WS_TE + 256 * 1024, WS_TG = WS_TP + 256 * 1024;
constexpr size_t WS_END = 1002 * MiB;
static_assert(WS_XIN + (size_t)NEXP * XCAP * 1024 <= WS_A && WS_A + (size_t)MAXROWS * 1024 <= WS_XMID && WS_XMID + (size_t)TOK * DM * 4 <= WS_YB && WS_YB + (size_t)MAXROWS * 1024 <= WS_TE, "MoE map");
constexpr int CW_BAR = 4096;
constexpr int CW_MOD = 8192;
constexpr int CW_CNT = 7680;
constexpr int CW_MODRDY = 7744;
static_assert(CW_BAR + 3456 <= CW_CNT && (CW_MODRDY + 64) * 4 <= (int)CTL_ZERO_BYTES && CW_MODRDY + 64 <= CW_MOD, "ctl");
constexpr int LDS_BYTES = 160 * 1024 - 512, MISC_OFF = LDS_BYTES - 256;

__device__ __forceinline__ float bflo(unsigned w) { return __uint_as_float(w << 16); }
__device__ __forceinline__ float bfhi(unsigned w) { return __uint_as_float(w & 0xffff0000u); }
typedef float f32x2_t_ __attribute__((ext_vector_type(2))); typedef __bf16 bf16x2_t_ __attribute__((ext_vector_type(2)));
__device__ __forceinline__ unsigned cvtpk(float lo, float hi) { const f32x2_t_ v = {lo, hi}; const bf16x2_t_ b = __builtin_convertvector(v, bf16x2_t_); return __builtin_bit_cast(unsigned, b); }
__device__ __forceinline__ unsigned f8x2bf(unsigned w, bool hi) { typedef float f32x2_ __attribute__((ext_vector_type(2))); const f32x2_ f = hi ? __builtin_amdgcn_cvt_pk_f32_fp8((int)w, true) : __builtin_amdgcn_cvt_pk_f32_fp8((int)w, false); return cvtpk(f.x, f.y); }
__device__ __forceinline__ float wave_sum(float v) {
#pragma unroll
    for (int o = 1; o < 64; o <<= 1) v += __shfl_xor(v, o);
    return v;
}
static __device__ const double ROPE_C[64] = {0.15915494309189535, 0.13782250260398285, 0.11934937021124886, 0.10335229661843406, 0.089499401608891013, 0.077503288755374058, 0.067115083005227255, 0.058119267441876246, 0.050329212104487035, 0.04358330210530733, 0.037741584717419771, 0.032682865872356998, 0.028302195830623399, 0.024508691862069852, 0.02122365276477766, 0.018378926105679667, 0.015915494309189534, 0.013782250260398284, 0.011934937021124886, 0.010335229661843406, 0.0089499401608891024, 0.0077503288755374055, 0.0067115083005227253, 0.0058119267441876241, 0.0050329212104487037, 0.0043583302105307331, 0.0037741584717419772, 0.0032682865872356993, 0.0028302195830623399, 0.0024508691862069852, 0.0021223652764777662, 0.0018378926105679667, 0.0015915494309189536, 0.0013782250260398288, 0.0011934937021124885, 0.0010335229661843405, 0.00089499401608891024, 0.00077503288755374051, 0.0006711508300522726, 0.00058119267441876239, 0.00050329212104487033, 0.00043583302105307329, 0.00037741584717419774, 0.00032682865872356992, 0.00028302195830623395, 0.00024508691862069854, 0.00021223652764777661, 0.00018378926105679666, 0.00015915494309189535, 0.00013782250260398286, 0.00011934937021124886, 0.00010335229661843406, 8.9499401608891018e-05, 7.7503288755374056e-05, 6.7115083005227254e-05, 5.8119267441876239e-05, 5.0329212104487035e-05, 4.3583302105307322e-05, 3.7741584717419777e-05, 3.2682865872356999e-05, 2.8302195830623396e-05, 2.4508691862069852e-05, 2.1223652764777659e-05, 1.8378926105679668e-05};
__device__ __forceinline__ float log2g(int h) { return h == 0 ? -0.0458036896f : (h == 1 ? -0.0227200765f : (h == 2 ? -0.0113153132f : -0.00564656314f)); }

constexpr size_t UBLK = (size_t)TOK * 256; constexpr int ULD = 256;
__device__ __forceinline__ const bf16* ucol(const unsigned char* ws, int col) { return (const bf16*)(ws + WS_U) + (size_t)(col >> 8) * UBLK + (col & 255); }
__device__ __forceinline__ const unsigned char* ucol8(const unsigned char* ws, int col) { return ws + WS_U + (size_t)(N16 / 256) * UBLK * 2 + (size_t)((col >> 8) - N16 / 256) * UBLK + (col & 255); }
typedef short v4i16_t __attribute__((ext_vector_type(4)));
struct Args { const float* in[18]; float* out; unsigned char* ws; int ph_lo, ph_hi; };
struct Frame { LAS unsigned char* lds; volatile LAS unsigned* MISC; gu32* ctl; int tid, lane, wave, vcu, G; };

template <bool F8, int NB = 32>
__device__ __forceinline__ void p0_transpose_item(const float* W, int K, int N, bf16* WT, LAS float* scr, int item, int lane, int ldk = 0) {
    if (ldk == 0) ldk = K;
    const int nblk = N / 32, kb = item / nblk, nb = item % nblk, k0 = 64 * kb, n0 = 32 * nb;
#pragma unroll
    for (int hb = 0; hb < 32 / NB; ++hb) { float t[NB];
      const float* wp = W + (size_t)(k0 + 2 * NB * hb + (lane >> 5)) * N + n0 + (lane & 31);
#pragma unroll
      for (int i = 0; i < NB; ++i) t[i] = __builtin_nontemporal_load(wp + (size_t)(2 * i) * N);
#pragma unroll
      for (int i = 0; i < NB; ++i) scr[(2 * (NB * hb + i) + (lane >> 5)) * 33 + (lane & 31)] = t[i]; }
    LDS_WAIT(); asm volatile("" ::: "memory");
    const int c = lane & 7;
#pragma unroll
    for (int j = 0; j < 4; ++j) { const int n = (lane >> 3) + 8 * j; const LAS float* s = scr + (8 * c) * 33 + n;
        if (F8) { int w0 = 0, w1 = 0;
            w0 = __builtin_amdgcn_cvt_pk_fp8_f32(s[0 * 33] * 32.f, s[1 * 33] * 32.f, w0, false); w0 = __builtin_amdgcn_cvt_pk_fp8_f32(s[2 * 33] * 32.f, s[3 * 33] * 32.f, w0, true);
            w1 = __builtin_amdgcn_cvt_pk_fp8_f32(s[4 * 33] * 32.f, s[5 * 33] * 32.f, w1, false); w1 = __builtin_amdgcn_cvt_pk_fp8_f32(s[6 * 33] * 32.f, s[7 * 33] * 32.f, w1, true);
            typedef int i32x2 __attribute__((ext_vector_type(2)));
            *(GAS i32x2*)((unsigned char*)WT + (size_t)(n0 + n) * ldk + k0 + 8 * c) = (i32x2){w0, w1};
        } else { v4u o; o.x = pk2(s[0 * 33], s[1 * 33]); o.y = pk2(s[2 * 33], s[3 * 33]); o.z = pk2(s[4 * 33], s[5 * 33]); o.w = pk2(s[6 * 33], s[7 * 33]);
            *(GAS v4u*)(WT + (size_t)(n0 + n) * ldk + k0 + 8 * c) = o; } }
    LDS_WAIT(); asm volatile("" ::: "memory");
}
__device__ __forceinline__ void p0_prologue(const Args& a, Frame& F) {
    const int gw = F.vcu * NWAVES + F.wave, NGW = F.G * NWAVES;
    { float2* rope = (float2*)(a.ws + WS_ROPE);
      for (int idx = F.vcu * NTHR + F.tid; idx < SEQ * 64; idx += F.G * NTHR) { const int pos = idx >> 6, i = idx & 63;
          double rev = (double)pos * ROPE_C[i]; rev -= __builtin_floor(rev); const float f = (float)rev;
          rope[idx] = make_float2(__builtin_amdgcn_cosf(f), __builtin_amdgcn_sinf(f)); } }
    { bf16* wrt = (bf16*)(a.ws + WS_WRT); const float* wr = a.in[11];
      for (int idx = F.vcu * NTHR + F.tid; idx < 1024 * 32; idx += F.G * NTHR) { const int k = idx >> 5, e = idx & 31; const float w = wr[idx];
          const unsigned hi = f2bf(w); const float lo = w - __uint_as_float(hi << 16); wrt[e * 1024 + k] = (bf16)hi; wrt[32768 + e * 1024 + k] = (bf16)f2bf(lo); } }
    if (F.vcu < 96) { float* mod = (float*)(a.ws + WS_CTL) + CW_MOD; const float* c = a.in[1]; const float* w_ada = a.in[2]; const float* b_ada = a.in[3];
      const int cg = F.vcu, col = cg * 64 + F.lane; LAS float* red = (LAS float*)(F.lds + 8 * 16384);
      float acc[4] = {0.f, 0.f, 0.f, 0.f};
      for (int kc = 0; kc < 2; ++kc) { const int k0 = F.wave * 128 + kc * 64; float cs[4];
#pragma unroll
          for (int b = 0; b < 4; ++b) { const float cv = c[b * DM + k0 + F.lane]; cs[b] = cv / (1.0f + __expf(-cv)); }
#pragma unroll 16
          for (int kk = 0; kk < 64; ++kk) { const float w = w_ada[(size_t)(k0 + kk) * 6144 + col];
#pragma unroll
              for (int b = 0; b < 4; ++b) acc[b] += __shfl(cs[b], kk) * w; } }
#pragma unroll
      for (int b = 0; b < 4; ++b) red[(F.wave * 4 + b) * 64 + F.lane] = acc[b];
      __syncthreads();
      if (F.tid < 256) { const int b = F.tid >> 6, ln = F.tid & 63; float s = b_ada[cg * 64 + ln];
#pragma unroll
          for (int w = 0; w < 8; ++w) s += red[(w * 4 + b) * 64 + ln];
          mod[b * 6144 + cg * 64 + ln] = s; }
      asm volatile("s_waitcnt vmcnt(0)" ::: "memory"); __syncthreads();
      if (F.tid == 0) { __builtin_amdgcn_fence(__ATOMIC_RELEASE, "agent"); asm volatile("s_waitcnt vmcnt(0)" ::: "memory"); __hip_atomic_fetch_add(F.ctl + CW_MODRDY, 1u, RLX_AGENT); } }
    { LAS float* scr = (LAS float*)(F.lds + F.wave * 16384);
      constexpr int I_IN = 16 * (INW / 32), I_RET = 16 * 32, I_ATT = 8 * 32, I_O = 16 * 32, I_1E = 16 * 64, I_2E = 16 * 32;
      constexpr int NITEMS = I_IN + I_RET + I_ATT + I_O;
      if (F.vcu >= 96 || F.G <= 96)
      for (int it = (F.G > 96 ? gw - 96 * NWAVES : gw); it < NITEMS; it += (F.G > 96 ? NGW - 96 * NWAVES : NGW)) { int r = it;
          if (r < I_IN) { const int nb = r % (INW / 32);
              if (nb < N16 / 32) p0_transpose_item<false>(a.in[5], 1024, INW, (bf16*)(a.ws + WS_WIN), scr, r, F.lane);
              else p0_transpose_item<true>(a.in[5], 1024, INW, (bf16*)(a.ws + WS_WIN8 - (size_t)N16 * 1024), scr, r, F.lane);
              continue; } r -= I_IN;
          if (r < I_RET) { p0_transpose_item<true>(a.in[7], 1024, 1024, (bf16*)(a.ws + WS_WRET), scr, r, F.lane, RA_LD); continue; } r -= I_RET;
          if (r < I_ATT) { p0_transpose_item<true>(a.in[8], 512, 1024, (bf16*)(a.ws + WS_WRET + 1024), scr, r, F.lane, RA_LD); continue; } r -= I_ATT;
          p0_transpose_item<false>(a.in[9], 1024, 1024, (bf16*)(a.ws + WS_WO), scr, r, F.lane); } }
}
__device__ __forceinline__ void moe_item8(const float* W, int N, unsigned char* WT8, LAS bf16* scr, int item, int lane) {
    const int nblk = N / 32, kb = item / nblk, nb = item % nblk, k0 = 128 * kb, n0 = 32 * nb, rr = lane >> 3, cq = lane & 7;
    typedef unsigned u32x2 __attribute__((ext_vector_type(2)));
    f32x4 t[16];
    { const float* wp = W + (size_t)(k0 + rr) * N + n0 + 4 * cq;
#pragma unroll
      for (int i = 0; i < 16; ++i) t[i] = __builtin_nontemporal_load((const GAS f32x4*)(wp + (size_t)(8 * i) * N)); }
#pragma unroll
    for (int i = 0; i < 16; ++i) *(LAS u32x2*)(scr + (8 * i + rr) * 40 + 4 * cq) = (u32x2){cvtpk(t[i].x, t[i].y), cvtpk(t[i].z, t[i].w)};
    LDS_WAIT(); asm volatile("" ::: "memory");
    const int g = lane >> 4, i15 = lane & 15, qq = i15 >> 2, p = i15 & 3;
#pragma unroll
    for (int c0 = 0; c0 < 32; c0 += 16)
#pragma unroll
        for (int kh = 0; kh < 2; ++kh) { const LAS bf16* a0 = scr + (64 * kh + 16 * g + qq) * 40 + c0 + 4 * p; v4u o;
#pragma unroll
            for (int sb = 0; sb < 4; ++sb) { const v4i16_t v = __builtin_amdgcn_ds_read_tr16_b64_v4i16((LAS v4i16_t*)(a0 + 4 * sb * 40)); const u32x2 w2 = __builtin_bit_cast(u32x2, v);
                int w8 = 0; w8 = __builtin_amdgcn_cvt_pk_fp8_f32(bflo(w2.x) * 32.f, bfhi(w2.x) * 32.f, w8, false); w8 = __builtin_amdgcn_cvt_pk_fp8_f32(bflo(w2.y) * 32.f, bfhi(w2.y) * 32.f, w8, true);
                if (sb == 0) o.x = (unsigned)w8; else if (sb == 1) o.y = (unsigned)w8; else if (sb == 2) o.z = (unsigned)w8; else o.w = (unsigned)w8; }
            *(GAS v4u*)(WT8 + (size_t)(n0 + c0 + i15) * 1024 + k0 + 64 * kh + 16 * g) = o; }
    LDS_WAIT(); asm volatile("" ::: "memory");
}
__device__ __forceinline__ void moe_convert(const Args& a, Frame& F, int k0, int nk) {
    LAS bf16* scr = (LAS bf16*)(F.lds + F.wave * 16384); const int gw = F.vcu * NWAVES + F.wave, NGW = F.G * NWAVES;
    constexpr int I_1E = 8 * 64, I_2E = 8 * 32;
    for (int k = k0; k < k0 + nk; ++k) { int r = gw + NGW * k;
        if (r < NEXP * I_1E) { const int e = r / I_1E; moe_item8(a.in[13] + (size_t)e * 1024 * FF2, FF2, a.ws + WS_W1 + (size_t)e * FF2 * 1024, scr, r % I_1E, F.lane); continue; } r -= NEXP * I_1E;
        if (r < NEXP * I_2E) { const int e = r / I_2E; moe_item8(a.in[15] + (size_t)e * FF * 1024, 1024, a.ws + WS_W2 + (size_t)e * 1024 * FF, scr, r % I_2E, F.lane); } }
}
__device__ __forceinline__ void norm_mod_row(const float* xrow, const float* g, const float* sc, const float* sh, bf16* orow, unsigned char* orow8, int lane) {
    const GAS f32x4* xr = (const GAS f32x4*)xrow + lane; f32x4 v[4]; float s = 0.f;
#pragma unroll
    for (int j = 0; j < 4; ++j) { v[j] = __builtin_nontemporal_load(xr + 64 * j); s += (v[j].x * v[j].x + v[j].y * v[j].y) + (v[j].z * v[j].z + v[j].w * v[j].w); }
    const float rstd = 1.0f / sqrtf(wave_sum(s) * (1.0f / DM) + RMS_EPS);
    GAS int* o4 = (GAS int*)orow8 + lane; GAS unsigned long long* o8 = (GAS unsigned long long*)orow + lane;
#pragma unroll
    for (int j = 0; j < 4; ++j) { const int c = 4 * (64 * j + lane); const f32x4 gg = *(const f32x4*)(g + c), ss = *(const f32x4*)(sc + c), hh = *(const f32x4*)(sh + c);
        const f32x4 o = v[j] * rstd * gg * (ss + 1.0f) + hh;
        int w8 = 0; w8 = __builtin_amdgcn_cvt_pk_fp8_f32(o.x, o.y, w8, false); w8 = __builtin_amdgcn_cvt_pk_fp8_f32(o.z, o.w, w8, true);
        o4[64 * j] = w8; o8[64 * j] = (unsigned long long)cvtpk(o.x, o.y) | ((unsigned long long)cvtpk(o.z, o.w) << 32); }
}
__device__ __forceinline__ void p1_norm1(const Args& a, Frame& F) {
    const int gw = F.vcu * NWAVES + F.wave, NGW = F.G * NWAVES, lane = F.lane; const float* mod = (const float*)(a.ws + WS_CTL) + CW_MOD;
    bool waited = false;
    for (int m0 = gw; m0 < TOK; m0 += 4 * NGW) {
        f32x4 v[4][4]; float rstd[4];
#pragma unroll
        for (int r = 0; r < 4; ++r) { const int m = m0 + r * NGW; const GAS f32x4* xr = (const GAS f32x4*)(a.in[0] + (size_t)(m < TOK ? m : m0) * DM) + lane;
#pragma unroll
            for (int j = 0; j < 4; ++j) v[r][j] = __builtin_nontemporal_load(xr + 64 * j); }
#pragma unroll
        for (int r = 0; r < 4; ++r) { float s = 0.f;
#pragma unroll
            for (int j = 0; j < 4; ++j) s += (v[r][j].x * v[r][j].x + v[r][j].y * v[r][j].y) + (v[r][j].z * v[r][j].z + v[r][j].w * v[r][j].w);
            rstd[r] = 1.0f / sqrtf(wave_sum(s) * (1.0f / DM) + RMS_EPS); }
        if (!waited) { waited = true;
            if (F.tid == 0) { unsigned sp = 0;
                while (__hip_atomic_load(F.ctl + CW_MODRDY, RLX_AGENT) < 96u && ++sp < (1u << 22)) __builtin_amdgcn_s_sleep(2);
                __builtin_amdgcn_fence(__ATOMIC_ACQUIRE, "agent"); asm volatile("s_waitcnt vmcnt(0)" ::: "memory"); }
            __syncthreads(); }
#pragma unroll
        for (int r = 0; r < 4; ++r) { const int m = m0 + r * NGW; if (m < TOK) { const int b = m / SEQ; const float* g = a.in[4]; const float* sc = mod + b * 6144 + 1024; const float* sh = mod + b * 6144;
            GAS int* o4 = (GAS int*)(a.ws + WS_H8 + (size_t)m * DM) + lane; GAS unsigned long long* o8 = (GAS unsigned long long*)((bf16*)(a.ws + WS_H) + (size_t)m * DM) + lane;
#pragma unroll
            for (int j = 0; j < 4; ++j) { const int c = 4 * (64 * j + lane); const f32x4 gg = *(const f32x4*)(g + c), ss = *(const f32x4*)(sc + c), hh = *(const f32x4*)(sh + c);
                const f32x4 o = v[r][j] * rstd[r] * gg * (ss + 1.0f) + hh;
                int w8 = 0; w8 = __builtin_amdgcn_cvt_pk_fp8_f32(o.x, o.y, w8, false); w8 = __builtin_amdgcn_cvt_pk_fp8_f32(o.z, o.w, w8, true);
                o4[64 * j] = w8; o8[64 * j] = (unsigned long long)cvtpk(o.x, o.y) | ((unsigned long long)cvtpk(o.z, o.w) << 32); } } }
    }
    if (!waited) { __syncthreads(); }
}

#define MFMA16(a, b, c) __builtin_amdgcn_mfma_f32_16x16x32_bf16((a), (b), (c), 0, 0, 0)
__device__ __forceinline__ bf16x8 ldsfrag(const LAS bf16* base, int pitch, int row0, int k0, int lane) { return *(const LAS bf16x8*)(base + (row0 + (lane & 15)) * pitch + k0 + 8 * (lane >> 4)); }

__device__ __forceinline__ bf16x8 ldsfrag_tr(const LAS bf16* M, int pitch, int k0, int c0, int lane) {
    const int g = lane >> 4, i = lane & 15, qq = i >> 2, p = i & 3;
    const LAS bf16* a0 = M + (k0 + 8 * g + qq) * pitch + c0 + 4 * p;
    const v4i16_t lo = __builtin_amdgcn_ds_read_tr16_b64_v4i16((LAS v4i16_t*)a0), hi = __builtin_amdgcn_ds_read_tr16_b64_v4i16((LAS v4i16_t*)(a0 + 4 * pitch));
    return (bf16x8){lo[0], lo[1], lo[2], lo[3], hi[0], hi[1], hi[2], hi[3]};
}
constexpr int AT_KP = 136, AT_PP = 168;
constexpr int AT_KS = 0, AT_VS = 256 * AT_KP * 2, AT_BIAS = AT_VS + 272 * AT_KP * 2;
struct AttnU { const unsigned char *Qb, *Kb, *Vb; size_t rstride; int i0, r, g, hh; size_t tok0; };
__device__ __forceinline__ AttnU attn_decode(const Args& a, int U) {
    AttnU u; const int ub = U & 31; u.hh = (U >> 5) & 3; u.g = (U >> 7) % 3; const int b = U / 384;
    const int rs = 2 * u.g; u.r = 1 << rs; const int ares = ub & (u.r - 1), blk = ub >> rs; u.i0 = blk * 128;
    u.tok0 = (size_t)(b * SEQ + ares); u.rstride = (size_t)u.r * ULD; const int hc = (u.g * 4 + u.hh) * 128;
    u.Qb = ucol8(a.ws, C_AQ + hc) + u.tok0 * ULD; u.Kb = ucol8(a.ws, C_AK + hc) + u.tok0 * ULD; u.Vb = ucol8(a.ws, C_AV + hc) + u.tok0 * ULD;
    return u;
}
__device__ __forceinline__ void attn_phase(const Args& a, Frame& F) {
    LAS bf16* KS = (LAS bf16*)(F.lds + AT_KS); LAS bf16* VS = (LAS bf16*)(F.lds + AT_VS); LAS float* BIAS = (LAS float*)(F.lds + AT_BIAS);
    const int tid = F.tid, lane = F.lane, w = F.wave, q = lane >> 4, l15 = lane & 15;
    typedef unsigned u32x2 __attribute__((ext_vector_type(2)));
    int U = F.vcu; if (U >= 1536) return;
    v4u kreg[4], vreg[4];
    { const AttnU u = attn_decode(a, U);
#pragma unroll
      for (int it = 0; it < 4; ++it) { const int c = tid + NTHR * it, kk = c >> 3, ch = c & 7; int i = u.i0 - 128 + kk; i = i < 0 ? 0 : i;
          const size_t ro = (size_t)i * u.rstride + ch * 16; kreg[it] = *(const GAS v4u*)(u.Kb + ro); vreg[it] = *(const GAS v4u*)(u.Vb + ro); }
    }
    if (tid < 256) { LAS v4u* z = (LAS v4u*)(VS + (256 + (tid >> 4)) * AT_KP + (tid & 15) * 8); z[0] = (v4u){0u, 0u, 0u, 0u}; }
    const bool bg_pre = (F.vcu & 1) != 0; int slot = 0;
    for (; U < 1536; U += F.G, ++slot) {
        if (bg_pre) { moe_convert(a, F, 2 * slot, 2); __syncthreads(); }
        const AttnU u = attn_decode(a, U);
        bf16x8 qf[4];
        { const unsigned char* qrow = u.Qb + (size_t)(u.i0 + 16 * w + l15) * u.rstride + 8 * q; typedef unsigned u32x2q __attribute__((ext_vector_type(2)));
          u32x2q qb[4];
#pragma unroll
          for (int ks = 0; ks < 4; ++ks) qb[ks] = *(const GAS u32x2q*)(qrow + 32 * ks);
#pragma unroll
          for (int ks = 0; ks < 4; ++ks) qf[ks] = __builtin_bit_cast(bf16x8, (v4u){f8x2bf(qb[ks].x, false), f8x2bf(qb[ks].x, true), f8x2bf(qb[ks].y, false), f8x2bf(qb[ks].y, true)}); }
#pragma unroll
        for (int it = 0; it < 4; ++it) { const int c = tid + NTHR * it, kk = c >> 3, ch = c & 7; const bool ok = (u.i0 - 128 + kk) >= 0;
            const v4u kz = ok ? kreg[it] : (v4u){0u, 0u, 0u, 0u}, vz = ok ? vreg[it] : (v4u){0u, 0u, 0u, 0u};
            *(LAS v4u*)(KS + kk * AT_KP + ch * 16) = (v4u){f8x2bf(kz.x, false), f8x2bf(kz.x, true), f8x2bf(kz.y, false), f8x2bf(kz.y, true)};
            *(LAS v4u*)(KS + kk * AT_KP + ch * 16 + 8) = (v4u){f8x2bf(kz.z, false), f8x2bf(kz.z, true), f8x2bf(kz.w, false), f8x2bf(kz.w, true)};
            *(LAS v4u*)(VS + kk * AT_KP + ch * 16) = (v4u){f8x2bf(vz.x, false), f8x2bf(vz.x, true), f8x2bf(vz.y, false), f8x2bf(vz.y, true)};
            *(LAS v4u*)(VS + kk * AT_KP + ch * 16 + 8) = (v4u){f8x2bf(vz.z, false), f8x2bf(vz.z, true), f8x2bf(vz.w, false), f8x2bf(vz.w, true)}; }
        if (tid < 129) { const int dist = u.r * tid; int bk;
            if (dist < 16) bk = dist; else { bk = 16 + (int)(__log2f((float)dist * 0.0625f) * (16.0f / 7.0f)); bk = bk > 31 ? 31 : bk; }
            BIAS[tid] = a.in[6][bk * 12 + u.g * 4 + u.hh]; }
        __syncthreads();
        if (U + F.G < 1536) { const AttnU n = attn_decode(a, U + F.G);
#pragma unroll
            for (int it = 0; it < 4; ++it) { const int c = tid + NTHR * it, kk = c >> 3, ch = c & 7; int i = n.i0 - 128 + kk; i = i < 0 ? 0 : i;
                const size_t ro = (size_t)i * n.rstride + ch * 16; kreg[it] = *(const GAS v4u*)(n.Kb + ro); vreg[it] = *(const GAS v4u*)(n.Vb + ro); } }
        f32x4 s[9];
#pragma unroll
        for (int t9 = 0; t9 < 9; ++t9) { f32x4 acc = (f32x4){0.f, 0.f, 0.f, 0.f};
#pragma unroll
            for (int ks = 0; ks < 4; ++ks) acc = MFMA16(ldsfrag(KS, AT_KP, 16 * (w + t9), 32 * ks, lane), qf[ks], acc);
            s[t9] = acc; }
        const float scale = 0.08838834764831845f;
        float mx = -INFINITY;
#pragma unroll
        for (int t9 = 0; t9 < 9; ++t9)
#pragma unroll
            for (int rr = 0; rr < 4; ++rr) { const int krel = 16 * t9 + 4 * q + rr, dist = 128 + l15 - krel; const bool valid = (dist >= 0) && (dist <= 128) && (u.i0 - 128 + 16 * w + krel >= 0);
                const float v = valid ? s[t9][rr] * scale + BIAS[valid ? dist : 0] : -INFINITY; s[t9][rr] = v; mx = fmaxf(mx, v); }
        mx = fmaxf(mx, __shfl_xor(mx, 16)); mx = fmaxf(mx, __shfl_xor(mx, 32));
        float lsum = 0.f;
#pragma unroll
        for (int t9 = 0; t9 < 9; ++t9)
#pragma unroll
            for (int rr = 0; rr < 4; ++rr) { const float p = __expf(s[t9][rr] - mx); s[t9][rr] = p; lsum += p; }
        lsum += __shfl_xor(lsum, 16); lsum += __shfl_xor(lsum, 32);
        __syncthreads();
        LAS bf16* PS = KS + w * 16 * AT_PP;
#pragma unroll
        for (int t9 = 0; t9 < 9; ++t9) *(LAS u32x2*)(PS + l15 * AT_PP + 16 * t9 + 4 * q) = (u32x2){cvtpk(s[t9][0], s[t9][1]), cvtpk(s[t9][2], s[t9][3])};
        *(LAS u32x2*)(PS + l15 * AT_PP + 144 + 4 * q) = (u32x2){0u, 0u};
        __syncthreads();
        bf16x8 pf[5];
#pragma unroll
        for (int ks = 0; ks < 5; ++ks) pf[ks] = ldsfrag(PS, AT_PP, 0, 32 * ks, lane);
        const float inv = 1.0f / lsum;
        const size_t tokrow = u.tok0 + (size_t)(u.i0 + 16 * w + l15) * u.r;
        bf16* og = (bf16*)(a.ws + WS_OG) + (size_t)u.g * TOK * 512 + tokrow * 512 + u.hh * 128 + 4 * q;
#pragma unroll
        for (int dp = 0; dp < 8; dp += 2) { u32x2 pc[2];
#pragma unroll
            for (int d2 = 0; d2 < 2; ++d2) { f32x4 acc = (f32x4){0.f, 0.f, 0.f, 0.f};
#pragma unroll
                for (int ks = 0; ks < 5; ++ks) acc = MFMA16(ldsfrag_tr(VS, AT_KP, 16 * w + 32 * ks, 16 * (dp + d2), lane), pf[ks], acc);
                pc[d2] = (u32x2){cvtpk(acc[0] * inv, acc[1] * inv), cvtpk(acc[2] * inv, acc[3] * inv)}; }
            const bool odd = (q & 1) != 0;
            const unsigned r0 = (unsigned)__shfl_xor((int)(odd ? pc[0].x : pc[1].x), 16), r1 = (unsigned)__shfl_xor((int)(odd ? pc[0].y : pc[1].y), 16);
            *(GAS v4u*)(og - 4 * (q & 1) + 16 * (dp + (odd ? 1 : 0))) = odd ? (v4u){r0, r1, pc[1].x, pc[1].y} : (v4u){pc[0].x, pc[0].y, r0, r1}; }
        if (q == 0) ((float*)(a.ws + WS_LSE))[(size_t)u.g * TOK * 4 + tokrow * 4 + u.hh] = mx + __logf(lsum);
        __syncthreads();
        if (!bg_pre) { moe_convert(a, F, 2 * slot, 2); __syncthreads(); }
    }
}

constexpr int RT_P = 136, RV_P = 264;
struct RotRegs { v4u lo[2], hi[2]; };
__device__ __forceinline__ void rot_issue(Frame& F, const bf16* src, RotRegs& r) {
#pragma unroll
    for (int it = 0; it < 2; ++it) { const int pc = F.tid + NTHR * it, j = pc >> 3, d0 = (pc & 7) * 8; r.lo[it] = *(const GAS v4u*)(src + (size_t)j * ULD + d0); r.hi[it] = *(const GAS v4u*)(src + (size_t)j * ULD + d0 + 64); }
}
__device__ __forceinline__ void rope_issue(const Args& a, Frame& F, int pos0, f32x4 (&cs)[2][4]) {
    const float* rope = (const float*)(a.ws + WS_ROPE);
#pragma unroll
    for (int it = 0; it < 2; ++it) { const int pc = F.tid + NTHR * it, j = pc >> 3, d0 = (pc & 7) * 8; const GAS f32x4* rp = (const GAS f32x4*)(rope + ((size_t)(pos0 + j) * 64 + d0) * 2);
#pragma unroll
        for (int i = 0; i < 4; ++i) cs[it][i] = rp[i]; }
}
template <bool ZETA>
__device__ __forceinline__ void rot_finish(Frame& F, const RotRegs& r, const f32x4 (&cs)[2][4], float mul, float l2g, LAS bf16* dst) {
#pragma unroll
    for (int it = 0; it < 2; ++it) { const int pc = F.tid + NTHR * it, j = pc >> 3, d0 = (pc & 7) * 8;
        const float m = ZETA ? mul * __builtin_amdgcn_exp2f((float)(127 - j) * l2g) : mul;
        float ol[8], oh[8];
#pragma unroll
        for (int i = 0; i < 8; ++i) { const unsigned wl = i < 2 ? r.lo[it].x : (i < 4 ? r.lo[it].y : (i < 6 ? r.lo[it].z : r.lo[it].w)), wh = i < 2 ? r.hi[it].x : (i < 4 ? r.hi[it].y : (i < 6 ? r.hi[it].z : r.hi[it].w));
            const float tl = (i & 1) ? bfhi(wl) : bflo(wl), th = (i & 1) ? bfhi(wh) : bflo(wh); const float c = (i & 1) ? cs[it][i >> 1].z : cs[it][i >> 1].x, sn = (i & 1) ? cs[it][i >> 1].w : cs[it][i >> 1].y;
            ol[i] = (tl * c - th * sn) * m; oh[i] = (tl * sn + th * c) * m; }
        *(LAS v4u*)(dst + j * RT_P + d0) = (v4u){cvtpk(ol[0], ol[1]), cvtpk(ol[2], ol[3]), cvtpk(ol[4], ol[5]), cvtpk(ol[6], ol[7])};
        *(LAS v4u*)(dst + j * RT_P + d0 + 64) = (v4u){cvtpk(oh[0], oh[1]), cvtpk(oh[2], oh[3]), cvtpk(oh[4], oh[5]), cvtpk(oh[6], oh[7])}; }
}
__device__ __forceinline__ void v_issue(Frame& F, const bf16* src, v4u (&t)[8]) {
#pragma unroll
    for (int it = 0; it < 8; ++it) { const int c = F.tid + NTHR * it, j = c >> 5, ch = c & 31; t[it] = *(const GAS v4u*)(src + (size_t)j * ULD + ch * 8); }
}
__device__ __forceinline__ void v_finish(Frame& F, const v4u (&t)[8], LAS bf16* VS) {
#pragma unroll
    for (int it = 0; it < 8; ++it) { const int c = F.tid + NTHR * it, j = c >> 5, ch = c & 31; *(LAS v4u*)(VS + j * RV_P + ch * 8) = t[it]; }
}
__device__ __forceinline__ void ret_kv_item(const Args& a, Frame& F, int item) {
    const int h = item & 3, n = (item >> 2) & 31, b = item >> 7; const float l2g = log2g(h);
    const size_t r0 = (size_t)(b * SEQ + n * 128) * ULD;
    LAS bf16* KZ = (LAS bf16*)F.lds; LAS bf16* VS = (LAS bf16*)(F.lds + 128 * RT_P * 2);
    { RotRegs kr; f32x4 cs[2][4]; v4u vt[8];
      rot_issue(F, ucol(a.ws, C_RK + h * 128) + r0, kr); rope_issue(a, F, n * 128, cs); v_issue(F, ucol(a.ws, C_RV + h * 256) + r0, vt);
      rot_finish<true>(F, kr, cs, 0.08838834764831845f, l2g, KZ); v_finish(F, vt, VS); }
    __syncthreads();
    const int lane = F.lane, w = F.wave, q = lane >> 4, l15 = lane & 15;
    f32x4 acc[2][8];
#pragma unroll
    for (int e2 = 0; e2 < 2; ++e2)
#pragma unroll
        for (int dt = 0; dt < 8; ++dt) acc[e2][dt] = (f32x4){0.f, 0.f, 0.f, 0.f};
#pragma unroll
    for (int ks = 0; ks < 4; ++ks) { const bf16x8 v0 = ldsfrag_tr(VS, RV_P, 32 * ks, 32 * w, lane), v1 = ldsfrag_tr(VS, RV_P, 32 * ks, 32 * w + 16, lane);
#pragma unroll
        for (int dt = 0; dt < 8; ++dt) { const bf16x8 kk = ldsfrag_tr(KZ, RT_P, 32 * ks, 16 * dt, lane); acc[0][dt] = MFMA16(kk, v0, acc[0][dt]); acc[1][dt] = MFMA16(kk, v1, acc[1][dt]); } }
    bf16* kv = (bf16*)(a.ws + WS_KV) + (size_t)item * 32768; typedef unsigned u32x2 __attribute__((ext_vector_type(2)));
#pragma unroll
    for (int e2 = 0; e2 < 2; ++e2)
#pragma unroll
        for (int dt = 0; dt < 8; ++dt) *(GAS u32x2*)(kv + (32 * w + 16 * e2 + l15) * 128 + 16 * dt + 4 * q) = (u32x2){cvtpk(acc[e2][dt][0], acc[e2][dt][1]), cvtpk(acc[e2][dt][2], acc[e2][dt][3])};
    __syncthreads();
}
__device__ __forceinline__ void p4_scan_merge(const Args& a, Frame& F) {
    const bf16* kv = (const bf16*)(a.ws + WS_KV); bf16* rt = (bf16*)(a.ws + WS_RT);
    for (int idx = F.vcu * NTHR + F.tid; idx < 16 * 8192; idx += F.G * NTHR) {
        const int bh = idx >> 13, el = (idx & 8191) * 4, b = bh >> 2, h = bh & 3; const float gch = exp2f(128.0f * log2g(h));
        f32x4 R = (f32x4){0.f, 0.f, 0.f, 0.f};
        for (int n0 = 0; n0 < 32; n0 += 8) { unsigned long long k8[8];
#pragma unroll
            for (int i = 0; i < 8; ++i) k8[i] = __builtin_nontemporal_load((const GAS unsigned long long*)(kv + (size_t)(((b * 32 + n0 + i) << 2) + h) * 32768 + el));
#pragma unroll
            for (int i = 0; i < 8; ++i) { const size_t off = (size_t)(((b * 32 + n0 + i) << 2) + h) * 32768 + el;
                *(GAS unsigned long long*)(rt + off) = (unsigned long long)cvtpk(R.x, R.y) | ((unsigned long long)cvtpk(R.z, R.w) << 32);
                const unsigned lo = (unsigned)k8[i], hi = (unsigned)(k8[i] >> 32); R = R * gch + (f32x4){bflo(lo), bfhi(lo), bflo(hi), bfhi(hi)}; } } }
    const int gw = F.vcu * NWAVES + F.wave, NGW = F.G * NWAVES;
    const bf16* og = (const bf16*)(a.ws + WS_OG); const float* lse = (const float*)(a.ws + WS_LSE); bf16* att = (bf16*)(a.ws + WS_RET) + 1024;
    for (int t = gw; t < TOK; t += NGW) { const int hh = F.lane >> 4;
        const float l0 = lse[(size_t)t * 4 + hh], l1 = lse[(size_t)TOK * 4 + (size_t)t * 4 + hh], l2 = lse[(size_t)2 * TOK * 4 + (size_t)t * 4 + hh];
        const float m = fmaxf(l0, fmaxf(l1, l2)); float a0 = __expf(l0 - m), a1 = __expf(l1 - m), a2 = __expf(l2 - m); const float is = 1.0f / (a0 + a1 + a2); a0 *= is; a1 *= is; a2 *= is;
        const size_t o = (size_t)t * 512 + F.lane * 8;
        const v4u x0 = *(const GAS v4u*)(og + o), x1 = *(const GAS v4u*)(og + (size_t)TOK * 512 + o), x2 = *(const GAS v4u*)(og + (size_t)2 * TOK * 512 + o);
        v4u r;
        r.x = cvtpk(a0 * bflo(x0.x) + a1 * bflo(x1.x) + a2 * bflo(x2.x), a0 * bfhi(x0.x) + a1 * bfhi(x1.x) + a2 * bfhi(x2.x));
        r.y = cvtpk(a0 * bflo(x0.y) + a1 * bflo(x1.y) + a2 * bflo(x2.y), a0 * bfhi(x0.y) + a1 * bfhi(x1.y) + a2 * bfhi(x2.y));
        r.z = cvtpk(a0 * bflo(x0.z) + a1 * bflo(x1.z) + a2 * bflo(x2.z), a0 * bfhi(x0.z) + a1 * bfhi(x1.z) + a2 * bfhi(x2.z));
        r.w = cvtpk(a0 * bflo(x0.w) + a1 * bflo(x1.w) + a2 * bflo(x2.w), a0 * bfhi(x0.w) + a1 * bfhi(x1.w) + a2 * bfhi(x2.w));
        { typedef int i32x2 __attribute__((ext_vector_type(2))); int w0 = 0, w1 = 0;
          w0 = __builtin_amdgcn_cvt_pk_fp8_f32(bflo(r.x), bfhi(r.x), w0, false); w0 = __builtin_amdgcn_cvt_pk_fp8_f32(bflo(r.y), bfhi(r.y), w0, true);
          w1 = __builtin_amdgcn_cvt_pk_fp8_f32(bflo(r.z), bfhi(r.z), w1, false); w1 = __builtin_amdgcn_cvt_pk_fp8_f32(bflo(r.w), bfhi(r.w), w1, true);
          *(GAS i32x2*)(a.ws + WS_RET + (size_t)t * RA_LD + 1024 + F.lane * 8) = (i32x2){w0, w1}; } }
}
__device__ __forceinline__ void ret_out_item(const Args& a, Frame& F, int item) {
    const int h = item & 3, n = (item >> 2) & 31, b = item >> 7; const float l2g = log2g(h);
    const size_t r0 = (size_t)(b * SEQ + n * 128) * ULD;
    LAS bf16* QS = (LAS bf16*)F.lds; LAS bf16* KS = (LAS bf16*)(F.lds + 128 * RT_P * 2); LAS bf16* VS = (LAS bf16*)(F.lds + 2 * 128 * RT_P * 2);
    LAS float* RED = (LAS float*)(F.lds + 2 * 128 * RT_P * 2 + 128 * RV_P * 2);
    { RotRegs qr, kr; f32x4 cs[2][4]; v4u vt[8];
      rot_issue(F, ucol(a.ws, C_RQ + h * 128) + r0, qr); rot_issue(F, ucol(a.ws, C_RK + h * 128) + r0, kr); rope_issue(a, F, n * 128, cs); v_issue(F, ucol(a.ws, C_RV + h * 256) + r0, vt);
      rot_finish<false>(F, qr, cs, 1.0f, l2g, QS); rot_finish<false>(F, kr, cs, 0.08838834764831845f, l2g, KS); v_finish(F, vt, VS); }
    __syncthreads();
    const int lane = F.lane, w = F.wave, q = lane >> 4, l15 = lane & 15;
    typedef unsigned u32x2 __attribute__((ext_vector_type(2)));
    u32x2 pw[8];
    bf16x8 rf0[4], rf1[4];
    { const bf16* rtg = (const bf16*)(a.ws + WS_RT) + (size_t)item * 32768 + (size_t)(32 * w + l15) * 128 + 8 * q;
#pragma unroll
      for (int ks = 0; ks < 4; ++ks) { rf0[ks] = *(const GAS bf16x8*)(rtg + 32 * ks); rf1[ks] = *(const GAS bf16x8*)(rtg + 16 * 128 + 32 * ks); } }
    { bf16x8 qf[4];
#pragma unroll
      for (int ks = 0; ks < 4; ++ks) qf[ks] = ldsfrag(QS, RT_P, 16 * w, 32 * ks, lane);
#pragma unroll
      for (int jt = 0; jt < 8; ++jt) { f32x4 acc = (f32x4){0.f, 0.f, 0.f, 0.f};
          if (jt <= w) {
#pragma unroll
              for (int ks = 0; ks < 4; ++ks) acc = MFMA16(ldsfrag(KS, RT_P, 16 * jt, 32 * ks, lane), qf[ks], acc); }
          float p[4];
#pragma unroll
          for (int rr = 0; rr < 4; ++rr) { const int j = 16 * jt + 4 * q + rr, i = 16 * w + l15; p[rr] = (j <= i) ? acc[rr] * __builtin_amdgcn_exp2f(-(float)(j + 1) * l2g) : 0.f; }
          pw[jt] = (u32x2){cvtpk(p[0], p[1]), cvtpk(p[2], p[3])}; } }
    __syncthreads();
#pragma unroll
    for (int jt = 0; jt < 8; ++jt) *(LAS u32x2*)(KS + (16 * w + l15) * RT_P + 16 * jt + 4 * q) = pw[jt];
    __syncthreads();
    f32x4 acc[2][8];
#pragma unroll
    for (int e2 = 0; e2 < 2; ++e2)
#pragma unroll
        for (int it = 0; it < 8; ++it) acc[e2][it] = (f32x4){0.f, 0.f, 0.f, 0.f};
#pragma unroll
    for (int ks = 0; ks < 4; ++ks) { const bf16x8 a0 = ldsfrag_tr(VS, RV_P, 32 * ks, 32 * w, lane), a1 = ldsfrag_tr(VS, RV_P, 32 * ks, 32 * w + 16, lane);
#pragma unroll
        for (int it = 2 * ks; it < 8; ++it) { const bf16x8 pf = ldsfrag(KS, RT_P, 16 * it, 32 * ks, lane); acc[0][it] = MFMA16(a0, pf, acc[0][it]); acc[1][it] = MFMA16(a1, pf, acc[1][it]); } }
#pragma unroll
    for (int ks = 0; ks < 4; ++ks) {
#pragma unroll
        for (int it = 0; it < 8; ++it) { const bf16x8 qf = ldsfrag(QS, RT_P, 16 * it, 32 * ks, lane); acc[0][it] = MFMA16(rf0[ks], qf, acc[0][it]); acc[1][it] = MFMA16(rf1[ks], qf, acc[1][it]); } }
#pragma unroll
    for (int it = 0; it < 8; ++it) { const float xi = __builtin_amdgcn_exp2f((float)(16 * it + l15 + 1) * l2g); acc[0][it] = acc[0][it] * xi; acc[1][it] = acc[1][it] * xi;
        float s1 = (acc[0][it][0] + acc[0][it][1]) + (acc[0][it][2] + acc[0][it][3]) + (acc[1][it][0] + acc[1][it][1]) + (acc[1][it][2] + acc[1][it][3]);
        float s2 = (acc[0][it][0] * acc[0][it][0] + acc[0][it][1] * acc[0][it][1]) + (acc[0][it][2] * acc[0][it][2] + acc[0][it][3] * acc[0][it][3]) + (acc[1][it][0] * acc[1][it][0] + acc[1][it][1] * acc[1][it][1]) + (acc[1][it][2] * acc[1][it][2] + acc[1][it][3] * acc[1][it][3]);
        s1 += __shfl_xor(s1, 16); s1 += __shfl_xor(s1, 32); s2 += __shfl_xor(s2, 16); s2 += __shfl_xor(s2, 32);
        if (q == 0) *(LAS u32x2*)(RED + (16 * it + l15) * 16 + 2 * w) = (u32x2){__float_as_uint(s1), __float_as_uint(s2)}; }
    __syncthreads();
#pragma unroll
    for (int it = 0; it < 8; ++it) { const LAS f32x4* rp = (const LAS f32x4*)(RED + (16 * it + l15) * 16); const f32x4 r0 = rp[0], r1 = rp[1], r2 = rp[2], r3 = rp[3];
        const float s1 = (r0[0] + r0[2]) + (r1[0] + r1[2]) + (r2[0] + r2[2]) + (r3[0] + r3[2]), s2 = (r0[1] + r0[3]) + (r1[1] + r1[3]) + (r2[1] + r2[3]) + (r3[1] + r3[3]);
        const float mean = s1 * (1.0f / 256.0f), var = fmaxf(s2 * (1.0f / 256.0f) - mean * mean, 0.f), rstd = 1.0f / sqrtf(var + GN_EPS);
        const size_t tok = (size_t)(b * SEQ + n * 128 + 16 * it + l15);
        const bf16* gp = ucol(a.ws, C_RG + h * 256) + tok * ULD + 32 * w + 4 * q; unsigned char* op = a.ws + WS_RET + tok * RA_LD + h * 256 + 32 * w + 4 * q;
        int w8p[2];
#pragma unroll
        for (int e2 = 0; e2 < 2; ++e2) { const u32x2 gg = *(const GAS u32x2*)(gp + 16 * e2);
            const float g0 = bflo(gg.x), g1 = bfhi(gg.x), g2 = bflo(gg.y), g3 = bfhi(gg.y);
#define SILU_(x) ((x) * __builtin_amdgcn_rcpf(1.0f + __expf(-(x))))
            const float o0 = SILU_(g0) * (acc[e2][it][0] - mean) * rstd, o1 = SILU_(g1) * (acc[e2][it][1] - mean) * rstd, o2 = SILU_(g2) * (acc[e2][it][2] - mean) * rstd, o3 = SILU_(g3) * (acc[e2][it][3] - mean) * rstd;
#undef SILU_
            int w8 = 0; w8 = __builtin_amdgcn_cvt_pk_fp8_f32(o0, o1, w8, false); w8 = __builtin_amdgcn_cvt_pk_fp8_f32(o2, o3, w8, true); w8p[e2] = w8; }
        { const bool odd = (q & 1) != 0; const int recv = __shfl_xor(odd ? w8p[0] : w8p[1], 16);
          *(GAS u32x2*)(op - 4 * (q & 1) + (odd ? 16 : 0)) = odd ? (u32x2){(unsigned)recv, (unsigned)w8p[1]} : (u32x2){(unsigned)w8p[0], (unsigned)recv}; } }
    __syncthreads();
}

constexpr int P8_RSTD = 0, P8_LG = 1024, P8_CNT = P8_LG + 2 * 64 * 32 * 4, P8_LB = P8_CNT + 128, P8_LTE = P8_LB + 128, P8_LTP = P8_LTE + 1024, P8_H2 = P8_LTP + 1024;
__device__ __forceinline__ void p8_route(const Args& a, Frame& F) {
    LAS float* RSTD = (LAS float*)(F.lds + P8_RSTD); LAS float* LG = (LAS float*)(F.lds + P8_LG); LAS int* CNT = (LAS int*)(F.lds + P8_CNT);
    if (F.tid < 32) CNT[F.tid] = 0;
    const float* mod = (const float*)(a.ws + WS_CTL) + CW_MOD; const int lane = F.lane, w = F.wave, q = lane >> 4, l15 = lane & 15;
    const float* xm = (const float*)(a.ws + WS_XMID); LAS unsigned char* H2L = F.lds + P8_H2;
    LAS int* LB = (LAS int*)(F.lds + P8_LB); LAS int* LTE = (LAS int*)(F.lds + P8_LTE); LAS int* LTP = (LAS int*)(F.lds + P8_LTP);
    int* TE = (int*)(a.ws + WS_TE); int* TP = (int*)(a.ws + WS_TP); float* TG = (float*)(a.ws + WS_TG);
    const int t0 = F.vcu * 64, b = t0 / SEQ;
    const float* gf = a.in[10]; const float* scf = mod + b * 6144 + 4096; const float* shf = mod + b * 6144 + 3072;
#pragma unroll
    for (int hb = 0; hb < 2; ++hb) { f32x4 v[4][4];
#pragma unroll
        for (int ri = 0; ri < 4; ++ri) { const GAS f32x4* xr = (const GAS f32x4*)(xm + (size_t)(t0 + 8 * w + 4 * hb + ri) * DM) + lane;
#pragma unroll
            for (int j = 0; j < 4; ++j) v[ri][j] = xr[64 * j]; }
#pragma unroll
        for (int ri = 0; ri < 4; ++ri) { float s = 0.f;
#pragma unroll
            for (int j = 0; j < 4; ++j) s += (v[ri][j].x * v[ri][j].x + v[ri][j].y * v[ri][j].y) + (v[ri][j].z * v[ri][j].z + v[ri][j].w * v[ri][j].w);
            const float rstd = 1.0f / sqrtf(wave_sum(s) * (1.0f / DM) + RMS_EPS);
            if (lane == 0) RSTD[8 * w + 4 * hb + ri] = rstd;
            LAS int* o4 = (LAS int*)(H2L + (8 * w + 4 * hb + ri) * DM) + lane;
#pragma unroll
            for (int j = 0; j < 4; ++j) { const int c = 4 * (64 * j + lane); const f32x4 gg = *(const f32x4*)(gf + c), ss = *(const f32x4*)(scf + c), hh = *(const f32x4*)(shf + c);
                const f32x4 o = v[ri][j] * rstd * gg * (ss + 1.0f) + hh;
                int w8 = 0; w8 = __builtin_amdgcn_cvt_pk_fp8_f32(o.x, o.y, w8, false); w8 = __builtin_amdgcn_cvt_pk_fp8_f32(o.z, o.w, w8, true); o4[64 * j] = w8; } } }
    __syncthreads();
    { const int rt = w & 3, kh = w >> 2; const float rstd = RSTD[16 * rt + l15];
      const float* xrow = xm + (size_t)(t0 + 16 * rt + l15) * DM + 512 * kh + 8 * q;
      const bf16* wh = (const bf16*)(a.ws + WS_WRT) + (size_t)l15 * 1024 + 512 * kh + 8 * q; const bf16* wl = wh + 32768;
      f32x4 acc0 = (f32x4){0.f, 0.f, 0.f, 0.f}, acc1 = (f32x4){0.f, 0.f, 0.f, 0.f};
#pragma unroll 4
      for (int ks = 0; ks < 16; ++ks) { const int kc = 512 * kh + 32 * ks + 8 * q;
          const f32x4 x0 = *(const GAS f32x4*)(xrow + 32 * ks), x1 = *(const GAS f32x4*)(xrow + 32 * ks + 4);
          const f32x4 g0 = *(const f32x4*)(gf + kc), g1 = *(const f32x4*)(gf + kc + 4), s0 = *(const f32x4*)(scf + kc), s1 = *(const f32x4*)(scf + kc + 4), h0 = *(const f32x4*)(shf + kc), h1 = *(const f32x4*)(shf + kc + 4);
          const f32x4 o0 = x0 * rstd * g0 * (s0 + 1.0f) + h0, o1 = x1 * rstd * g1 * (s1 + 1.0f) + h1;
          v4u hi; hi.x = cvtpk(o0.x, o0.y); hi.y = cvtpk(o0.z, o0.w); hi.z = cvtpk(o1.x, o1.y); hi.w = cvtpk(o1.z, o1.w);
          v4u lo; lo.x = cvtpk(o0.x - bflo(hi.x), o0.y - bfhi(hi.x)); lo.y = cvtpk(o0.z - bflo(hi.y), o0.w - bfhi(hi.y)); lo.z = cvtpk(o1.x - bflo(hi.z), o1.y - bfhi(hi.z)); lo.w = cvtpk(o1.z - bflo(hi.w), o1.w - bfhi(hi.w));
          const bf16x8 ah = __builtin_bit_cast(bf16x8, hi), al = __builtin_bit_cast(bf16x8, lo);
          const bf16x8 wh0 = *(const GAS bf16x8*)(wh + 32 * ks), wh1 = *(const GAS bf16x8*)(wh + 16 * 1024 + 32 * ks), wl0 = *(const GAS bf16x8*)(wl + 32 * ks), wl1 = *(const GAS bf16x8*)(wl + 16 * 1024 + 32 * ks);
          acc0 = MFMA16(ah, wh0, acc0); acc0 = MFMA16(al, wh0, acc0); acc0 = MFMA16(ah, wl0, acc0);
          acc1 = MFMA16(ah, wh1, acc1); acc1 = MFMA16(al, wh1, acc1); acc1 = MFMA16(ah, wl1, acc1); }
#pragma unroll
      for (int rr = 0; rr < 4; ++rr) { LG[(kh * 64 + 16 * rt + 4 * q + rr) * 32 + l15] = acc0[rr]; LG[(kh * 64 + 16 * rt + 4 * q + rr) * 32 + 16 + l15] = acc1[rr]; } }
    __syncthreads();
    { const int e = lane & 31; const float br = a.in[12][e];
      for (int ri = 0; ri < 8; ++ri) { const int row = 8 * w + ri, t = t0 + row;
          float v = LG[row * 32 + e] + LG[(64 + row) * 32 + e] + br; float tv[4]; int ti[4];
#pragma unroll
          for (int k = 0; k < 4; ++k) { float m = v;
#pragma unroll
              for (int o = 1; o < 32; o <<= 1) m = fmaxf(m, __shfl_xor(m, o));
              const unsigned long long bal = __ballot(v == m); const int idx = __ffsll((long long)(bal & 0xffffffffull)) - 1;
              tv[k] = m; ti[k] = idx; if (e == idx) v = -INFINITY; }
          const float e1 = __expf(tv[1] - tv[0]), e2 = __expf(tv[2] - tv[0]), e3 = __expf(tv[3] - tv[0]); const float is = 1.0f / (1.0f + e1 + e2 + e3);
          if (lane < 4) { const int k = lane; const int ek = k == 0 ? ti[0] : (k == 1 ? ti[1] : (k == 2 ? ti[2] : ti[3])); const float gk = (k == 0 ? 1.0f : (k == 1 ? e1 : (k == 2 ? e2 : e3))) * is;
              const int lp = __hip_atomic_fetch_add(&CNT[ek], 1, __ATOMIC_RELAXED, __HIP_MEMORY_SCOPE_WORKGROUP);
              LTE[row * 4 + k] = ek; LTP[row * 4 + k] = lp; TE[t * 4 + k] = ek; TG[t * 4 + k] = gk; } } }
    __syncthreads();
    if (F.tid < 32) { const int cnt = CNT[F.tid]; LB[F.tid] = (int)__hip_atomic_fetch_add(F.ctl + CW_CNT + F.tid, (unsigned)cnt, RLX_AGENT); }
    __syncthreads();
    for (int pi = 0; pi < 32; ++pi) { const int p = w * 32 + pi, row = p >> 2; const int ek = LTE[p], pos = LB[ek] + LTP[p];
        if (lane == 0) TP[(t0 + row) * 4 + (p & 3)] = pos;
        *((GAS v4u*)(a.ws + WS_XIN + ((size_t)ek * XCAP + pos) * DM) + lane) = *((const LAS v4u*)(H2L + row * DM) + lane); }
    __syncthreads();
}
constexpr int MT_CS = 131072, MT_PM = MT_CS + 128, MT_E = MT_PM + 1280, MT_NT = MT_E + 1280;
__device__ __forceinline__ int moe_tables(Frame& F, bool sparse_a) {
    LAS int* CS = (LAS int*)(F.lds + MT_CS); LAS int* TPM = (LAS int*)(F.lds + MT_PM); LAS int* TEX = (LAS int*)(F.lds + MT_E); LAS int* NT = (LAS int*)(F.lds + MT_NT);
    if (F.tid < 64) { const int e = F.tid & 31; const int cnt = (int)__hip_atomic_load(F.ctl + CW_CNT + e, RLX_AGENT), n = (cnt + 255) >> 8;
        int incl = n;
#pragma unroll
        for (int o = 1; o < 32; o <<= 1) { const int v = __shfl_up(incl, o, 32); if (e >= o) incl += v; }
        const int t = incl - n;
        if (F.tid < 32) { CS[e] = t << 8;
            for (int j = 0; j < n; ++j) { TPM[t + j] = sparse_a ? e * (XCAP / 256) + j : t + j; TEX[t + j] = e; }
            if (e == 31) NT[0] = incl; } }
    __syncthreads();
    return __builtin_amdgcn_readfirstlane(NT[0]);
}
__device__ __forceinline__ void p12_final(const Args& a, Frame& F, bool with_moe, bool tables_ready) {
    LAS int* CS = (LAS int*)(F.lds + MT_CS); if (with_moe && !tables_ready) (void)moe_tables(F, false);
    const int gw = F.vcu * NWAVES + F.wave, NGW = F.G * NWAVES, lane = F.lane; const float* mod = (const float*)(a.ws + WS_CTL) + CW_MOD;
    const float* xm = (const float*)(a.ws + WS_XMID); const unsigned char* yb = a.ws + WS_YB; const int* TE = (const int*)(a.ws + WS_TE); const int* TP = (const int*)(a.ws + WS_TP); const float* TG = (const float*)(a.ws + WS_TG);
    for (int t = gw; t < TOK; t += NGW) { const int b = t / SEQ;
        f32x4 v[4], m4[4];
#pragma unroll
        for (int j = 0; j < 4; ++j) { v[j] = __builtin_nontemporal_load((const GAS f32x4*)(xm + (size_t)t * DM) + lane + 64 * j); m4[j] = (f32x4){0.f, 0.f, 0.f, 0.f}; }
        if (with_moe) {
#pragma unroll
            for (int k = 0; k < 4; ++k) { const int row = CS[TE[t * 4 + k]] + TP[t * 4 + k]; const float gk = TG[t * 4 + k]; const GAS int* yr = (const GAS int*)(yb + (size_t)row * DM) + lane;
#pragma unroll
                for (int j = 0; j < 4; ++j) { const int y4 = __builtin_nontemporal_load(yr + 64 * j); typedef float f32x2_ __attribute__((ext_vector_type(2)));
                    const f32x2_ lo = __builtin_amdgcn_cvt_pk_f32_fp8(y4, false), hi = __builtin_amdgcn_cvt_pk_f32_fp8(y4, true);
                    m4[j].x += gk * lo.x; m4[j].y += gk * lo.y; m4[j].z += gk * hi.x; m4[j].w += gk * hi.y; } }
        }
        float s = 0.f;
#pragma unroll
        for (int j = 0; j < 4; ++j) { const f32x4 gt = *(const f32x4*)(mod + b * 6144 + 5120 + 4 * (64 * j + lane)); v[j] = v[j] + gt * m4[j]; s += (v[j].x * v[j].x + v[j].y * v[j].y) + (v[j].z * v[j].z + v[j].w * v[j].w); }
        const float rstd = 1.0f / sqrtf(wave_sum(s) * (1.0f / DM) + RMS_EPS);
#pragma unroll
        for (int j = 0; j < 4; ++j) { const f32x4 gf = *(const f32x4*)(a.in[17] + 4 * (64 * j + lane)); __builtin_nontemporal_store(v[j] * rstd * gf, (GAS f32x4*)(a.out + (size_t)t * DM) + lane + 64 * j); } }
}

#ifndef ABL_NOMIX
#define ABL_NOMIX 0
#endif
#ifndef ABL_NOMOE
#define ABL_NOMOE 0
#endif
#ifndef ONE_LAUNCH
#define ONE_LAUNCH 1
#endif
constexpr int NPHASE = 13;
__global__ void __launch_bounds__(NTHR, 2) mk_fwd(Args args) {
    extern __shared__ __attribute__((aligned(16))) unsigned char lds[];
    Frame F;
    F.lds = (LAS unsigned char*)lds; F.MISC = (volatile LAS unsigned*)(F.lds + MISC_OFF);
    F.tid = threadIdx.x; F.lane = F.tid & 63; F.wave = __builtin_amdgcn_readfirstlane(F.tid >> 6);
    F.G = gridDim.x; { const int bx = blockIdx.x; F.vcu = (F.G % 8 == 0) ? (bx % 8) * (F.G / 8) + bx / 8 : bx; }
    unsigned char* ws = args.ws; F.ctl = (gu32*)(ws + WS_CTL);
    if (F.tid < 64) F.MISC[F.tid] = 0u;
    __syncthreads();
    XcdBarrier bar = xcd_barrier_post((unsigned*)(F.ctl + CW_BAR), F.MISC + 8);
    const int lo = args.ph_lo, hi = args.ph_hi;
#ifndef PHMASK
#define PHMASK 0x1fff
#endif
#define IN(k) (lo <= (k) && (k) < hi && ((PHMASK >> (k)) & 1))
#ifndef REPMASK
#define REPMASK 0
#endif
#define REP(k) for (int rep_ = 0; rep_ < ((((REPMASK) >> (k)) & 1) ? 2 : 1); ++rep_)
#ifndef XBAR
#define XBAR 0
#endif
#define SEAM(k) do { if (IN(k) && IN((k) + 1)) { xcd_barrier(bar); if ((XBAR >> (k)) & 1) { xcd_barrier(bar); xcd_barrier(bar); } } } while (0)
    typedef pg8::bf16_t pb;
    if (IN(0)) REP(0) { p0_prologue(args, F); }
#if !ABL_NOMIX
    if (IN(1)) REP(1) { p1_norm1(args, F); } SEAM(1);
    if (IN(2)) REP(2) {
        { pg8::Gemm g{(const pb*)(ws + WS_H), (const pb*)(ws + WS_WIN), TOK, N16, DM}; pg8::SplitOrder S; S.init(TOK, N16, F.G, (int)blockIdx.x); S.nx = 4; S.ny = 2;
          pg8::EpiBf16<0> E{(pb*)(ws + WS_U), ULD, nullptr, 256, UBLK, 1.f};
          pg8::gemm_phase<pg8::EpiBf16<0>, pg8::SplitOrder, true, true>(F.lds, g, S, E); }
        __syncthreads();
        { pg8::Gemm g{(const pb*)(ws + WS_H8), (const pb*)(ws + WS_WIN8), TOK, INW - N16, DM / 2}; pg8::SplitOrder S; S.init(TOK, INW - N16, F.G, (int)blockIdx.x); S.nx = 5; S.ny = 8;
          pg8::EpiFp8Blk E{ws + WS_U + (size_t)(N16 / 256) * UBLK * 2, UBLK};
          pg8::gemm_phase<pg8::EpiFp8Blk, pg8::SplitOrder, true, true, true>(F.lds, g, S, E); } } SEAM(2);
    if (IN(3)) { REP(3) { attn_phase(args, F); }
        REP(13) { for (int it = (F.vcu + 128) % F.G; it < 512; it += F.G) ret_kv_item(args, F, it); } } SEAM(3);
    if (IN(4)) REP(4) { p4_scan_merge(args, F); } SEAM(4);
    if (IN(5)) REP(5) { for (int it = F.vcu; it < 512; it += F.G) ret_out_item(args, F, it); } SEAM(5);
    if (IN(6)) REP(6) { pg8::Gemm g{(const pb*)(ws + WS_RET), (const pb*)(ws + WS_WRET), TOK, DM, RA_LD / 2}; pg8::StaticOrder S; S.init(TOK, DM, F.G, (int)blockIdx.x);
        pg8::EpiGate2<8> E{(pb*)(ws + WS_MERGED), DM, ucol8(ws, C_GA), ucol8(ws, C_GB), UBLK};
        pg8::gemm_phase<pg8::EpiGate2<8>, pg8::StaticOrder, true, true, true>(F.lds, g, S, E); } SEAM(6);
    if (IN(7)) REP(7) { pg8::Gemm g{(const pb*)(ws + WS_MERGED), (const pb*)(ws + WS_WO), TOK, DM, 1024}; pg8::StaticOrder S; S.init(TOK, DM, F.G, (int)blockIdx.x);
        pg8::EpiResid E{(float*)(ws + WS_XMID), args.in[0], DM, (const float*)(ws + WS_CTL) + CW_MOD + 2048, 6144, SEQ / 256};
        pg8::gemm_phase<pg8::EpiResid, pg8::StaticOrder, true, true>(F.lds, g, S, E); } SEAM(7);
#else
    if (IN(7)) { const f32x4* s = (const f32x4*)args.in[0]; f32x4* d = (f32x4*)(ws + WS_XMID); for (size_t i = (size_t)blockIdx.x * NTHR + F.tid; i < (size_t)TOK * DM / 4; i += (size_t)F.G * NTHR) d[i] = s[i]; } SEAM(7);
#endif
#if !ABL_NOMOE
    if (IN(8)) { p8_route(args, F); } if (IN(8) && IN(10)) xcd_barrier(bar);
    if (IN(10)) REP(10) { const int nt = moe_tables(F, true);
        pg8::Gemm g{(const pb*)(ws + WS_XIN), (const pb*)(ws + WS_W1), nt * 256, NEXP * FF2, DM / 2}; pg8::MoeOrder S{nt, FF2 / 256, F.G, F.vcu  , (const LAS int*)(F.lds + MT_PM), (const LAS int*)(F.lds + MT_E)};
        pg8::EpiSwiglu E{(pb*)(ws + WS_A), FF, args.in[14], FF2 / 256};
        pg8::gemm_phase<pg8::EpiSwiglu, pg8::MoeOrder, true, true, true>(F.lds, g, S, E); } SEAM(10);
    if (IN(11)) REP(11) { const int nt = IN(10) ? __builtin_amdgcn_readfirstlane(((LAS int*)(F.lds + MT_NT))[0]) : moe_tables(F, true);
        pg8::Gemm g{(const pb*)(ws + WS_A), (const pb*)(ws + WS_W2), nt * 256, NEXP * DM, FF / 2}; pg8::MoeOrder S{nt, DM / 256, F.G, F.vcu, (const LAS int*)nullptr, (const LAS int*)(F.lds + MT_E)};
        pg8::EpiFp8Row E{ws + WS_YB, DM, args.in[16], DM / 256};
        pg8::gemm_phase<pg8::EpiFp8Row, pg8::MoeOrder, true, true, true>(F.lds, g, S, E); } SEAM(11);
#endif
    if (IN(12)) REP(12) { p12_final(args, F, !ABL_NOMOE, IN(10)); }
#undef IN
#undef SEAM
}

extern "C" void kernel_launch(void* const* d_in, const int* in_sizes, int n_in, void* d_out, int out_size, void* d_ws, size_t ws_size, hipStream_t stream) {
    static int grid = 0;
    if (grid == 0) {
        if (n_in != 18 || in_sizes[0] != TOK * DM || out_size != TOK * DM || ws_size < WS_END) { fprintf(stderr, "kernel_launch: unexpected shapes n_in %d in0 %d out %d ws %zu\n", n_in, n_in > 0 ? in_sizes[0] : -1, out_size, ws_size); grid = -1; return; }
        int dev = 0, cus = 0, per_cu = 0;
        if (hipGetDevice(&dev) != hipSuccess || hipDeviceGetAttribute(&cus, hipDeviceAttributeMultiprocessorCount, dev) != hipSuccess) { grid = -1; return; }
        if (hipFuncSetAttribute((const void*)mk_fwd, hipFuncAttributeMaxDynamicSharedMemorySize, LDS_BYTES) != hipSuccess) { fprintf(stderr, "kernel_launch: hipFuncSetAttribute failed\n"); grid = -1; return; }
        if (hipOccupancyMaxActiveBlocksPerMultiprocessor(&per_cu, (const void*)mk_fwd, NTHR, LDS_BYTES) != hipSuccess || per_cu < 1) fprintf(stderr, "kernel_launch: occupancy query says %d\n", per_cu);
        (void)hipGetLastError();
        grid = cus;
        if (grid != 256) fprintf(stderr, "kernel_launch: %d CUs (built for 256)\n", grid);
    }
    if (grid < 0) return;
    (void)hipMemsetAsync((char*)d_ws + WS_CTL, 0, CTL_ZERO_BYTES, stream);
    Args a{};
    for (int i = 0; i < 18; ++i) a.in[i] = (const float*)d_in[i];
    a.out = (float*)d_out; a.ws = (unsigned char*)d_ws;
#if ONE_LAUNCH
    a.ph_lo = 0; a.ph_hi = NPHASE;
    hipLaunchKernelGGL(mk_fwd, dim3(grid), dim3(NTHR), LDS_BYTES, stream, a);
#else
    for (int p = 0; p < NPHASE; ++p) {
#if ABL_NOMIX
        if (p >= 1 && p <= 6) continue;
#endif
#if ABL_NOMOE
        if (p >= 8 && p <= 11) continue;
#endif
        a.ph_lo = p; a.ph_hi = p + 1;
        hipLaunchKernelGGL(mk_fwd, dim3(grid), dim3(NTHR), LDS_BYTES, stream, a);
    }
#endif
}
```

```cpp
#include <hip/hip_runtime.h>
#include <cstdio>
#include <cstdint>
namespace pg8 {
#define PG8_LAS __attribute__((address_space(3)))
typedef unsigned short bf16_t;
typedef short bf16x8 __attribute__((ext_vector_type(8)));
typedef float f32x4 __attribute__((ext_vector_type(4)));
typedef unsigned u32x4 __attribute__((ext_vector_type(4)));
constexpr int BM = 256, BK = 64, HALF = 128, HTB = HALF * BK * 2  , STAGE_BYTES = 8 * HTB, NXCD = 8, WGM = 4;

__host__ __device__ __forceinline__ int lds_byte(int r, int c) { const int st = (r >> 4) * 2 + (c >> 5), rr = r & 15, cc = c & 31, ob = rr * 64 + cc * 2; return st * 1024 + (ob ^ (((ob >> 9) & 1) << 5)); }
__host__ __device__ __forceinline__ void stage_rc(int b, int& R, int& C) { const int st = b / 1024, sb = b % 1024, swz = sb ^ (((sb >> 9) & 1) << 5); R = (st >> 1) * 16 + swz / 64; C = (st & 1) * 32 + (swz % 64) / 2; }
__host__ __device__ __forceinline__ int perm32(int rho) { const int n = rho >> 4, i = rho & 15; return 8 * (i >> 2) + 4 * n + (i & 3); }

struct Unit { int pm, pn, po; };
struct Gemm { const bf16_t* A; const bf16_t* Bt; int M, N, K; };

struct StaticOrder {
    int nM, nN, nwg, G, c;
    __host__ __device__ void init(int M, int N, int G_, int c_) { nM = M / BM; nN = N / BM; nwg = nM * nN; G = G_; c = c_; }
    __host__ __device__ bool next(int i, Unit& u) const {
        const long L = (long)i * G + c; if (L >= nwg) return false;
        int wgid = (int)L; { const int q = nwg / NXCD, r = nwg % NXCD, xcd = wgid % NXCD, off = wgid / NXCD; wgid = (xcd < r ? xcd * (q + 1) : r * (q + 1) + (xcd - r) * q) + off; }
        const int nig = WGM * nN, gid = wgid / nig, fm = gid * WGM, gsz = (nM - fm) < WGM ? (nM - fm) : WGM;
        u.pm = fm + ((wgid % nig) % gsz); u.pn = (wgid % nig) / gsz; u.po = u.pm; return true;
    }
    __device__ __forceinline__ void a_ready(const Unit&) const {}
    __device__ __forceinline__ void done(const Unit&) const {}
};

__device__ __forceinline__ unsigned cvt_pk_bf16(float lo, float hi) { unsigned r; asm volatile("v_cvt_pk_bf16_f32 %0, %1, %2" : "=v"(r) : "v"(lo), "v"(hi)); return r; }
typedef float f32x2 __attribute__((ext_vector_type(2)));
__device__ __forceinline__ f32x2 gelu_pk(f32x2 v) {
    const f32x2 av = __builtin_elementwise_abs(v), d = av * 0.2316418882f + 1.0f;
    f32x2 t; t.x = __builtin_amdgcn_rcpf(d.x); t.y = __builtin_amdgcn_rcpf(d.y);
    f32x2 q = t * 0.5307027145f + (-0.7265760135f); q = q * t + 0.7107068705f; q = q * t + (-0.142248368f); q = q * t + 0.127414796f; q = q * t;
    const f32x2 s = (v * v) * (-0.72134752044f);
    f32x2 e; e.x = __builtin_amdgcn_exp2f(s.x); e.y = __builtin_amdgcn_exp2f(s.y);
    const f32x2 m = v * (q * e), r = v - m;
    f32x2 o; o.x = v.x < 0.f ? m.x : r.x; o.y = v.y < 0.f ? m.y : r.y; return o;
}

template <int ACT  > struct EpiBf16 {
    static constexpr bool PERM = true, AFTER_DRAIN = false; static constexpr int MID_T = 0; static_assert(ACT == 0 || ACT == 1, "EpiBf16: ACT is 0 (none) or 1 (gelu_pk)");
    bf16_t* O; int ldc; const float* bias; int split_cols; size_t split_stride; float scale0;
    __device__ __forceinline__ void operator()(const f32x4 (&acc)[2][2][4][2], const Unit& u, int wr, int wc, int fr, int fq) const {
        const int row0 = u.pm * BM + wr * 64 + fr; int colt = u.pn * BM; bf16_t* base = O;
        float sc = 1.f; if (split_cols) { const int t = colt / split_cols; base += (size_t)t * split_stride; colt -= t * split_cols; if (t == 0) sc = scale0; }
        const int col0 = colt + wc * 32 + 8 * fq, bcol0 = u.pn * BM + wc * 32 + 8 * fq;
        f32x4 bv[2][2];
#pragma unroll
        for (int bj = 0; bj < 2; ++bj)
#pragma unroll
            for (int n = 0; n < 2; ++n) bv[bj][n] = bias ? *(const f32x4*)(bias + bcol0 + bj * HALF + 4 * n) : (f32x4){0.f, 0.f, 0.f, 0.f};
#pragma unroll
        for (int ai = 0; ai < 2; ++ai)
#pragma unroll
            for (int m = 0; m < 4; ++m) { bf16_t* rowp = base + (size_t)(row0 + ai * HALF + m * 16) * ldc + col0;
#pragma unroll
                for (int bj = 0; bj < 2; ++bj) { f32x4 v0 = acc[ai][bj][m][0] + bv[bj][0], v1 = acc[ai][bj][m][1] + bv[bj][1];
                    if (ACT == 1) { f32x2 a = gelu_pk((f32x2){v0[0], v0[1]}), b = gelu_pk((f32x2){v0[2], v0[3]}), c = gelu_pk((f32x2){v1[0], v1[1]}), d = gelu_pk((f32x2){v1[2], v1[3]});
                        v0 = (f32x4){a.x, a.y, b.x, b.y}; v1 = (f32x4){c.x, c.y, d.x, d.y}; }
                    v0 = v0 * sc; v1 = v1 * sc; u32x4 w; w.x = cvt_pk_bf16(v0[0], v0[1]); w.y = cvt_pk_bf16(v0[2], v0[3]); w.z = cvt_pk_bf16(v1[0], v1[1]); w.w = cvt_pk_bf16(v1[2], v1[3]);
                    *(u32x4*)(rowp + bj * HALF) = w; } }
    }
};
__device__ __forceinline__ float bf_lo(unsigned w) { return __uint_as_float(w << 16); }
__device__ __forceinline__ float bf_hi(unsigned w) { return __uint_as_float(w & 0xffff0000u); }
__device__ __forceinline__ float sigmf(float x) { return __builtin_amdgcn_rcpf(1.0f + __expf(-x)); }

template <int MIDT> struct EpiGate2 {
    static constexpr bool PERM = true, AFTER_DRAIN = false; static constexpr int MID_T = MIDT;
    bf16_t* O; int ldc; const unsigned char* Ga; const unsigned char* Gb; size_t gblk;
    __device__ __forceinline__ void mid(f32x4 (&acc)[2][2][4][2], const Unit& u, int wr, int wc, int fr, int fq) const {
        int row0 = u.pm * BM + wr * 64 + fr, col0 = wc * 32 + 8 * fq;
        asm volatile("" : "+v"(row0), "+v"(col0));
        const unsigned char* Gat = Ga + (size_t)u.pn * gblk; const unsigned char* Gbt = Gb + (size_t)u.pn * gblk;
        typedef int i32x2 __attribute__((ext_vector_type(2))); typedef float f32x2_ __attribute__((ext_vector_type(2)));
#pragma unroll
        for (int ai = 0; ai < 2; ++ai)
#pragma unroll
            for (int m = 0; m < 4; ++m) { const size_t row = (size_t)(row0 + ai * HALF + m * 16);
#pragma unroll
                for (int bj = 0; bj < 2; ++bj) { const int col = col0 + bj * HALF;
                    const i32x2 a = *(const i32x2*)(Gat + row * 256 + col), b = *(const i32x2*)(Gbt + row * 256 + col);
#define RAT_(x, y) ((1.0f + __expf(-(y))) * __builtin_amdgcn_rcpf(1.0f + __expf(-(x))))
                    const f32x2_ a0 = __builtin_amdgcn_cvt_pk_f32_fp8(a.x, false), a1 = __builtin_amdgcn_cvt_pk_f32_fp8(a.x, true), a2 = __builtin_amdgcn_cvt_pk_f32_fp8(a.y, false), a3 = __builtin_amdgcn_cvt_pk_f32_fp8(a.y, true);
                    const f32x2_ b0 = __builtin_amdgcn_cvt_pk_f32_fp8(b.x, false), b1 = __builtin_amdgcn_cvt_pk_f32_fp8(b.x, true), b2 = __builtin_amdgcn_cvt_pk_f32_fp8(b.y, false), b3 = __builtin_amdgcn_cvt_pk_f32_fp8(b.y, true);
                    f32x4 v0 = acc[ai][bj][m][0], v1 = acc[ai][bj][m][1];
                    v0[0] *= RAT_(a0.x, b0.x); v0[1] *= RAT_(a0.y, b0.y); v0[2] *= RAT_(a1.x, b1.x); v0[3] *= RAT_(a1.y, b1.y);
                    v1[0] *= RAT_(a2.x, b2.x); v1[1] *= RAT_(a2.y, b2.y); v1[2] *= RAT_(a3.x, b3.x); v1[3] *= RAT_(a3.y, b3.y);
#undef RAT_
                    acc[ai][bj][m][0] = v0; acc[ai][bj][m][1] = v1; }
                asm volatile("" ::: "memory"); }
    }
    __device__ __forceinline__ void operator()(const f32x4 (&acc)[2][2][4][2], const Unit& u, int wr, int wc, int fr, int fq) const {
        const int row0 = u.pm * BM + wr * 64 + fr, col0 = u.pn * BM + wc * 32 + 8 * fq;
#pragma unroll
        for (int ai = 0; ai < 2; ++ai)
#pragma unroll
            for (int m = 0; m < 4; ++m) { const size_t row = (size_t)(row0 + ai * HALF + m * 16);
#pragma unroll
                for (int bj = 0; bj < 2; ++bj) { const int col = col0 + bj * HALF;
                    typedef int i32x2 __attribute__((ext_vector_type(2))); typedef float f32x2_ __attribute__((ext_vector_type(2)));
                    const i32x2 g = *(const i32x2*)(Gb + (size_t)u.pn * gblk + row * 256 + (col - u.pn * BM));
                    const f32x2_ g0 = __builtin_amdgcn_cvt_pk_f32_fp8(g.x, false), g1 = __builtin_amdgcn_cvt_pk_f32_fp8(g.x, true), g2 = __builtin_amdgcn_cvt_pk_f32_fp8(g.y, false), g3 = __builtin_amdgcn_cvt_pk_f32_fp8(g.y, true);
                    f32x4 v0 = acc[ai][bj][m][0], v1 = acc[ai][bj][m][1];
                    v0[0] *= sigmf(g0.x); v0[1] *= sigmf(g0.y); v0[2] *= sigmf(g1.x); v0[3] *= sigmf(g1.y);
                    v1[0] *= sigmf(g2.x); v1[1] *= sigmf(g2.y); v1[2] *= sigmf(g3.x); v1[3] *= sigmf(g3.y);
                    u32x4 w; w.x = cvt_pk_bf16(v0[0], v0[1]); w.y = cvt_pk_bf16(v0[2], v0[3]); w.z = cvt_pk_bf16(v1[0], v1[1]); w.w = cvt_pk_bf16(v1[2], v1[3]);
                    *(u32x4*)(O + row * ldc + col) = w; } }
    }
};
struct EpiResid {
    static constexpr bool PERM = false, AFTER_DRAIN = false; static constexpr int MID_T = 0;
    float* O; const float* base; int ldc; const float* gvec; int gstride; int tiles_per_b;
    __device__ __forceinline__ void operator()(const f32x4 (&acc)[2][2][4][2], const Unit& u, int wr, int wc, int fr, int fq) const {
        const int row0 = u.pm * BM + wr * 64 + fr, col0 = u.pn * BM + wc * 32 + 4 * fq;
        const float* gv = gvec + (size_t)(u.pm / tiles_per_b) * gstride;
#pragma unroll
        for (int bj = 0; bj < 2; ++bj)
#pragma unroll
            for (int n = 0; n < 2; ++n) { const int col = col0 + bj * HALF + n * 16; const f32x4 gt = *(const f32x4*)(gv + col);
#pragma unroll
                for (int ai = 0; ai < 2; ++ai)
#pragma unroll
                    for (int m = 0; m < 4; ++m) { const size_t off = (size_t)(row0 + ai * HALF + m * 16) * ldc + col;
                        const f32x4 b = *(const f32x4*)(base + off); *(f32x4*)(O + off) = b + gt * acc[ai][bj][m][n]; } }
    }
};
struct EpiSwiglu {
    static constexpr bool PERM = true, AFTER_DRAIN = false; static constexpr int MID_T = 0;
    bf16_t* O; int lda; const float* bias; int nN;
    __device__ __forceinline__ int act4(const f32x4& v0, const f32x4& v1) const {
        f32x4 G = (f32x4){v0[0], v0[2], v1[0], v1[2]}, L = (f32x4){v0[1], v0[3], v1[1], v1[3]};
        G = __builtin_elementwise_min(G, (f32x4){7.f, 7.f, 7.f, 7.f});
        L = __builtin_elementwise_min(__builtin_elementwise_max(L, (f32x4){-7.f, -7.f, -7.f, -7.f}), (f32x4){7.f, 7.f, 7.f, 7.f}) + 1.0f;
        const f32x4 X = G * (-1.702f * 1.4426950408889634f);
        f32x4 S; S[0] = __builtin_amdgcn_exp2f(X[0]); S[1] = __builtin_amdgcn_exp2f(X[1]); S[2] = __builtin_amdgcn_exp2f(X[2]); S[3] = __builtin_amdgcn_exp2f(X[3]);
        S = S + 1.0f; S[0] = __builtin_amdgcn_rcpf(S[0]); S[1] = __builtin_amdgcn_rcpf(S[1]); S[2] = __builtin_amdgcn_rcpf(S[2]); S[3] = __builtin_amdgcn_rcpf(S[3]);
        const f32x4 A4 = G * S * L;
        int w8 = 0; w8 = __builtin_amdgcn_cvt_pk_fp8_f32(A4[0], A4[1], w8, false); w8 = __builtin_amdgcn_cvt_pk_fp8_f32(A4[2], A4[3], w8, true); return w8;
    }
    __device__ __forceinline__ void operator()(const f32x4 (&acc)[2][2][4][2], const Unit& u, int wr, int wc, int fr, int fq) const {
        const int row0 = u.po * BM + wr * 64 + fr; const int pnl = u.pn % nN;
        const int bcol0 = u.pn * BM + wc * 32 + 8 * fq; const bool odd = (fq & 1) != 0;
        const int bytecol = (pnl * BM + wc * 32 + 8 * (fq & ~1)) / 2 + (odd ? 64 : 0);
        f32x4 bv[2][2];
#pragma unroll
        for (int bj = 0; bj < 2; ++bj)
#pragma unroll
            for (int n = 0; n < 2; ++n) bv[bj][n] = *(const f32x4*)(bias + bcol0 + bj * HALF + 4 * n);
        typedef int i32x2 __attribute__((ext_vector_type(2)));
#pragma unroll
        for (int ai = 0; ai < 2; ++ai)
#pragma unroll
            for (int m = 0; m < 4; ++m) {
                const int wA = act4(acc[ai][0][m][0] + bv[0][0], acc[ai][0][m][1] + bv[0][1]), wB = act4(acc[ai][1][m][0] + bv[1][0], acc[ai][1][m][1] + bv[1][1]);
                const int recv = __shfl_xor(odd ? wA : wB, 16);
                *(i32x2*)((unsigned char*)O + (size_t)(row0 + ai * HALF + m * 16) * lda + bytecol) = odd ? (i32x2){recv, wB} : (i32x2){wA, recv}; }
    }
};
struct EpiFp8Blk {
    static constexpr bool PERM = true, AFTER_DRAIN = false; static constexpr int MID_T = 0;
    unsigned char* O; size_t blk;
    __device__ __forceinline__ void operator()(const f32x4 (&acc)[2][2][4][2], const Unit& u, int wr, int wc, int fr, int fq) const {
        const bool odd = (fq & 1) != 0;
        const int row0 = u.pm * BM + wr * 64 + fr, col0 = wc * 32 + 8 * (fq & ~1) + (odd ? HALF : 0); unsigned char* base = O + (size_t)u.pn * blk;
#pragma unroll
        for (int ai = 0; ai < 2; ++ai)
#pragma unroll
            for (int m = 0; m < 4; ++m) { unsigned char* rowp = base + (size_t)(row0 + ai * HALF + m * 16) * 256 + col0; int w[2][2];
#pragma unroll
                for (int bj = 0; bj < 2; ++bj) { const f32x4 v0 = acc[ai][bj][m][0], v1 = acc[ai][bj][m][1]; int w0 = 0, w1 = 0;
                    w0 = __builtin_amdgcn_cvt_pk_fp8_f32(v0[0], v0[1], w0, false); w0 = __builtin_amdgcn_cvt_pk_fp8_f32(v0[2], v0[3], w0, true);
                    w1 = __builtin_amdgcn_cvt_pk_fp8_f32(v1[0], v1[1], w1, false); w1 = __builtin_amdgcn_cvt_pk_fp8_f32(v1[2], v1[3], w1, true); w[bj][0] = w0; w[bj][1] = w1; }
                const int r0 = __shfl_xor(odd ? w[0][0] : w[1][0], 16), r1 = __shfl_xor(odd ? w[0][1] : w[1][1], 16);
                *(u32x4*)rowp = odd ? (u32x4){(unsigned)r0, (unsigned)r1, (unsigned)w[1][0], (unsigned)w[1][1]} : (u32x4){(unsigned)w[0][0], (unsigned)w[0][1], (unsigned)r0, (unsigned)r1}; }
    }
};
struct EpiFp8Row {
    static constexpr bool PERM = true, AFTER_DRAIN = false; static constexpr int MID_T = 0;
    unsigned char* O; int ldc; const float* bias; int nN;
    __device__ __forceinline__ void operator()(const f32x4 (&acc)[2][2][4][2], const Unit& u, int wr, int wc, int fr, int fq) const {
        const bool odd = (fq & 1) != 0;
        const int row0 = u.po * BM + wr * 64 + fr, col0 = (u.pn % nN) * BM + wc * 32 + 8 * (fq & ~1) + (odd ? HALF : 0), bcol0 = u.pn * BM + wc * 32 + 8 * fq;
        f32x4 bv[2][2];
#pragma unroll
        for (int bj = 0; bj < 2; ++bj)
#pragma unroll
            for (int n = 0; n < 2; ++n) bv[bj][n] = *(const f32x4*)(bias + bcol0 + bj * HALF + 4 * n);
#pragma unroll
        for (int ai = 0; ai < 2; ++ai)
#pragma unroll
            for (int m = 0; m < 4; ++m) { unsigned char* rowp = O + (size_t)(row0 + ai * HALF + m * 16) * ldc + col0; int w[2][2];
#pragma unroll
                for (int bj = 0; bj < 2; ++bj) { const f32x4 v0 = acc[ai][bj][m][0] + bv[bj][0], v1 = acc[ai][bj][m][1] + bv[bj][1]; int w0 = 0, w1 = 0;
                    w0 = __builtin_amdgcn_cvt_pk_fp8_f32(v0[0], v0[1], w0, false); w0 = __builtin_amdgcn_cvt_pk_fp8_f32(v0[2], v0[3], w0, true);
                    w1 = __builtin_amdgcn_cvt_pk_fp8_f32(v1[0], v1[1], w1, false); w1 = __builtin_amdgcn_cvt_pk_fp8_f32(v1[2], v1[3], w1, true); w[bj][0] = w0; w[bj][1] = w1; }
                const int r0 = __shfl_xor(odd ? w[0][0] : w[1][0], 16), r1 = __shfl_xor(odd ? w[0][1] : w[1][1], 16);
                *(u32x4*)rowp = odd ? (u32x4){(unsigned)r0, (unsigned)r1, (unsigned)w[1][0], (unsigned)w[1][1]} : (u32x4){(unsigned)w[0][0], (unsigned)w[0][1], (unsigned)r0, (unsigned)r1}; }
    }
};
struct MoeOrder {
    int ntiles, nN, G, c; const PG8_LAS int* tpm; const PG8_LAS int* te;
    __device__ bool next(int i, Unit& u) const {
        const long L = (long)i * G + c; if (L >= (long)ntiles * nN) return false;
        const int t = (int)(L / nN), pnl = (int)(L % nN);
        u.pm = tpm ? __builtin_amdgcn_readfirstlane(tpm[t]) : t; u.po = t; u.pn = __builtin_amdgcn_readfirstlane(te[t]) * nN + pnl; return true;
    }
    __device__ __forceinline__ void a_ready(const Unit&) const {}
    __device__ __forceinline__ void done(const Unit&) const {}
};

struct SplitOrder : StaticOrder {
    int nx, ny;
    __device__ bool next(int i, Unit& u) const {
        const int half = G >> 1, grp = (c >> 3) & 1, ci = ((c >> 4) << 3) | (c & 7);
        long L; if (grp == 0) { if (i >= nx) return false; L = (long)i * half + ci; } else { if (i >= ny) return false; L = (long)nx * half + (long)i * half + ci; }
        if (L >= nwg) return false;
        int wgid = (int)L; { const int q = nwg / NXCD, r = nwg % NXCD, xcd = wgid % NXCD, off = wgid / NXCD; wgid = (xcd < r ? xcd * (q + 1) : r * (q + 1) + (xcd - r) * q) + off; }
        const int nig = WGM * nN, gid = wgid / nig, fm = gid * WGM, gsz = (nM - fm) < WGM ? (nM - fm) : WGM;
        u.pm = fm + ((wgid % nig) % gsz); u.pn = (wgid % nig) / gsz; u.po = u.pm; return true;
    }
};
typedef int v4i_ __attribute__((ext_vector_type(4))); typedef int v8i_ __attribute__((ext_vector_type(8)));
template <bool F8> struct FragT { bf16x8 h[2]; __device__ __forceinline__ void set(int k, bf16x8 v) { h[k] = v; } };
template <> struct FragT<true> { v8i_ w; __device__ __forceinline__ void set(int k, bf16x8 v) { if (k == 0) w.lo = __builtin_bit_cast(v4i_, v); else w.hi = __builtin_bit_cast(v4i_, v); } };
template <class Epi, class Sched, bool ALIGN_EPI = false, bool SP2 = false, bool F8 = false>
__device__ __forceinline__ void gemm_phase(PG8_LAS unsigned char* lds, const Gemm g, const Sched& S, const Epi& E) {
    const int tid = threadIdx.x, wid = __builtin_amdgcn_readfirstlane(tid >> 6), lane = tid & 63, wr = wid >> 2, wc = wid & 3, fr = lane & 15, fq = lane >> 4;
    const int K = g.K, nt = K / BK;
    unsigned voffA[2], voffB[2];
#pragma unroll
    for (int i = 0; i < 2; ++i) { int R, C; stage_rc(tid * 16 + i * 8192, R, C); const int Rb = Epi::PERM ? ((R & ~31) + perm32(R & 31)) : R;
        voffA[i] = (unsigned)(R * K + C) * 2u; voffB[i] = (unsigned)(Rb * K + C) * 2u; }
    const size_t kstep = (size_t)(BK * 2);
    const size_t hstep = (size_t)HALF * K * 2;
    const size_t tstep = 2 * hstep;
    const unsigned ldsw = (unsigned)wid * 1024u;
    const int aoff = lds_byte(wr * 64 + fr, fq * 8), boff = lds_byte(wc * 32 + fr, fq * 8);
#define PG8_SA(b, h) (((b) * 2 + (h)) * HTB)
#define PG8_SB(b, h) ((4 + (b) * 2 + (h)) * HTB)
#define PG8_STAGE(bufoff, gbase, voff) do { _Pragma("unroll") for (int _i = 0; _i < 2; ++_i) \
        __builtin_amdgcn_global_load_lds((const unsigned*)((const char*)(gbase) + (voff)[_i]), (PG8_LAS unsigned*)(lds + (bufoff) + ldsw + _i * 8192), 16, 0, 0); } while (0)
#define PG8_LDA(dst, b, h) do { _Pragma("unroll") for (int m = 0; m < 4; ++m) _Pragma("unroll") for (int k = 0; k < 2; ++k) dst[m].set(k, *(const PG8_LAS bf16x8*)(lds + PG8_SA(b, h) + aoff + m * 2048 + k * 1024)); } while (0)
#define PG8_LDB(dst, b, h) do { _Pragma("unroll") for (int n = 0; n < 2; ++n) _Pragma("unroll") for (int k = 0; k < 2; ++k) dst[n].set(k, *(const PG8_LAS bf16x8*)(lds + PG8_SB(b, h) + boff + n * 2048 + k * 1024)); } while (0)
#define PG8_MMA(ai, bj, At, Bt) do { __builtin_amdgcn_s_setprio(1); _Pragma("unroll") for (int m = 0; m < 4; ++m) _Pragma("unroll") for (int n = 0; n < 2; ++n) { \
        if constexpr (F8) { asm volatile("v_mfma_scale_f32_16x16x128_f8f6f4 %0, %1, %2, %0, %3, %4 op_sel_hi:[0,0,0]" : "+v"(acc[ai][bj][m][n]) : "v"(Bt[n].w), "v"(At[m].w), "v"(sc_w), "v"(sc_x)); \
        } else { _Pragma("unroll") for (int k = 0; k < 2; ++k) \
        acc[ai][bj][m][n] = __builtin_amdgcn_mfma_f32_16x16x32_bf16(Bt[n].h[k], At[m].h[k], acc[ai][bj][m][n], 0, 0, 0); } } __builtin_amdgcn_s_setprio(0); } while (0)
#define PG8_WAIT_V(n) asm volatile("s_waitcnt vmcnt(" #n ")" ::: "memory")
#define PG8_WAIT_L(n) asm volatile("s_waitcnt lgkmcnt(" #n ")" ::: "memory")
#define PG8_BAR __builtin_amdgcn_s_barrier()
#define PG8_SCHED __builtin_amdgcn_sched_barrier(0)
    Unit cur, nxt; int ui = 0;
    if (!S.next(0, cur)) return;
    f32x4 acc[2][2][4][2];
#pragma unroll
    for (int a = 0; a < 2; ++a)
#pragma unroll
        for (int b = 0; b < 2; ++b)
#pragma unroll
            for (int m = 0; m < 4; ++m)
#pragma unroll
                for (int n = 0; n < 2; ++n) acc[a][b][m][n] = (f32x4){0.f, 0.f, 0.f, 0.f};
    FragT<F8> At[4], B0[2], B1[2];
    int sc_w = 0x7a7a7a7a, sc_x = 0x7f7f7f7f;
    if constexpr (F8) { asm volatile("" : "+v"(sc_w), "+v"(sc_x)); }
    const char* cA = (const char*)g.A + (size_t)cur.pm * tstep; const char* cB = (const char*)g.Bt + (size_t)cur.pn * tstep;
    S.a_ready(cur);
    if constexpr (SP2) {
        PG8_STAGE(PG8_SB(0, 0), cB, voffB); PG8_STAGE(PG8_SB(0, 1), cB + hstep, voffB); PG8_STAGE(PG8_SA(0, 0), cA, voffA); PG8_STAGE(PG8_SA(0, 1), cA + hstep, voffA);
        if (wr == 1) PG8_BAR;
        PG8_WAIT_V(2); PG8_BAR;
        PG8_STAGE(PG8_SB(1, 0), cB + kstep, voffB); PG8_STAGE(PG8_SA(1, 0), cA + kstep, voffA); PG8_STAGE(PG8_SB(1, 1), cB + hstep + kstep, voffB);
        PG8_WAIT_V(6); PG8_BAR;
    } else {
        PG8_STAGE(PG8_SB(0, 0), cB, voffB); PG8_STAGE(PG8_SA(0, 0), cA, voffA); PG8_STAGE(PG8_SB(0, 1), cB + hstep, voffB); PG8_STAGE(PG8_SA(0, 1), cA + hstep, voffA);
        if (wr == 1) PG8_BAR;
        PG8_WAIT_V(4); PG8_BAR;
        PG8_STAGE(PG8_SB(1, 0), cB + kstep, voffB); PG8_STAGE(PG8_SA(1, 0), cA + kstep, voffA); PG8_STAGE(PG8_SB(1, 1), cB + hstep + kstep, voffB);
        PG8_WAIT_V(6); PG8_BAR;
    }
    for (;;) {
        const bool has_next = S.next(ui + 1, nxt);
        const char* nA = has_next ? (const char*)g.A + (size_t)nxt.pm * tstep : cA; const char* nB = has_next ? (const char*)g.Bt + (size_t)nxt.pn * tstep : cB;
        for (int t = 0; t < nt; t += 2) {
            if constexpr (Epi::MID_T > 0) { if (t == Epi::MID_T) { if constexpr (F8) asm volatile("s_nop 15\n\ts_nop 3" ::: "memory"); E.mid(acc, cur, wr, wc, fr, fq); if constexpr (F8) asm volatile("s_nop 7" ::: "memory"); } }
            const bool last = (t == nt - 2);
            const char* a1 = cA + (size_t)(t + 1) * kstep;
            const char* a2 = last ? nA : cA + (size_t)(t + 2) * kstep; const char* b2 = last ? nB : cB + (size_t)(t + 2) * kstep;
            const char* a3 = a2 + kstep; const char* b3 = b2 + kstep;
            if (last && has_next) S.a_ready(nxt);
            if constexpr (SP2) {
            PG8_LDB(B0, 0, 0); PG8_LDB(B1, 0, 1); PG8_SCHED; PG8_LDA(At, 0, 0); PG8_STAGE(PG8_SA(1, 1), a1 + hstep, voffA);
            PG8_WAIT_V(8); PG8_WAIT_L(0); PG8_BAR; PG8_MMA(0, 0, At, B0); PG8_MMA(0, 1, At, B1); PG8_BAR; PG8_SCHED;
            PG8_LDA(At, 0, 1); PG8_STAGE(PG8_SB(0, 0), b2, voffB); PG8_STAGE(PG8_SB(0, 1), b2 + hstep, voffB); PG8_STAGE(PG8_SA(0, 0), a2, voffA);
            PG8_WAIT_V(8); PG8_WAIT_L(0); PG8_BAR; PG8_MMA(1, 0, At, B0); PG8_MMA(1, 1, At, B1); PG8_BAR; PG8_SCHED;
            PG8_LDB(B0, 1, 0); PG8_LDB(B1, 1, 1); PG8_SCHED; PG8_LDA(At, 1, 0); PG8_STAGE(PG8_SA(0, 1), a2 + hstep, voffA);
            PG8_WAIT_V(8); PG8_WAIT_L(0); PG8_BAR; PG8_MMA(0, 0, At, B0); PG8_MMA(0, 1, At, B1); PG8_BAR; PG8_SCHED;
            PG8_LDA(At, 1, 1); PG8_STAGE(PG8_SB(1, 0), b3, voffB); PG8_STAGE(PG8_SB(1, 1), b3 + hstep, voffB); PG8_STAGE(PG8_SA(1, 0), a3, voffA);
            PG8_WAIT_V(8); PG8_WAIT_L(0); PG8_BAR; PG8_MMA(1, 0, At, B0); PG8_MMA(1, 1, At, B1); PG8_BAR; PG8_SCHED;
            } else {
            PG8_LDB(B0, 0, 0); PG8_SCHED; PG8_LDA(At, 0, 0); PG8_STAGE(PG8_SA(1, 1), a1 + hstep, voffA);
            PG8_WAIT_L(8); PG8_BAR; PG8_WAIT_L(0); PG8_MMA(0, 0, At, B0); PG8_BAR; PG8_SCHED;
            PG8_LDB(B1, 0, 1); PG8_STAGE(PG8_SB(0, 0), b2, voffB);
            PG8_BAR; PG8_WAIT_L(0); PG8_MMA(0, 1, At, B1); PG8_BAR;
            PG8_LDA(At, 0, 1); PG8_STAGE(PG8_SA(0, 0), a2, voffA);
            PG8_BAR; PG8_WAIT_L(0); PG8_MMA(1, 0, At, B0); PG8_BAR; PG8_SCHED;
            PG8_STAGE(PG8_SB(0, 1), b2 + hstep, voffB);
            PG8_WAIT_V(6); PG8_BAR; PG8_MMA(1, 1, At, B1); PG8_BAR;
            PG8_LDB(B0, 1, 0); PG8_SCHED; PG8_LDA(At, 1, 0); PG8_STAGE(PG8_SA(0, 1), a2 + hstep, voffA);
            PG8_WAIT_L(8); PG8_BAR; PG8_WAIT_L(0); PG8_MMA(0, 0, At, B0); PG8_BAR; PG8_SCHED;
            PG8_LDB(B1, 1, 1); PG8_STAGE(PG8_SB(1, 0), b3, voffB);
            PG8_BAR; PG8_WAIT_L(0); PG8_MMA(0, 1, At, B1); PG8_BAR;
            PG8_LDA(At, 1, 1); PG8_STAGE(PG8_SA(1, 0), a3, voffA);
            PG8_BAR; PG8_WAIT_L(0); PG8_MMA(1, 0, At, B0); PG8_BAR; PG8_SCHED;
            PG8_STAGE(PG8_SB(1, 1), b3 + hstep, voffB);
            PG8_WAIT_V(6); PG8_BAR; PG8_MMA(1, 1, At, B1); PG8_BAR;
            }
        }
        if constexpr (F8) { asm volatile("s_nop 15\n\ts_nop 3" ::: "memory"); }
        if constexpr (ALIGN_EPI) { if (wr == 0) PG8_BAR; }
        if constexpr (!Epi::AFTER_DRAIN) { E(acc, cur, wr, wc, fr, fq); S.done(cur); }
        if (!has_next) break;
#pragma unroll
        for (int a = 0; a < 2; ++a)
#pragma unroll
            for (int b = 0; b < 2; ++b)
#pragma unroll
                for (int m = 0; m < 4; ++m)
#pragma unroll
                    for (int n = 0; n < 2; ++n) acc[a][b][m][n] = (f32x4){0.f, 0.f, 0.f, 0.f};
        cur = nxt; cA = nA; cB = nB; ++ui;
        if constexpr (ALIGN_EPI) { if (wr == 1) PG8_BAR; }
    }
    PG8_WAIT_V(0);
    if constexpr (!ALIGN_EPI) { if (wr == 0) PG8_BAR; }
    PG8_BAR;
    if constexpr (Epi::AFTER_DRAIN) { E.fused(acc, cur, wr, wc, fr, fq, lds, wid, lane); S.done(cur); }
#undef PG8_SA
#undef PG8_SB
#undef PG8_STAGE
#undef PG8_LDA
#undef PG8_LDB
#undef PG8_MMA
#undef PG8_WAIT_V
#undef PG8_WAIT_L
#undef PG8_BAR
#undef PG8_SCHED
}
}
#define GAS __attribute__((address_space(1)))
#define LAS __attribute__((address_space(3)))
typedef unsigned short bf16;
typedef unsigned v4u __attribute__((ext_vector_type(4)));
typedef float f32x4 __attribute__((ext_vector_type(4)));
typedef short bf16x8 __attribute__((ext_vector_type(8)));
typedef GAS unsigned gu32;
typedef GAS unsigned long long gu64;
#define RLX_AGENT __ATOMIC_RELAXED, __HIP_MEMORY_SCOPE_AGENT
#define LDS_WAIT() asm volatile("s_waitcnt lgkmcnt(0)" ::: "memory")
#define VM_WAIT() asm volatile("s_waitcnt vmcnt(0)" ::: "memory")
__device__ __forceinline__ unsigned long long rt() { return __builtin_amdgcn_s_memrealtime(); }
__device__ __forceinline__ unsigned f2bf(float f) { unsigned u = __builtin_bit_cast(unsigned, f); return (u + 0x7fffu + ((u >> 16) & 1u)) >> 16; }
__device__ __forceinline__ unsigned pk2(float lo, float hi) { return f2bf(lo) | (f2bf(hi) << 16); }

#define XB_TMO      128
#define XB_XCNT(j)  (256  + 64 * (j))
#define XB_XSUB(j)  (1280 + 64 * (j))
#define XB_XGEN(j)  (2304 + 64 * (j))
#define XB_TOP      3328
#define XB_TOPGEN   3392
#define XCD_BAR_WORDS 3456
#define XB_SPIN_CAP (1u << 18)

__device__ __forceinline__ unsigned xb_ld(unsigned* p)              { return __hip_atomic_load(p, __ATOMIC_RELAXED, __HIP_MEMORY_SCOPE_AGENT); }
__device__ __forceinline__ unsigned xb_add(unsigned* p, unsigned v) { return __hip_atomic_fetch_add(p, v, __ATOMIC_RELAXED, __HIP_MEMORY_SCOPE_AGENT); }
__device__ __forceinline__ unsigned xb_xcc_id() { return (unsigned)__builtin_amdgcn_s_getreg((3 << 11) | 20) & 0xFu; }
#define XB_SPIN(cond, bar) do { unsigned _sp = 0; while (cond) { __builtin_amdgcn_s_sleep(1); \
    if ((++_sp & 255u) == 0u) { if (xb_ld(&(bar)[XB_TMO])) break; if (_sp > XB_SPIN_CAP) { atomicAdd(&(bar)[XB_TMO], 1u); break; } } } } while (0)

struct XcdBarrier {
    unsigned* bar; unsigned x;
    volatile LAS unsigned* st;
};

__device__ __forceinline__ XcdBarrier xcd_barrier_post(unsigned* bar, volatile LAS unsigned* st) {
    XcdBarrier b; b.bar = bar; b.x = xb_xcc_id(); b.st = st;
    if (threadIdx.x == 0) (void)xb_add(&bar[XB_XCNT(b.x)], 1u);
    return b;
}
__device__ __forceinline__ void xcd_barrier_complete(unsigned* bar, unsigned x, unsigned& nloc, unsigned& nx) {
    const unsigned G = gridDim.x * gridDim.y * gridDim.z;
    unsigned sum, cnt, mine, sp = 0u;
    for (;;) {
        sum = 0u; cnt = 0u; mine = 0u;
#pragma unroll
        for (unsigned j = 0; j < 16; ++j) { const unsigned c = xb_ld(&bar[XB_XCNT(j)]); sum += c; cnt += (c > 0u) ? 1u : 0u; mine = (j == x) ? c : mine; }
        if (sum == G) break;
        __builtin_amdgcn_s_sleep(1);
        if ((++sp & 255u) == 0u) { if (xb_ld(&bar[XB_TMO])) break; if (sp > XB_SPIN_CAP) { atomicAdd(&bar[XB_TMO], 1u); break; } }
    }
    nloc = mine > 0u ? mine : 1u; nx = cnt > 0u ? cnt : 1u;
}

__device__ __forceinline__ void xcd_barrier(const XcdBarrier& b) {
    asm volatile("s_waitcnt vmcnt(0)" ::: "memory");
    __syncthreads();
    if (threadIdx.x == 0) {
        unsigned* bar = b.bar;
        __builtin_amdgcn_s_waitcnt(0);
        unsigned nloc = b.st[0], nx = b.st[1];
        if (nloc == 0u) { xcd_barrier_complete(bar, b.x, nloc, nx); b.st[0] = nloc; b.st[1] = nx; }
        const unsigned old = xb_add(&bar[XB_XSUB(b.x)], 1u);
        const unsigned gen = old / nloc;
        if (old + 1u == (gen + 1u) * nloc) {
            __builtin_amdgcn_fence(__ATOMIC_RELEASE, "agent");
            asm volatile("s_waitcnt vmcnt(0)" ::: "memory");
            const unsigned og = xb_add(&bar[XB_TOP], 1u);
            const unsigned tg = og / nx;
            if (og + 1u == (tg + 1u) * nx) xb_add(&bar[XB_TOPGEN], 1u);
            else XB_SPIN(xb_ld(&bar[XB_TOPGEN]) == tg, bar);
            __builtin_amdgcn_fence(__ATOMIC_ACQUIRE, "agent");
            xb_add(&bar[XB_XGEN(b.x)], 1u);
            asm volatile("s_waitcnt vmcnt(0)" ::: "memory");
        } else {
            XB_SPIN(xb_ld(&bar[XB_XGEN(b.x)]) == gen, bar);
            __builtin_amdgcn_fence(__ATOMIC_ACQUIRE, "agent");
            asm volatile("s_waitcnt vmcnt(0)" ::: "memory");
        }
    }
    __syncthreads();
}

constexpr int NWAVES = 8, NTHR = 512;
constexpr int BATCH = 4, SEQ = 4096, DM = 1024, TOK = BATCH * SEQ;
constexpr int INW = 9728;
constexpr int C_RQ = 0, C_RK = 512, C_RV = 1024, C_RG = 2048, C_AQ = 3072, C_AK = 4608, C_AV = 6144, C_GA = 7680, C_GB = 8704;
constexpr int NEXP = 32, FF = 1024, FF2 = 2048;
constexpr int MAXROWS = TOK * 4 + NEXP * 256;
constexpr float RMS_EPS = 1e-6f, GN_EPS = 1e-5f;
constexpr size_t MiB = 1u << 20;
constexpr size_t WS_CTL = 0, CTL_ZERO_BYTES = 32 * 1024;
constexpr size_t WS_ROPE = 1 * MiB;
constexpr size_t WS_WRT = 3 * MiB;
constexpr int N16 = 3072;
constexpr size_t WS_WIN8 = 12 * MiB;
constexpr size_t WS_WIN = 4 * MiB, WS_WRET = 24 * MiB  , WS_WO = 27 * MiB;
constexpr size_t WS_W1 = 32 * MiB, WS_W2 = 160 * MiB;
constexpr size_t WS_H8 = 208 * MiB;
constexpr size_t WS_H = 224 * MiB;
constexpr size_t WS_U = 256 * MiB;
constexpr size_t WS_KV = 560 * MiB;
constexpr size_t WS_RT = 624 * MiB;
constexpr size_t WS_RET = 656 * MiB;
constexpr int RA_LD = 1536;
constexpr size_t WS_OG = 704 * MiB;
constexpr size_t WS_LSE = 752 * MiB;
constexpr size_t WS_MERGED = 753 * MiB;
constexpr size_t WS_XMID = 849 * MiB;
constexpr size_t WS_XIN = 256 * MiB;
constexpr int XCAP = 16384;
constexpr size_t WS_A = 768 * MiB;
constexpr size_t WS_YB = 913 * MiB;
constexpr size_t WS_TE = 1000 * MiB, WS_TP = WS_TE + 256 * 1024, WS_TG = WS_TP + 256 * 1024;
constexpr size_t WS_END = 1002 * MiB;
static_assert(WS_XIN + (size_t)NEXP * XCAP * 1024 <= WS_A && WS_A + (size_t)MAXROWS * 1024 <= WS_XMID && WS_XMID + (size_t)TOK * DM * 4 <= WS_YB && WS_YB + (size_t)MAXROWS * 1024 <= WS_TE, "MoE map");
constexpr int CW_BAR = 4096;
constexpr int CW_MOD = 8192;
constexpr int CW_CNT = 7680;
constexpr int CW_MODRDY = 7744;
static_assert(CW_BAR + 3456 <= CW_CNT && (CW_MODRDY + 64) * 4 <= (int)CTL_ZERO_BYTES && CW_MODRDY + 64 <= CW_MOD, "ctl");
constexpr int LDS_BYTES = 160 * 1024 - 512, MISC_OFF = LDS_BYTES - 256;

__device__ __forceinline__ float bflo(unsigned w) { return __uint_as_float(w << 16); }
__device__ __forceinline__ float bfhi(unsigned w) { return __uint_as_float(w & 0xffff0000u); }
typedef float f32x2_t_ __attribute__((ext_vector_type(2))); typedef __bf16 bf16x2_t_ __attribute__((ext_vector_type(2)));
__device__ __forceinline__ unsigned cvtpk(float lo, float hi) { const f32x2_t_ v = {lo, hi}; const bf16x2_t_ b = __builtin_convertvector(v, bf16x2_t_); return __builtin_bit_cast(unsigned, b); }
__device__ __forceinline__ unsigned f8x2bf(unsigned w, bool hi) { typedef float f32x2_ __attribute__((ext_vector_type(2))); const f32x2_ f = hi ? __builtin_amdgcn_cvt_pk_f32_fp8((int)w, true) : __builtin_amdgcn_cvt_pk_f32_fp8((int)w, false); return cvtpk(f.x, f.y); }
__device__ __forceinline__ float wave_sum(float v) {
#pragma unroll
    for (int o = 1; o < 64; o <<= 1) v += __shfl_xor(v, o);
    return v;
}
static __device__ const double ROPE_C[64] = {0.15915494309189535, 0.13782250260398285, 0.11934937021124886, 0.10335229661843406, 0.089499401608891013, 0.077503288755374058, 0.067115083005227255, 0.058119267441876246, 0.050329212104487035, 0.04358330210530733, 0.037741584717419771, 0.032682865872356998, 0.028302195830623399, 0.024508691862069852, 0.02122365276477766, 0.018378926105679667, 0.015915494309189534, 0.013782250260398284, 0.011934937021124886, 0.010335229661843406, 0.0089499401608891024, 0.0077503288755374055, 0.0067115083005227253, 0.0058119267441876241, 0.0050329212104487037, 0.0043583302105307331, 0.0037741584717419772, 0.0032682865872356993, 0.0028302195830623399, 0.0024508691862069852, 0.0021223652764777662, 0.0018378926105679667, 0.0015915494309189536, 0.0013782250260398288, 0.0011934937021124885, 0.0010335229661843405, 0.00089499401608891024, 0.00077503288755374051, 0.0006711508300522726, 0.00058119267441876239, 0.00050329212104487033, 0.00043583302105307329, 0.00037741584717419774, 0.00032682865872356992, 0.00028302195830623395, 0.00024508691862069854, 0.00021223652764777661, 0.00018378926105679666, 0.00015915494309189535, 0.00013782250260398286, 0.00011934937021124886, 0.00010335229661843406, 8.9499401608891018e-05, 7.7503288755374056e-05, 6.7115083005227254e-05, 5.8119267441876239e-05, 5.0329212104487035e-05, 4.3583302105307322e-05, 3.7741584717419777e-05, 3.2682865872356999e-05, 2.8302195830623396e-05, 2.4508691862069852e-05, 2.1223652764777659e-05, 1.8378926105679668e-05};
__device__ __forceinline__ float log2g(int h) { return h == 0 ? -0.0458036896f : (h == 1 ? -0.0227200765f : (h == 2 ? -0.0113153132f : -0.00564656314f)); }

constexpr size_t UBLK = (size_t)TOK * 256; constexpr int ULD = 256;
__device__ __forceinline__ const bf16* ucol(const unsigned char* ws, int col) { return (const bf16*)(ws + WS_U) + (size_t)(col >> 8) * UBLK + (col & 255); }
__device__ __forceinline__ const unsigned char* ucol8(const unsigned char* ws, int col) { return ws + WS_U + (size_t)(N16 / 256) * UBLK * 2 + (size_t)((col >> 8) - N16 / 256) * UBLK + (col & 255); }
typedef short v4i16_t __attribute__((ext_vector_type(4)));
struct Args { const float* in[18]; float* out; unsigned char* ws; int ph_lo, ph_hi; };
struct Frame { LAS unsigned char* lds; volatile LAS unsigned* MISC; gu32* ctl; int tid, lane, wave, vcu, G; };

template <bool F8, int NB = 32>
__device__ __forceinline__ void p0_transpose_item(const float* W, int K, int N, bf16* WT, LAS float* scr, int item, int lane, int ldk = 0) {
    if (ldk == 0) ldk = K;
    const int nblk = N / 32, kb = item / nblk, nb = item % nblk, k0 = 64 * kb, n0 = 32 * nb;
#pragma unroll
    for (int hb = 0; hb < 32 / NB; ++hb) { float t[NB];
      const float* wp = W + (size_t)(k0 + 2 * NB * hb + (lane >> 5)) * N + n0 + (lane & 31);
#pragma unroll
      for (int i = 0; i < NB; ++i) t[i] = __builtin_nontemporal_load(wp + (size_t)(2 * i) * N);
#pragma unroll
      for (int i = 0; i < NB; ++i) scr[(2 * (NB * hb + i) + (lane >> 5)) * 33 + (lane & 31)] = t[i]; }
    LDS_WAIT(); asm volatile("" ::: "memory");
    const int c = lane & 7;
#pragma unroll
    for (int j = 0; j < 4; ++j) { const int n = (lane >> 3) + 8 * j; const LAS float* s = scr + (8 * c) * 33 + n;
        if (F8) { int w0 = 0, w1 = 0;
            w0 = __builtin_amdgcn_cvt_pk_fp8_f32(s[0 * 33] * 32.f, s[1 * 33] * 32.f, w0, false); w0 = __builtin_amdgcn_cvt_pk_fp8_f32(s[2 * 33] * 32.f, s[3 * 33] * 32.f, w0, true);
            w1 = __builtin_amdgcn_cvt_pk_fp8_f32(s[4 * 33] * 32.f, s[5 * 33] * 32.f, w1, false); w1 = __builtin_amdgcn_cvt_pk_fp8_f32(s[6 * 33] * 32.f, s[7 * 33] * 32.f, w1, true);
            typedef int i32x2 __attribute__((ext_vector_type(2)));
            *(GAS i32x2*)((unsigned char*)WT + (size_t)(n0 + n) * ldk + k0 + 8 * c) = (i32x2){w0, w1};
        } else { v4u o; o.x = pk2(s[0 * 33], s[1 * 33]); o.y = pk2(s[2 * 33], s[3 * 33]); o.z = pk2(s[4 * 33], s[5 * 33]); o.w = pk2(s[6 * 33], s[7 * 33]);
            *(GAS v4u*)(WT + (size_t)(n0 + n) * ldk + k0 + 8 * c) = o; } }
    LDS_WAIT(); asm volatile("" ::: "memory");
}
__device__ __forceinline__ void p0_prologue(const Args& a, Frame& F) {
    const int gw = F.vcu * NWAVES + F.wave, NGW = F.G * NWAVES;
    { float2* rope = (float2*)(a.ws + WS_ROPE);
      for (int idx = F.vcu * NTHR + F.tid; idx < SEQ * 64; idx += F.G * NTHR) { const int pos = idx >> 6, i = idx & 63;
          double rev = (double)pos * ROPE_C[i]; rev -= __builtin_floor(rev); const float f = (float)rev;
          rope[idx] = make_float2(__builtin_amdgcn_cosf(f), __builtin_amdgcn_sinf(f)); } }
    { bf16* wrt = (bf16*)(a.ws + WS_WRT); const float* wr = a.in[11];
      for (int idx = F.vcu * NTHR + F.tid; idx < 1024 * 32; idx += F.G * NTHR) { const int k = idx >> 5, e = idx & 31; const float w = wr[idx];
          const unsigned hi = f2bf(w); const float lo = w - __uint_as_float(hi << 16); wrt[e * 1024 + k] = (bf16)hi; wrt[32768 + e * 1024 + k] = (bf16)f2bf(lo); } }
    if (F.vcu < 96) { float* mod = (float*)(a.ws + WS_CTL) + CW_MOD; const float* c = a.in[1]; const float* w_ada = a.in[2]; const float* b_ada = a.in[3];
      const int cg = F.vcu, col = cg * 64 + F.lane; LAS float* red = (LAS float*)(F.lds + 8 * 16384);
      float acc[4] = {0.f, 0.f, 0.f, 0.f};
      for (int kc = 0; kc < 2; ++kc) { const int k0 = F.wave * 128 + kc * 64; float cs[4];
#pragma unroll
          for (int b = 0; b < 4; ++b) { const float cv = c[b * DM + k0 + F.lane]; cs[b] = cv / (1.0f + __expf(-cv)); }
#pragma unroll 16
          for (int kk = 0; kk < 64; ++kk) { const float w = w_ada[(size_t)(k0 + kk) * 6144 + col];
#pragma unroll
              for (int b = 0; b < 4; ++b) acc[b] += __shfl(cs[b], kk) * w; } }
#pragma unroll
      for (int b = 0; b < 4; ++b) red[(F.wave * 4 + b) * 64 + F.lane] = acc[b];
      __syncthreads();
      if (F.tid < 256) { const int b = F.tid >> 6, ln = F.tid & 63; float s = b_ada[cg * 64 + ln];
#pragma unroll
          for (int w = 0; w < 8; ++w) s += red[(w * 4 + b) * 64 + ln];
          mod[b * 6144 + cg * 64 + ln] = s; }
      asm volatile("s_waitcnt vmcnt(0)" ::: "memory"); __syncthreads();
      if (F.tid == 0) { __builtin_amdgcn_fence(__ATOMIC_RELEASE, "agent"); asm volatile("s_waitcnt vmcnt(0)" ::: "memory"); __hip_atomic_fetch_add(F.ctl + CW_MODRDY, 1u, RLX_AGENT); } }
    { LAS float* scr = (LAS float*)(F.lds + F.wave * 16384);
      constexpr int I_IN = 16 * (INW / 32), I_RET = 16 * 32, I_ATT = 8 * 32, I_O = 16 * 32, I_1E = 16 * 64, I_2E = 16 * 32;
      constexpr int NITEMS = I_IN + I_RET + I_ATT + I_O;
      if (F.vcu >= 96 || F.G <= 96)
      for (int it = (F.G > 96 ? gw - 96 * NWAVES : gw); it < NITEMS; it += (F.G > 96 ? NGW - 96 * NWAVES : NGW)) { int r = it;
          if (r < I_IN) { const int nb = r % (INW / 32);
              if (nb < N16 / 32) p0_transpose_item<false>(a.in[5], 1024, INW, (bf16*)(a.ws + WS_WIN), scr, r, F.lane);
              else p0_transpose_item<true>(a.in[5], 1024, INW, (bf16*)(a.ws + WS_WIN8 - (size_t)N16 * 1024), scr, r, F.lane);
              continue; } r -= I_IN;
          if (r < I_RET) { p0_transpose_item<true>(a.in[7], 1024, 1024, (bf16*)(a.ws + WS_WRET), scr, r, F.lane, RA_LD); continue; } r -= I_RET;
          if (r < I_ATT) { p0_transpose_item<true>(a.in[8], 512, 1024, (bf16*)(a.ws + WS_WRET + 1024), scr, r, F.lane, RA_LD); continue; } r -= I_ATT;
          p0_transpose_item<false>(a.in[9], 1024, 1024, (bf16*)(a.ws + WS_WO), scr, r, F.lane); } }
}
__device__ __forceinline__ void moe_item8(const float* W, int N, unsigned char* WT8, LAS bf16* scr, int item, int lane) {
    const int nblk = N / 32, kb = item / nblk, nb = item % nblk, k0 = 128 * kb, n0 = 32 * nb, rr = lane >> 3, cq = lane & 7;
    typedef unsigned u32x2 __attribute__((ext_vector_type(2)));
    f32x4 t[16];
    { const float* wp = W + (size_t)(k0 + rr) * N + n0 + 4 * cq;
#pragma unroll
      for (int i = 0; i < 16; ++i) t[i] = __builtin_nontemporal_load((const GAS f32x4*)(wp + (size_t)(8 * i) * N)); }
#pragma unroll
    for (int i = 0; i < 16; ++i) *(LAS u32x2*)(scr + (8 * i + rr) * 40 + 4 * cq) = (u32x2){cvtpk(t[i].x, t[i].y), cvtpk(t[i].z, t[i].w)};
    LDS_WAIT(); asm volatile("" ::: "memory");
    const int g = lane >> 4, i15 = lane & 15, qq = i15 >> 2, p = i15 & 3;
#pragma unroll
    for (int c0 = 0; c0 < 32; c0 += 16)
#pragma unroll
        for (int kh = 0; kh < 2; ++kh) { const LAS bf16* a0 = scr + (64 * kh + 16 * g + qq) * 40 + c0 + 4 * p; v4u o;
#pragma unroll
            for (int sb = 0; sb < 4; ++sb) { const v4i16_t v = __builtin_amdgcn_ds_read_tr16_b64_v4i16((LAS v4i16_t*)(a0 + 4 * sb * 40)); const u32x2 w2 = __builtin_bit_cast(u32x2, v);
                int w8 = 0; w8 = __builtin_amdgcn_cvt_pk_fp8_f32(bflo(w2.x) * 32.f, bfhi(w2.x) * 32.f, w8, false); w8 = __builtin_amdgcn_cvt_pk_fp8_f32(bflo(w2.y) * 32.f, bfhi(w2.y) * 32.f, w8, true);
                if (sb == 0) o.x = (unsigned)w8; else if (sb == 1) o.y = (unsigned)w8; else if (sb == 2) o.z = (unsigned)w8; else o.w = (unsigned)w8; }
            *(GAS v4u*)(WT8 + (size_t)(n0 + c0 + i15) * 1024 + k0 + 64 * kh + 16 * g) = o; }
    LDS_WAIT(); asm volatile("" ::: "memory");
}
__device__ __forceinline__ void moe_convert(const Args& a, Frame& F, int k0, int nk) {
    LAS bf16* scr = (LAS bf16*)(F.lds + F.wave * 16384); const int gw = F.vcu * NWAVES + F.wave, NGW = F.G * NWAVES;
    constexpr int I_1E = 8 * 64, I_2E = 8 * 32;
    for (int k = k0; k < k0 + nk; ++k) { int r = gw + NGW * k;
        if (r < NEXP * I_1E) { const int e = r / I_1E; moe_item8(a.in[13] + (size_t)e * 1024 * FF2, FF2, a.ws + WS_W1 + (size_t)e * FF2 * 1024, scr, r % I_1E, F.lane); continue; } r -= NEXP * I_1E;
        if (r < NEXP * I_2E) { const int e = r / I_2E; moe_item8(a.in[15] + (size_t)e * FF * 1024, 1024, a.ws + WS_W2 + (size_t)e * 1024 * FF, scr, r % I_2E, F.lane); } }
}
__device__ __forceinline__ void norm_mod_row(const float* xrow, const float* g, const float* sc, const float* sh, bf16* orow, unsigned char* orow8, int lane) {
    const GAS f32x4* xr = (const GAS f32x4*)xrow + lane; f32x4 v[4]; float s = 0.f;
#pragma unroll
    for (int j = 0; j < 4; ++j) { v[j] = __builtin_nontemporal_load(xr + 64 * j); s += (v[j].x * v[j].x + v[j].y * v[j].y) + (v[j].z * v[j].z + v[j].w * v[j].w); }
    const float rstd = 1.0f / sqrtf(wave_sum(s) * (1.0f / DM) + RMS_EPS);
    GAS int* o4 = (GAS int*)orow8 + lane; GAS unsigned long long* o8 = (GAS unsigned long long*)orow + lane;
#pragma unroll
    for (int j = 0; j < 4; ++j) { const int c = 4 * (64 * j + lane); const f32x4 gg = *(const f32x4*)(g + c), ss = *(const f32x4*)(sc + c), hh = *(const f32x4*)(sh + c);
        const f32x4 o = v[j] * rstd * gg * (ss + 1.0f) + hh;
        int w8 = 0; w8 = __builtin_amdgcn_cvt_pk_fp8_f32(o.x, o.y, w8, false); w8 = __builtin_amdgcn_cvt_pk_fp8_f32(o.z, o.w, w8, true);
        o4[64 * j] = w8; o8[64 * j] = (unsigned long long)cvtpk(o.x, o.y) | ((unsigned long long)cvtpk(o.z, o.w) << 32); }
}
__device__ __forceinline__ void p1_norm1(const Args& a, Frame& F) {
    const int gw = F.vcu * NWAVES + F.wave, NGW = F.G * NWAVES, lane = F.lane; const float* mod = (const float*)(a.ws + WS_CTL) + CW_MOD;
    bool waited = false;
    for (int m0 = gw; m0 < TOK; m0 += 4 * NGW) {
        f32x4 v[4][4]; float rstd[4];
#pragma unroll
        for (int r = 0; r < 4; ++r) { const int m = m0 + r * NGW; const GAS f32x4* xr = (const GAS f32x4*)(a.in[0] + (size_t)(m < TOK ? m : m0) * DM) + lane;
#pragma unroll
            for (int j = 0; j < 4; ++j) v[r][j] = __builtin_nontemporal_load(xr + 64 * j); }
#pragma unroll
        for (int r = 0; r < 4; ++r) { float s = 0.f;
#pragma unroll
            for (int j = 0; j < 4; ++j) s += (v[r][j].x * v[r][j].x + v[r][j].y * v[r][j].y) + (v[r][j].z * v[r][j].z + v[r][j].w * v[r][j].w);
            rstd[r] = 1.0f / sqrtf(wave_sum(s) * (1.0f / DM) + RMS_EPS); }
        if (!waited) { waited = true;
            if (F.tid == 0) { unsigned sp = 0;
                while (__hip_atomic_load(F.ctl + CW_MODRDY, RLX_AGENT) < 96u && ++sp < (1u << 22)) __builtin_amdgcn_s_sleep(2);
                __builtin_amdgcn_fence(__ATOMIC_ACQUIRE, "agent"); asm volatile("s_waitcnt vmcnt(0)" ::: "memory"); }
            __syncthreads(); }
#pragma unroll
        for (int r = 0; r < 4; ++r) { const int m = m0 + r * NGW; if (m < TOK) { const int b = m / SEQ; const float* g = a.in[4]; const float* sc = mod + b * 6144 + 1024; const float* sh = mod + b * 6144;
            GAS int* o4 = (GAS int*)(a.ws + WS_H8 + (size_t)m * DM) + lane; GAS unsigned long long* o8 = (GAS unsigned long long*)((bf16*)(a.ws + WS_H) + (size_t)m * DM) + lane;
#pragma unroll
            for (int j = 0; j < 4; ++j) { const int c = 4 * (64 * j + lane); const f32x4 gg = *(const f32x4*)(g + c), ss = *(const f32x4*)(sc + c), hh = *(const f32x4*)(sh + c);
                const f32x4 o = v[r][j] * rstd[r] * gg * (ss + 1.0f) + hh;
                int w8 = 0; w8 = __builtin_amdgcn_cvt_pk_fp8_f32(o.x, o.y, w8, false); w8 = __builtin_amdgcn_cvt_pk_fp8_f32(o.z, o.w, w8, true);
                o4[64 * j] = w8; o8[64 * j] = (unsigned long long)cvtpk(o.x, o.y) | ((unsigned long long)cvtpk(o.z, o.w) << 32); } } }
    }
    if (!waited) { __syncthreads(); }
}

#define MFMA16(a, b, c) __builtin_amdgcn_mfma_f32_16x16x32_bf16((a), (b), (c), 0, 0, 0)
__device__ __forceinline__ bf16x8 ldsfrag(const LAS bf16* base, int pitch, int row0, int k0, int lane) { return *(const LAS bf16x8*)(base + (row0 + (lane & 15)) * pitch + k0 + 8 * (lane >> 4)); }

__device__ __forceinline__ bf16x8 ldsfrag_tr(const LAS bf16* M, int pitch, int k0, int c0, int lane) {
    const int g = lane >> 4, i = lane & 15, qq = i >> 2, p = i & 3;
    const LAS bf16* a0 = M + (k0 + 8 * g + qq) * pitch + c0 + 4 * p;
    const v4i16_t lo = __builtin_amdgcn_ds_read_tr16_b64_v4i16((LAS v4i16_t*)a0), hi = __builtin_amdgcn_ds_read_tr16_b64_v4i16((LAS v4i16_t*)(a0 + 4 * pitch));
    return (bf16x8){lo[0], lo[1], lo[2], lo[3], hi[0], hi[1], hi[2], hi[3]};
}
constexpr int AT_KP = 136, AT_PP = 168;
constexpr int AT_KS = 0, AT_VS = 256 * AT_KP * 2, AT_BIAS = AT_VS + 272 * AT_KP * 2;
struct AttnU { const unsigned char *Qb, *Kb, *Vb; size_t rstride; int i0, r, g, hh; size_t tok0; };
__device__ __forceinline__ AttnU attn_decode(const Args& a, int U) {
    AttnU u; const int ub = U & 31; u.hh = (U >> 5) & 3; u.g = (U >> 7) % 3; const int b = U / 384;
    const int rs = 2 * u.g; u.r = 1 << rs; const int ares = ub & (u.r - 1), blk = ub >> rs; u.i0 = blk * 128;
    u.tok0 = (size_t)(b * SEQ + ares); u.rstride = (size_t)u.r * ULD; const int hc = (u.g * 4 + u.hh) * 128;
    u.Qb = ucol8(a.ws, C_AQ + hc) + u.tok0 * ULD; u.Kb = ucol8(a.ws, C_AK + hc) + u.tok0 * ULD; u.Vb = ucol8(a.ws, C_AV + hc) + u.tok0 * ULD;
    return u;
}
__device__ __forceinline__ void attn_phase(const Args& a, Frame& F) {
    LAS bf16* KS = (LAS bf16*)(F.lds + AT_KS); LAS bf16* VS = (LAS bf16*)(F.lds + AT_VS); LAS float* BIAS = (LAS float*)(F.lds + AT_BIAS);
    const int tid = F.tid, lane = F.lane, w = F.wave, q = lane >> 4, l15 = lane & 15;
    typedef unsigned u32x2 __attribute__((ext_vector_type(2)));
    int U = F.vcu; if (U >= 1536) return;
    v4u kreg[4], vreg[4];
    { const AttnU u = attn_decode(a, U);
#pragma unroll
      for (int it = 0; it < 4; ++it) { const int c = tid + NTHR * it, kk = c >> 3, ch = c & 7; int i = u.i0 - 128 + kk; i = i < 0 ? 0 : i;
          const size_t ro = (size_t)i * u.rstride + ch * 16; kreg[it] = *(const GAS v4u*)(u.Kb + ro); vreg[it] = *(const GAS v4u*)(u.Vb + ro); }
    }
    if (tid < 256) { LAS v4u* z = (LAS v4u*)(VS + (256 + (tid >> 4)) * AT_KP + (tid & 15) * 8); z[0] = (v4u){0u, 0u, 0u, 0u}; }
    const bool bg_pre = (F.vcu & 1) != 0; int slot = 0;
    for (; U < 1536; U += F.G, ++slot) {
        if (bg_pre) { moe_convert(a, F, 2 * slot, 2); __syncthreads(); }
        const AttnU u = attn_decode(a, U);
        bf16x8 qf[4];
        { const unsigned char* qrow = u.Qb + (size_t)(u.i0 + 16 * w + l15) * u.rstride + 8 * q; typedef unsigned u32x2q __attribute__((ext_vector_type(2)));
          u32x2q qb[4];
#pragma unroll
          for (int ks = 0; ks < 4; ++ks) qb[ks] = *(const GAS u32x2q*)(qrow + 32 * ks);
#pragma unroll
          for (int ks = 0; ks < 4; ++ks) qf[ks] = __builtin_bit_cast(bf16x8, (v4u){f8x2bf(qb[ks].x, false), f8x2bf(qb[ks].x, true), f8x2bf(qb[ks].y, false), f8x2bf(qb[ks].y, true)}); }
#pragma unroll
        for (int it = 0; it < 4; ++it) { const int c = tid + NTHR * it, kk = c >> 3, ch = c & 7; const bool ok = (u.i0 - 128 + kk) >= 0;
            const v4u kz = ok ? kreg[it] : (v4u){0u, 0u, 0u, 0u}, vz = ok ? vreg[it] : (v4u){0u, 0u, 0u, 0u};
            *(LAS v4u*)(KS + kk * AT_KP + ch * 16) = (v4u){f8x2bf(kz.x, false), f8x2bf(kz.x, true), f8x2bf(kz.y, false), f8x2bf(kz.y, true)};
            *(LAS v4u*)(KS + kk * AT_KP + ch * 16 + 8) = (v4u){f8x2bf(kz.z, false), f8x2bf(kz.z, true), f8x2bf(kz.w, false), f8x2bf(kz.w, true)};
            *(LAS v4u*)(VS + kk * AT_KP + ch * 16) = (v4u){f8x2bf(vz.x, false), f8x2bf(vz.x, true), f8x2bf(vz.y, false), f8x2bf(vz.y, true)};
            *(LAS v4u*)(VS + kk * AT_KP + ch * 16 + 8) = (v4u){f8x2bf(vz.z, false), f8x2bf(vz.z, true), f8x2bf(vz.w, false), f8x2bf(vz.w, true)}; }
        if (tid < 129) { const int dist = u.r * tid; int bk;
            if (dist < 16) bk = dist; else { bk = 16 + (int)(__log2f((float)dist * 0.0625f) * (16.0f / 7.0f)); bk = bk > 31 ? 31 : bk; }
            BIAS[tid] = a.in[6][bk * 12 + u.g * 4 + u.hh]; }
        __syncthreads();
        if (U + F.G < 1536) { const AttnU n = attn_decode(a, U + F.G);
#pragma unroll
            for (int it = 0; it < 4; ++it) { const int c = tid + NTHR * it, kk = c >> 3, ch = c & 7; int i = n.i0 - 128 + kk; i = i < 0 ? 0 : i;
                const size_t ro = (size_t)i * n.rstride + ch * 16; kreg[it] = *(const GAS v4u*)(n.Kb + ro); vreg[it] = *(const GAS v4u*)(n.Vb + ro); } }
        f32x4 s[9];
#pragma unroll
        for (int t9 = 0; t9 < 9; ++t9) { f32x4 acc = (f32x4){0.f, 0.f, 0.f, 0.f};
#pragma unroll
            for (int ks = 0; ks < 4; ++ks) acc = MFMA16(ldsfrag(KS, AT_KP, 16 * (w + t9), 32 * ks, lane), qf[ks], acc);
            s[t9] = acc; }
        const float scale = 0.08838834764831845f;
        float mx = -INFINITY;
#pragma unroll
        for (int t9 = 0; t9 < 9; ++t9)
#pragma unroll
            for (int rr = 0; rr < 4; ++rr) { const int krel = 16 * t9 + 4 * q + rr, dist = 128 + l15 - krel; const bool valid = (dist >= 0) && (dist <= 128) && (u.i0 - 128 + 16 * w + krel >= 0);
                const float v = valid ? s[t9][rr] * scale + BIAS[valid ? dist : 0] : -INFINITY; s[t9][rr] = v; mx = fmaxf(mx, v); }
        mx = fmaxf(mx, __shfl_xor(mx, 16)); mx = fmaxf(mx, __shfl_xor(mx, 32));
        float lsum = 0.f;
#pragma unroll
        for (int t9 = 0; t9 < 9; ++t9)
#pragma unroll
            for (int rr = 0; rr < 4; ++rr) { const float p = __expf(s[t9][rr] - mx); s[t9][rr] = p; lsum += p; }
        lsum += __shfl_xor(lsum, 16); lsum += __shfl_xor(lsum, 32);
        __syncthreads();
        LAS bf16* PS = KS + w * 16 * AT_PP;
#pragma unroll
        for (int t9 = 0; t9 < 9; ++t9) *(LAS u32x2*)(PS + l15 * AT_PP + 16 * t9 + 4 * q) = (u32x2){cvtpk(s[t9][0], s[t9][1]), cvtpk(s[t9][2], s[t9][3])};
        *(LAS u32x2*)(PS + l15 * AT_PP + 144 + 4 * q) = (u32x2){0u, 0u};
        __syncthreads();
        bf16x8 pf[5];
#pragma unroll
        for (int ks = 0; ks < 5; ++ks) pf[ks] = ldsfrag(PS, AT_PP, 0, 32 * ks, lane);
        const float inv = 16.0f / lsum;
        const size_t tokrow = u.tok0 + (size_t)(u.i0 + 16 * w + l15) * u.r;
        unsigned char* og = a.ws + WS_OG + (size_t)u.g * TOK * 512 + tokrow * 512 + u.hh * 128 + 4 * (q & 2);
#pragma unroll
        for (int dp = 0; dp < 8; dp += 2) { int pc[2];
#pragma unroll
            for (int d2 = 0; d2 < 2; ++d2) { f32x4 acc = (f32x4){0.f, 0.f, 0.f, 0.f};
#pragma unroll
                for (int ks = 0; ks < 5; ++ks) acc = MFMA16(ldsfrag_tr(VS, AT_KP, 16 * w + 32 * ks, 16 * (dp + d2), lane), pf[ks], acc);
                int pk = 0; pk = __builtin_amdgcn_cvt_pk_fp8_f32(acc[0] * inv, acc[1] * inv, pk, false); pk = __builtin_amdgcn_cvt_pk_fp8_f32(acc[2] * inv, acc[3] * inv, pk, true); pc[d2] = pk; }
            const bool odd = (q & 1) != 0;
            const int r0 = __shfl_xor(odd ? pc[0] : pc[1], 16);
            typedef int i32x2 __attribute__((ext_vector_type(2)));
            *(GAS i32x2*)(og + 16 * (dp + (odd ? 1 : 0))) = odd ? (i32x2){r0, pc[1]} : (i32x2){pc[0], r0}; }
        if (q == 0) ((float*)(a.ws + WS_LSE))[(size_t)u.g * TOK * 4 + tokrow * 4 + u.hh] = mx + __logf(lsum);
        __syncthreads();
        if (!bg_pre) { moe_convert(a, F, 2 * slot, 2); __syncthreads(); }
    }
}

constexpr int RT_P = 136, RV_P = 264;
struct RotRegs { v4u lo[2], hi[2]; };
__device__ __forceinline__ void rot_issue(Frame& F, const bf16* src, RotRegs& r) {
#pragma unroll
    for (int it = 0; it < 2; ++it) { const int pc = F.tid + NTHR * it, j = pc >> 3, d0 = (pc & 7) * 8; r.lo[it] = *(const GAS v4u*)(src + (size_t)j * ULD + d0); r.hi[it] = *(const GAS v4u*)(src + (size_t)j * ULD + d0 + 64); }
}
__device__ __forceinline__ void rope_issue(const Args& a, Frame& F, int pos0, f32x4 (&cs)[2][4]) {
    const float* rope = (const float*)(a.ws + WS_ROPE);
#pragma unroll
    for (int it = 0; it < 2; ++it) { const int pc = F.tid + NTHR * it, j = pc >> 3, d0 = (pc & 7) * 8; const GAS f32x4* rp = (const GAS f32x4*)(rope + ((size_t)(pos0 + j) * 64 + d0) * 2);
#pragma unroll
        for (int i = 0; i < 4; ++i) cs[it][i] = rp[i]; }
}
template <bool ZETA>
__device__ __forceinline__ void rot_finish(Frame& F, const RotRegs& r, const f32x4 (&cs)[2][4], float mul, float l2g, LAS bf16* dst) {
#pragma unroll
    for (int it = 0; it < 2; ++it) { const int pc = F.tid + NTHR * it, j = pc >> 3, d0 = (pc & 7) * 8;
        const float m = ZETA ? mul * __builtin_amdgcn_exp2f((float)(127 - j) * l2g) : mul;
        float ol[8], oh[8];
#pragma unroll
        for (int i = 0; i < 8; ++i) { const unsigned wl = i < 2 ? r.lo[it].x : (i < 4 ? r.lo[it].y : (i < 6 ? r.lo[it].z : r.lo[it].w)), wh = i < 2 ? r.hi[it].x : (i < 4 ? r.hi[it].y : (i < 6 ? r.hi[it].z : r.hi[it].w));
            const float tl = (i & 1) ? bfhi(wl) : bflo(wl), th = (i & 1) ? bfhi(wh) : bflo(wh); const float c = (i & 1) ? cs[it][i >> 1].z : cs[it][i >> 1].x, sn = (i & 1) ? cs[it][i >> 1].w : cs[it][i >> 1].y;
            ol[i] = (tl * c - th * sn) * m; oh[i] = (tl * sn + th * c) * m; }
        *(LAS v4u*)(dst + j * RT_P + d0) = (v4u){cvtpk(ol[0], ol[1]), cvtpk(ol[2], ol[3]), cvtpk(ol[4], ol[5]), cvtpk(ol[6], ol[7])};
        *(LAS v4u*)(dst + j * RT_P + d0 + 64) = (v4u){cvtpk(oh[0], oh[1]), cvtpk(oh[2], oh[3]), cvtpk(oh[4], oh[5]), cvtpk(oh[6], oh[7])}; }
}
__device__ __forceinline__ void v_issue(Frame& F, const bf16* src, v4u (&t)[8]) {
#pragma unroll
    for (int it = 0; it < 8; ++it) { const int c = F.tid + NTHR * it, j = c >> 5, ch = c & 31; t[it] = *(const GAS v4u*)(src + (size_t)j * ULD + ch * 8); }
}
__device__ __forceinline__ void v_finish(Frame& F, const v4u (&t)[8], LAS bf16* VS) {
#pragma unroll
    for (int it = 0; it < 8; ++it) { const int c = F.tid + NTHR * it, j = c >> 5, ch = c & 31; *(LAS v4u*)(VS + j * RV_P + ch * 8) = t[it]; }
}
__device__ __forceinline__ void ret_kv_item(const Args& a, Frame& F, int item) {
    const int h = item & 3, n = (item >> 2) & 31, b = item >> 7; const float l2g = log2g(h);
    const size_t r0 = (size_t)(b * SEQ + n * 128) * ULD;
    LAS bf16* KZ = (LAS bf16*)F.lds; LAS bf16* VS = (LAS bf16*)(F.lds + 128 * RT_P * 2);
    { RotRegs kr; f32x4 cs[2][4]; v4u vt[8];
      rot_issue(F, ucol(a.ws, C_RK + h * 128) + r0, kr); rope_issue(a, F, n * 128, cs); v_issue(F, ucol(a.ws, C_RV + h * 256) + r0, vt);
      rot_finish<true>(F, kr, cs, 0.08838834764831845f, l2g, KZ); v_finish(F, vt, VS); }
    __syncthreads();
    const int lane = F.lane, w = F.wave, q = lane >> 4, l15 = lane & 15;
    f32x4 acc[2][8];
#pragma unroll
    for (int e2 = 0; e2 < 2; ++e2)
#pragma unroll
        for (int dt = 0; dt < 8; ++dt) acc[e2][dt] = (f32x4){0.f, 0.f, 0.f, 0.f};
#pragma unroll
    for (int ks = 0; ks < 4; ++ks) { const bf16x8 v0 = ldsfrag_tr(VS, RV_P, 32 * ks, 32 * w, lane), v1 = ldsfrag_tr(VS, RV_P, 32 * ks, 32 * w + 16, lane);
#pragma unroll
        for (int dt = 0; dt < 8; ++dt) { const bf16x8 kk = ldsfrag_tr(KZ, RT_P, 32 * ks, 16 * dt, lane); acc[0][dt] = MFMA16(kk, v0, acc[0][dt]); acc[1][dt] = MFMA16(kk, v1, acc[1][dt]); } }
    bf16* kv = (bf16*)(a.ws + WS_KV) + (size_t)item * 32768; typedef unsigned u32x2 __attribute__((ext_vector_type(2)));
#pragma unroll
    for (int e2 = 0; e2 < 2; ++e2)
#pragma unroll
        for (int dt = 0; dt < 8; ++dt) *(GAS u32x2*)(kv + (32 * w + 16 * e2 + l15) * 128 + 16 * dt + 4 * q) = (u32x2){cvtpk(acc[e2][dt][0], acc[e2][dt][1]), cvtpk(acc[e2][dt][2], acc[e2][dt][3])};
    __syncthreads();
}
__device__ __forceinline__ void p4_scan_merge(const Args& a, Frame& F) {
    const bf16* kv = (const bf16*)(a.ws + WS_KV); bf16* rt = (bf16*)(a.ws + WS_RT);
    for (int idx = F.vcu * NTHR + F.tid; idx < 16 * 8192; idx += F.G * NTHR) {
        const int bh = idx >> 13, el = (idx & 8191) * 4, b = bh >> 2, h = bh & 3; const float gch = exp2f(128.0f * log2g(h));
        f32x4 R = (f32x4){0.f, 0.f, 0.f, 0.f};
        for (int n0 = 0; n0 < 32; n0 += 8) { unsigned long long k8[8];
#pragma unroll
            for (int i = 0; i < 8; ++i) k8[i] = __builtin_nontemporal_load((const GAS unsigned long long*)(kv + (size_t)(((b * 32 + n0 + i) << 2) + h) * 32768 + el));
#pragma unroll
            for (int i = 0; i < 8; ++i) { const size_t off = (size_t)(((b * 32 + n0 + i) << 2) + h) * 32768 + el;
                *(GAS unsigned long long*)(rt + off) = (unsigned long long)cvtpk(R.x, R.y) | ((unsigned long long)cvtpk(R.z, R.w) << 32);
                const unsigned lo = (unsigned)k8[i], hi = (unsigned)(k8[i] >> 32); R = R * gch + (f32x4){bflo(lo), bfhi(lo), bflo(hi), bfhi(hi)}; } } }
    const int gw = F.vcu * NWAVES + F.wave, NGW = F.G * NWAVES;
    const unsigned char* og = a.ws + WS_OG; const float* lse = (const float*)(a.ws + WS_LSE);
    for (int t2 = gw; t2 < TOK / 2; t2 += NGW) { const int t = 2 * t2 + (F.lane >> 5), l31 = F.lane & 31, hh = l31 >> 3;
        const float l0 = lse[(size_t)t * 4 + hh], l1 = lse[(size_t)TOK * 4 + (size_t)t * 4 + hh], l2 = lse[(size_t)2 * TOK * 4 + (size_t)t * 4 + hh];
        const float m = fmaxf(l0, fmaxf(l1, l2)); float a0 = __expf(l0 - m), a1 = __expf(l1 - m), a2 = __expf(l2 - m); const float is = 0.0625f / (a0 + a1 + a2); a0 *= is; a1 *= is; a2 *= is;
        const size_t o = (size_t)t * 512 + l31 * 16;
        const v4u x0 = *(const GAS v4u*)(og + o), x1 = *(const GAS v4u*)(og + (size_t)TOK * 512 + o), x2 = *(const GAS v4u*)(og + (size_t)2 * TOK * 512 + o);
        v4u r;
#pragma unroll
        for (int j = 0; j < 4; ++j) { const unsigned w0 = j == 0 ? x0.x : (j == 1 ? x0.y : (j == 2 ? x0.z : x0.w)), w1 = j == 0 ? x1.x : (j == 1 ? x1.y : (j == 2 ? x1.z : x1.w)), w2 = j == 0 ? x2.x : (j == 1 ? x2.y : (j == 2 ? x2.z : x2.w));
            const f32x2_t_ p0 = __builtin_amdgcn_cvt_pk_f32_fp8((int)w0, false), q0 = __builtin_amdgcn_cvt_pk_f32_fp8((int)w0, true);
            const f32x2_t_ p1 = __builtin_amdgcn_cvt_pk_f32_fp8((int)w1, false), q1 = __builtin_amdgcn_cvt_pk_f32_fp8((int)w1, true);
            const f32x2_t_ p2 = __builtin_amdgcn_cvt_pk_f32_fp8((int)w2, false), q2 = __builtin_amdgcn_cvt_pk_f32_fp8((int)w2, true);
            int pk = 0; pk = __builtin_amdgcn_cvt_pk_fp8_f32(a0 * p0.x + a1 * p1.x + a2 * p2.x, a0 * p0.y + a1 * p1.y + a2 * p2.y, pk, false);
            pk = __builtin_amdgcn_cvt_pk_fp8_f32(a0 * q0.x + a1 * q1.x + a2 * q2.x, a0 * q0.y + a1 * q1.y + a2 * q2.y, pk, true);
            if (j == 0) r.x = (unsigned)pk; else if (j == 1) r.y = (unsigned)pk; else if (j == 2) r.z = (unsigned)pk; else r.w = (unsigned)pk; }
        *(GAS v4u*)(a.ws + WS_RET + (size_t)t * RA_LD + 1024 + l31 * 16) = r; }
}
__device__ __forceinline__ void ret_out_item(const Args& a, Frame& F, int item) {
    const int h = item & 3, n = (item >> 2) & 31, b = item >> 7; const float l2g = log2g(h);
    const size_t r0 = (size_t)(b * SEQ + n * 128) * ULD;
    LAS bf16* QS = (LAS bf16*)F.lds; LAS bf16* KS = (LAS bf16*)(F.lds + 128 * RT_P * 2); LAS bf16* VS = (LAS bf16*)(F.lds + 2 * 128 * RT_P * 2);
    LAS float* RED = (LAS float*)(F.lds + 2 * 128 * RT_P * 2 + 128 * RV_P * 2);
    { RotRegs qr, kr; f32x4 cs[2][4]; v4u vt[8];
      rot_issue(F, ucol(a.ws, C_RQ + h * 128) + r0, qr); rot_issue(F, ucol(a.ws, C_RK + h * 128) + r0, kr); rope_issue(a, F, n * 128, cs); v_issue(F, ucol(a.ws, C_RV + h * 256) + r0, vt);
      rot_finish<false>(F, qr, cs, 1.0f, l2g, QS); rot_finish<false>(F, kr, cs, 0.08838834764831845f, l2g, KS); v_finish(F, vt, VS); }
    __syncthreads();
    const int lane = F.lane, w = F.wave, q = lane >> 4, l15 = lane & 15;
    typedef unsigned u32x2 __attribute__((ext_vector_type(2)));
    u32x2 pw[8];
    bf16x8 rf0[4], rf1[4];
    { const bf16* rtg = (const bf16*)(a.ws + WS_RT) + (size_t)item * 32768 + (size_t)(32 * w + l15) * 128 + 8 * q;
#pragma unroll
      for (int ks = 0; ks < 4; ++ks) { rf0[ks] = *(const GAS bf16x8*)(rtg + 32 * ks); rf1[ks] = *(const GAS bf16x8*)(rtg + 16 * 128 + 32 * ks); } }
    { bf16x8 qf[4];
#pragma unroll
      for (int ks = 0; ks < 4; ++ks) qf[ks] = ldsfrag(QS, RT_P, 16 * w, 32 * ks, lane);
#pragma unroll
      for (int jt = 0; jt < 8; ++jt) { f32x4 acc = (f32x4){0.f, 0.f, 0.f, 0.f};
          if (jt <= w) {
#pragma unroll
              for (int ks = 0; ks < 4; ++ks) acc = MFMA16(ldsfrag(KS, RT_P, 16 * jt, 32 * ks, lane), qf[ks], acc); }
          float p[4];
#pragma unroll
          for (int rr = 0; rr < 4; ++rr) { const int j = 16 * jt + 4 * q + rr, i = 16 * w + l15; p[rr] = (j <= i) ? acc[rr] * __builtin_amdgcn_exp2f(-(float)(j + 1) * l2g) : 0.f; }
          pw[jt] = (u32x2){cvtpk(p[0], p[1]), cvtpk(p[2], p[3])}; } }
    __syncthreads();
#pragma unroll
    for (int jt = 0; jt < 8; ++jt) *(LAS u32x2*)(KS + (16 * w + l15) * RT_P + 16 * jt + 4 * q) = pw[jt];
    __syncthreads();
    f32x4 acc[2][8];
#pragma unroll
    for (int e2 = 0; e2 < 2; ++e2)
#pragma unroll
        for (int it = 0; it < 8; ++it) acc[e2][it] = (f32x4){0.f, 0.f, 0.f, 0.f};
#pragma unroll
    for (int ks = 0; ks < 4; ++ks) { const bf16x8 a0 = ldsfrag_tr(VS, RV_P, 32 * ks, 32 * w, lane), a1 = ldsfrag_tr(VS, RV_P, 32 * ks, 32 * w + 16, lane);
#pragma unroll
        for (int it = 2 * ks; it < 8; ++it) { const bf16x8 pf = ldsfrag(KS, RT_P, 16 * it, 32 * ks, lane); acc[0][it] = MFMA16(a0, pf, acc[0][it]); acc[1][it] = MFMA16(a1, pf, acc[1][it]); } }
#pragma unroll
    for (int ks = 0; ks < 4; ++ks) {
#pragma unroll
        for (int it = 0; it < 8; ++it) { const bf16x8 qf = ldsfrag(QS, RT_P, 16 * it, 32 * ks, lane); acc[0][it] = MFMA16(rf0[ks], qf, acc[0][it]); acc[1][it] = MFMA16(rf1[ks], qf, acc[1][it]); } }
#pragma unroll
    for (int it = 0; it < 8; ++it) { const float xi = __builtin_amdgcn_exp2f((float)(16 * it + l15 + 1) * l2g); acc[0][it] = acc[0][it] * xi; acc[1][it] = acc[1][it] * xi;
        float s1 = (acc[0][it][0] + acc[0][it][1]) + (acc[0][it][2] + acc[0][it][3]) + (acc[1][it][0] + acc[1][it][1]) + (acc[1][it][2] + acc[1][it][3]);
        float s2 = (acc[0][it][0] * acc[0][it][0] + acc[0][it][1] * acc[0][it][1]) + (acc[0][it][2] * acc[0][it][2] + acc[0][it][3] * acc[0][it][3]) + (acc[1][it][0] * acc[1][it][0] + acc[1][it][1] * acc[1][it][1]) + (acc[1][it][2] * acc[1][it][2] + acc[1][it][3] * acc[1][it][3]);
        s1 += __shfl_xor(s1, 16); s1 += __shfl_xor(s1, 32); s2 += __shfl_xor(s2, 16); s2 += __shfl_xor(s2, 32);
        if (q == 0) *(LAS u32x2*)(RED + (16 * it + l15) * 16 + 2 * w) = (u32x2){__float_as_uint(s1), __float_as_uint(s2)}; }
    __syncthreads();
#pragma unroll
    for (int it = 0; it < 8; ++it) { const LAS f32x4* rp = (const LAS f32x4*)(RED + (16 * it + l15) * 16); const f32x4 r0 = rp[0], r1 = rp[1], r2 = rp[2], r3 = rp[3];
        const float s1 = (r0[0] + r0[2]) + (r1[0] + r1[2]) + (r2[0] + r2[2]) + (r3[0] + r3[2]), s2 = (r0[1] + r0[3]) + (r1[1] + r1[3]) + (r2[1] + r2[3]) + (r3[1] + r3[3]);
        const float mean = s1 * (1.0f / 256.0f), var = fmaxf(s2 * (1.0f / 256.0f) - mean * mean, 0.f), rstd = 1.0f / sqrtf(var + GN_EPS);
        const size_t tok = (size_t)(b * SEQ + n * 128 + 16 * it + l15);
        const bf16* gp = ucol(a.ws, C_RG + h * 256) + tok * ULD + 32 * w + 4 * q; unsigned char* op = a.ws + WS_RET + tok * RA_LD + h * 256 + 32 * w + 4 * q;
        int w8p[2];
#pragma unroll
        for (int e2 = 0; e2 < 2; ++e2) { const u32x2 gg = *(const GAS u32x2*)(gp + 16 * e2);
            const float g0 = bflo(gg.x), g1 = bfhi(gg.x), g2 = bflo(gg.y), g3 = bfhi(gg.y);
#define SILU_(x) ((x) * __builtin_amdgcn_rcpf(1.0f + __expf(-(x))))
            const float o0 = SILU_(g0) * (acc[e2][it][0] - mean) * rstd, o1 = SILU_(g1) * (acc[e2][it][1] - mean) * rstd, o2 = SILU_(g2) * (acc[e2][it][2] - mean) * rstd, o3 = SILU_(g3) * (acc[e2][it][3] - mean) * rstd;
#undef SILU_
            int w8 = 0; w8 = __builtin_amdgcn_cvt_pk_fp8_f32(o0, o1, w8, false); w8 = __builtin_amdgcn_cvt_pk_fp8_f32(o2, o3, w8, true); w8p[e2] = w8; }
        { const bool odd = (q & 1) != 0; const int recv = __shfl_xor(odd ? w8p[0] : w8p[1], 16);
          *(GAS u32x2*)(op - 4 * (q & 1) + (odd ? 16 : 0)) = odd ? (u32x2){(unsigned)recv, (unsigned)w8p[1]} : (u32x2){(unsigned)w8p[0], (unsigned)recv}; } }
    __syncthreads();
}

constexpr int P8_RSTD = 0, P8_LG = 1024, P8_CNT = P8_LG + 2 * 64 * 32 * 4, P8_LB = P8_CNT + 128, P8_LTE = P8_LB + 128, P8_LTP = P8_LTE + 1024, P8_H2 = P8_LTP + 1024;
__device__ __forceinline__ void p8_route(const Args& a, Frame& F) {
    LAS float* RSTD = (LAS float*)(F.lds + P8_RSTD); LAS float* LG = (LAS float*)(F.lds + P8_LG); LAS int* CNT = (LAS int*)(F.lds + P8_CNT);
    if (F.tid < 32) CNT[F.tid] = 0;
    const float* mod = (const float*)(a.ws + WS_CTL) + CW_MOD; const int lane = F.lane, w = F.wave, q = lane >> 4, l15 = lane & 15;
    const float* xm = (const float*)(a.ws + WS_XMID); LAS unsigned char* H2L = F.lds + P8_H2;
    LAS int* LB = (LAS int*)(F.lds + P8_LB); LAS int* LTE = (LAS int*)(F.lds + P8_LTE); LAS int* LTP = (LAS int*)(F.lds + P8_LTP);
    int* TE = (int*)(a.ws + WS_TE); int* TP = (int*)(a.ws + WS_TP); float* TG = (float*)(a.ws + WS_TG);
    const int t0 = F.vcu * 64, b = t0 / SEQ;
    const float* gf = a.in[10]; const float* scf = mod + b * 6144 + 4096; const float* shf = mod + b * 6144 + 3072;
#pragma unroll
    for (int hb = 0; hb < 2; ++hb) { f32x4 v[4][4];
#pragma unroll
        for (int ri = 0; ri < 4; ++ri) { const GAS f32x4* xr = (const GAS f32x4*)(xm + (size_t)(t0 + 8 * w + 4 * hb + ri) * DM) + lane;
#pragma unroll
            for (int j = 0; j < 4; ++j) v[ri][j] = xr[64 * j]; }
#pragma unroll
        for (int ri = 0; ri < 4; ++ri) { float s = 0.f;
#pragma unroll
            for (int j = 0; j < 4; ++j) s += (v[ri][j].x * v[ri][j].x + v[ri][j].y * v[ri][j].y) + (v[ri][j].z * v[ri][j].z + v[ri][j].w * v[ri][j].w);
            const float rstd = 1.0f / sqrtf(wave_sum(s) * (1.0f / DM) + RMS_EPS);
            if (lane == 0) RSTD[8 * w + 4 * hb + ri] = rstd;
            LAS int* o4 = (LAS int*)(H2L + (8 * w + 4 * hb + ri) * DM) + lane;
#pragma unroll
            for (int j = 0; j < 4; ++j) { const int c = 4 * (64 * j + lane); const f32x4 gg = *(const f32x4*)(gf + c), ss = *(const f32x4*)(scf + c), hh = *(const f32x4*)(shf + c);
                const f32x4 o = v[ri][j] * rstd * gg * (ss + 1.0f) + hh;
                int w8 = 0; w8 = __builtin_amdgcn_cvt_pk_fp8_f32(o.x, o.y, w8, false); w8 = __builtin_amdgcn_cvt_pk_fp8_f32(o.z, o.w, w8, true); o4[64 * j] = w8; } } }
    __syncthreads();
    { const int rt = w & 3, kh = w >> 2; const float rstd = RSTD[16 * rt + l15];
      const float* xrow = xm + (size_t)(t0 + 16 * rt + l15) * DM + 512 * kh + 8 * q;
      const bf16* wh = (const bf16*)(a.ws + WS_WRT) + (size_t)l15 * 1024 + 512 * kh + 8 * q; const bf16* wl = wh + 32768;
      f32x4 acc0 = (f32x4){0.f, 0.f, 0.f, 0.f}, acc1 = (f32x4){0.f, 0.f, 0.f, 0.f};
#pragma unroll 4
      for (int ks = 0; ks < 16; ++ks) { const int kc = 512 * kh + 32 * ks + 8 * q;
          const f32x4 x0 = *(const GAS f32x4*)(xrow + 32 * ks), x1 = *(const GAS f32x4*)(xrow + 32 * ks + 4);
          const f32x4 g0 = *(const f32x4*)(gf + kc), g1 = *(const f32x4*)(gf + kc + 4), s0 = *(const f32x4*)(scf + kc), s1 = *(const f32x4*)(scf + kc + 4), h0 = *(const f32x4*)(shf + kc), h1 = *(const f32x4*)(shf + kc + 4);
          const f32x4 o0 = x0 * rstd * g0 * (s0 + 1.0f) + h0, o1 = x1 * rstd * g1 * (s1 + 1.0f) + h1;
          v4u hi; hi.x = cvtpk(o0.x, o0.y); hi.y = cvtpk(o0.z, o0.w); hi.z = cvtpk(o1.x, o1.y); hi.w = cvtpk(o1.z, o1.w);
          v4u lo; lo.x = cvtpk(o0.x - bflo(hi.x), o0.y - bfhi(hi.x)); lo.y = cvtpk(o0.z - bflo(hi.y), o0.w - bfhi(hi.y)); lo.z = cvtpk(o1.x - bflo(hi.z), o1.y - bfhi(hi.z)); lo.w = cvtpk(o1.z - bflo(hi.w), o1.w - bfhi(hi.w));
          const bf16x8 ah = __builtin_bit_cast(bf16x8, hi), al = __builtin_bit_cast(bf16x8, lo);
          const bf16x8 wh0 = *(const GAS bf16x8*)(wh + 32 * ks), wh1 = *(const GAS bf16x8*)(wh + 16 * 1024 + 32 * ks), wl0 = *(const GAS bf16x8*)(wl + 32 * ks), wl1 = *(const GAS bf16x8*)(wl + 16 * 1024 + 32 * ks);
          acc0 = MFMA16(ah, wh0, acc0); acc0 = MFMA16(al, wh0, acc0); acc0 = MFMA16(ah, wl0, acc0);
          acc1 = MFMA16(ah, wh1, acc1); acc1 = MFMA16(al, wh1, acc1); acc1 = MFMA16(ah, wl1, acc1); }
#pragma unroll
      for (int rr = 0; rr < 4; ++rr) { LG[(kh * 64 + 16 * rt + 4 * q + rr) * 32 + l15] = acc0[rr]; LG[(kh * 64 + 16 * rt + 4 * q + rr) * 32 + 16 + l15] = acc1[rr]; } }
    __syncthreads();
    { const int e = lane & 31; const float br = a.in[12][e];
      for (int ri = 0; ri < 8; ++ri) { const int row = 8 * w + ri, t = t0 + row;
          float v = LG[row * 32 + e] + LG[(64 + row) * 32 + e] + br; float tv[4]; int ti[4];
#pragma unroll
          for (int k = 0; k < 4; ++k) { float m = v;
#pragma unroll
              for (int o = 1; o < 32; o <<= 1) m = fmaxf(m, __shfl_xor(m, o));
              const unsigned long long bal = __ballot(v == m); const int idx = __ffsll((long long)(bal & 0xffffffffull)) - 1;
              tv[k] = m; ti[k] = idx; if (e == idx) v = -INFINITY; }
          const float e1 = __expf(tv[1] - tv[0]), e2 = __expf(tv[2] - tv[0]), e3 = __expf(tv[3] - tv[0]); const float is = 1.0f / (1.0f + e1 + e2 + e3);
          if (lane < 4) { const int k = lane; const int ek = k == 0 ? ti[0] : (k == 1 ? ti[1] : (k == 2 ? ti[2] : ti[3])); const float gk = (k == 0 ? 1.0f : (k == 1 ? e1 : (k == 2 ? e2 : e3))) * is;
              const int lp = __hip_atomic_fetch_add(&CNT[ek], 1, __ATOMIC_RELAXED, __HIP_MEMORY_SCOPE_WORKGROUP);
              LTE[row * 4 + k] = ek; LTP[row * 4 + k] = lp; TE[t * 4 + k] = ek; TG[t * 4 + k] = gk; } } }
    __syncthreads();
    if (F.tid < 32) { const int cnt = CNT[F.tid]; LB[F.tid] = (int)__hip_atomic_fetch_add(F.ctl + CW_CNT + F.tid, (unsigned)cnt, RLX_AGENT); }
    __syncthreads();
    for (int pi = 0; pi < 32; ++pi) { const int p = w * 32 + pi, row = p >> 2; const int ek = LTE[p], pos = LB[ek] + LTP[p];
        if (lane == 0) TP[(t0 + row) * 4 + (p & 3)] = pos;
        *((GAS v4u*)(a.ws + WS_XIN + ((size_t)ek * XCAP + pos) * DM) + lane) = *((const LAS v4u*)(H2L + row * DM) + lane); }
    __syncthreads();
}
constexpr int MT_CS = 131072, MT_PM = MT_CS + 128, MT_E = MT_PM + 1280, MT_NT = MT_E + 1280;
__device__ __forceinline__ int moe_tables(Frame& F, bool sparse_a) {
    LAS int* CS = (LAS int*)(F.lds + MT_CS); LAS int* TPM = (LAS int*)(F.lds + MT_PM); LAS int* TEX = (LAS int*)(F.lds + MT_E); LAS int* NT = (LAS int*)(F.lds + MT_NT);
    if (F.tid < 64) { const int e = F.tid & 31; const int cnt = (int)__hip_atomic_load(F.ctl + CW_CNT + e, RLX_AGENT), n = (cnt + 255) >> 8;
        int incl = n;
#pragma unroll
        for (int o = 1; o < 32; o <<= 1) { const int v = __shfl_up(incl, o, 32); if (e >= o) incl += v; }
        const int t = incl - n;
        if (F.tid < 32) { CS[e] = t << 8;
            for (int j = 0; j < n; ++j) { TPM[t + j] = sparse_a ? e * (XCAP / 256) + j : t + j; TEX[t + j] = e; }
            if (e == 31) NT[0] = incl; } }
    __syncthreads();
    return __builtin_amdgcn_readfirstlane(NT[0]);
}
__device__ __forceinline__ void p12_final(const Args& a, Frame& F, bool with_moe, bool tables_ready) {
    LAS int* CS = (LAS int*)(F.lds + MT_CS); if (with_moe && !tables_ready) (void)moe_tables(F, false);
    const int gw = F.vcu * NWAVES + F.wave, NGW = F.G * NWAVES, lane = F.lane; const float* mod = (const float*)(a.ws + WS_CTL) + CW_MOD;
    const float* xm = (const float*)(a.ws + WS_XMID); const unsigned char* yb = a.ws + WS_YB; const int* TE = (const int*)(a.ws + WS_TE); const int* TP = (const int*)(a.ws + WS_TP); const float* TG = (const float*)(a.ws + WS_TG);
    for (int t = gw; t < TOK; t += NGW) { const int b = t / SEQ;
        f32x4 v[4], m4[4];
#pragma unroll
        for (int j = 0; j < 4; ++j) { v[j] = __builtin_nontemporal_load((const GAS f32x4*)(xm + (size_t)t * DM) + lane + 64 * j); m4[j] = (f32x4){0.f, 0.f, 0.f, 0.f}; }
        if (with_moe) {
#pragma unroll
            for (int k = 0; k < 4; ++k) { const int row = CS[TE[t * 4 + k]] + TP[t * 4 + k]; const float gk = TG[t * 4 + k]; const GAS int* yr = (const GAS int*)(yb + (size_t)row * DM) + lane;
#pragma unroll
                for (int j = 0; j < 4; ++j) { const int y4 = __builtin_nontemporal_load(yr + 64 * j); typedef float f32x2_ __attribute__((ext_vector_type(2)));
                    const f32x2_ lo = __builtin_amdgcn_cvt_pk_f32_fp8(y4, false), hi = __builtin_amdgcn_cvt_pk_f32_fp8(y4, true);
                    m4[j].x += gk * lo.x; m4[j].y += gk * lo.y; m4[j].z += gk * hi.x; m4[j].w += gk * hi.y; } }
        }
        float s = 0.f;
#pragma unroll
        for (int j = 0; j < 4; ++j) { const f32x4 gt = *(const f32x4*)(mod + b * 6144 + 5120 + 4 * (64 * j + lane)); v[j] = v[j] + gt * m4[j]; s += (v[j].x * v[j].x + v[j].y * v[j].y) + (v[j].z * v[j].z + v[j].w * v[j].w); }
        const float rstd = 1.0f / sqrtf(wave_sum(s) * (1.0f / DM) + RMS_EPS);
#pragma unroll
        for (int j = 0; j < 4; ++j) { const f32x4 gf = *(const f32x4*)(a.in[17] + 4 * (64 * j + lane)); __builtin_nontemporal_store(v[j] * rstd * gf, (GAS f32x4*)(a.out + (size_t)t * DM) + lane + 64 * j); } }
}

#ifndef ABL_NOMIX
#define ABL_NOMIX 0
#endif
#ifndef ABL_NOMOE
#define ABL_NOMOE 0
#endif
#ifndef ONE_LAUNCH
#define ONE_LAUNCH 1
#endif
constexpr int NPHASE = 13;
__global__ void __launch_bounds__(NTHR, 2) mk_fwd(Args args) {
    extern __shared__ __attribute__((aligned(16))) unsigned char lds[];
    Frame F;
    F.lds = (LAS unsigned char*)lds; F.MISC = (volatile LAS unsigned*)(F.lds + MISC_OFF);
    F.tid = threadIdx.x; F.lane = F.tid & 63; F.wave = __builtin_amdgcn_readfirstlane(F.tid >> 6);
    F.G = gridDim.x; { const int bx = blockIdx.x; F.vcu = (F.G % 8 == 0) ? (bx % 8) * (F.G / 8) + bx / 8 : bx; }
    unsigned char* ws = args.ws; F.ctl = (gu32*)(ws + WS_CTL);
    if (F.tid < 64) F.MISC[F.tid] = 0u;
    __syncthreads();
    XcdBarrier bar = xcd_barrier_post((unsigned*)(F.ctl + CW_BAR), F.MISC + 8);
    const int lo = args.ph_lo, hi = args.ph_hi;
#ifndef PHMASK
#define PHMASK 0x1fff
#endif
#define IN(k) (lo <= (k) && (k) < hi && ((PHMASK >> (k)) & 1))
#ifndef REPMASK
#define REPMASK 0
#endif
#define REP(k) for (int rep_ = 0; rep_ < ((((REPMASK) >> (k)) & 1) ? 2 : 1); ++rep_)
#ifndef XBAR
#define XBAR 0
#endif
#define SEAM(k) do { if (IN(k) && IN((k) + 1)) { xcd_barrier(bar); if ((XBAR >> (k)) & 1) { xcd_barrier(bar); xcd_barrier(bar); } } } while (0)
    typedef pg8::bf16_t pb;
    if (IN(0)) REP(0) { p0_prologue(args, F); }
#if !ABL_NOMIX
    if (IN(1)) REP(1) { p1_norm1(args, F); } SEAM(1);
    if (IN(2)) REP(2) {
        { pg8::Gemm g{(const pb*)(ws + WS_H), (const pb*)(ws + WS_WIN), TOK, N16, DM}; pg8::SplitOrder S; S.init(TOK, N16, F.G, (int)blockIdx.x); S.nx = 4; S.ny = 2;
          pg8::EpiBf16<0> E{(pb*)(ws + WS_U), ULD, nullptr, 256, UBLK, 1.f};
          pg8::gemm_phase<pg8::EpiBf16<0>, pg8::SplitOrder, true, true>(F.lds, g, S, E); }
        __syncthreads();
        { pg8::Gemm g{(const pb*)(ws + WS_H8), (const pb*)(ws + WS_WIN8), TOK, INW - N16, DM / 2}; pg8::SplitOrder S; S.init(TOK, INW - N16, F.G, (int)blockIdx.x); S.nx = 5; S.ny = 8;
          pg8::EpiFp8Blk E{ws + WS_U + (size_t)(N16 / 256) * UBLK * 2, UBLK};
          pg8::gemm_phase<pg8::EpiFp8Blk, pg8::SplitOrder, true, true, true>(F.lds, g, S, E); } } SEAM(2);
    if (IN(3)) { REP(3) { attn_phase(args, F); }
        REP(13) { for (int it = (F.vcu + 128) % F.G; it < 512; it += F.G) ret_kv_item(args, F, it); } } SEAM(3);
    if (IN(4)) REP(4) { p4_scan_merge(args, F); } SEAM(4);
    if (IN(5)) REP(5) { for (int it = F.vcu; it < 512; it += F.G) ret_out_item(args, F, it); } SEAM(5);
    if (IN(6)) REP(6) { pg8::Gemm g{(const pb*)(ws + WS_RET), (const pb*)(ws + WS_WRET), TOK, DM, RA_LD / 2}; pg8::StaticOrder S; S.init(TOK, DM, F.G, (int)blockIdx.x);
        pg8::EpiGate2<8> E{(pb*)(ws + WS_MERGED), DM, ucol8(ws, C_GA), ucol8(ws, C_GB), UBLK};
        pg8::gemm_phase<pg8::EpiGate2<8>, pg8::StaticOrder, true, true, true>(F.lds, g, S, E); } SEAM(6);
    if (IN(7)) REP(7) { pg8::Gemm g{(const pb*)(ws + WS_MERGED), (const pb*)(ws + WS_WO), TOK, DM, 1024}; pg8::StaticOrder S; S.init(TOK, DM, F.G, (int)blockIdx.x);
        pg8::EpiResid E{(float*)(ws + WS_XMID), args.in[0], DM, (const float*)(ws + WS_CTL) + CW_MOD + 2048, 6144, SEQ / 256};
        pg8::gemm_phase<pg8::EpiResid, pg8::StaticOrder, true, true>(F.lds, g, S, E); } SEAM(7);
#else
    if (IN(7)) { const f32x4* s = (const f32x4*)args.in[0]; f32x4* d = (f32x4*)(ws + WS_XMID); for (size_t i = (size_t)blockIdx.x * NTHR + F.tid; i < (size_t)TOK * DM / 4; i += (size_t)F.G * NTHR) d[i] = s[i]; } SEAM(7);
#endif
#if !ABL_NOMOE
    if (IN(8)) { p8_route(args, F); } if (IN(8) && IN(10)) xcd_barrier(bar);
    if (IN(10)) REP(10) { const int nt = moe_tables(F, true);
        pg8::Gemm g{(const pb*)(ws + WS_XIN), (const pb*)(ws + WS_W1), nt * 256, NEXP * FF2, DM / 2}; pg8::MoeOrder S{nt, FF2 / 256, F.G, F.vcu  , (const LAS int*)(F.lds + MT_PM), (const LAS int*)(F.lds + MT_E)};
        pg8::EpiSwiglu E{(pb*)(ws + WS_A), FF, args.in[14], FF2 / 256};
        pg8::gemm_phase<pg8::EpiSwiglu, pg8::MoeOrder, true, true, true>(F.lds, g, S, E); } SEAM(10);
    if (IN(11)) REP(11) { const int nt = IN(10) ? __builtin_amdgcn_readfirstlane(((LAS int*)(F.lds + MT_NT))[0]) : moe_tables(F, true);
        pg8::Gemm g{(const pb*)(ws + WS_A), (const pb*)(ws + WS_W2), nt * 256, NEXP * DM, FF / 2}; pg8::MoeOrder S{nt, DM / 256, F.G, F.vcu, (const LAS int*)nullptr, (const LAS int*)(F.lds + MT_E)};
        pg8::EpiFp8Row E{ws + WS_YB, DM, args.in[16], DM / 256};
        pg8::gemm_phase<pg8::EpiFp8Row, pg8::MoeOrder, true, true, true>(F.lds, g, S, E); } SEAM(11);
#endif
    if (IN(12)) REP(12) { p12_final(args, F, !ABL_NOMOE, IN(10)); }
#undef IN
#undef SEAM
}

extern "C" void kernel_launch(void* const* d_in, const int* in_sizes, int n_in, void* d_out, int out_size, void* d_ws, size_t ws_size, hipStream_t stream) {
    static int grid = 0;
    if (grid == 0) {
        if (n_in != 18 || in_sizes[0] != TOK * DM || out_size != TOK * DM || ws_size < WS_END) { fprintf(stderr, "kernel_launch: unexpected shapes n_in %d in0 %d out %d ws %zu\n", n_in, n_in > 0 ? in_sizes[0] : -1, out_size, ws_size); grid = -1; return; }
        int dev = 0, cus = 0, per_cu = 0;
        if (hipGetDevice(&dev) != hipSuccess || hipDeviceGetAttribute(&cus, hipDeviceAttributeMultiprocessorCount, dev) != hipSuccess) { grid = -1; return; }
        if (hipFuncSetAttribute((const void*)mk_fwd, hipFuncAttributeMaxDynamicSharedMemorySize, LDS_BYTES) != hipSuccess) { fprintf(stderr, "kernel_launch: hipFuncSetAttribute failed\n"); grid = -1; return; }
        if (hipOccupancyMaxActiveBlocksPerMultiprocessor(&per_cu, (const void*)mk_fwd, NTHR, LDS_BYTES) != hipSuccess || per_cu < 1) fprintf(stderr, "kernel_launch: occupancy query says %d\n", per_cu);
        (void)hipGetLastError();
        grid = cus;
        if (grid != 256) fprintf(stderr, "kernel_launch: %d CUs (built for 256)\n", grid);
    }
    if (grid < 0) return;
    (void)hipMemsetAsync((char*)d_ws + WS_CTL, 0, CTL_ZERO_BYTES, stream);
    Args a{};
    for (int i = 0; i < 18; ++i) a.in[i] = (const float*)d_in[i];
    a.out = (float*)d_out; a.ws = (unsigned char*)d_ws;
#if ONE_LAUNCH
    a.ph_lo = 0; a.ph_hi = NPHASE;
    hipLaunchKernelGGL(mk_fwd, dim3(grid), dim3(NTHR), LDS_BYTES, stream, a);
#else
    for (int p = 0; p < NPHASE; ++p) {
#if ABL_NOMIX
        if (p >= 1 && p <= 6) continue;
#endif
#if ABL_NOMOE
        if (p >= 8 && p <= 11) continue;
#endif
        a.ph_lo = p; a.ph_hi = p + 1;
        hipLaunchKernelGGL(mk_fwd, dim3(grid), dim3(NTHR), LDS_BYTES, stream, a);
    }
#endif
}
```

```cpp
#include <hip/hip_runtime.h>
#include <cstdio>
#include <cstdint>
namespace pg8 {
#define PG8_LAS __attribute__((address_space(3)))
typedef unsigned short bf16_t;
typedef short bf16x8 __attribute__((ext_vector_type(8)));
typedef float f32x4 __attribute__((ext_vector_type(4)));
typedef unsigned u32x4 __attribute__((ext_vector_type(4)));
constexpr int BM = 256, BK = 64, HALF = 128, HTB = HALF * BK * 2  , STAGE_BYTES = 8 * HTB, NXCD = 8, WGM = 4;

__host__ __device__ __forceinline__ int lds_byte(int r, int c) { const int st = (r >> 4) * 2 + (c >> 5), rr = r & 15, cc = c & 31, ob = rr * 64 + cc * 2; return st * 1024 + (ob ^ (((ob >> 9) & 1) << 5)); }
__host__ __device__ __forceinline__ void stage_rc(int b, int& R, int& C) { const int st = b / 1024, sb = b % 1024, swz = sb ^ (((sb >> 9) & 1) << 5); R = (st >> 1) * 16 + swz / 64; C = (st & 1) * 32 + (swz % 64) / 2; }
__host__ __device__ __forceinline__ int perm32(int rho) { const int n = rho >> 4, i = rho & 15; return 8 * (i >> 2) + 4 * n + (i & 3); }

struct Unit { int pm, pn, po; };
struct Gemm { const bf16_t* A; const bf16_t* Bt; int M, N, K; };

struct StaticOrder {
    int nM, nN, nwg, G, c;
    __host__ __device__ void init(int M, int N, int G_, int c_) { nM = M / BM; nN = N / BM; nwg = nM * nN; G = G_; c = c_; }
    __host__ __device__ bool next(int i, Unit& u) const {
        const long L = (long)i * G + c; if (L >= nwg) return false;
        int wgid = (int)L; { const int q = nwg / NXCD, r = nwg % NXCD, xcd = wgid % NXCD, off = wgid / NXCD; wgid = (xcd < r ? xcd * (q + 1) : r * (q + 1) + (xcd - r) * q) + off; }
        const int nig = WGM * nN, gid = wgid / nig, fm = gid * WGM, gsz = (nM - fm) < WGM ? (nM - fm) : WGM;
        u.pm = fm + ((wgid % nig) % gsz); u.pn = (wgid % nig) / gsz; u.po = u.pm; return true;
    }
    __device__ __forceinline__ void a_ready(const Unit&) const {}
    __device__ __forceinline__ void done(const Unit&) const {}
};

__device__ __forceinline__ unsigned cvt_pk_bf16(float lo, float hi) { unsigned r; asm volatile("v_cvt_pk_bf16_f32 %0, %1, %2" : "=v"(r) : "v"(lo), "v"(hi)); return r; }
typedef float f32x2 __attribute__((ext_vector_type(2)));
__device__ __forceinline__ f32x2 gelu_pk(f32x2 v) {
    const f32x2 av = __builtin_elementwise_abs(v), d = av * 0.2316418882f + 1.0f;
    f32x2 t; t.x = __builtin_amdgcn_rcpf(d.x); t.y = __builtin_amdgcn_rcpf(d.y);
    f32x2 q = t * 0.5307027145f + (-0.7265760135f); q = q * t + 0.7107068705f; q = q * t + (-0.142248368f); q = q * t + 0.127414796f; q = q * t;
    const f32x2 s = (v * v) * (-0.72134752044f);
    f32x2 e; e.x = __builtin_amdgcn_exp2f(s.x); e.y = __builtin_amdgcn_exp2f(s.y);
    const f32x2 m = v * (q * e), r = v - m;
    f32x2 o; o.x = v.x < 0.f ? m.x : r.x; o.y = v.y < 0.f ? m.y : r.y; return o;
}

template <int ACT  > struct EpiBf16 {
    static constexpr bool PERM = true, AFTER_DRAIN = false; static constexpr int MID_T = 0; static_assert(ACT == 0 || ACT == 1, "EpiBf16: ACT is 0 (none) or 1 (gelu_pk)");
    bf16_t* O; int ldc; const float* bias; int split_cols; size_t split_stride; float scale0;
    __device__ __forceinline__ void operator()(const f32x4 (&acc)[2][2][4][2], const Unit& u, int wr, int wc, int fr, int fq) const {
        const int row0 = u.pm * BM + wr * 64 + fr; int colt = u.pn * BM; bf16_t* base = O;
        float sc = 1.f; if (split_cols) { const int t = colt / split_cols; base += (size_t)t * split_stride; colt -= t * split_cols; if (t == 0) sc = scale0; }
        const int col0 = colt + wc * 32 + 8 * fq, bcol0 = u.pn * BM + wc * 32 + 8 * fq;
        f32x4 bv[2][2];
#pragma unroll
        for (int bj = 0; bj < 2; ++bj)
#pragma unroll
            for (int n = 0; n < 2; ++n) bv[bj][n] = bias ? *(const f32x4*)(bias + bcol0 + bj * HALF + 4 * n) : (f32x4){0.f, 0.f, 0.f, 0.f};
#pragma unroll
        for (int ai = 0; ai < 2; ++ai)
#pragma unroll
            for (int m = 0; m < 4; ++m) { bf16_t* rowp = base + (size_t)(row0 + ai * HALF + m * 16) * ldc + col0;
#pragma unroll
                for (int bj = 0; bj < 2; ++bj) { f32x4 v0 = acc[ai][bj][m][0] + bv[bj][0], v1 = acc[ai][bj][m][1] + bv[bj][1];
                    if (ACT == 1) { f32x2 a = gelu_pk((f32x2){v0[0], v0[1]}), b = gelu_pk((f32x2){v0[2], v0[3]}), c = gelu_pk((f32x2){v1[0], v1[1]}), d = gelu_pk((f32x2){v1[2], v1[3]});
                        v0 = (f32x4){a.x, a.y, b.x, b.y}; v1 = (f32x4){c.x, c.y, d.x, d.y}; }
                    v0 = v0 * sc; v1 = v1 * sc; u32x4 w; w.x = cvt_pk_bf16(v0[0], v0[1]); w.y = cvt_pk_bf16(v0[2], v0[3]); w.z = cvt_pk_bf16(v1[0], v1[1]); w.w = cvt_pk_bf16(v1[2], v1[3]);
                    *(u32x4*)(rowp + bj * HALF) = w; } }
    }
};
__device__ __forceinline__ float bf_lo(unsigned w) { return __uint_as_float(w << 16); }
__device__ __forceinline__ float bf_hi(unsigned w) { return __uint_as_float(w & 0xffff0000u); }
__device__ __forceinline__ float sigmf(float x) { return __builtin_amdgcn_rcpf(1.0f + __expf(-x)); }

template <int MIDT> struct EpiGate2 {
    static constexpr bool PERM = true, AFTER_DRAIN = false; static constexpr int MID_T = MIDT;
    bf16_t* O; int ldc; const unsigned char* Ga; const unsigned char* Gb; size_t gblk;
    __device__ __forceinline__ void mid(f32x4 (&acc)[2][2][4][2], const Unit& u, int wr, int wc, int fr, int fq) const {
        int row0 = u.pm * BM + wr * 64 + fr, col0 = wc * 32 + 8 * fq;
        asm volatile("" : "+v"(row0), "+v"(col0));
        const unsigned char* Gat = Ga + (size_t)u.pn * gblk; const unsigned char* Gbt = Gb + (size_t)u.pn * gblk;
        typedef int i32x2 __attribute__((ext_vector_type(2))); typedef float f32x2_ __attribute__((ext_vector_type(2)));
#pragma unroll
        for (int ai = 0; ai < 2; ++ai)
#pragma unroll
            for (int m = 0; m < 4; ++m) { const size_t row = (size_t)(row0 + ai * HALF + m * 16);
#pragma unroll
                for (int bj = 0; bj < 2; ++bj) { const int col = col0 + bj * HALF;
                    const i32x2 a = *(const i32x2*)(Gat + row * 256 + col), b = *(const i32x2*)(Gbt + row * 256 + col);
#define RAT_(x, y) ((1.0f + __expf(-(y))) * __builtin_amdgcn_rcpf(1.0f + __expf(-(x))))
                    const f32x2_ a0 = __builtin_amdgcn_cvt_pk_f32_fp8(a.x, false), a1 = __builtin_amdgcn_cvt_pk_f32_fp8(a.x, true), a2 = __builtin_amdgcn_cvt_pk_f32_fp8(a.y, false), a3 = __builtin_amdgcn_cvt_pk_f32_fp8(a.y, true);
                    const f32x2_ b0 = __builtin_amdgcn_cvt_pk_f32_fp8(b.x, false), b1 = __builtin_amdgcn_cvt_pk_f32_fp8(b.x, true), b2 = __builtin_amdgcn_cvt_pk_f32_fp8(b.y, false), b3 = __builtin_amdgcn_cvt_pk_f32_fp8(b.y, true);
                    f32x4 v0 = acc[ai][bj][m][0], v1 = acc[ai][bj][m][1];
                    v0[0] *= RAT_(a0.x, b0.x); v0[1] *= RAT_(a0.y, b0.y); v0[2] *= RAT_(a1.x, b1.x); v0[3] *= RAT_(a1.y, b1.y);
                    v1[0] *= RAT_(a2.x, b2.x); v1[1] *= RAT_(a2.y, b2.y); v1[2] *= RAT_(a3.x, b3.x); v1[3] *= RAT_(a3.y, b3.y);
#undef RAT_
                    acc[ai][bj][m][0] = v0; acc[ai][bj][m][1] = v1; }
                asm volatile("" ::: "memory"); }
    }
    __device__ __forceinline__ void operator()(const f32x4 (&acc)[2][2][4][2], const Unit& u, int wr, int wc, int fr, int fq) const {
        const int row0 = u.pm * BM + wr * 64 + fr, col0 = u.pn * BM + wc * 32 + 8 * fq;
#pragma unroll
        for (int ai = 0; ai < 2; ++ai)
#pragma unroll
            for (int m = 0; m < 4; ++m) { const size_t row = (size_t)(row0 + ai * HALF + m * 16);
#pragma unroll
                for (int bj = 0; bj < 2; ++bj) { const int col = col0 + bj * HALF;
                    typedef int i32x2 __attribute__((ext_vector_type(2))); typedef float f32x2_ __attribute__((ext_vector_type(2)));
                    const i32x2 g = *(const i32x2*)(Gb + (size_t)u.pn * gblk + row * 256 + (col - u.pn * BM));
                    const f32x2_ g0 = __builtin_amdgcn_cvt_pk_f32_fp8(g.x, false), g1 = __builtin_amdgcn_cvt_pk_f32_fp8(g.x, true), g2 = __builtin_amdgcn_cvt_pk_f32_fp8(g.y, false), g3 = __builtin_amdgcn_cvt_pk_f32_fp8(g.y, true);
                    f32x4 v0 = acc[ai][bj][m][0], v1 = acc[ai][bj][m][1];
                    v0[0] *= sigmf(g0.x); v0[1] *= sigmf(g0.y); v0[2] *= sigmf(g1.x); v0[3] *= sigmf(g1.y);
                    v1[0] *= sigmf(g2.x); v1[1] *= sigmf(g2.y); v1[2] *= sigmf(g3.x); v1[3] *= sigmf(g3.y);
                    u32x4 w; w.x = cvt_pk_bf16(v0[0], v0[1]); w.y = cvt_pk_bf16(v0[2], v0[3]); w.z = cvt_pk_bf16(v1[0], v1[1]); w.w = cvt_pk_bf16(v1[2], v1[3]);
                    *(u32x4*)(O + row * ldc + col) = w; } }
    }
};
struct EpiResid {
    static constexpr bool PERM = true, AFTER_DRAIN = false; static constexpr int MID_T = 0;
    bf16_t* O; const float* base; int ldc; const float* gvec; int gstride; int tiles_per_b;
    __device__ __forceinline__ void operator()(const f32x4 (&acc)[2][2][4][2], const Unit& u, int wr, int wc, int fr, int fq) const {
        const int row0 = u.pm * BM + wr * 64 + fr, col0 = u.pn * BM + wc * 32 + 8 * fq;
        const float* gv = gvec + (size_t)(u.pm / tiles_per_b) * gstride;
#pragma unroll
        for (int bj = 0; bj < 2; ++bj) { const int col = col0 + bj * HALF; const f32x4 g0 = *(const f32x4*)(gv + col), g1 = *(const f32x4*)(gv + col + 4);
#pragma unroll
            for (int ai = 0; ai < 2; ++ai)
#pragma unroll
                for (int m = 0; m < 4; ++m) { const size_t off = (size_t)(row0 + ai * HALF + m * 16) * ldc + col;
                    const f32x4 b0 = *(const f32x4*)(base + off), b1 = *(const f32x4*)(base + off + 4);
                    const f32x4 r0 = b0 + g0 * acc[ai][bj][m][0], r1 = b1 + g1 * acc[ai][bj][m][1];
                    typedef float f32x2_ __attribute__((ext_vector_type(2))); typedef __bf16 bf16x2_ __attribute__((ext_vector_type(2)));
                    u32x4 o;
                    o.x = __builtin_bit_cast(unsigned, __builtin_convertvector((f32x2_){r0[0], r0[1]}, bf16x2_)); o.y = __builtin_bit_cast(unsigned, __builtin_convertvector((f32x2_){r0[2], r0[3]}, bf16x2_));
                    o.z = __builtin_bit_cast(unsigned, __builtin_convertvector((f32x2_){r1[0], r1[1]}, bf16x2_)); o.w = __builtin_bit_cast(unsigned, __builtin_convertvector((f32x2_){r1[2], r1[3]}, bf16x2_));
                    *(u32x4*)(O + off) = o; } }
    }
};
struct EpiSwiglu {
    static constexpr bool PERM = true, AFTER_DRAIN = false; static constexpr int MID_T = 0;
    bf16_t* O; int lda; const float* bias; int nN;
    __device__ __forceinline__ int act4(const f32x4& v0, const f32x4& v1) const {
        f32x4 G = (f32x4){v0[0], v0[2], v1[0], v1[2]}, L = (f32x4){v0[1], v0[3], v1[1], v1[3]};
        G = __builtin_elementwise_min(G, (f32x4){7.f, 7.f, 7.f, 7.f});
        L = __builtin_elementwise_min(__builtin_elementwise_max(L, (f32x4){-7.f, -7.f, -7.f, -7.f}), (f32x4){7.f, 7.f, 7.f, 7.f}) + 1.0f;
        const f32x4 X = G * (-1.702f * 1.4426950408889634f);
        f32x4 S; S[0] = __builtin_amdgcn_exp2f(X[0]); S[1] = __builtin_amdgcn_exp2f(X[1]); S[2] = __builtin_amdgcn_exp2f(X[2]); S[3] = __builtin_amdgcn_exp2f(X[3]);
        S = S + 1.0f; S[0] = __builtin_amdgcn_rcpf(S[0]); S[1] = __builtin_amdgcn_rcpf(S[1]); S[2] = __builtin_amdgcn_rcpf(S[2]); S[3] = __builtin_amdgcn_rcpf(S[3]);
        const f32x4 A4 = G * S * L;
        int w8 = 0; w8 = __builtin_amdgcn_cvt_pk_fp8_f32(A4[0], A4[1], w8, false); w8 = __builtin_amdgcn_cvt_pk_fp8_f32(A4[2], A4[3], w8, true); return w8;
    }
    __device__ __forceinline__ void operator()(const f32x4 (&acc)[2][2][4][2], const Unit& u, int wr, int wc, int fr, int fq) const {
        const int row0 = u.po * BM + wr * 64 + fr; const int pnl = u.pn % nN;
        const int bcol0 = u.pn * BM + wc * 32 + 8 * fq; const bool odd = (fq & 1) != 0;
        const int bytecol = (pnl * BM + wc * 32 + 8 * (fq & ~1)) / 2 + (odd ? 64 : 0);
        f32x4 bv[2][2];
#pragma unroll
        for (int bj = 0; bj < 2; ++bj)
#pragma unroll
            for (int n = 0; n < 2; ++n) bv[bj][n] = *(const f32x4*)(bias + bcol0 + bj * HALF + 4 * n);
        typedef int i32x2 __attribute__((ext_vector_type(2)));
#pragma unroll
        for (int ai = 0; ai < 2; ++ai)
#pragma unroll
            for (int m = 0; m < 4; ++m) {
                const int wA = act4(acc[ai][0][m][0] + bv[0][0], acc[ai][0][m][1] + bv[0][1]), wB = act4(acc[ai][1][m][0] + bv[1][0], acc[ai][1][m][1] + bv[1][1]);
                const int recv = __shfl_xor(odd ? wA : wB, 16);
                *(i32x2*)((unsigned char*)O + (size_t)(row0 + ai * HALF + m * 16) * lda + bytecol) = odd ? (i32x2){recv, wB} : (i32x2){wA, recv}; }
    }
};
struct EpiFp8Blk {
    static constexpr bool PERM = true, AFTER_DRAIN = false; static constexpr int MID_T = 0;
    unsigned char* O; size_t blk;
    __device__ __forceinline__ void operator()(const f32x4 (&acc)[2][2][4][2], const Unit& u, int wr, int wc, int fr, int fq) const {
        const bool odd = (fq & 1) != 0;
        const int row0 = u.pm * BM + wr * 64 + fr, col0 = wc * 32 + 8 * (fq & ~1) + (odd ? HALF : 0); unsigned char* base = O + (size_t)u.pn * blk;
#pragma unroll
        for (int ai = 0; ai < 2; ++ai)
#pragma unroll
            for (int m = 0; m < 4; ++m) { unsigned char* rowp = base + (size_t)(row0 + ai * HALF + m * 16) * 256 + col0; int w[2][2];
#pragma unroll
                for (int bj = 0; bj < 2; ++bj) { const f32x4 v0 = acc[ai][bj][m][0], v1 = acc[ai][bj][m][1]; int w0 = 0, w1 = 0;
                    w0 = __builtin_amdgcn_cvt_pk_fp8_f32(v0[0], v0[1], w0, false); w0 = __builtin_amdgcn_cvt_pk_fp8_f32(v0[2], v0[3], w0, true);
                    w1 = __builtin_amdgcn_cvt_pk_fp8_f32(v1[0], v1[1], w1, false); w1 = __builtin_amdgcn_cvt_pk_fp8_f32(v1[2], v1[3], w1, true); w[bj][0] = w0; w[bj][1] = w1; }
                const int r0 = __shfl_xor(odd ? w[0][0] : w[1][0], 16), r1 = __shfl_xor(odd ? w[0][1] : w[1][1], 16);
                *(u32x4*)rowp = odd ? (u32x4){(unsigned)r0, (unsigned)r1, (unsigned)w[1][0], (unsigned)w[1][1]} : (u32x4){(unsigned)w[0][0], (unsigned)w[0][1], (unsigned)r0, (unsigned)r1}; }
    }
};
struct EpiFp8Row {
    static constexpr bool PERM = true, AFTER_DRAIN = false; static constexpr int MID_T = 0;
    unsigned char* O; int ldc; const float* bias; int nN;
    __device__ __forceinline__ void operator()(const f32x4 (&acc)[2][2][4][2], const Unit& u, int wr, int wc, int fr, int fq) const {
        const bool odd = (fq & 1) != 0;
        const int row0 = u.po * BM + wr * 64 + fr, col0 = (u.pn % nN) * BM + wc * 32 + 8 * (fq & ~1) + (odd ? HALF : 0), bcol0 = u.pn * BM + wc * 32 + 8 * fq;
        f32x4 bv[2][2];
#pragma unroll
        for (int bj = 0; bj < 2; ++bj)
#pragma unroll
            for (int n = 0; n < 2; ++n) bv[bj][n] = *(const f32x4*)(bias + bcol0 + bj * HALF + 4 * n);
#pragma unroll
        for (int ai = 0; ai < 2; ++ai)
#pragma unroll
            for (int m = 0; m < 4; ++m) { unsigned char* rowp = O + (size_t)(row0 + ai * HALF + m * 16) * ldc + col0; int w[2][2];
#pragma unroll
                for (int bj = 0; bj < 2; ++bj) { const f32x4 v0 = acc[ai][bj][m][0] + bv[bj][0], v1 = acc[ai][bj][m][1] + bv[bj][1]; int w0 = 0, w1 = 0;
                    w0 = __builtin_amdgcn_cvt_pk_fp8_f32(v0[0], v0[1], w0, false); w0 = __builtin_amdgcn_cvt_pk_fp8_f32(v0[2], v0[3], w0, true);
                    w1 = __builtin_amdgcn_cvt_pk_fp8_f32(v1[0], v1[1], w1, false); w1 = __builtin_amdgcn_cvt_pk_fp8_f32(v1[2], v1[3], w1, true); w[bj][0] = w0; w[bj][1] = w1; }
                const int r0 = __shfl_xor(odd ? w[0][0] : w[1][0], 16), r1 = __shfl_xor(odd ? w[0][1] : w[1][1], 16);
                *(u32x4*)rowp = odd ? (u32x4){(unsigned)r0, (unsigned)r1, (unsigned)w[1][0], (unsigned)w[1][1]} : (u32x4){(unsigned)w[0][0], (unsigned)w[0][1], (unsigned)r0, (unsigned)r1}; }
    }
};
struct MoeOrder {
    int ntiles, nN, G, c; const PG8_LAS int* tpm; const PG8_LAS int* te;
    __device__ bool next(int i, Unit& u) const {
        const long L = (long)i * G + c; if (L >= (long)ntiles * nN) return false;
        const int t = (int)(L / nN), pnl = (int)(L % nN);
        u.pm = tpm ? __builtin_amdgcn_readfirstlane(tpm[t]) : t; u.po = t; u.pn = __builtin_amdgcn_readfirstlane(te[t]) * nN + pnl; return true;
    }
    __device__ __forceinline__ void a_ready(const Unit&) const {}
    __device__ __forceinline__ void done(const Unit&) const {}
};

struct SplitOrder : StaticOrder {
    int nx, ny;
    __device__ bool next(int i, Unit& u) const {
        const int half = G >> 1, grp = (c >> 3) & 1, ci = ((c >> 4) << 3) | (c & 7);
        long L; if (grp == 0) { if (i >= nx) return false; L = (long)i * half + ci; } else { if (i >= ny) return false; L = (long)nx * half + (long)i * half + ci; }
        if (L >= nwg) return false;
        int wgid = (int)L; { const int q = nwg / NXCD, r = nwg % NXCD, xcd = wgid % NXCD, off = wgid / NXCD; wgid = (xcd < r ? xcd * (q + 1) : r * (q + 1) + (xcd - r) * q) + off; }
        const int nig = WGM * nN, gid = wgid / nig, fm = gid * WGM, gsz = (nM - fm) < WGM ? (nM - fm) : WGM;
        u.pm = fm + ((wgid % nig) % gsz); u.pn = (wgid % nig) / gsz; u.po = u.pm; return true;
    }
};
typedef int v4i_ __attribute__((ext_vector_type(4))); typedef int v8i_ __attribute__((ext_vector_type(8)));
template <bool F8> struct FragT { bf16x8 h[2]; __device__ __forceinline__ void set(int k, bf16x8 v) { h[k] = v; } };
template <> struct FragT<true> { v8i_ w; __device__ __forceinline__ void set(int k, bf16x8 v) { if (k == 0) w.lo = __builtin_bit_cast(v4i_, v); else w.hi = __builtin_bit_cast(v4i_, v); } };
template <class Epi, class Sched, bool ALIGN_EPI = false, bool SP2 = false, bool F8 = false>
__device__ __forceinline__ void gemm_phase(PG8_LAS unsigned char* lds, const Gemm g, const Sched& S, const Epi& E) {
    const int tid = threadIdx.x, wid = __builtin_amdgcn_readfirstlane(tid >> 6), lane = tid & 63, wr = wid >> 2, wc = wid & 3, fr = lane & 15, fq = lane >> 4;
    const int K = g.K, nt = K / BK;
    unsigned voffA[2], voffB[2];
#pragma unroll
    for (int i = 0; i < 2; ++i) { int R, C; stage_rc(tid * 16 + i * 8192, R, C); const int Rb = Epi::PERM ? ((R & ~31) + perm32(R & 31)) : R;
        voffA[i] = (unsigned)(R * K + C) * 2u; voffB[i] = (unsigned)(Rb * K + C) * 2u; }
    const size_t kstep = (size_t)(BK * 2);
    const size_t hstep = (size_t)HALF * K * 2;
    const size_t tstep = 2 * hstep;
    const unsigned ldsw = (unsigned)wid * 1024u;
    const int aoff = lds_byte(wr * 64 + fr, fq * 8), boff = lds_byte(wc * 32 + fr, fq * 8);
#define PG8_SA(b, h) (((b) * 2 + (h)) * HTB)
#define PG8_SB(b, h) ((4 + (b) * 2 + (h)) * HTB)
#define PG8_STAGE(bufoff, gbase, voff) do { _Pragma("unroll") for (int _i = 0; _i < 2; ++_i) \
        __builtin_amdgcn_global_load_lds((const unsigned*)((const char*)(gbase) + (voff)[_i]), (PG8_LAS unsigned*)(lds + (bufoff) + ldsw + _i * 8192), 16, 0, 0); } while (0)
#define PG8_LDA(dst, b, h) do { _Pragma("unroll") for (int m = 0; m < 4; ++m) _Pragma("unroll") for (int k = 0; k < 2; ++k) dst[m].set(k, *(const PG8_LAS bf16x8*)(lds + PG8_SA(b, h) + aoff + m * 2048 + k * 1024)); } while (0)
#define PG8_LDB(dst, b, h) do { _Pragma("unroll") for (int n = 0; n < 2; ++n) _Pragma("unroll") for (int k = 0; k < 2; ++k) dst[n].set(k, *(const PG8_LAS bf16x8*)(lds + PG8_SB(b, h) + boff + n * 2048 + k * 1024)); } while (0)
#define PG8_MMA(ai, bj, At, Bt) do { __builtin_amdgcn_s_setprio(1); _Pragma("unroll") for (int m = 0; m < 4; ++m) _Pragma("unroll") for (int n = 0; n < 2; ++n) { \
        if constexpr (F8) { asm volatile("v_mfma_scale_f32_16x16x128_f8f6f4 %0, %1, %2, %0, %3, %4 op_sel_hi:[0,0,0]" : "+v"(acc[ai][bj][m][n]) : "v"(Bt[n].w), "v"(At[m].w), "v"(sc_w), "v"(sc_x)); \
        } else { _Pragma("unroll") for (int k = 0; k < 2; ++k) \
        acc[ai][bj][m][n] = __builtin_amdgcn_mfma_f32_16x16x32_bf16(Bt[n].h[k], At[m].h[k], acc[ai][bj][m][n], 0, 0, 0); } } __builtin_amdgcn_s_setprio(0); } while (0)
#define PG8_WAIT_V(n) asm volatile("s_waitcnt vmcnt(" #n ")" ::: "memory")
#define PG8_WAIT_L(n) asm volatile("s_waitcnt lgkmcnt(" #n ")" ::: "memory")
#define PG8_BAR __builtin_amdgcn_s_barrier()
#define PG8_SCHED __builtin_amdgcn_sched_barrier(0)
    Unit cur, nxt; int ui = 0;
    if (!S.next(0, cur)) return;
    f32x4 acc[2][2][4][2];
#pragma unroll
    for (int a = 0; a < 2; ++a)
#pragma unroll
        for (int b = 0; b < 2; ++b)
#pragma unroll
            for (int m = 0; m < 4; ++m)
#pragma unroll
                for (int n = 0; n < 2; ++n) acc[a][b][m][n] = (f32x4){0.f, 0.f, 0.f, 0.f};
    FragT<F8> At[4], B0[2], B1[2];
    int sc_w = 0x7a7a7a7a, sc_x = 0x7f7f7f7f;
    if constexpr (F8) { asm volatile("" : "+v"(sc_w), "+v"(sc_x)); }
    const char* cA = (const char*)g.A + (size_t)cur.pm * tstep; const char* cB = (const char*)g.Bt + (size_t)cur.pn * tstep;
    S.a_ready(cur);
    if constexpr (SP2) {
        PG8_STAGE(PG8_SB(0, 0), cB, voffB); PG8_STAGE(PG8_SB(0, 1), cB + hstep, voffB); PG8_STAGE(PG8_SA(0, 0), cA, voffA); PG8_STAGE(PG8_SA(0, 1), cA + hstep, voffA);
        if (wr == 1) PG8_BAR;
        PG8_WAIT_V(2); PG8_BAR;
        PG8_STAGE(PG8_SB(1, 0), cB + kstep, voffB); PG8_STAGE(PG8_SA(1, 0), cA + kstep, voffA); PG8_STAGE(PG8_SB(1, 1), cB + hstep + kstep, voffB);
        PG8_WAIT_V(6); PG8_BAR;
    } else {
        PG8_STAGE(PG8_SB(0, 0), cB, voffB); PG8_STAGE(PG8_SA(0, 0), cA, voffA); PG8_STAGE(PG8_SB(0, 1), cB + hstep, voffB); PG8_STAGE(PG8_SA(0, 1), cA + hstep, voffA);
        if (wr == 1) PG8_BAR;
        PG8_WAIT_V(4); PG8_BAR;
        PG8_STAGE(PG8_SB(1, 0), cB + kstep, voffB); PG8_STAGE(PG8_SA(1, 0), cA + kstep, voffA); PG8_STAGE(PG8_SB(1, 1), cB + hstep + kstep, voffB);
        PG8_WAIT_V(6); PG8_BAR;
    }
    for (;;) {
        const bool has_next = S.next(ui + 1, nxt);
        const char* nA = has_next ? (const char*)g.A + (size_t)nxt.pm * tstep : cA; const char* nB = has_next ? (const char*)g.Bt + (size_t)nxt.pn * tstep : cB;
        for (int t = 0; t < nt; t += 2) {
            if constexpr (Epi::MID_T > 0) { if (t == Epi::MID_T) { if constexpr (F8) asm volatile("s_nop 15\n\ts_nop 3" ::: "memory"); E.mid(acc, cur, wr, wc, fr, fq); if constexpr (F8) asm volatile("s_nop 7" ::: "memory"); } }
            const bool last = (t == nt - 2);
            const char* a1 = cA + (size_t)(t + 1) * kstep;
            const char* a2 = last ? nA : cA + (size_t)(t + 2) * kstep; const char* b2 = last ? nB : cB + (size_t)(t + 2) * kstep;
            const char* a3 = a2 + kstep; const char* b3 = b2 + kstep;
            if (last && has_next) S.a_ready(nxt);
            if constexpr (SP2) {
            PG8_LDB(B0, 0, 0); PG8_LDB(B1, 0, 1); PG8_SCHED; PG8_LDA(At, 0, 0); PG8_STAGE(PG8_SA(1, 1), a1 + hstep, voffA);
            PG8_WAIT_V(8); PG8_WAIT_L(0); PG8_BAR; PG8_MMA(0, 0, At, B0); PG8_MMA(0, 1, At, B1); PG8_BAR; PG8_SCHED;
            PG8_LDA(At, 0, 1); PG8_STAGE(PG8_SB(0, 0), b2, voffB); PG8_STAGE(PG8_SB(0, 1), b2 + hstep, voffB); PG8_STAGE(PG8_SA(0, 0), a2, voffA);
            PG8_WAIT_V(8); PG8_WAIT_L(0); PG8_BAR; PG8_MMA(1, 0, At, B0); PG8_MMA(1, 1, At, B1); PG8_BAR; PG8_SCHED;
            PG8_LDB(B0, 1, 0); PG8_LDB(B1, 1, 1); PG8_SCHED; PG8_LDA(At, 1, 0); PG8_STAGE(PG8_SA(0, 1), a2 + hstep, voffA);
            PG8_WAIT_V(8); PG8_WAIT_L(0); PG8_BAR; PG8_MMA(0, 0, At, B0); PG8_MMA(0, 1, At, B1); PG8_BAR; PG8_SCHED;
            PG8_LDA(At, 1, 1); PG8_STAGE(PG8_SB(1, 0), b3, voffB); PG8_STAGE(PG8_SB(1, 1), b3 + hstep, voffB); PG8_STAGE(PG8_SA(1, 0), a3, voffA);
            PG8_WAIT_V(8); PG8_WAIT_L(0); PG8_BAR; PG8_MMA(1, 0, At, B0); PG8_MMA(1, 1, At, B1); PG8_BAR; PG8_SCHED;
            } else {
            PG8_LDB(B0, 0, 0); PG8_SCHED; PG8_LDA(At, 0, 0); PG8_STAGE(PG8_SA(1, 1), a1 + hstep, voffA);
            PG8_WAIT_L(8); PG8_BAR; PG8_WAIT_L(0); PG8_MMA(0, 0, At, B0); PG8_BAR; PG8_SCHED;
            PG8_LDB(B1, 0, 1); PG8_STAGE(PG8_SB(0, 0), b2, voffB);
            PG8_BAR; PG8_WAIT_L(0); PG8_MMA(0, 1, At, B1); PG8_BAR;
            PG8_LDA(At, 0, 1); PG8_STAGE(PG8_SA(0, 0), a2, voffA);
            PG8_BAR; PG8_WAIT_L(0); PG8_MMA(1, 0, At, B0); PG8_BAR; PG8_SCHED;
            PG8_STAGE(PG8_SB(0, 1), b2 + hstep, voffB);
            PG8_WAIT_V(6); PG8_BAR; PG8_MMA(1, 1, At, B1); PG8_BAR;
            PG8_LDB(B0, 1, 0); PG8_SCHED; PG8_LDA(At, 1, 0); PG8_STAGE(PG8_SA(0, 1), a2 + hstep, voffA);
            PG8_WAIT_L(8); PG8_BAR; PG8_WAIT_L(0); PG8_MMA(0, 0, At, B0); PG8_BAR; PG8_SCHED;
            PG8_LDB(B1, 1, 1); PG8_STAGE(PG8_SB(1, 0), b3, voffB);
            PG8_BAR; PG8_WAIT_L(0); PG8_MMA(0, 1, At, B1); PG8_BAR;
            PG8_LDA(At, 1, 1); PG8_STAGE(PG8_SA(1, 0), a3, voffA);
            PG8_BAR; PG8_WAIT_L(0); PG8_MMA(1, 0, At, B0); PG8_BAR; PG8_SCHED;
            PG8_STAGE(PG8_SB(1, 1), b3 + hstep, voffB);
            PG8_WAIT_V(6); PG8_BAR; PG8_MMA(1, 1, At, B1); PG8_BAR;
            }
        }
        if constexpr (F8) { asm volatile("s_nop 15\n\ts_nop 3" ::: "memory"); }
        if constexpr (ALIGN_EPI) { if (wr == 0) PG8_BAR; }
        if constexpr (!Epi::AFTER_DRAIN) { E(acc, cur, wr, wc, fr, fq); S.done(cur); }
        if (!has_next) break;
#pragma unroll
        for (int a = 0; a < 2; ++a)
#pragma unroll
            for (int b = 0; b < 2; ++b)
#pragma unroll
                for (int m = 0; m < 4; ++m)
#pragma unroll
                    for (int n = 0; n < 2; ++n) acc[a][b][m][n] = (f32x4){0.f, 0.f, 0.f, 0.f};
        cur = nxt; cA = nA; cB = nB; ++ui;
        if constexpr (ALIGN_EPI) { if (wr == 1) PG8_BAR; }
    }
    PG8_WAIT_V(0);
    if constexpr (!ALIGN_EPI) { if (wr == 0) PG8_BAR; }
    PG8_BAR;
    if constexpr (Epi::AFTER_DRAIN) { E.fused(acc, cur, wr, wc, fr, fq, lds, wid, lane); S.done(cur); }
#undef PG8_SA
#undef PG8_SB
#undef PG8_STAGE
#undef PG8_LDA
#undef PG8_LDB
#undef PG8_MMA
#undef PG8_WAIT_V
#undef PG8_WAIT_L
#undef PG8_BAR
#undef PG8_SCHED
}
}
#define GAS __attribute__((address_space(1)))
#define LAS __attribute__((address_space(3)))
typedef unsigned short bf16;
typedef unsigned v4u __attribute__((ext_vector_type(4)));
typedef float f32x4 __attribute__((ext_vector_type(4)));
typedef short bf16x8 __attribute__((ext_vector_type(8)));
typedef GAS unsigned gu32;
typedef GAS unsigned long long gu64;
#define RLX_AGENT __ATOMIC_RELAXED, __HIP_MEMORY_SCOPE_AGENT
#define LDS_WAIT() asm volatile("s_waitcnt lgkmcnt(0)" ::: "memory")
#define VM_WAIT() asm volatile("s_waitcnt vmcnt(0)" ::: "memory")
__device__ __forceinline__ unsigned long long rt() { return __builtin_amdgcn_s_memrealtime(); }
__device__ __forceinline__ unsigned f2bf(float f) { unsigned u = __builtin_bit_cast(unsigned, f); return (u + 0x7fffu + ((u >> 16) & 1u)) >> 16; }
__device__ __forceinline__ unsigned pk2(float lo, float hi) { return f2bf(lo) | (f2bf(hi) << 16); }

#define XB_TMO      128
#define XB_XCNT(j)  (256  + 64 * (j))
#define XB_XSUB(j)  (1280 + 64 * (j))
#define XB_XGEN(j)  (2304 + 64 * (j))
#define XB_TOP      3328
#define XB_TOPGEN   3392
#define XCD_BAR_WORDS 3456
#define XB_SPIN_CAP (1u << 18)

__device__ __forceinline__ unsigned xb_ld(unsigned* p)              { return __hip_atomic_load(p, __ATOMIC_RELAXED, __HIP_MEMORY_SCOPE_AGENT); }
__device__ __forceinline__ unsigned xb_add(unsigned* p, unsigned v) { return __hip_atomic_fetch_add(p, v, __ATOMIC_RELAXED, __HIP_MEMORY_SCOPE_AGENT); }
__device__ __forceinline__ unsigned xb_xcc_id() { return (unsigned)__builtin_amdgcn_s_getreg((3 << 11) | 20) & 0xFu; }
#define XB_SPIN(cond, bar) do { unsigned _sp = 0; while (cond) { __builtin_amdgcn_s_sleep(1); \
    if ((++_sp & 255u) == 0u) { if (xb_ld(&(bar)[XB_TMO])) break; if (_sp > XB_SPIN_CAP) { atomicAdd(&(bar)[XB_TMO], 1u); break; } } } } while (0)

struct XcdBarrier {
    unsigned* bar; unsigned x;
    volatile LAS unsigned* st;
};

__device__ __forceinline__ XcdBarrier xcd_barrier_post(unsigned* bar, volatile LAS unsigned* st) {
    XcdBarrier b; b.bar = bar; b.x = xb_xcc_id(); b.st = st;
    if (threadIdx.x == 0) (void)xb_add(&bar[XB_XCNT(b.x)], 1u);
    return b;
}
__device__ __forceinline__ void xcd_barrier_complete(unsigned* bar, unsigned x, unsigned& nloc, unsigned& nx) {
    const unsigned G = gridDim.x * gridDim.y * gridDim.z;
    unsigned sum, cnt, mine, sp = 0u;
    for (;;) {
        sum = 0u; cnt = 0u; mine = 0u;
#pragma unroll
        for (unsigned j = 0; j < 16; ++j) { const unsigned c = xb_ld(&bar[XB_XCNT(j)]); sum += c; cnt += (c > 0u) ? 1u : 0u; mine = (j == x) ? c : mine; }
        if (sum == G) break;
        __builtin_amdgcn_s_sleep(1);
        if ((++sp & 255u) == 0u) { if (xb_ld(&bar[XB_TMO])) break; if (sp > XB_SPIN_CAP) { atomicAdd(&bar[XB_TMO], 1u); break; } }
    }
    nloc = mine > 0u ? mine : 1u; nx = cnt > 0u ? cnt : 1u;
}

__device__ __forceinline__ void xcd_barrier(const XcdBarrier& b) {
    asm volatile("s_waitcnt vmcnt(0)" ::: "memory");
    __syncthreads();
    if (threadIdx.x == 0) {
        unsigned* bar = b.bar;
        __builtin_amdgcn_s_waitcnt(0);
        unsigned nloc = b.st[0], nx = b.st[1];
        if (nloc == 0u) { xcd_barrier_complete(bar, b.x, nloc, nx); b.st[0] = nloc; b.st[1] = nx; }
        const unsigned old = xb_add(&bar[XB_XSUB(b.x)], 1u);
        const unsigned gen = old / nloc;
        if (old + 1u == (gen + 1u) * nloc) {
            __builtin_amdgcn_fence(__ATOMIC_RELEASE, "agent");
            asm volatile("s_waitcnt vmcnt(0)" ::: "memory");
            const unsigned og = xb_add(&bar[XB_TOP], 1u);
            const unsigned tg = og / nx;
            if (og + 1u == (tg + 1u) * nx) xb_add(&bar[XB_TOPGEN], 1u);
            else XB_SPIN(xb_ld(&bar[XB_TOPGEN]) == tg, bar);
            __builtin_amdgcn_fence(__ATOMIC_ACQUIRE, "agent");
            xb_add(&bar[XB_XGEN(b.x)], 1u);
            asm volatile("s_waitcnt vmcnt(0)" ::: "memory");
        } else {
            XB_SPIN(xb_ld(&bar[XB_XGEN(b.x)]) == gen, bar);
            __builtin_amdgcn_fence(__ATOMIC_ACQUIRE, "agent");
            asm volatile("s_waitcnt vmcnt(0)" ::: "memory");
        }
    }
    __syncthreads();
}

constexpr int NWAVES = 8, NTHR = 512;
constexpr int BATCH = 4, SEQ = 4096, DM = 1024, TOK = BATCH * SEQ;
constexpr int INW = 9728;
constexpr int C_RQ = 0, C_RK = 512, C_RV = 1024, C_RG = 2048, C_AQ = 3072, C_AK = 4608, C_AV = 6144, C_GA = 7680, C_GB = 8704;
constexpr int NEXP = 32, FF = 1024, FF2 = 2048;
constexpr int MAXROWS = TOK * 4 + NEXP * 256;
constexpr float RMS_EPS = 1e-6f, GN_EPS = 1e-5f;
constexpr size_t MiB = 1u << 20;
constexpr size_t WS_CTL = 0, CTL_ZERO_BYTES = 32 * 1024;
constexpr size_t WS_ROPE = 1 * MiB;
constexpr size_t WS_WRT = 3 * MiB;
constexpr int N16 = 3072;
constexpr size_t WS_WIN8 = 12 * MiB;
constexpr size_t WS_WIN = 4 * MiB, WS_WRET = 24 * MiB  , WS_WO = 27 * MiB;
constexpr size_t WS_W1 = 32 * MiB, WS_W2 = 160 * MiB;
constexpr size_t WS_H8 = 208 * MiB;
constexpr size_t WS_H = 224 * MiB;
constexpr size_t WS_U = 256 * MiB;
constexpr size_t WS_KV = 560 * MiB;
constexpr size_t WS_RT = 624 * MiB;
constexpr size_t WS_RET = 656 * MiB;
constexpr int RA_LD = 1536;
constexpr size_t WS_OG = 704 * MiB;
constexpr size_t WS_LSE = 752 * MiB;
constexpr size_t WS_MERGED = 753 * MiB;
constexpr size_t WS_XMID = 849 * MiB;
constexpr size_t WS_XIN = 256 * MiB;
constexpr int XCAP = 16384;
constexpr size_t WS_A = 768 * MiB;
constexpr size_t WS_YB = 913 * MiB;
constexpr size_t WS_TE = 1000 * MiB, WS_TP = WS_TE + 256 * 1024, WS_TG = WS_TP + 256 * 1024;
constexpr size_t WS_END = 1002 * MiB;
static_assert(WS_XIN + (size_t)NEXP * XCAP * 1024 <= WS_A && WS_A + (size_t)MAXROWS * 1024 <= WS_XMID && WS_XMID + (size_t)TOK * DM * 4 <= WS_YB && WS_YB + (size_t)MAXROWS * 1024 <= WS_TE, "MoE map");
constexpr int CW_BAR = 4096;
constexpr int CW_MOD = 8192;
constexpr int CW_CNT = 7680;
constexpr int CW_MODRDY = 7744;
static_assert(CW_BAR + 3456 <= CW_CNT && (CW_MODRDY + 64) * 4 <= (int)CTL_ZERO_BYTES && CW_MODRDY + 64 <= CW_MOD, "ctl");
constexpr int LDS_BYTES = 160 * 1024 - 512, MISC_OFF = LDS_BYTES - 256;

__device__ __forceinline__ float bflo(unsigned w) { return __uint_as_float(w << 16); }
__device__ __forceinline__ float bfhi(unsigned w) { return __uint_as_float(w & 0xffff0000u); }
typedef float f32x2_t_ __attribute__((ext_vector_type(2))); typedef __bf16 bf16x2_t_ __attribute__((ext_vector_type(2)));
__device__ __forceinline__ unsigned cvtpk(float lo, float hi) { const f32x2_t_ v = {lo, hi}; const bf16x2_t_ b = __builtin_convertvector(v, bf16x2_t_); return __builtin_bit_cast(unsigned, b); }
__device__ __forceinline__ unsigned f8x2bf(unsigned w, bool hi) { typedef float f32x2_ __attribute__((ext_vector_type(2))); const f32x2_ f = hi ? __builtin_amdgcn_cvt_pk_f32_fp8((int)w, true) : __builtin_amdgcn_cvt_pk_f32_fp8((int)w, false); return cvtpk(f.x, f.y); }
__device__ __forceinline__ float wave_sum(float v) {
#pragma unroll
    for (int o = 1; o < 64; o <<= 1) v += __shfl_xor(v, o);
    return v;
}
static __device__ const double ROPE_C[64] = {0.15915494309189535, 0.13782250260398285, 0.11934937021124886, 0.10335229661843406, 0.089499401608891013, 0.077503288755374058, 0.067115083005227255, 0.058119267441876246, 0.050329212104487035, 0.04358330210530733, 0.037741584717419771, 0.032682865872356998, 0.028302195830623399, 0.024508691862069852, 0.02122365276477766, 0.018378926105679667, 0.015915494309189534, 0.013782250260398284, 0.011934937021124886, 0.010335229661843406, 0.0089499401608891024, 0.0077503288755374055, 0.0067115083005227253, 0.0058119267441876241, 0.0050329212104487037, 0.0043583302105307331, 0.0037741584717419772, 0.0032682865872356993, 0.0028302195830623399, 0.0024508691862069852, 0.0021223652764777662, 0.0018378926105679667, 0.0015915494309189536, 0.0013782250260398288, 0.0011934937021124885, 0.0010335229661843405, 0.00089499401608891024, 0.00077503288755374051, 0.0006711508300522726, 0.00058119267441876239, 0.00050329212104487033, 0.00043583302105307329, 0.00037741584717419774, 0.00032682865872356992, 0.00028302195830623395, 0.00024508691862069854, 0.00021223652764777661, 0.00018378926105679666, 0.00015915494309189535, 0.00013782250260398286, 0.00011934937021124886, 0.00010335229661843406, 8.9499401608891018e-05, 7.7503288755374056e-05, 6.7115083005227254e-05, 5.8119267441876239e-05, 5.0329212104487035e-05, 4.3583302105307322e-05, 3.7741584717419777e-05, 3.2682865872356999e-05, 2.8302195830623396e-05, 2.4508691862069852e-05, 2.1223652764777659e-05, 1.8378926105679668e-05};
__device__ __forceinline__ float log2g(int h) { return h == 0 ? -0.0458036896f : (h == 1 ? -0.0227200765f : (h == 2 ? -0.0113153132f : -0.00564656314f)); }

constexpr size_t UBLK = (size_t)TOK * 256; constexpr int ULD = 256;
__device__ __forceinline__ const bf16* ucol(const unsigned char* ws, int col) { return (const bf16*)(ws + WS_U) + (size_t)(col >> 8) * UBLK + (col & 255); }
__device__ __forceinline__ const unsigned char* ucol8(const unsigned char* ws, int col) { return ws + WS_U + (size_t)(N16 / 256) * UBLK * 2 + (size_t)((col >> 8) - N16 / 256) * UBLK + (col & 255); }
typedef short v4i16_t __attribute__((ext_vector_type(4)));
struct Args { const float* in[18]; float* out; unsigned char* ws; int ph_lo, ph_hi; };
struct Frame { LAS unsigned char* lds; volatile LAS unsigned* MISC; gu32* ctl; int tid, lane, wave, vcu, G; };

template <bool F8, int NB = 32>
__device__ __forceinline__ void p0_transpose_item(const float* W, int K, int N, bf16* WT, LAS float* scr, int item, int lane, int ldk = 0) {
    if (ldk == 0) ldk = K;
    const int nblk = N / 32, kb = item / nblk, nb = item % nblk, k0 = 64 * kb, n0 = 32 * nb;
#pragma unroll
    for (int hb = 0; hb < 32 / NB; ++hb) { float t[NB];
      const float* wp = W + (size_t)(k0 + 2 * NB * hb + (lane >> 5)) * N + n0 + (lane & 31);
#pragma unroll
      for (int i = 0; i < NB; ++i) t[i] = __builtin_nontemporal_load(wp + (size_t)(2 * i) * N);
#pragma unroll
      for (int i = 0; i < NB; ++i) scr[(2 * (NB * hb + i) + (lane >> 5)) * 33 + (lane & 31)] = t[i]; }
    LDS_WAIT(); asm volatile("" ::: "memory");
    const int c = lane & 7;
#pragma unroll
    for (int j = 0; j < 4; ++j) { const int n = (lane >> 3) + 8 * j; const LAS float* s = scr + (8 * c) * 33 + n;
        if (F8) { int w0 = 0, w1 = 0;
            w0 = __builtin_amdgcn_cvt_pk_fp8_f32(s[0 * 33] * 32.f, s[1 * 33] * 32.f, w0, false); w0 = __builtin_amdgcn_cvt_pk_fp8_f32(s[2 * 33] * 32.f, s[3 * 33] * 32.f, w0, true);
            w1 = __builtin_amdgcn_cvt_pk_fp8_f32(s[4 * 33] * 32.f, s[5 * 33] * 32.f, w1, false); w1 = __builtin_amdgcn_cvt_pk_fp8_f32(s[6 * 33] * 32.f, s[7 * 33] * 32.f, w1, true);
            typedef int i32x2 __attribute__((ext_vector_type(2)));
            *(GAS i32x2*)((unsigned char*)WT + (size_t)(n0 + n) * ldk + k0 + 8 * c) = (i32x2){w0, w1};
        } else { v4u o; o.x = pk2(s[0 * 33], s[1 * 33]); o.y = pk2(s[2 * 33], s[3 * 33]); o.z = pk2(s[4 * 33], s[5 * 33]); o.w = pk2(s[6 * 33], s[7 * 33]);
            *(GAS v4u*)(WT + (size_t)(n0 + n) * ldk + k0 + 8 * c) = o; } }
    LDS_WAIT(); asm volatile("" ::: "memory");
}
__device__ __forceinline__ void p0_prologue(const Args& a, Frame& F) {
    const int gw = F.vcu * NWAVES + F.wave, NGW = F.G * NWAVES;
    { float2* rope = (float2*)(a.ws + WS_ROPE);
      for (int idx = F.vcu * NTHR + F.tid; idx < SEQ * 64; idx += F.G * NTHR) { const int pos = idx >> 6, i = idx & 63;
          double rev = (double)pos * ROPE_C[i]; rev -= __builtin_floor(rev); const float f = (float)rev;
          rope[idx] = make_float2(__builtin_amdgcn_cosf(f), __builtin_amdgcn_sinf(f)); } }
    { bf16* wrt = (bf16*)(a.ws + WS_WRT); const float* wr = a.in[11];
      for (int idx = F.vcu * NTHR + F.tid; idx < 1024 * 32; idx += F.G * NTHR) { const int k = idx >> 5, e = idx & 31; const float w = wr[idx];
          const unsigned hi = f2bf(w); const float lo = w - __uint_as_float(hi << 16); wrt[e * 1024 + k] = (bf16)hi; wrt[32768 + e * 1024 + k] = (bf16)f2bf(lo); } }
    if (F.vcu < 96) { float* mod = (float*)(a.ws + WS_CTL) + CW_MOD; const float* c = a.in[1]; const float* w_ada = a.in[2]; const float* b_ada = a.in[3];
      const int cg = F.vcu, col = cg * 64 + F.lane; LAS float* red = (LAS float*)(F.lds + 8 * 16384);
      float acc[4] = {0.f, 0.f, 0.f, 0.f};
      for (int kc = 0; kc < 2; ++kc) { const int k0 = F.wave * 128 + kc * 64; float cs[4];
#pragma unroll
          for (int b = 0; b < 4; ++b) { const float cv = c[b * DM + k0 + F.lane]; cs[b] = cv / (1.0f + __expf(-cv)); }
#pragma unroll 16
          for (int kk = 0; kk < 64; ++kk) { const float w = w_ada[(size_t)(k0 + kk) * 6144 + col];
#pragma unroll
              for (int b = 0; b < 4; ++b) acc[b] += __shfl(cs[b], kk) * w; } }
#pragma unroll
      for (int b = 0; b < 4; ++b) red[(F.wave * 4 + b) * 64 + F.lane] = acc[b];
      __syncthreads();
      if (F.tid < 256) { const int b = F.tid >> 6, ln = F.tid & 63; float s = b_ada[cg * 64 + ln];
#pragma unroll
          for (int w = 0; w < 8; ++w) s += red[(w * 4 + b) * 64 + ln];
          mod[b * 6144 + cg * 64 + ln] = s; }
      asm volatile("s_waitcnt vmcnt(0)" ::: "memory"); __syncthreads();
      if (F.tid == 0) { __builtin_amdgcn_fence(__ATOMIC_RELEASE, "agent"); asm volatile("s_waitcnt vmcnt(0)" ::: "memory"); __hip_atomic_fetch_add(F.ctl + CW_MODRDY, 1u, RLX_AGENT); } }
    { LAS float* scr = (LAS float*)(F.lds + F.wave * 16384);
      constexpr int I_IN = 16 * (INW / 32), I_RET = 16 * 32, I_ATT = 8 * 32, I_O = 16 * 32, I_1E = 16 * 64, I_2E = 16 * 32;
      constexpr int NITEMS = I_IN + I_RET + I_ATT + I_O;
      if (F.vcu >= 96 || F.G <= 96)
      for (int it = (F.G > 96 ? gw - 96 * NWAVES : gw); it < NITEMS; it += (F.G > 96 ? NGW - 96 * NWAVES : NGW)) { int r = it;
          if (r < I_IN) { const int nb = r % (INW / 32);
              if (nb < N16 / 32) p0_transpose_item<false>(a.in[5], 1024, INW, (bf16*)(a.ws + WS_WIN), scr, r, F.lane);
              else p0_transpose_item<true>(a.in[5], 1024, INW, (bf16*)(a.ws + WS_WIN8 - (size_t)N16 * 1024), scr, r, F.lane);
              continue; } r -= I_IN;
          if (r < I_RET) { p0_transpose_item<true>(a.in[7], 1024, 1024, (bf16*)(a.ws + WS_WRET), scr, r, F.lane, RA_LD); continue; } r -= I_RET;
          if (r < I_ATT) { p0_transpose_item<true>(a.in[8], 512, 1024, (bf16*)(a.ws + WS_WRET + 1024), scr, r, F.lane, RA_LD); continue; } r -= I_ATT;
          p0_transpose_item<false>(a.in[9], 1024, 1024, (bf16*)(a.ws + WS_WO), scr, r, F.lane); } }
}
__device__ __forceinline__ void moe_item8(const float* W, int N, unsigned char* WT8, LAS bf16* scr, int item, int lane) {
    const int nblk = N / 32, kb = item / nblk, nb = item % nblk, k0 = 128 * kb, n0 = 32 * nb, rr = lane >> 3, cq = lane & 7;
    typedef unsigned u32x2 __attribute__((ext_vector_type(2)));
    f32x4 t[16];
    { const float* wp = W + (size_t)(k0 + rr) * N + n0 + 4 * cq;
#pragma unroll
      for (int i = 0; i < 16; ++i) t[i] = __builtin_nontemporal_load((const GAS f32x4*)(wp + (size_t)(8 * i) * N)); }
#pragma unroll
    for (int i = 0; i < 16; ++i) *(LAS u32x2*)(scr + (8 * i + rr) * 40 + 4 * cq) = (u32x2){cvtpk(t[i].x, t[i].y), cvtpk(t[i].z, t[i].w)};
    LDS_WAIT(); asm volatile("" ::: "memory");
    const int g = lane >> 4, i15 = lane & 15, qq = i15 >> 2, p = i15 & 3;
#pragma unroll
    for (int c0 = 0; c0 < 32; c0 += 16)
#pragma unroll
        for (int kh = 0; kh < 2; ++kh) { const LAS bf16* a0 = scr + (64 * kh + 16 * g + qq) * 40 + c0 + 4 * p; v4u o;
#pragma unroll
            for (int sb = 0; sb < 4; ++sb) { const v4i16_t v = __builtin_amdgcn_ds_read_tr16_b64_v4i16((LAS v4i16_t*)(a0 + 4 * sb * 40)); const u32x2 w2 = __builtin_bit_cast(u32x2, v);
                int w8 = 0; w8 = __builtin_amdgcn_cvt_pk_fp8_f32(bflo(w2.x) * 32.f, bfhi(w2.x) * 32.f, w8, false); w8 = __builtin_amdgcn_cvt_pk_fp8_f32(bflo(w2.y) * 32.f, bfhi(w2.y) * 32.f, w8, true);
                if (sb == 0) o.x = (unsigned)w8; else if (sb == 1) o.y = (unsigned)w8; else if (sb == 2) o.z = (unsigned)w8; else o.w = (unsigned)w8; }
            *(GAS v4u*)(WT8 + (size_t)(n0 + c0 + i15) * 1024 + k0 + 64 * kh + 16 * g) = o; }
    LDS_WAIT(); asm volatile("" ::: "memory");
}
__device__ __forceinline__ void moe_convert(const Args& a, Frame& F, int k0, int nk) {
    LAS bf16* scr = (LAS bf16*)(F.lds + F.wave * 16384); const int gw = F.vcu * NWAVES + F.wave, NGW = F.G * NWAVES;
    constexpr int I_1E = 8 * 64, I_2E = 8 * 32;
    for (int k = k0; k < k0 + nk; ++k) { int r = gw + NGW * k;
        if (r < NEXP * I_1E) { const int e = r / I_1E; moe_item8(a.in[13] + (size_t)e * 1024 * FF2, FF2, a.ws + WS_W1 + (size_t)e * FF2 * 1024, scr, r % I_1E, F.lane); continue; } r -= NEXP * I_1E;
        if (r < NEXP * I_2E) { const int e = r / I_2E; moe_item8(a.in[15] + (size_t)e * FF * 1024, 1024, a.ws + WS_W2 + (size_t)e * 1024 * FF, scr, r % I_2E, F.lane); } }
}
__device__ __forceinline__ void norm_mod_row(const float* xrow, const float* g, const float* sc, const float* sh, bf16* orow, unsigned char* orow8, int lane) {
    const GAS f32x4* xr = (const GAS f32x4*)xrow + lane; f32x4 v[4]; float s = 0.f;
#pragma unroll
    for (int j = 0; j < 4; ++j) { v[j] = __builtin_nontemporal_load(xr + 64 * j); s += (v[j].x * v[j].x + v[j].y * v[j].y) + (v[j].z * v[j].z + v[j].w * v[j].w); }
    const float rstd = 1.0f / sqrtf(wave_sum(s) * (1.0f / DM) + RMS_EPS);
    GAS int* o4 = (GAS int*)orow8 + lane; GAS unsigned long long* o8 = (GAS unsigned long long*)orow + lane;
#pragma unroll
    for (int j = 0; j < 4; ++j) { const int c = 4 * (64 * j + lane); const f32x4 gg = *(const f32x4*)(g + c), ss = *(const f32x4*)(sc + c), hh = *(const f32x4*)(sh + c);
        const f32x4 o = v[j] * rstd * gg * (ss + 1.0f) + hh;
        int w8 = 0; w8 = __builtin_amdgcn_cvt_pk_fp8_f32(o.x, o.y, w8, false); w8 = __builtin_amdgcn_cvt_pk_fp8_f32(o.z, o.w, w8, true);
        o4[64 * j] = w8; o8[64 * j] = (unsigned long long)cvtpk(o.x, o.y) | ((unsigned long long)cvtpk(o.z, o.w) << 32); }
}
__device__ __forceinline__ void p1_norm1(const Args& a, Frame& F) {
    const int gw = F.vcu * NWAVES + F.wave, NGW = F.G * NWAVES, lane = F.lane; const float* mod = (const float*)(a.ws + WS_CTL) + CW_MOD;
    bool waited = false;
    for (int m0 = gw; m0 < TOK; m0 += 4 * NGW) {
        f32x4 v[4][4]; float rstd[4];
#pragma unroll
        for (int r = 0; r < 4; ++r) { const int m = m0 + r * NGW; const GAS f32x4* xr = (const GAS f32x4*)(a.in[0] + (size_t)(m < TOK ? m : m0) * DM) + lane;
#pragma unroll
            for (int j = 0; j < 4; ++j) v[r][j] = __builtin_nontemporal_load(xr + 64 * j); }
#pragma unroll
        for (int r = 0; r < 4; ++r) { float s = 0.f;
#pragma unroll
            for (int j = 0; j < 4; ++j) s += (v[r][j].x * v[r][j].x + v[r][j].y * v[r][j].y) + (v[r][j].z * v[r][j].z + v[r][j].w * v[r][j].w);
            rstd[r] = 1.0f / sqrtf(wave_sum(s) * (1.0f / DM) + RMS_EPS); }
        if (!waited) { waited = true;
            if (F.tid == 0) { unsigned sp = 0;
                while (__hip_atomic_load(F.ctl + CW_MODRDY, RLX_AGENT) < 96u && ++sp < (1u << 22)) __builtin_amdgcn_s_sleep(2);
                __builtin_amdgcn_fence(__ATOMIC_ACQUIRE, "agent"); asm volatile("s_waitcnt vmcnt(0)" ::: "memory"); }
            __syncthreads(); }
#pragma unroll
        for (int r = 0; r < 4; ++r) { const int m = m0 + r * NGW; if (m < TOK) { const int b = m / SEQ; const float* g = a.in[4]; const float* sc = mod + b * 6144 + 1024; const float* sh = mod + b * 6144;
            GAS int* o4 = (GAS int*)(a.ws + WS_H8 + (size_t)m * DM) + lane; GAS unsigned long long* o8 = (GAS unsigned long long*)((bf16*)(a.ws + WS_H) + (size_t)m * DM) + lane;
#pragma unroll
            for (int j = 0; j < 4; ++j) { const int c = 4 * (64 * j + lane); const f32x4 gg = *(const f32x4*)(g + c), ss = *(const f32x4*)(sc + c), hh = *(const f32x4*)(sh + c);
                const f32x4 o = v[r][j] * rstd[r] * gg * (ss + 1.0f) + hh;
                int w8 = 0; w8 = __builtin_amdgcn_cvt_pk_fp8_f32(o.x, o.y, w8, false); w8 = __builtin_amdgcn_cvt_pk_fp8_f32(o.z, o.w, w8, true);
                o4[64 * j] = w8; o8[64 * j] = (unsigned long long)cvtpk(o.x, o.y) | ((unsigned long long)cvtpk(o.z, o.w) << 32); } } }
    }
    if (!waited) { __syncthreads(); }
}

#define MFMA16(a, b, c) __builtin_amdgcn_mfma_f32_16x16x32_bf16((a), (b), (c), 0, 0, 0)
__device__ __forceinline__ bf16x8 ldsfrag(const LAS bf16* base, int pitch, int row0, int k0, int lane) { return *(const LAS bf16x8*)(base + (row0 + (lane & 15)) * pitch + k0 + 8 * (lane >> 4)); }

__device__ __forceinline__ bf16x8 ldsfrag_tr(const LAS bf16* M, int pitch, int k0, int c0, int lane) {
    const int g = lane >> 4, i = lane & 15, qq = i >> 2, p = i & 3;
    const LAS bf16* a0 = M + (k0 + 8 * g + qq) * pitch + c0 + 4 * p;
    const v4i16_t lo = __builtin_amdgcn_ds_read_tr16_b64_v4i16((LAS v4i16_t*)a0), hi = __builtin_amdgcn_ds_read_tr16_b64_v4i16((LAS v4i16_t*)(a0 + 4 * pitch));
    return (bf16x8){lo[0], lo[1], lo[2], lo[3], hi[0], hi[1], hi[2], hi[3]};
}
constexpr int AT_KP = 136, AT_PP = 168;
constexpr int AT_KS = 0, AT_VS = 256 * AT_KP * 2, AT_BIAS = AT_VS + 272 * AT_KP * 2;
struct AttnU { const unsigned char *Qb, *Kb, *Vb; size_t rstride; int i0, r, g, hh; size_t tok0; };
__device__ __forceinline__ AttnU attn_decode(const Args& a, int U) {
    AttnU u; const int ub = U & 31; u.hh = (U >> 5) & 3; u.g = (U >> 7) % 3; const int b = U / 384;
    const int rs = 2 * u.g; u.r = 1 << rs; const int ares = ub & (u.r - 1), blk = ub >> rs; u.i0 = blk * 128;
    u.tok0 = (size_t)(b * SEQ + ares); u.rstride = (size_t)u.r * ULD; const int hc = (u.g * 4 + u.hh) * 128;
    u.Qb = ucol8(a.ws, C_AQ + hc) + u.tok0 * ULD; u.Kb = ucol8(a.ws, C_AK + hc) + u.tok0 * ULD; u.Vb = ucol8(a.ws, C_AV + hc) + u.tok0 * ULD;
    return u;
}
__device__ __forceinline__ void attn_phase(const Args& a, Frame& F) {
    LAS bf16* KS = (LAS bf16*)(F.lds + AT_KS); LAS bf16* VS = (LAS bf16*)(F.lds + AT_VS); LAS float* BIAS = (LAS float*)(F.lds + AT_BIAS);
    const int tid = F.tid, lane = F.lane, w = F.wave, q = lane >> 4, l15 = lane & 15;
    typedef unsigned u32x2 __attribute__((ext_vector_type(2)));
    int U = F.vcu; if (U >= 1536) return;
    v4u kreg[4], vreg[4];
    { const AttnU u = attn_decode(a, U);
#pragma unroll
      for (int it = 0; it < 4; ++it) { const int c = tid + NTHR * it, kk = c >> 3, ch = c & 7; int i = u.i0 - 128 + kk; i = i < 0 ? 0 : i;
          const size_t ro = (size_t)i * u.rstride + ch * 16; kreg[it] = *(const GAS v4u*)(u.Kb + ro); vreg[it] = *(const GAS v4u*)(u.Vb + ro); }
    }
    if (tid < 256) { LAS v4u* z = (LAS v4u*)(VS + (256 + (tid >> 4)) * AT_KP + (tid & 15) * 8); z[0] = (v4u){0u, 0u, 0u, 0u}; }
    const bool bg_pre = (F.vcu & 1) != 0; int slot = 0;
    for (; U < 1536; U += F.G, ++slot) {
        if (bg_pre) { moe_convert(a, F, 2 * slot, 2); __syncthreads(); }
        const AttnU u = attn_decode(a, U);
        bf16x8 qf[4];
        { const unsigned char* qrow = u.Qb + (size_t)(u.i0 + 16 * w + l15) * u.rstride + 8 * q; typedef unsigned u32x2q __attribute__((ext_vector_type(2)));
          u32x2q qb[4];
#pragma unroll
          for (int ks = 0; ks < 4; ++ks) qb[ks] = *(const GAS u32x2q*)(qrow + 32 * ks);
#pragma unroll
          for (int ks = 0; ks < 4; ++ks) qf[ks] = __builtin_bit_cast(bf16x8, (v4u){f8x2bf(qb[ks].x, false), f8x2bf(qb[ks].x, true), f8x2bf(qb[ks].y, false), f8x2bf(qb[ks].y, true)}); }
#pragma unroll
        for (int it = 0; it < 4; ++it) { const int c = tid + NTHR * it, kk = c >> 3, ch = c & 7; const bool ok = (u.i0 - 128 + kk) >= 0;
            const v4u kz = ok ? kreg[it] : (v4u){0u, 0u, 0u, 0u}, vz = ok ? vreg[it] : (v4u){0u, 0u, 0u, 0u};
            *(LAS v4u*)(KS + kk * AT_KP + ch * 16) = (v4u){f8x2bf(kz.x, false), f8x2bf(kz.x, true), f8x2bf(kz.y, false), f8x2bf(kz.y, true)};
            *(LAS v4u*)(KS + kk * AT_KP + ch * 16 + 8) = (v4u){f8x2bf(kz.z, false), f8x2bf(kz.z, true), f8x2bf(kz.w, false), f8x2bf(kz.w, true)};
            *(LAS v4u*)(VS + kk * AT_KP + ch * 16) = (v4u){f8x2bf(vz.x, false), f8x2bf(vz.x, true), f8x2bf(vz.y, false), f8x2bf(vz.y, true)};
            *(LAS v4u*)(VS + kk * AT_KP + ch * 16 + 8) = (v4u){f8x2bf(vz.z, false), f8x2bf(vz.z, true), f8x2bf(vz.w, false), f8x2bf(vz.w, true)}; }
        if (tid < 129) { const int dist = u.r * tid; int bk;
            if (dist < 16) bk = dist; else { bk = 16 + (int)(__log2f((float)dist * 0.0625f) * (16.0f / 7.0f)); bk = bk > 31 ? 31 : bk; }
            BIAS[tid] = a.in[6][bk * 12 + u.g * 4 + u.hh]; }
        __syncthreads();
        if (U + F.G < 1536) { const AttnU n = attn_decode(a, U + F.G);
#pragma unroll
            for (int it = 0; it < 4; ++it) { const int c = tid + NTHR * it, kk = c >> 3, ch = c & 7; int i = n.i0 - 128 + kk; i = i < 0 ? 0 : i;
                const size_t ro = (size_t)i * n.rstride + ch * 16; kreg[it] = *(const GAS v4u*)(n.Kb + ro); vreg[it] = *(const GAS v4u*)(n.Vb + ro); } }
        f32x4 s[9];
#pragma unroll
        for (int t9 = 0; t9 < 9; ++t9) { f32x4 acc = (f32x4){0.f, 0.f, 0.f, 0.f};
#pragma unroll
            for (int ks = 0; ks < 4; ++ks) acc = MFMA16(ldsfrag(KS, AT_KP, 16 * (w + t9), 32 * ks, lane), qf[ks], acc);
            s[t9] = acc; }
        const float scale = 0.08838834764831845f;
        float mx = -INFINITY;
#pragma unroll
        for (int t9 = 0; t9 < 9; ++t9)
#pragma unroll
            for (int rr = 0; rr < 4; ++rr) { const int krel = 16 * t9 + 4 * q + rr, dist = 128 + l15 - krel; const bool valid = (dist >= 0) && (dist <= 128) && (u.i0 - 128 + 16 * w + krel >= 0);
                const float v = valid ? s[t9][rr] * scale + BIAS[valid ? dist : 0] : -INFINITY; s[t9][rr] = v; mx = fmaxf(mx, v); }
        mx = fmaxf(mx, __shfl_xor(mx, 16)); mx = fmaxf(mx, __shfl_xor(mx, 32));
        float lsum = 0.f;
#pragma unroll
        for (int t9 = 0; t9 < 9; ++t9)
#pragma unroll
            for (int rr = 0; rr < 4; ++rr) { const float p = __expf(s[t9][rr] - mx); s[t9][rr] = p; lsum += p; }
        lsum += __shfl_xor(lsum, 16); lsum += __shfl_xor(lsum, 32);
        __syncthreads();
        LAS bf16* PS = KS + w * 16 * AT_PP;
#pragma unroll
        for (int t9 = 0; t9 < 9; ++t9) *(LAS u32x2*)(PS + l15 * AT_PP + 16 * t9 + 4 * q) = (u32x2){cvtpk(s[t9][0], s[t9][1]), cvtpk(s[t9][2], s[t9][3])};
        *(LAS u32x2*)(PS + l15 * AT_PP + 144 + 4 * q) = (u32x2){0u, 0u};
        __syncthreads();
        bf16x8 pf[5];
#pragma unroll
        for (int ks = 0; ks < 5; ++ks) pf[ks] = ldsfrag(PS, AT_PP, 0, 32 * ks, lane);
        const float inv = 16.0f / lsum;
        const size_t tokrow = u.tok0 + (size_t)(u.i0 + 16 * w + l15) * u.r;
        unsigned char* og = a.ws + WS_OG + (size_t)u.g * TOK * 512 + tokrow * 512 + u.hh * 128 + 4 * (q & 2);
#pragma unroll
        for (int dp = 0; dp < 8; dp += 2) { int pc[2];
#pragma unroll
            for (int d2 = 0; d2 < 2; ++d2) { f32x4 acc = (f32x4){0.f, 0.f, 0.f, 0.f};
#pragma unroll
                for (int ks = 0; ks < 5; ++ks) acc = MFMA16(ldsfrag_tr(VS, AT_KP, 16 * w + 32 * ks, 16 * (dp + d2), lane), pf[ks], acc);
                int pk = 0; pk = __builtin_amdgcn_cvt_pk_fp8_f32(acc[0] * inv, acc[1] * inv, pk, false); pk = __builtin_amdgcn_cvt_pk_fp8_f32(acc[2] * inv, acc[3] * inv, pk, true); pc[d2] = pk; }
            const bool odd = (q & 1) != 0;
            const int r0 = __shfl_xor(odd ? pc[0] : pc[1], 16);
            typedef int i32x2 __attribute__((ext_vector_type(2)));
            *(GAS i32x2*)(og + 16 * (dp + (odd ? 1 : 0))) = odd ? (i32x2){r0, pc[1]} : (i32x2){pc[0], r0}; }
        if (q == 0) ((float*)(a.ws + WS_LSE))[(size_t)u.g * TOK * 4 + tokrow * 4 + u.hh] = mx + __logf(lsum);
        __syncthreads();
        if (!bg_pre) { moe_convert(a, F, 2 * slot, 2); __syncthreads(); }
    }
}

constexpr int RT_P = 136, RV_P = 264;
struct RotRegs { v4u lo[2], hi[2]; };
__device__ __forceinline__ void rot_issue(Frame& F, const bf16* src, RotRegs& r) {
#pragma unroll
    for (int it = 0; it < 2; ++it) { const int pc = F.tid + NTHR * it, j = pc >> 3, d0 = (pc & 7) * 8; r.lo[it] = *(const GAS v4u*)(src + (size_t)j * ULD + d0); r.hi[it] = *(const GAS v4u*)(src + (size_t)j * ULD + d0 + 64); }
}
__device__ __forceinline__ void rope_issue(const Args& a, Frame& F, int pos0, f32x4 (&cs)[2][4]) {
    const float* rope = (const float*)(a.ws + WS_ROPE);
#pragma unroll
    for (int it = 0; it < 2; ++it) { const int pc = F.tid + NTHR * it, j = pc >> 3, d0 = (pc & 7) * 8; const GAS f32x4* rp = (const GAS f32x4*)(rope + ((size_t)(pos0 + j) * 64 + d0) * 2);
#pragma unroll
        for (int i = 0; i < 4; ++i) cs[it][i] = rp[i]; }
}
template <bool ZETA>
__device__ __forceinline__ void rot_finish(Frame& F, const RotRegs& r, const f32x4 (&cs)[2][4], float mul, float l2g, LAS bf16* dst) {
#pragma unroll
    for (int it = 0; it < 2; ++it) { const int pc = F.tid + NTHR * it, j = pc >> 3, d0 = (pc & 7) * 8;
        const float m = ZETA ? mul * __builtin_amdgcn_exp2f((float)(127 - j) * l2g) : mul;
        float ol[8], oh[8];
#pragma unroll
        for (int i = 0; i < 8; ++i) { const unsigned wl = i < 2 ? r.lo[it].x : (i < 4 ? r.lo[it].y : (i < 6 ? r.lo[it].z : r.lo[it].w)), wh = i < 2 ? r.hi[it].x : (i < 4 ? r.hi[it].y : (i < 6 ? r.hi[it].z : r.hi[it].w));
            const float tl = (i & 1) ? bfhi(wl) : bflo(wl), th = (i & 1) ? bfhi(wh) : bflo(wh); const float c = (i & 1) ? cs[it][i >> 1].z : cs[it][i >> 1].x, sn = (i & 1) ? cs[it][i >> 1].w : cs[it][i >> 1].y;
            ol[i] = (tl * c - th * sn) * m; oh[i] = (tl * sn + th * c) * m; }
        *(LAS v4u*)(dst + j * RT_P + d0) = (v4u){cvtpk(ol[0], ol[1]), cvtpk(ol[2], ol[3]), cvtpk(ol[4], ol[5]), cvtpk(ol[6], ol[7])};
        *(LAS v4u*)(dst + j * RT_P + d0 + 64) = (v4u){cvtpk(oh[0], oh[1]), cvtpk(oh[2], oh[3]), cvtpk(oh[4], oh[5]), cvtpk(oh[6], oh[7])}; }
}
__device__ __forceinline__ void v_issue(Frame& F, const bf16* src, v4u (&t)[8]) {
#pragma unroll
    for (int it = 0; it < 8; ++it) { const int c = F.tid + NTHR * it, j = c >> 5, ch = c & 31; t[it] = *(const GAS v4u*)(src + (size_t)j * ULD + ch * 8); }
}
__device__ __forceinline__ void v_finish(Frame& F, const v4u (&t)[8], LAS bf16* VS) {
#pragma unroll
    for (int it = 0; it < 8; ++it) { const int c = F.tid + NTHR * it, j = c >> 5, ch = c & 31; *(LAS v4u*)(VS + j * RV_P + ch * 8) = t[it]; }
}
__device__ __forceinline__ void ret_kv_item(const Args& a, Frame& F, int item) {
    const int h = item & 3, n = (item >> 2) & 31, b = item >> 7; const float l2g = log2g(h);
    const size_t r0 = (size_t)(b * SEQ + n * 128) * ULD;
    LAS bf16* KZ = (LAS bf16*)F.lds; LAS bf16* VS = (LAS bf16*)(F.lds + 128 * RT_P * 2);
    { RotRegs kr; f32x4 cs[2][4]; v4u vt[8];
      rot_issue(F, ucol(a.ws, C_RK + h * 128) + r0, kr); rope_issue(a, F, n * 128, cs); v_issue(F, ucol(a.ws, C_RV + h * 256) + r0, vt);
      rot_finish<true>(F, kr, cs, 0.08838834764831845f, l2g, KZ); v_finish(F, vt, VS); }
    __syncthreads();
    const int lane = F.lane, w = F.wave, q = lane >> 4, l15 = lane & 15;
    f32x4 acc[2][8];
#pragma unroll
    for (int e2 = 0; e2 < 2; ++e2)
#pragma unroll
        for (int dt = 0; dt < 8; ++dt) acc[e2][dt] = (f32x4){0.f, 0.f, 0.f, 0.f};
#pragma unroll
    for (int ks = 0; ks < 4; ++ks) { const bf16x8 v0 = ldsfrag_tr(VS, RV_P, 32 * ks, 32 * w, lane), v1 = ldsfrag_tr(VS, RV_P, 32 * ks, 32 * w + 16, lane);
#pragma unroll
        for (int dt = 0; dt < 8; ++dt) { const bf16x8 kk = ldsfrag_tr(KZ, RT_P, 32 * ks, 16 * dt, lane); acc[0][dt] = MFMA16(kk, v0, acc[0][dt]); acc[1][dt] = MFMA16(kk, v1, acc[1][dt]); } }
    bf16* kv = (bf16*)(a.ws + WS_KV) + (size_t)item * 32768; typedef unsigned u32x2 __attribute__((ext_vector_type(2)));
#pragma unroll
    for (int e2 = 0; e2 < 2; ++e2)
#pragma unroll
        for (int dt = 0; dt < 8; ++dt) *(GAS u32x2*)(kv + (32 * w + 16 * e2 + l15) * 128 + 16 * dt + 4 * q) = (u32x2){cvtpk(acc[e2][dt][0], acc[e2][dt][1]), cvtpk(acc[e2][dt][2], acc[e2][dt][3])};
    __syncthreads();
}
__device__ __forceinline__ void p4_scan_merge(const Args& a, Frame& F) {
    const bf16* kv = (const bf16*)(a.ws + WS_KV); bf16* rt = (bf16*)(a.ws + WS_RT);
    for (int idx = F.vcu * NTHR + F.tid; idx < 16 * 8192; idx += F.G * NTHR) {
        const int bh = idx >> 13, el = (idx & 8191) * 4, b = bh >> 2, h = bh & 3; const float gch = exp2f(128.0f * log2g(h));
        f32x4 R = (f32x4){0.f, 0.f, 0.f, 0.f};
        for (int n0 = 0; n0 < 32; n0 += 8) { unsigned long long k8[8];
#pragma unroll
            for (int i = 0; i < 8; ++i) k8[i] = __builtin_nontemporal_load((const GAS unsigned long long*)(kv + (size_t)(((b * 32 + n0 + i) << 2) + h) * 32768 + el));
#pragma unroll
            for (int i = 0; i < 8; ++i) { const size_t off = (size_t)(((b * 32 + n0 + i) << 2) + h) * 32768 + el;
                *(GAS unsigned long long*)(rt + off) = (unsigned long long)cvtpk(R.x, R.y) | ((unsigned long long)cvtpk(R.z, R.w) << 32);
                const unsigned lo = (unsigned)k8[i], hi = (unsigned)(k8[i] >> 32); R = R * gch + (f32x4){bflo(lo), bfhi(lo), bflo(hi), bfhi(hi)}; } } }
    const int gw = F.vcu * NWAVES + F.wave, NGW = F.G * NWAVES;
    const unsigned char* og = a.ws + WS_OG; const float* lse = (const float*)(a.ws + WS_LSE);
    for (int t2 = gw; t2 < TOK / 2; t2 += NGW) { const int t = 2 * t2 + (F.lane >> 5), l31 = F.lane & 31, hh = l31 >> 3;
        const float l0 = lse[(size_t)t * 4 + hh], l1 = lse[(size_t)TOK * 4 + (size_t)t * 4 + hh], l2 = lse[(size_t)2 * TOK * 4 + (size_t)t * 4 + hh];
        const float m = fmaxf(l0, fmaxf(l1, l2)); float a0 = __expf(l0 - m), a1 = __expf(l1 - m), a2 = __expf(l2 - m); const float is = 0.0625f / (a0 + a1 + a2); a0 *= is; a1 *= is; a2 *= is;
        const size_t o = (size_t)t * 512 + l31 * 16;
        const v4u x0 = *(const GAS v4u*)(og + o), x1 = *(const GAS v4u*)(og + (size_t)TOK * 512 + o), x2 = *(const GAS v4u*)(og + (size_t)2 * TOK * 512 + o);
        v4u r;
#pragma unroll
        for (int j = 0; j < 4; ++j) { const unsigned w0 = j == 0 ? x0.x : (j == 1 ? x0.y : (j == 2 ? x0.z : x0.w)), w1 = j == 0 ? x1.x : (j == 1 ? x1.y : (j == 2 ? x1.z : x1.w)), w2 = j == 0 ? x2.x : (j == 1 ? x2.y : (j == 2 ? x2.z : x2.w));
            const f32x2_t_ p0 = __builtin_amdgcn_cvt_pk_f32_fp8((int)w0, false), q0 = __builtin_amdgcn_cvt_pk_f32_fp8((int)w0, true);
            const f32x2_t_ p1 = __builtin_amdgcn_cvt_pk_f32_fp8((int)w1, false), q1 = __builtin_amdgcn_cvt_pk_f32_fp8((int)w1, true);
            const f32x2_t_ p2 = __builtin_amdgcn_cvt_pk_f32_fp8((int)w2, false), q2 = __builtin_amdgcn_cvt_pk_f32_fp8((int)w2, true);
            int pk = 0; pk = __builtin_amdgcn_cvt_pk_fp8_f32(a0 * p0.x + a1 * p1.x + a2 * p2.x, a0 * p0.y + a1 * p1.y + a2 * p2.y, pk, false);
            pk = __builtin_amdgcn_cvt_pk_fp8_f32(a0 * q0.x + a1 * q1.x + a2 * q2.x, a0 * q0.y + a1 * q1.y + a2 * q2.y, pk, true);
            if (j == 0) r.x = (unsigned)pk; else if (j == 1) r.y = (unsigned)pk; else if (j == 2) r.z = (unsigned)pk; else r.w = (unsigned)pk; }
        *(GAS v4u*)(a.ws + WS_RET + (size_t)t * RA_LD + 1024 + l31 * 16) = r; }
}
__device__ __forceinline__ void ret_out_item(const Args& a, Frame& F, int item) {
    const int h = item & 3, n = (item >> 2) & 31, b = item >> 7; const float l2g = log2g(h);
    const size_t r0 = (size_t)(b * SEQ + n * 128) * ULD;
    LAS bf16* QS = (LAS bf16*)F.lds; LAS bf16* KS = (LAS bf16*)(F.lds + 128 * RT_P * 2); LAS bf16* VS = (LAS bf16*)(F.lds + 2 * 128 * RT_P * 2);
    LAS float* RED = (LAS float*)(F.lds + 2 * 128 * RT_P * 2 + 128 * RV_P * 2);
    { RotRegs qr, kr; f32x4 cs[2][4]; v4u vt[8];
      rot_issue(F, ucol(a.ws, C_RQ + h * 128) + r0, qr); rot_issue(F, ucol(a.ws, C_RK + h * 128) + r0, kr); rope_issue(a, F, n * 128, cs); v_issue(F, ucol(a.ws, C_RV + h * 256) + r0, vt);
      rot_finish<false>(F, qr, cs, 1.0f, l2g, QS); rot_finish<false>(F, kr, cs, 0.08838834764831845f, l2g, KS); v_finish(F, vt, VS); }
    __syncthreads();
    const int lane = F.lane, w = F.wave, q = lane >> 4, l15 = lane & 15;
    typedef unsigned u32x2 __attribute__((ext_vector_type(2)));
    u32x2 pw[8];
    bf16x8 rf0[4], rf1[4];
    { const bf16* rtg = (const bf16*)(a.ws + WS_RT) + (size_t)item * 32768 + (size_t)(32 * w + l15) * 128 + 8 * q;
#pragma unroll
      for (int ks = 0; ks < 4; ++ks) { rf0[ks] = *(const GAS bf16x8*)(rtg + 32 * ks); rf1[ks] = *(const GAS bf16x8*)(rtg + 16 * 128 + 32 * ks); } }
    { bf16x8 qf[4];
#pragma unroll
      for (int ks = 0; ks < 4; ++ks) qf[ks] = ldsfrag(QS, RT_P, 16 * w, 32 * ks, lane);
#pragma unroll
      for (int jt = 0; jt < 8; ++jt) { f32x4 acc = (f32x4){0.f, 0.f, 0.f, 0.f};
          if (jt <= w) {
#pragma unroll
              for (int ks = 0; ks < 4; ++ks) acc = MFMA16(ldsfrag(KS, RT_P, 16 * jt, 32 * ks, lane), qf[ks], acc); }
          float p[4];
#pragma unroll
          for (int rr = 0; rr < 4; ++rr) { const int j = 16 * jt + 4 * q + rr, i = 16 * w + l15; p[rr] = (j <= i) ? acc[rr] * __builtin_amdgcn_exp2f(-(float)(j + 1) * l2g) : 0.f; }
          pw[jt] = (u32x2){cvtpk(p[0], p[1]), cvtpk(p[2], p[3])}; } }
    __syncthreads();
#pragma unroll
    for (int jt = 0; jt < 8; ++jt) *(LAS u32x2*)(KS + (16 * w + l15) * RT_P + 16 * jt + 4 * q) = pw[jt];
    __syncthreads();
    f32x4 acc[2][8];
#pragma unroll
    for (int e2 = 0; e2 < 2; ++e2)
#pragma unroll
        for (int it = 0; it < 8; ++it) acc[e2][it] = (f32x4){0.f, 0.f, 0.f, 0.f};
#pragma unroll
    for (int ks = 0; ks < 4; ++ks) { const bf16x8 a0 = ldsfrag_tr(VS, RV_P, 32 * ks, 32 * w, lane), a1 = ldsfrag_tr(VS, RV_P, 32 * ks, 32 * w + 16, lane);
#pragma unroll
        for (int it = 2 * ks; it < 8; ++it) { const bf16x8 pf = ldsfrag(KS, RT_P, 16 * it, 32 * ks, lane); acc[0][it] = MFMA16(a0, pf, acc[0][it]); acc[1][it] = MFMA16(a1, pf, acc[1][it]); } }
#pragma unroll
    for (int ks = 0; ks < 4; ++ks) {
#pragma unroll
        for (int it = 0; it < 8; ++it) { const bf16x8 qf = ldsfrag(QS, RT_P, 16 * it, 32 * ks, lane); acc[0][it] = MFMA16(rf0[ks], qf, acc[0][it]); acc[1][it] = MFMA16(rf1[ks], qf, acc[1][it]); } }
#pragma unroll
    for (int it = 0; it < 8; ++it) { const float xi = __builtin_amdgcn_exp2f((float)(16 * it + l15 + 1) * l2g); acc[0][it] = acc[0][it] * xi; acc[1][it] = acc[1][it] * xi;
        float s1 = (acc[0][it][0] + acc[0][it][1]) + (acc[0][it][2] + acc[0][it][3]) + (acc[1][it][0] + acc[1][it][1]) + (acc[1][it][2] + acc[1][it][3]);
        float s2 = (acc[0][it][0] * acc[0][it][0] + acc[0][it][1] * acc[0][it][1]) + (acc[0][it][2] * acc[0][it][2] + acc[0][it][3] * acc[0][it][3]) + (acc[1][it][0] * acc[1][it][0] + acc[1][it][1] * acc[1][it][1]) + (acc[1][it][2] * acc[1][it][2] + acc[1][it][3] * acc[1][it][3]);
        s1 += __shfl_xor(s1, 16); s1 += __shfl_xor(s1, 32); s2 += __shfl_xor(s2, 16); s2 += __shfl_xor(s2, 32);
        if (q == 0) *(LAS u32x2*)(RED + (16 * it + l15) * 16 + 2 * w) = (u32x2){__float_as_uint(s1), __float_as_uint(s2)}; }
    __syncthreads();
#pragma unroll
    for (int it = 0; it < 8; ++it) { const LAS f32x4* rp = (const LAS f32x4*)(RED + (16 * it + l15) * 16); const f32x4 r0 = rp[0], r1 = rp[1], r2 = rp[2], r3 = rp[3];
        const float s1 = (r0[0] + r0[2]) + (r1[0] + r1[2]) + (r2[0] + r2[2]) + (r3[0] + r3[2]), s2 = (r0[1] + r0[3]) + (r1[1] + r1[3]) + (r2[1] + r2[3]) + (r3[1] + r3[3]);
        const float mean = s1 * (1.0f / 256.0f), var = fmaxf(s2 * (1.0f / 256.0f) - mean * mean, 0.f), rstd = 1.0f / sqrtf(var + GN_EPS);
        const size_t tok = (size_t)(b * SEQ + n * 128 + 16 * it + l15);
        const bf16* gp = ucol(a.ws, C_RG + h * 256) + tok * ULD + 32 * w + 4 * q; unsigned char* op = a.ws + WS_RET + tok * RA_LD + h * 256 + 32 * w + 4 * q;
        int w8p[2];
#pragma unroll
        for (int e2 = 0; e2 < 2; ++e2) { const u32x2 gg = *(const GAS u32x2*)(gp + 16 * e2);
            const float g0 = bflo(gg.x), g1 = bfhi(gg.x), g2 = bflo(gg.y), g3 = bfhi(gg.y);
#define SILU_(x) ((x) * __builtin_amdgcn_rcpf(1.0f + __expf(-(x))))
            const float o0 = SILU_(g0) * (acc[e2][it][0] - mean) * rstd, o1 = SILU_(g1) * (acc[e2][it][1] - mean) * rstd, o2 = SILU_(g2) * (acc[e2][it][2] - mean) * rstd, o3 = SILU_(g3) * (acc[e2][it][3] - mean) * rstd;
#undef SILU_
            int w8 = 0; w8 = __builtin_amdgcn_cvt_pk_fp8_f32(o0, o1, w8, false); w8 = __builtin_amdgcn_cvt_pk_fp8_f32(o2, o3, w8, true); w8p[e2] = w8; }
        { const bool odd = (q & 1) != 0; const int recv = __shfl_xor(odd ? w8p[0] : w8p[1], 16);
          *(GAS u32x2*)(op - 4 * (q & 1) + (odd ? 16 : 0)) = odd ? (u32x2){(unsigned)recv, (unsigned)w8p[1]} : (u32x2){(unsigned)w8p[0], (unsigned)recv}; } }
    __syncthreads();
}

constexpr int P8_RSTD = 0, P8_LG = 1024, P8_CNT = P8_LG + 2 * 64 * 32 * 4, P8_LB = P8_CNT + 128, P8_LTE = P8_LB + 128, P8_LTP = P8_LTE + 1024, P8_H2 = P8_LTP + 1024;
__device__ __forceinline__ void p8_route(const Args& a, Frame& F) {
    LAS float* RSTD = (LAS float*)(F.lds + P8_RSTD); LAS float* LG = (LAS float*)(F.lds + P8_LG); LAS int* CNT = (LAS int*)(F.lds + P8_CNT);
    if (F.tid < 32) CNT[F.tid] = 0;
    const float* mod = (const float*)(a.ws + WS_CTL) + CW_MOD; const int lane = F.lane, w = F.wave, q = lane >> 4, l15 = lane & 15;
    const bf16* xm = (const bf16*)(a.ws + WS_XMID); LAS unsigned char* H2L = F.lds + P8_H2;
    LAS int* LB = (LAS int*)(F.lds + P8_LB); LAS int* LTE = (LAS int*)(F.lds + P8_LTE); LAS int* LTP = (LAS int*)(F.lds + P8_LTP);
    int* TE = (int*)(a.ws + WS_TE); int* TP = (int*)(a.ws + WS_TP); float* TG = (float*)(a.ws + WS_TG);
    const int t0 = F.vcu * 64, b = t0 / SEQ;
    const float* gf = a.in[10]; const float* scf = mod + b * 6144 + 4096; const float* shf = mod + b * 6144 + 3072;
#pragma unroll
    for (int hb = 0; hb < 2; ++hb) { v4u v[4][2];
#pragma unroll
        for (int ri = 0; ri < 4; ++ri) { const GAS v4u* xr = (const GAS v4u*)(xm + (size_t)(t0 + 8 * w + 4 * hb + ri) * DM) + lane;
#pragma unroll
            for (int j = 0; j < 2; ++j) v[ri][j] = xr[64 * j]; }
#pragma unroll
        for (int ri = 0; ri < 4; ++ri) { float s = 0.f; f32x4 f[2][2];
#pragma unroll
            for (int j = 0; j < 2; ++j) { f[j][0] = (f32x4){bflo(v[ri][j].x), bfhi(v[ri][j].x), bflo(v[ri][j].y), bfhi(v[ri][j].y)}; f[j][1] = (f32x4){bflo(v[ri][j].z), bfhi(v[ri][j].z), bflo(v[ri][j].w), bfhi(v[ri][j].w)};
#pragma unroll
                for (int k = 0; k < 2; ++k) s += (f[j][k].x * f[j][k].x + f[j][k].y * f[j][k].y) + (f[j][k].z * f[j][k].z + f[j][k].w * f[j][k].w); }
            const float rstd = 1.0f / sqrtf(wave_sum(s) * (1.0f / DM) + RMS_EPS);
            if (lane == 0) RSTD[8 * w + 4 * hb + ri] = rstd;
            typedef int i32x2 __attribute__((ext_vector_type(2)));
            LAS i32x2* o8 = (LAS i32x2*)(H2L + (8 * w + 4 * hb + ri) * DM) + lane;
#pragma unroll
            for (int j = 0; j < 2; ++j) { i32x2 w8;
#pragma unroll
                for (int k = 0; k < 2; ++k) { const int c = 8 * (64 * j + lane) + 4 * k; const f32x4 gg = *(const f32x4*)(gf + c), ss = *(const f32x4*)(scf + c), hh = *(const f32x4*)(shf + c);
                    const f32x4 o = f[j][k] * rstd * gg * (ss + 1.0f) + hh;
                    int p = 0; p = __builtin_amdgcn_cvt_pk_fp8_f32(o.x, o.y, p, false); p = __builtin_amdgcn_cvt_pk_fp8_f32(o.z, o.w, p, true); if (k == 0) w8.x = p; else w8.y = p; }
                o8[64 * j] = w8; } } }
    __syncthreads();
    { const int rt = w & 3, kh = w >> 2; const float rstd = RSTD[16 * rt + l15];
      const bf16* xrow = xm + (size_t)(t0 + 16 * rt + l15) * DM + 512 * kh + 8 * q;
      const bf16* wh = (const bf16*)(a.ws + WS_WRT) + (size_t)l15 * 1024 + 512 * kh + 8 * q; const bf16* wl = wh + 32768;
      f32x4 acc0 = (f32x4){0.f, 0.f, 0.f, 0.f}, acc1 = (f32x4){0.f, 0.f, 0.f, 0.f};
#pragma unroll 4
      for (int ks = 0; ks < 16; ++ks) { const int kc = 512 * kh + 32 * ks + 8 * q;
          const v4u xw = *(const GAS v4u*)(xrow + 32 * ks); const f32x4 x0 = (f32x4){bflo(xw.x), bfhi(xw.x), bflo(xw.y), bfhi(xw.y)}, x1 = (f32x4){bflo(xw.z), bfhi(xw.z), bflo(xw.w), bfhi(xw.w)};
          const f32x4 g0 = *(const f32x4*)(gf + kc), g1 = *(const f32x4*)(gf + kc + 4), s0 = *(const f32x4*)(scf + kc), s1 = *(const f32x4*)(scf + kc + 4), h0 = *(const f32x4*)(shf + kc), h1 = *(const f32x4*)(shf + kc + 4);
          const f32x4 o0 = x0 * rstd * g0 * (s0 + 1.0f) + h0, o1 = x1 * rstd * g1 * (s1 + 1.0f) + h1;
          v4u hi; hi.x = cvtpk(o0.x, o0.y); hi.y = cvtpk(o0.z, o0.w); hi.z = cvtpk(o1.x, o1.y); hi.w = cvtpk(o1.z, o1.w);
          v4u lo; lo.x = cvtpk(o0.x - bflo(hi.x), o0.y - bfhi(hi.x)); lo.y = cvtpk(o0.z - bflo(hi.y), o0.w - bfhi(hi.y)); lo.z = cvtpk(o1.x - bflo(hi.z), o1.y - bfhi(hi.z)); lo.w = cvtpk(o1.z - bflo(hi.w), o1.w - bfhi(hi.w));
          const bf16x8 ah = __builtin_bit_cast(bf16x8, hi), al = __builtin_bit_cast(bf16x8, lo);
          const bf16x8 wh0 = *(const GAS bf16x8*)(wh + 32 * ks), wh1 = *(const GAS bf16x8*)(wh + 16 * 1024 + 32 * ks), wl0 = *(const GAS bf16x8*)(wl + 32 * ks), wl1 = *(const GAS bf16x8*)(wl + 16 * 1024 + 32 * ks);
          acc0 = MFMA16(ah, wh0, acc0); acc0 = MFMA16(al, wh0, acc0); acc0 = MFMA16(ah, wl0, acc0);
          acc1 = MFMA16(ah, wh1, acc1); acc1 = MFMA16(al, wh1, acc1); acc1 = MFMA16(ah, wl1, acc1); }
#pragma unroll
      for (int rr = 0; rr < 4; ++rr) { LG[(kh * 64 + 16 * rt + 4 * q + rr) * 32 + l15] = acc0[rr]; LG[(kh * 64 + 16 * rt + 4 * q + rr) * 32 + 16 + l15] = acc1[rr]; } }
    __syncthreads();
    { const int e = lane & 31; const float br = a.in[12][e];
      for (int ri = 0; ri < 8; ++ri) { const int row = 8 * w + ri, t = t0 + row;
          float v = LG[row * 32 + e] + LG[(64 + row) * 32 + e] + br; float tv[4]; int ti[4];
#pragma unroll
          for (int k = 0; k < 4; ++k) { float m = v;
#pragma unroll
              for (int o = 1; o < 32; o <<= 1) m = fmaxf(m, __shfl_xor(m, o));
              const unsigned long long bal = __ballot(v == m); const int idx = __ffsll((long long)(bal & 0xffffffffull)) - 1;
              tv[k] = m; ti[k] = idx; if (e == idx) v = -INFINITY; }
          const float e1 = __expf(tv[1] - tv[0]), e2 = __expf(tv[2] - tv[0]), e3 = __expf(tv[3] - tv[0]); const float is = 1.0f / (1.0f + e1 + e2 + e3);
          if (lane < 4) { const int k = lane; const int ek = k == 0 ? ti[0] : (k == 1 ? ti[1] : (k == 2 ? ti[2] : ti[3])); const float gk = (k == 0 ? 1.0f : (k == 1 ? e1 : (k == 2 ? e2 : e3))) * is;
              const int lp = __hip_atomic_fetch_add(&CNT[ek], 1, __ATOMIC_RELAXED, __HIP_MEMORY_SCOPE_WORKGROUP);
              LTE[row * 4 + k] = ek; LTP[row * 4 + k] = lp; TE[t * 4 + k] = ek; TG[t * 4 + k] = gk; } } }
    __syncthreads();
    if (F.tid < 32) { const int cnt = CNT[F.tid]; LB[F.tid] = (int)__hip_atomic_fetch_add(F.ctl + CW_CNT + F.tid, (unsigned)cnt, RLX_AGENT); }
    __syncthreads();
    for (int pi = 0; pi < 32; ++pi) { const int p = w * 32 + pi, row = p >> 2; const int ek = LTE[p], pos = LB[ek] + LTP[p];
        if (lane == 0) TP[(t0 + row) * 4 + (p & 3)] = pos;
        *((GAS v4u*)(a.ws + WS_XIN + ((size_t)ek * XCAP + pos) * DM) + lane) = *((const LAS v4u*)(H2L + row * DM) + lane); }
    __syncthreads();
}
constexpr int MT_CS = 131072, MT_PM = MT_CS + 128, MT_E = MT_PM + 1280, MT_NT = MT_E + 1280;
__device__ __forceinline__ int moe_tables(Frame& F, bool sparse_a) {
    LAS int* CS = (LAS int*)(F.lds + MT_CS); LAS int* TPM = (LAS int*)(F.lds + MT_PM); LAS int* TEX = (LAS int*)(F.lds + MT_E); LAS int* NT = (LAS int*)(F.lds + MT_NT);
    if (F.tid < 64) { const int e = F.tid & 31; const int cnt = (int)__hip_atomic_load(F.ctl + CW_CNT + e, RLX_AGENT), n = (cnt + 255) >> 8;
        int incl = n;
#pragma unroll
        for (int o = 1; o < 32; o <<= 1) { const int v = __shfl_up(incl, o, 32); if (e >= o) incl += v; }
        const int t = incl - n;
        if (F.tid < 32) { CS[e] = t << 8;
            for (int j = 0; j < n; ++j) { TPM[t + j] = sparse_a ? e * (XCAP / 256) + j : t + j; TEX[t + j] = e; }
            if (e == 31) NT[0] = incl; } }
    __syncthreads();
    return __builtin_amdgcn_readfirstlane(NT[0]);
}
__device__ __forceinline__ void p12_final(const Args& a, Frame& F, bool with_moe, bool tables_ready) {
    LAS int* CS = (LAS int*)(F.lds + MT_CS); if (with_moe && !tables_ready) (void)moe_tables(F, false);
    const int gw = F.vcu * NWAVES + F.wave, NGW = F.G * NWAVES, lane = F.lane; const float* mod = (const float*)(a.ws + WS_CTL) + CW_MOD;
    const bf16* xm = (const bf16*)(a.ws + WS_XMID); const unsigned char* yb = a.ws + WS_YB; const int* TE = (const int*)(a.ws + WS_TE); const int* TP = (const int*)(a.ws + WS_TP); const float* TG = (const float*)(a.ws + WS_TG);
    for (int t = gw; t < TOK; t += NGW) { const int b = t / SEQ;
        f32x4 v[4], m4[4];
#pragma unroll
        for (int j = 0; j < 4; ++j) { const unsigned long long xw = __builtin_nontemporal_load((const GAS unsigned long long*)(xm + (size_t)t * DM) + lane + 64 * j); const unsigned lo = (unsigned)xw, hi = (unsigned)(xw >> 32);
            v[j] = (f32x4){bflo(lo), bfhi(lo), bflo(hi), bfhi(hi)}; m4[j] = (f32x4){0.f, 0.f, 0.f, 0.f}; }
        if (with_moe) {
#pragma unroll
            for (int k = 0; k < 4; ++k) { const int row = CS[TE[t * 4 + k]] + TP[t * 4 + k]; const float gk = TG[t * 4 + k]; const GAS int* yr = (const GAS int*)(yb + (size_t)row * DM) + lane;
#pragma unroll
                for (int j = 0; j < 4; ++j) { const int y4 = __builtin_nontemporal_load(yr + 64 * j); typedef float f32x2_ __attribute__((ext_vector_type(2)));
                    const f32x2_ lo = __builtin_amdgcn_cvt_pk_f32_fp8(y4, false), hi = __builtin_amdgcn_cvt_pk_f32_fp8(y4, true);
                    m4[j].x += gk * lo.x; m4[j].y += gk * lo.y; m4[j].z += gk * hi.x; m4[j].w += gk * hi.y; } }
        }
        float s = 0.f;
#pragma unroll
        for (int j = 0; j < 4; ++j) { const f32x4 gt = *(const f32x4*)(mod + b * 6144 + 5120 + 4 * (64 * j + lane)); v[j] = v[j] + gt * m4[j]; s += (v[j].x * v[j].x + v[j].y * v[j].y) + (v[j].z * v[j].z + v[j].w * v[j].w); }
        const float rstd = 1.0f / sqrtf(wave_sum(s) * (1.0f / DM) + RMS_EPS);
#pragma unroll
        for (int j = 0; j < 4; ++j) { const f32x4 gf = *(const f32x4*)(a.in[17] + 4 * (64 * j + lane)); __builtin_nontemporal_store(v[j] * rstd * gf, (GAS f32x4*)(a.out + (size_t)t * DM) + lane + 64 * j); } }
}

#ifndef ABL_NOMIX
#define ABL_NOMIX 0
#endif
#ifndef ABL_NOMOE
#define ABL_NOMOE 0
#endif
#ifndef ONE_LAUNCH
#define ONE_LAUNCH 1
#endif
constexpr int NPHASE = 13;
__global__ void __launch_bounds__(NTHR, 2) mk_fwd(Args args) {
    extern __shared__ __attribute__((aligned(16))) unsigned char lds[];
    Frame F;
    F.lds = (LAS unsigned char*)lds; F.MISC = (volatile LAS unsigned*)(F.lds + MISC_OFF);
    F.tid = threadIdx.x; F.lane = F.tid & 63; F.wave = __builtin_amdgcn_readfirstlane(F.tid >> 6);
    F.G = gridDim.x; { const int bx = blockIdx.x; F.vcu = (F.G % 8 == 0) ? (bx % 8) * (F.G / 8) + bx / 8 : bx; }
    unsigned char* ws = args.ws; F.ctl = (gu32*)(ws + WS_CTL);
    if (F.tid < 64) F.MISC[F.tid] = 0u;
    __syncthreads();
    XcdBarrier bar = xcd_barrier_post((unsigned*)(F.ctl + CW_BAR), F.MISC + 8);
    const int lo = args.ph_lo, hi = args.ph_hi;
#ifndef PHMASK
#define PHMASK 0x1fff
#endif
#define IN(k) (lo <= (k) && (k) < hi && ((PHMASK >> (k)) & 1))
#ifndef REPMASK
#define REPMASK 0
#endif
#define REP(k) for (int rep_ = 0; rep_ < ((((REPMASK) >> (k)) & 1) ? 2 : 1); ++rep_)
#ifndef XBAR
#define XBAR 0
#endif
#define SEAM(k) do { if (IN(k) && IN((k) + 1)) { xcd_barrier(bar); if ((XBAR >> (k)) & 1) { xcd_barrier(bar); xcd_barrier(bar); } } } while (0)
    typedef pg8::bf16_t pb;
    if (IN(0)) REP(0) { p0_prologue(args, F); }
#if !ABL_NOMIX
    if (IN(1)) REP(1) { p1_norm1(args, F); } SEAM(1);
    if (IN(2)) REP(2) {
        { pg8::Gemm g{(const pb*)(ws + WS_H), (const pb*)(ws + WS_WIN), TOK, N16, DM}; pg8::SplitOrder S; S.init(TOK, N16, F.G, (int)blockIdx.x); S.nx = 4; S.ny = 2;
          pg8::EpiBf16<0> E{(pb*)(ws + WS_U), ULD, nullptr, 256, UBLK, 1.f};
          pg8::gemm_phase<pg8::EpiBf16<0>, pg8::SplitOrder, true, true>(F.lds, g, S, E); }
        __syncthreads();
        { pg8::Gemm g{(const pb*)(ws + WS_H8), (const pb*)(ws + WS_WIN8), TOK, INW - N16, DM / 2}; pg8::SplitOrder S; S.init(TOK, INW - N16, F.G, (int)blockIdx.x); S.nx = 5; S.ny = 8;
          pg8::EpiFp8Blk E{ws + WS_U + (size_t)(N16 / 256) * UBLK * 2, UBLK};
          pg8::gemm_phase<pg8::EpiFp8Blk, pg8::SplitOrder, true, true, true>(F.lds, g, S, E); } } SEAM(2);
    if (IN(3)) { REP(3) { attn_phase(args, F); }
        REP(13) { for (int it = (F.vcu + 128) % F.G; it < 512; it += F.G) ret_kv_item(args, F, it); } } SEAM(3);
    if (IN(4)) REP(4) { p4_scan_merge(args, F); } SEAM(4);
    if (IN(5)) REP(5) { for (int it = F.vcu; it < 512; it += F.G) ret_out_item(args, F, it); } SEAM(5);
    if (IN(6)) REP(6) { pg8::Gemm g{(const pb*)(ws + WS_RET), (const pb*)(ws + WS_WRET), TOK, DM, RA_LD / 2}; pg8::StaticOrder S; S.init(TOK, DM, F.G, (int)blockIdx.x);
        pg8::EpiGate2<8> E{(pb*)(ws + WS_MERGED), DM, ucol8(ws, C_GA), ucol8(ws, C_GB), UBLK};
        pg8::gemm_phase<pg8::EpiGate2<8>, pg8::StaticOrder, true, true, true>(F.lds, g, S, E); } SEAM(6);
    if (IN(7)) REP(7) { pg8::Gemm g{(const pb*)(ws + WS_MERGED), (const pb*)(ws + WS_WO), TOK, DM, 1024}; pg8::StaticOrder S; S.init(TOK, DM, F.G, (int)blockIdx.x);
        pg8::EpiResid E{(pg8::bf16_t*)(ws + WS_XMID), args.in[0], DM, (const float*)(ws + WS_CTL) + CW_MOD + 2048, 6144, SEQ / 256};
        pg8::gemm_phase<pg8::EpiResid, pg8::StaticOrder, true, true>(F.lds, g, S, E); } SEAM(7);
#else
    if (IN(7)) { const f32x4* s = (const f32x4*)args.in[0]; unsigned long long* d = (unsigned long long*)(ws + WS_XMID); for (size_t i = (size_t)blockIdx.x * NTHR + F.tid; i < (size_t)TOK * DM / 4; i += (size_t)F.G * NTHR) { const f32x4 x = s[i]; d[i] = (unsigned long long)cvtpk(x.x, x.y) | ((unsigned long long)cvtpk(x.z, x.w) << 32); } } SEAM(7);
#endif
#if !ABL_NOMOE
    if (IN(8)) { p8_route(args, F); } if (IN(8) && IN(10)) xcd_barrier(bar);
    if (IN(10)) REP(10) { const int nt = moe_tables(F, true);
        pg8::Gemm g{(const pb*)(ws + WS_XIN), (const pb*)(ws + WS_W1), nt * 256, NEXP * FF2, DM / 2}; pg8::MoeOrder S{nt, FF2 / 256, F.G, F.vcu  , (const LAS int*)(F.lds + MT_PM), (const LAS int*)(F.lds + MT_E)};
        pg8::EpiSwiglu E{(pb*)(ws + WS_A), FF, args.in[14], FF2 / 256};
        pg8::gemm_phase<pg8::EpiSwiglu, pg8::MoeOrder, true, true, true>(F.lds, g, S, E); } SEAM(10);
    if (IN(11)) REP(11) { const int nt = IN(10) ? __builtin_amdgcn_readfirstlane(((LAS int*)(F.lds + MT_NT))[0]) : moe_tables(F, true);
        pg8::Gemm g{(const pb*)(ws + WS_A), (const pb*)(ws + WS_W2), nt * 256, NEXP * DM, FF / 2}; pg8::MoeOrder S{nt, DM / 256, F.G, F.vcu, (const LAS int*)nullptr, (const LAS int*)(F.lds + MT_E)};
        pg8::EpiFp8Row E{ws + WS_YB, DM, args.in[16], DM / 256};
        pg8::gemm_phase<pg8::EpiFp8Row, pg8::MoeOrder, true, true, true>(F.lds, g, S, E); } SEAM(11);
#endif
    if (IN(12)) REP(12) { p12_final(args, F, !ABL_NOMOE, IN(10)); }
#undef IN
#undef SEAM
}

extern "C" void kernel_launch(void* const* d_in, const int* in_sizes, int n_in, void* d_out, int out_size, void* d_ws, size_t ws_size, hipStream_t stream) {
    static int grid = 0;
    if (grid == 0) {
        if (n_in != 18 || in_sizes[0] != TOK * DM || out_size != TOK * DM || ws_size < WS_END) { fprintf(stderr, "kernel_launch: unexpected shapes n_in %d in0 %d out %d ws %zu\n", n_in, n_in > 0 ? in_sizes[0] : -1, out_size, ws_size); grid = -1; return; }
        int dev = 0, cus = 0, per_cu = 0;
        if (hipGetDevice(&dev) != hipSuccess || hipDeviceGetAttribute(&cus, hipDeviceAttributeMultiprocessorCount, dev) != hipSuccess) { grid = -1; return; }
        if (hipFuncSetAttribute((const void*)mk_fwd, hipFuncAttributeMaxDynamicSharedMemorySize, LDS_BYTES) != hipSuccess) { fprintf(stderr, "kernel_launch: hipFuncSetAttribute failed\n"); grid = -1; return; }
        if (hipOccupancyMaxActiveBlocksPerMultiprocessor(&per_cu, (const void*)mk_fwd, NTHR, LDS_BYTES) != hipSuccess || per_cu < 1) fprintf(stderr, "kernel_launch: occupancy query says %d\n", per_cu);
        (void)hipGetLastError();
        grid = cus;
        if (grid != 256) fprintf(stderr, "kernel_launch: %d CUs (built for 256)\n", grid);
    }
    if (grid < 0) return;
    (void)hipMemsetAsync((char*)d_ws + WS_CTL, 0, CTL_ZERO_BYTES, stream);
    Args a{};
    for (int i = 0; i < 18; ++i) a.in[i] = (const float*)d_in[i];
    a.out = (float*)d_out; a.ws = (unsigned char*)d_ws;
#if ONE_LAUNCH
    a.ph_lo = 0; a.ph_hi = NPHASE;
    hipLaunchKernelGGL(mk_fwd, dim3(grid), dim3(NTHR), LDS_BYTES, stream, a);
#else
    for (int p = 0; p < NPHASE; ++p) {
#if ABL_NOMIX
        if (p >= 1 && p <= 6) continue;
#endif
#if ABL_NOMOE
        if (p >= 8 && p <= 11) continue;
#endif
        a.ph_lo = p; a.ph_hi = p + 1;
        hipLaunchKernelGGL(mk_fwd, dim3(grid), dim3(NTHR), LDS_BYTES, stream, a);
    }
#endif
}
```

```cpp
#include <hip/hip_runtime.h>
#include <cstdio>
#include <cstdint>
namespace pg8 {
#define PG8_LAS __attribute__((address_space(3)))
typedef unsigned short bf16_t;
typedef short bf16x8 __attribute__((ext_vector_type(8)));
typedef float f32x4 __attribute__((ext_vector_type(4)));
typedef unsigned u32x4 __attribute__((ext_vector_type(4)));
constexpr int BM = 256, BK = 64, HALF = 128, HTB = HALF * BK * 2  , STAGE_BYTES = 8 * HTB, NXCD = 8, WGM = 4;

__host__ __device__ __forceinline__ int lds_byte(int r, int c) { const int st = (r >> 4) * 2 + (c >> 5), rr = r & 15, cc = c & 31, ob = rr * 64 + cc * 2; return st * 1024 + (ob ^ (((ob >> 9) & 1) << 5)); }
__host__ __device__ __forceinline__ void stage_rc(int b, int& R, int& C) { const int st = b / 1024, sb = b % 1024, swz = sb ^ (((sb >> 9) & 1) << 5); R = (st >> 1) * 16 + swz / 64; C = (st & 1) * 32 + (swz % 64) / 2; }
__host__ __device__ __forceinline__ int perm32(int rho) { const int n = rho >> 4, i = rho & 15; return 8 * (i >> 2) + 4 * n + (i & 3); }

struct Unit { int pm, pn, po; };
struct Gemm { const bf16_t* A; const bf16_t* Bt; int M, N, K; };

struct StaticOrder {
    static constexpr bool GATHER = false;
    int nM, nN, nwg, G, c;
    __host__ __device__ void init(int M, int N, int G_, int c_) { nM = M / BM; nN = N / BM; nwg = nM * nN; G = G_; c = c_; }
    __host__ __device__ bool next(int i, Unit& u) const {
        const long L = (long)i * G + c; if (L >= nwg) return false;
        int wgid = (int)L; { const int q = nwg / NXCD, r = nwg % NXCD, xcd = wgid % NXCD, off = wgid / NXCD; wgid = (xcd < r ? xcd * (q + 1) : r * (q + 1) + (xcd - r) * q) + off; }
        const int nig = WGM * nN, gid = wgid / nig, fm = gid * WGM, gsz = (nM - fm) < WGM ? (nM - fm) : WGM;
        u.pm = fm + ((wgid % nig) % gsz); u.pn = (wgid % nig) / gsz; u.po = u.pm; return true;
    }
    __device__ __forceinline__ void a_ready(const Unit&) const {}
    __device__ __forceinline__ void done(const Unit&) const {}
};

__device__ __forceinline__ unsigned cvt_pk_bf16(float lo, float hi) { unsigned r; asm volatile("v_cvt_pk_bf16_f32 %0, %1, %2" : "=v"(r) : "v"(lo), "v"(hi)); return r; }
typedef float f32x2 __attribute__((ext_vector_type(2)));
__device__ __forceinline__ f32x2 gelu_pk(f32x2 v) {
    const f32x2 av = __builtin_elementwise_abs(v), d = av * 0.2316418882f + 1.0f;
    f32x2 t; t.x = __builtin_amdgcn_rcpf(d.x); t.y = __builtin_amdgcn_rcpf(d.y);
    f32x2 q = t * 0.5307027145f + (-0.7265760135f); q = q * t + 0.7107068705f; q = q * t + (-0.142248368f); q = q * t + 0.127414796f; q = q * t;
    const f32x2 s = (v * v) * (-0.72134752044f);
    f32x2 e; e.x = __builtin_amdgcn_exp2f(s.x); e.y = __builtin_amdgcn_exp2f(s.y);
    const f32x2 m = v * (q * e), r = v - m;
    f32x2 o; o.x = v.x < 0.f ? m.x : r.x; o.y = v.y < 0.f ? m.y : r.y; return o;
}

template <int ACT  > struct EpiBf16 {
    static constexpr bool PERM = true, AFTER_DRAIN = false; static constexpr int MID_T = 0; static_assert(ACT == 0 || ACT == 1, "EpiBf16: ACT is 0 (none) or 1 (gelu_pk)");
    bf16_t* O; int ldc; const float* bias; int split_cols; size_t split_stride; float scale0;
    __device__ __forceinline__ void operator()(const f32x4 (&acc)[2][2][4][2], const Unit& u, int wr, int wc, int fr, int fq) const {
        const int row0 = u.pm * BM + wr * 64 + fr; int colt = u.pn * BM; bf16_t* base = O;
        float sc = 1.f; if (split_cols) { const int t = colt / split_cols; base += (size_t)t * split_stride; colt -= t * split_cols; if (t == 0) sc = scale0; }
        const int col0 = colt + wc * 32 + 8 * fq, bcol0 = u.pn * BM + wc * 32 + 8 * fq;
        f32x4 bv[2][2];
#pragma unroll
        for (int bj = 0; bj < 2; ++bj)
#pragma unroll
            for (int n = 0; n < 2; ++n) bv[bj][n] = bias ? *(const f32x4*)(bias + bcol0 + bj * HALF + 4 * n) : (f32x4){0.f, 0.f, 0.f, 0.f};
#pragma unroll
        for (int ai = 0; ai < 2; ++ai)
#pragma unroll
            for (int m = 0; m < 4; ++m) { bf16_t* rowp = base + (size_t)(row0 + ai * HALF + m * 16) * ldc + col0;
#pragma unroll
                for (int bj = 0; bj < 2; ++bj) { f32x4 v0 = acc[ai][bj][m][0] + bv[bj][0], v1 = acc[ai][bj][m][1] + bv[bj][1];
                    if (ACT == 1) { f32x2 a = gelu_pk((f32x2){v0[0], v0[1]}), b = gelu_pk((f32x2){v0[2], v0[3]}), c = gelu_pk((f32x2){v1[0], v1[1]}), d = gelu_pk((f32x2){v1[2], v1[3]});
                        v0 = (f32x4){a.x, a.y, b.x, b.y}; v1 = (f32x4){c.x, c.y, d.x, d.y}; }
                    v0 = v0 * sc; v1 = v1 * sc; u32x4 w; w.x = cvt_pk_bf16(v0[0], v0[1]); w.y = cvt_pk_bf16(v0[2], v0[3]); w.z = cvt_pk_bf16(v1[0], v1[1]); w.w = cvt_pk_bf16(v1[2], v1[3]);
                    *(u32x4*)(rowp + bj * HALF) = w; } }
    }
};
__device__ __forceinline__ float bf_lo(unsigned w) { return __uint_as_float(w << 16); }
__device__ __forceinline__ float bf_hi(unsigned w) { return __uint_as_float(w & 0xffff0000u); }
__device__ __forceinline__ float sigmf(float x) { return __builtin_amdgcn_rcpf(1.0f + __expf(-x)); }

template <int MIDT> struct EpiGate2 {
    static constexpr bool PERM = true, AFTER_DRAIN = false; static constexpr int MID_T = MIDT;
    bf16_t* O; int ldc; const unsigned char* Ga; const unsigned char* Gb; size_t gblk;
    __device__ __forceinline__ void mid(f32x4 (&acc)[2][2][4][2], const Unit& u, int wr, int wc, int fr, int fq) const {
        int row0 = u.pm * BM + wr * 64 + fr, col0 = wc * 32 + 8 * fq;
        asm volatile("" : "+v"(row0), "+v"(col0));
        const unsigned char* Gat = Ga + (size_t)u.pn * gblk; const unsigned char* Gbt = Gb + (size_t)u.pn * gblk;
        typedef int i32x2 __attribute__((ext_vector_type(2))); typedef float f32x2_ __attribute__((ext_vector_type(2)));
#pragma unroll
        for (int ai = 0; ai < 2; ++ai)
#pragma unroll
            for (int m = 0; m < 4; ++m) { const size_t row = (size_t)(row0 + ai * HALF + m * 16);
#pragma unroll
                for (int bj = 0; bj < 2; ++bj) { const int col = col0 + bj * HALF;
                    const i32x2 a = *(const i32x2*)(Gat + row * 256 + col), b = *(const i32x2*)(Gbt + row * 256 + col);
#define RAT_(x, y) ((1.0f + __expf(-(y))) * __builtin_amdgcn_rcpf(1.0f + __expf(-(x))))
                    const f32x2_ a0 = __builtin_amdgcn_cvt_pk_f32_fp8(a.x, false), a1 = __builtin_amdgcn_cvt_pk_f32_fp8(a.x, true), a2 = __builtin_amdgcn_cvt_pk_f32_fp8(a.y, false), a3 = __builtin_amdgcn_cvt_pk_f32_fp8(a.y, true);
                    const f32x2_ b0 = __builtin_amdgcn_cvt_pk_f32_fp8(b.x, false), b1 = __builtin_amdgcn_cvt_pk_f32_fp8(b.x, true), b2 = __builtin_amdgcn_cvt_pk_f32_fp8(b.y, false), b3 = __builtin_amdgcn_cvt_pk_f32_fp8(b.y, true);
                    f32x4 v0 = acc[ai][bj][m][0], v1 = acc[ai][bj][m][1];
                    v0[0] *= RAT_(a0.x, b0.x); v0[1] *= RAT_(a0.y, b0.y); v0[2] *= RAT_(a1.x, b1.x); v0[3] *= RAT_(a1.y, b1.y);
                    v1[0] *= RAT_(a2.x, b2.x); v1[1] *= RAT_(a2.y, b2.y); v1[2] *= RAT_(a3.x, b3.x); v1[3] *= RAT_(a3.y, b3.y);
#undef RAT_
                    acc[ai][bj][m][0] = v0; acc[ai][bj][m][1] = v1; }
                asm volatile("" ::: "memory"); }
    }
    __device__ __forceinline__ void operator()(const f32x4 (&acc)[2][2][4][2], const Unit& u, int wr, int wc, int fr, int fq) const {
        const int row0 = u.pm * BM + wr * 64 + fr, col0 = u.pn * BM + wc * 32 + 8 * fq;
#pragma unroll
        for (int ai = 0; ai < 2; ++ai)
#pragma unroll
            for (int m = 0; m < 4; ++m) { const size_t row = (size_t)(row0 + ai * HALF + m * 16);
#pragma unroll
                for (int bj = 0; bj < 2; ++bj) { const int col = col0 + bj * HALF;
                    typedef int i32x2 __attribute__((ext_vector_type(2))); typedef float f32x2_ __attribute__((ext_vector_type(2)));
                    const i32x2 g = *(const i32x2*)(Gb + (size_t)u.pn * gblk + row * 256 + (col - u.pn * BM));
                    const f32x2_ g0 = __builtin_amdgcn_cvt_pk_f32_fp8(g.x, false), g1 = __builtin_amdgcn_cvt_pk_f32_fp8(g.x, true), g2 = __builtin_amdgcn_cvt_pk_f32_fp8(g.y, false), g3 = __builtin_amdgcn_cvt_pk_f32_fp8(g.y, true);
                    f32x4 v0 = acc[ai][bj][m][0], v1 = acc[ai][bj][m][1];
                    v0[0] *= sigmf(g0.x); v0[1] *= sigmf(g0.y); v0[2] *= sigmf(g1.x); v0[3] *= sigmf(g1.y);
                    v1[0] *= sigmf(g2.x); v1[1] *= sigmf(g2.y); v1[2] *= sigmf(g3.x); v1[3] *= sigmf(g3.y);
                    u32x4 w; w.x = cvt_pk_bf16(v0[0], v0[1]); w.y = cvt_pk_bf16(v0[2], v0[3]); w.z = cvt_pk_bf16(v1[0], v1[1]); w.w = cvt_pk_bf16(v1[2], v1[3]);
                    *(u32x4*)(O + row * ldc + col) = w; } }
    }
};
struct EpiResid {
    static constexpr bool PERM = true, AFTER_DRAIN = false; static constexpr int MID_T = 0;
    bf16_t* O; const float* base; int ldc; const float* gvec; int gstride; int tiles_per_b;
    __device__ __forceinline__ void operator()(const f32x4 (&acc)[2][2][4][2], const Unit& u, int wr, int wc, int fr, int fq) const {
        const int row0 = u.pm * BM + wr * 64 + fr, col0 = u.pn * BM + wc * 32 + 8 * fq;
        const float* gv = gvec + (size_t)(u.pm / tiles_per_b) * gstride;
#pragma unroll
        for (int bj = 0; bj < 2; ++bj) { const int col = col0 + bj * HALF; const f32x4 g0 = *(const f32x4*)(gv + col), g1 = *(const f32x4*)(gv + col + 4);
#pragma unroll
            for (int ai = 0; ai < 2; ++ai)
#pragma unroll
                for (int m = 0; m < 4; ++m) { const size_t off = (size_t)(row0 + ai * HALF + m * 16) * ldc + col;
                    const f32x4 b0 = *(const f32x4*)(base + off), b1 = *(const f32x4*)(base + off + 4);
                    const f32x4 r0 = b0 + g0 * acc[ai][bj][m][0], r1 = b1 + g1 * acc[ai][bj][m][1];
                    typedef float f32x2_ __attribute__((ext_vector_type(2))); typedef __bf16 bf16x2_ __attribute__((ext_vector_type(2)));
                    u32x4 o;
                    o.x = __builtin_bit_cast(unsigned, __builtin_convertvector((f32x2_){r0[0], r0[1]}, bf16x2_)); o.y = __builtin_bit_cast(unsigned, __builtin_convertvector((f32x2_){r0[2], r0[3]}, bf16x2_));
                    o.z = __builtin_bit_cast(unsigned, __builtin_convertvector((f32x2_){r1[0], r1[1]}, bf16x2_)); o.w = __builtin_bit_cast(unsigned, __builtin_convertvector((f32x2_){r1[2], r1[3]}, bf16x2_));
                    *(u32x4*)(O + off) = o; } }
    }
};
struct EpiSwiglu {
    static constexpr bool PERM = true, AFTER_DRAIN = false; static constexpr int MID_T = 0;
    bf16_t* O; int lda; const float* bias; int nN;
    __device__ __forceinline__ int act4(const f32x4& v0, const f32x4& v1) const {
        f32x4 G = (f32x4){v0[0], v0[2], v1[0], v1[2]}, L = (f32x4){v0[1], v0[3], v1[1], v1[3]};
        G = __builtin_elementwise_min(G, (f32x4){7.f, 7.f, 7.f, 7.f});
        L = __builtin_elementwise_min(__builtin_elementwise_max(L, (f32x4){-7.f, -7.f, -7.f, -7.f}), (f32x4){7.f, 7.f, 7.f, 7.f}) + 1.0f;
        const f32x4 X = G * (-1.702f * 1.4426950408889634f);
        f32x4 S; S[0] = __builtin_amdgcn_exp2f(X[0]); S[1] = __builtin_amdgcn_exp2f(X[1]); S[2] = __builtin_amdgcn_exp2f(X[2]); S[3] = __builtin_amdgcn_exp2f(X[3]);
        S = S + 1.0f; S[0] = __builtin_amdgcn_rcpf(S[0]); S[1] = __builtin_amdgcn_rcpf(S[1]); S[2] = __builtin_amdgcn_rcpf(S[2]); S[3] = __builtin_amdgcn_rcpf(S[3]);
        const f32x4 A4 = G * S * L;
        int w8 = 0; w8 = __builtin_amdgcn_cvt_pk_fp8_f32(A4[0], A4[1], w8, false); w8 = __builtin_amdgcn_cvt_pk_fp8_f32(A4[2], A4[3], w8, true); return w8;
    }
    __device__ __forceinline__ void operator()(const f32x4 (&acc)[2][2][4][2], const Unit& u, int wr, int wc, int fr, int fq) const {
        const int row0 = u.po * BM + wr * 64 + fr; const int pnl = u.pn % nN;
        const int bcol0 = u.pn * BM + wc * 32 + 8 * fq; const bool odd = (fq & 1) != 0;
        const int bytecol = (pnl * BM + wc * 32 + 8 * (fq & ~1)) / 2 + (odd ? 64 : 0);
        f32x4 bv[2][2];
#pragma unroll
        for (int bj = 0; bj < 2; ++bj)
#pragma unroll
            for (int n = 0; n < 2; ++n) bv[bj][n] = *(const f32x4*)(bias + bcol0 + bj * HALF + 4 * n);
        typedef int i32x2 __attribute__((ext_vector_type(2)));
#pragma unroll
        for (int ai = 0; ai < 2; ++ai)
#pragma unroll
            for (int m = 0; m < 4; ++m) {
                const int wA = act4(acc[ai][0][m][0] + bv[0][0], acc[ai][0][m][1] + bv[0][1]), wB = act4(acc[ai][1][m][0] + bv[1][0], acc[ai][1][m][1] + bv[1][1]);
                const int recv = __shfl_xor(odd ? wA : wB, 16);
                *(i32x2*)((unsigned char*)O + (size_t)(row0 + ai * HALF + m * 16) * lda + bytecol) = odd ? (i32x2){recv, wB} : (i32x2){wA, recv}; }
    }
};
struct EpiFp8Blk {
    static constexpr bool PERM = true, AFTER_DRAIN = false; static constexpr int MID_T = 0;
    unsigned char* O; size_t blk;
    __device__ __forceinline__ void operator()(const f32x4 (&acc)[2][2][4][2], const Unit& u, int wr, int wc, int fr, int fq) const {
        const bool odd = (fq & 1) != 0;
        const int row0 = u.pm * BM + wr * 64 + fr, col0 = wc * 32 + 8 * (fq & ~1) + (odd ? HALF : 0); unsigned char* base = O + (size_t)u.pn * blk;
#pragma unroll
        for (int ai = 0; ai < 2; ++ai)
#pragma unroll
            for (int m = 0; m < 4; ++m) { unsigned char* rowp = base + (size_t)(row0 + ai * HALF + m * 16) * 256 + col0; int w[2][2];
#pragma unroll
                for (int bj = 0; bj < 2; ++bj) { const f32x4 v0 = acc[ai][bj][m][0], v1 = acc[ai][bj][m][1]; int w0 = 0, w1 = 0;
                    w0 = __builtin_amdgcn_cvt_pk_fp8_f32(v0[0], v0[1], w0, false); w0 = __builtin_amdgcn_cvt_pk_fp8_f32(v0[2], v0[3], w0, true);
                    w1 = __builtin_amdgcn_cvt_pk_fp8_f32(v1[0], v1[1], w1, false); w1 = __builtin_amdgcn_cvt_pk_fp8_f32(v1[2], v1[3], w1, true); w[bj][0] = w0; w[bj][1] = w1; }
                const int r0 = __shfl_xor(odd ? w[0][0] : w[1][0], 16), r1 = __shfl_xor(odd ? w[0][1] : w[1][1], 16);
                *(u32x4*)rowp = odd ? (u32x4){(unsigned)r0, (unsigned)r1, (unsigned)w[1][0], (unsigned)w[1][1]} : (u32x4){(unsigned)w[0][0], (unsigned)w[0][1], (unsigned)r0, (unsigned)r1}; }
    }
};
struct EpiFp8Row {
    static constexpr bool PERM = true, AFTER_DRAIN = false; static constexpr int MID_T = 0;
    unsigned char* O; int ldc; const float* bias; int nN;
    __device__ __forceinline__ void operator()(const f32x4 (&acc)[2][2][4][2], const Unit& u, int wr, int wc, int fr, int fq) const {
        const bool odd = (fq & 1) != 0;
        const int row0 = u.po * BM + wr * 64 + fr, col0 = (u.pn % nN) * BM + wc * 32 + 8 * (fq & ~1) + (odd ? HALF : 0), bcol0 = u.pn * BM + wc * 32 + 8 * fq;
        f32x4 bv[2][2];
#pragma unroll
        for (int bj = 0; bj < 2; ++bj)
#pragma unroll
            for (int n = 0; n < 2; ++n) bv[bj][n] = *(const f32x4*)(bias + bcol0 + bj * HALF + 4 * n);
#pragma unroll
        for (int ai = 0; ai < 2; ++ai)
#pragma unroll
            for (int m = 0; m < 4; ++m) { unsigned char* rowp = O + (size_t)(row0 + ai * HALF + m * 16) * ldc + col0; int w[2][2];
#pragma unroll
                for (int bj = 0; bj < 2; ++bj) { const f32x4 v0 = acc[ai][bj][m][0] + bv[bj][0], v1 = acc[ai][bj][m][1] + bv[bj][1]; int w0 = 0, w1 = 0;
                    w0 = __builtin_amdgcn_cvt_pk_fp8_f32(v0[0], v0[1], w0, false); w0 = __builtin_amdgcn_cvt_pk_fp8_f32(v0[2], v0[3], w0, true);
                    w1 = __builtin_amdgcn_cvt_pk_fp8_f32(v1[0], v1[1], w1, false); w1 = __builtin_amdgcn_cvt_pk_fp8_f32(v1[2], v1[3], w1, true); w[bj][0] = w0; w[bj][1] = w1; }
                const int r0 = __shfl_xor(odd ? w[0][0] : w[1][0], 16), r1 = __shfl_xor(odd ? w[0][1] : w[1][1], 16);
                *(u32x4*)rowp = odd ? (u32x4){(unsigned)r0, (unsigned)r1, (unsigned)w[1][0], (unsigned)w[1][1]} : (u32x4){(unsigned)w[0][0], (unsigned)w[0][1], (unsigned)r0, (unsigned)r1}; }
    }
};
struct MoeOrder {
    static constexpr bool GATHER = false;
    int ntiles, nN, G, c; const PG8_LAS int* tpm; const PG8_LAS int* te;
    __device__ bool next(int i, Unit& u) const {
        const long L = (long)i * G + c; if (L >= (long)ntiles * nN) return false;
        const int t = (int)(L / nN), pnl = (int)(L % nN);
        u.pm = tpm ? __builtin_amdgcn_readfirstlane(tpm[t]) : t; u.po = t; u.pn = __builtin_amdgcn_readfirstlane(te[t]) * nN + pnl; return true;
    }
    __device__ __forceinline__ void a_ready(const Unit&) const {}
    __device__ __forceinline__ void done(const Unit&) const {}
};
struct MoeGather : MoeOrder {
    static constexpr bool GATHER = true;
    const int* idx; PG8_LAS int* idxl; int maxrow;
};

struct SplitOrder : StaticOrder {
    int nx, ny;
    __device__ bool next(int i, Unit& u) const {
        const int half = G >> 1, grp = (c >> 3) & 1, ci = ((c >> 4) << 3) | (c & 7);
        long L; if (grp == 0) { if (i >= nx) return false; L = (long)i * half + ci; } else { if (i >= ny) return false; L = (long)nx * half + (long)i * half + ci; }
        if (L >= nwg) return false;
        int wgid = (int)L; { const int q = nwg / NXCD, r = nwg % NXCD, xcd = wgid % NXCD, off = wgid / NXCD; wgid = (xcd < r ? xcd * (q + 1) : r * (q + 1) + (xcd - r) * q) + off; }
        const int nig = WGM * nN, gid = wgid / nig, fm = gid * WGM, gsz = (nM - fm) < WGM ? (nM - fm) : WGM;
        u.pm = fm + ((wgid % nig) % gsz); u.pn = (wgid % nig) / gsz; u.po = u.pm; return true;
    }
};
typedef int v4i_ __attribute__((ext_vector_type(4))); typedef int v8i_ __attribute__((ext_vector_type(8)));
template <bool F8> struct FragT { bf16x8 h[2]; __device__ __forceinline__ void set(int k, bf16x8 v) { h[k] = v; } };
template <> struct FragT<true> { v8i_ w; __device__ __forceinline__ void set(int k, bf16x8 v) { if (k == 0) w.lo = __builtin_bit_cast(v4i_, v); else w.hi = __builtin_bit_cast(v4i_, v); } };
template <class Epi, class Sched, bool ALIGN_EPI = false, bool SP2 = false, bool F8 = false>
__device__ __forceinline__ void gemm_phase(PG8_LAS unsigned char* lds, const Gemm g, const Sched& S, const Epi& E) {
    const int tid = threadIdx.x, wid = __builtin_amdgcn_readfirstlane(tid >> 6), lane = tid & 63, wr = wid >> 2, wc = wid & 3, fr = lane & 15, fq = lane >> 4;
    const int K = g.K, nt = K / BK;
    unsigned voffA[2], voffB[2];
#pragma unroll
    for (int i = 0; i < 2; ++i) { int R, C; stage_rc(tid * 16 + i * 8192, R, C); const int Rb = Epi::PERM ? ((R & ~31) + perm32(R & 31)) : R;
        voffA[i] = (unsigned)(R * K + C) * 2u; voffB[i] = (unsigned)(Rb * K + C) * 2u; }
    constexpr bool GA = Sched::GATHER;
    unsigned gc[2][2];
    static_assert(!GA || SP2, "gather is wired into the SP2 loop only");
    auto dma_idx = [&](int slot, const Unit& u) { if constexpr (GA) { if (wid < 4) __builtin_amdgcn_global_load_lds((const unsigned*)(S.idx + (size_t)u.pm * 256 + wid * 64 + lane), (PG8_LAS unsigned*)(S.idxl + slot * 256 + wid * 64), 4, 0, 0); } };
    auto fetch_half = [&](int slot, int h, unsigned (&dst)[2]) { if constexpr (GA) {
        _Pragma("unroll") for (int i = 0; i < 2; ++i) { int R, C; stage_rc(tid * 16 + i * 8192, R, C);
            const unsigned tok = (unsigned)S.idxl[slot * 256 + h * HALF + R]; dst[i] = (tok < (unsigned)S.maxrow ? tok : (unsigned)S.maxrow) * (unsigned)(K * 2) + (unsigned)(C * 2); } } };
    const size_t kstep = (size_t)(BK * 2);
    const size_t hstep = (size_t)HALF * K * 2;
    const size_t tstep = 2 * hstep;
    const unsigned ldsw = (unsigned)wid * 1024u;
    const int aoff = lds_byte(wr * 64 + fr, fq * 8), boff = lds_byte(wc * 32 + fr, fq * 8);
#define PG8_SA(b, h) (((b) * 2 + (h)) * HTB)
#define PG8_SB(b, h) ((4 + (b) * 2 + (h)) * HTB)
#define PG8_STAGE(bufoff, gbase, voff) do { _Pragma("unroll") for (int _i = 0; _i < 2; ++_i) \
        __builtin_amdgcn_global_load_lds((const unsigned*)((const char*)(gbase) + (voff)[_i]), (PG8_LAS unsigned*)(lds + (bufoff) + ldsw + _i * 8192), 16, 0, 0); } while (0)
#define PG8_STAGE_A(bufoff, gbase, h, goff) do { if constexpr (GA) { PG8_STAGE(bufoff, gbase, goff); } else { PG8_STAGE(bufoff, (gbase) + (h) * hstep, voffA); } } while (0)
#define PG8_LDA(dst, b, h) do { _Pragma("unroll") for (int m = 0; m < 4; ++m) _Pragma("unroll") for (int k = 0; k < 2; ++k) dst[m].set(k, *(const PG8_LAS bf16x8*)(lds + PG8_SA(b, h) + aoff + m * 2048 + k * 1024)); } while (0)
#define PG8_LDB(dst, b, h) do { _Pragma("unroll") for (int n = 0; n < 2; ++n) _Pragma("unroll") for (int k = 0; k < 2; ++k) dst[n].set(k, *(const PG8_LAS bf16x8*)(lds + PG8_SB(b, h) + boff + n * 2048 + k * 1024)); } while (0)
#define PG8_MMA(ai, bj, At, Bt) do { __builtin_amdgcn_s_setprio(1); _Pragma("unroll") for (int m = 0; m < 4; ++m) _Pragma("unroll") for (int n = 0; n < 2; ++n) { \
        if constexpr (F8) { asm volatile("v_mfma_scale_f32_16x16x128_f8f6f4 %0, %1, %2, %0, %3, %4 op_sel_hi:[0,0,0]" : "+v"(acc[ai][bj][m][n]) : "v"(Bt[n].w), "v"(At[m].w), "v"(sc_w), "v"(sc_x)); \
        } else { _Pragma("unroll") for (int k = 0; k < 2; ++k) \
        acc[ai][bj][m][n] = __builtin_amdgcn_mfma_f32_16x16x32_bf16(Bt[n].h[k], At[m].h[k], acc[ai][bj][m][n], 0, 0, 0); } } __builtin_amdgcn_s_setprio(0); } while (0)
#define PG8_WAIT_V(n) asm volatile("s_waitcnt vmcnt(" #n ")" ::: "memory")
#define PG8_WAIT_L(n) asm volatile("s_waitcnt lgkmcnt(" #n ")" ::: "memory")
#define PG8_BAR __builtin_amdgcn_s_barrier()
#define PG8_SCHED __builtin_amdgcn_sched_barrier(0)
    Unit cur, nxt; int ui = 0;
    if (!S.next(0, cur)) return;
    f32x4 acc[2][2][4][2];
#pragma unroll
    for (int a = 0; a < 2; ++a)
#pragma unroll
        for (int b = 0; b < 2; ++b)
#pragma unroll
            for (int m = 0; m < 4; ++m)
#pragma unroll
                for (int n = 0; n < 2; ++n) acc[a][b][m][n] = (f32x4){0.f, 0.f, 0.f, 0.f};
    FragT<F8> At[4], B0[2], B1[2];
    int sc_w = 0x7a7a7a7a, sc_x = 0x7f7f7f7f;
    if constexpr (F8) { asm volatile("" : "+v"(sc_w), "+v"(sc_x)); }
    const char* cA = (const char*)g.A + (GA ? (size_t)0 : (size_t)cur.pm * tstep); const char* cB = (const char*)g.Bt + (size_t)cur.pn * tstep;
    S.a_ready(cur);
    if constexpr (GA) { dma_idx(0, cur); PG8_WAIT_V(0); PG8_BAR; fetch_half(0, 0, gc[0]); fetch_half(0, 1, gc[1]); }
    if constexpr (SP2) {
        PG8_STAGE(PG8_SB(0, 0), cB, voffB); PG8_STAGE(PG8_SB(0, 1), cB + hstep, voffB); PG8_STAGE_A(PG8_SA(0, 0), cA, 0, gc[0]); PG8_STAGE_A(PG8_SA(0, 1), cA, 1, gc[1]);
        if (wr == 1) PG8_BAR;
        PG8_WAIT_V(2); PG8_BAR;
        PG8_STAGE(PG8_SB(1, 0), cB + kstep, voffB); PG8_STAGE_A(PG8_SA(1, 0), cA + kstep, 0, gc[0]); PG8_STAGE(PG8_SB(1, 1), cB + hstep + kstep, voffB);
        PG8_WAIT_V(6); PG8_BAR;
    } else {
        PG8_STAGE(PG8_SB(0, 0), cB, voffB); PG8_STAGE(PG8_SA(0, 0), cA, voffA); PG8_STAGE(PG8_SB(0, 1), cB + hstep, voffB); PG8_STAGE(PG8_SA(0, 1), cA + hstep, voffA);
        if (wr == 1) PG8_BAR;
        PG8_WAIT_V(4); PG8_BAR;
        PG8_STAGE(PG8_SB(1, 0), cB + kstep, voffB); PG8_STAGE(PG8_SA(1, 0), cA + kstep, voffA); PG8_STAGE(PG8_SB(1, 1), cB + hstep + kstep, voffB);
        PG8_WAIT_V(6); PG8_BAR;
    }
    for (;;) {
        const bool has_next = S.next(ui + 1, nxt);
        const char* nA = has_next ? (const char*)g.A + (GA ? (size_t)0 : (size_t)nxt.pm * tstep) : cA;
        if constexpr (GA) { if (has_next) dma_idx((ui + 1) & 1, nxt); } const char* nB = has_next ? (const char*)g.Bt + (size_t)nxt.pn * tstep : cB;
        for (int t = 0; t < nt; t += 2) {
            if constexpr (Epi::MID_T > 0) { if (t == Epi::MID_T) { if constexpr (F8) asm volatile("s_nop 15\n\ts_nop 3" ::: "memory"); E.mid(acc, cur, wr, wc, fr, fq); if constexpr (F8) asm volatile("s_nop 7" ::: "memory"); } }
            const bool last = (t == nt - 2);
            const char* a1 = cA + (size_t)(t + 1) * kstep;
            const char* a2 = last ? nA : cA + (size_t)(t + 2) * kstep; const char* b2 = last ? nB : cB + (size_t)(t + 2) * kstep;
            const char* a3 = a2 + kstep; const char* b3 = b2 + kstep;
            if (last && has_next) S.a_ready(nxt);
            if constexpr (GA) { if (last && has_next) fetch_half((ui + 1) & 1, 0, gc[0]); }
            if constexpr (SP2) {
            PG8_LDB(B0, 0, 0); PG8_LDB(B1, 0, 1); PG8_SCHED; PG8_LDA(At, 0, 0); PG8_STAGE_A(PG8_SA(1, 1), a1, 1, gc[1]);
            if constexpr (GA) { if (last && has_next) fetch_half((ui + 1) & 1, 1, gc[1]); }
            PG8_WAIT_V(8); PG8_WAIT_L(0); PG8_BAR; PG8_MMA(0, 0, At, B0); PG8_MMA(0, 1, At, B1); PG8_BAR; PG8_SCHED;
            PG8_LDA(At, 0, 1); PG8_STAGE(PG8_SB(0, 0), b2, voffB); PG8_STAGE(PG8_SB(0, 1), b2 + hstep, voffB); PG8_STAGE_A(PG8_SA(0, 0), a2, 0, gc[0]);
            PG8_WAIT_V(8); PG8_WAIT_L(0); PG8_BAR; PG8_MMA(1, 0, At, B0); PG8_MMA(1, 1, At, B1); PG8_BAR; PG8_SCHED;
            PG8_LDB(B0, 1, 0); PG8_LDB(B1, 1, 1); PG8_SCHED; PG8_LDA(At, 1, 0); PG8_STAGE_A(PG8_SA(0, 1), a2, 1, gc[1]);
            PG8_WAIT_V(8); PG8_WAIT_L(0); PG8_BAR; PG8_MMA(0, 0, At, B0); PG8_MMA(0, 1, At, B1); PG8_BAR; PG8_SCHED;
            PG8_LDA(At, 1, 1); PG8_STAGE(PG8_SB(1, 0), b3, voffB); PG8_STAGE(PG8_SB(1, 1), b3 + hstep, voffB); PG8_STAGE_A(PG8_SA(1, 0), a3, 0, gc[0]);
            PG8_WAIT_V(8); PG8_WAIT_L(0); PG8_BAR; PG8_MMA(1, 0, At, B0); PG8_MMA(1, 1, At, B1); PG8_BAR; PG8_SCHED;
            } else {
            PG8_LDB(B0, 0, 0); PG8_SCHED; PG8_LDA(At, 0, 0); PG8_STAGE(PG8_SA(1, 1), a1 + hstep, voffA);
            PG8_WAIT_L(8); PG8_BAR; PG8_WAIT_L(0); PG8_MMA(0, 0, At, B0); PG8_BAR; PG8_SCHED;
            PG8_LDB(B1, 0, 1); PG8_STAGE(PG8_SB(0, 0), b2, voffB);
            PG8_BAR; PG8_WAIT_L(0); PG8_MMA(0, 1, At, B1); PG8_BAR;
            PG8_LDA(At, 0, 1); PG8_STAGE(PG8_SA(0, 0), a2, voffA);
            PG8_BAR; PG8_WAIT_L(0); PG8_MMA(1, 0, At, B0); PG8_BAR; PG8_SCHED;
            PG8_STAGE(PG8_SB(0, 1), b2 + hstep, voffB);
            PG8_WAIT_V(6); PG8_BAR; PG8_MMA(1, 1, At, B1); PG8_BAR;
            PG8_LDB(B0, 1, 0); PG8_SCHED; PG8_LDA(At, 1, 0); PG8_STAGE(PG8_SA(0, 1), a2 + hstep, voffA);
            PG8_WAIT_L(8); PG8_BAR; PG8_WAIT_L(0); PG8_MMA(0, 0, At, B0); PG8_BAR; PG8_SCHED;
            PG8_LDB(B1, 1, 1); PG8_STAGE(PG8_SB(1, 0), b3, voffB);
            PG8_BAR; PG8_WAIT_L(0); PG8_MMA(0, 1, At, B1); PG8_BAR;
            PG8_LDA(At, 1, 1); PG8_STAGE(PG8_SA(1, 0), a3, voffA);
            PG8_BAR; PG8_WAIT_L(0); PG8_MMA(1, 0, At, B0); PG8_BAR; PG8_SCHED;
            PG8_STAGE(PG8_SB(1, 1), b3 + hstep, voffB);
            PG8_WAIT_V(6); PG8_BAR; PG8_MMA(1, 1, At, B1); PG8_BAR;
            }
        }
        if constexpr (F8) { asm volatile("s_nop 15\n\ts_nop 3" ::: "memory"); }
        if constexpr (ALIGN_EPI) { if (wr == 0) PG8_BAR; }
        if constexpr (!Epi::AFTER_DRAIN) { E(acc, cur, wr, wc, fr, fq); S.done(cur); }
        if (!has_next) break;
#pragma unroll
        for (int a = 0; a < 2; ++a)
#pragma unroll
            for (int b = 0; b < 2; ++b)
#pragma unroll
                for (int m = 0; m < 4; ++m)
#pragma unroll
                    for (int n = 0; n < 2; ++n) acc[a][b][m][n] = (f32x4){0.f, 0.f, 0.f, 0.f};
        cur = nxt; cA = nA; cB = nB; ++ui;
        if constexpr (ALIGN_EPI) { if (wr == 1) PG8_BAR; }
    }
    PG8_WAIT_V(0);
    if constexpr (!ALIGN_EPI) { if (wr == 0) PG8_BAR; }
    PG8_BAR;
    if constexpr (Epi::AFTER_DRAIN) { E.fused(acc, cur, wr, wc, fr, fq, lds, wid, lane); S.done(cur); }
#undef PG8_SA
#undef PG8_SB
#undef PG8_STAGE
#undef PG8_STAGE_A
#undef PG8_LDA
#undef PG8_LDB
#undef PG8_MMA
#undef PG8_WAIT_V
#undef PG8_WAIT_L
#undef PG8_BAR
#undef PG8_SCHED
}
}
#define GAS __attribute__((address_space(1)))
#define LAS __attribute__((address_space(3)))
typedef unsigned short bf16;
typedef unsigned v4u __attribute__((ext_vector_type(4)));
typedef float f32x4 __attribute__((ext_vector_type(4)));
typedef short bf16x8 __attribute__((ext_vector_type(8)));
typedef GAS unsigned gu32;
typedef GAS unsigned long long gu64;
#define RLX_AGENT __ATOMIC_RELAXED, __HIP_MEMORY_SCOPE_AGENT
#define LDS_WAIT() asm volatile("s_waitcnt lgkmcnt(0)" ::: "memory")
#define VM_WAIT() asm volatile("s_waitcnt vmcnt(0)" ::: "memory")
__device__ __forceinline__ unsigned long long rt() { return __builtin_amdgcn_s_memrealtime(); }
__device__ __forceinline__ unsigned f2bf(float f) { unsigned u = __builtin_bit_cast(unsigned, f); return (u + 0x7fffu + ((u >> 16) & 1u)) >> 16; }
__device__ __forceinline__ unsigned pk2(float lo, float hi) { return f2bf(lo) | (f2bf(hi) << 16); }

#define XB_TMO      128
#define XB_XCNT(j)  (256  + 64 * (j))
#define XB_XSUB(j)  (1280 + 64 * (j))
#define XB_XGEN(j)  (2304 + 64 * (j))
#define XB_TOP      3328
#define XB_TOPGEN   3392
#define XCD_BAR_WORDS 3456
#define XB_SPIN_CAP (1u << 18)

__device__ __forceinline__ unsigned xb_ld(unsigned* p)              { return __hip_atomic_load(p, __ATOMIC_RELAXED, __HIP_MEMORY_SCOPE_AGENT); }
__device__ __forceinline__ unsigned xb_add(unsigned* p, unsigned v) { return __hip_atomic_fetch_add(p, v, __ATOMIC_RELAXED, __HIP_MEMORY_SCOPE_AGENT); }
__device__ __forceinline__ unsigned xb_xcc_id() { return (unsigned)__builtin_amdgcn_s_getreg((3 << 11) | 20) & 0xFu; }
#define XB_SPIN(cond, bar) do { unsigned _sp = 0; while (cond) { __builtin_amdgcn_s_sleep(1); \
    if ((++_sp & 255u) == 0u) { if (xb_ld(&(bar)[XB_TMO])) break; if (_sp > XB_SPIN_CAP) { atomicAdd(&(bar)[XB_TMO], 1u); break; } } } } while (0)

struct XcdBarrier {
    unsigned* bar; unsigned x;
    volatile LAS unsigned* st;
};

__device__ __forceinline__ XcdBarrier xcd_barrier_post(unsigned* bar, volatile LAS unsigned* st) {
    XcdBarrier b; b.bar = bar; b.x = xb_xcc_id(); b.st = st;
    if (threadIdx.x == 0) (void)xb_add(&bar[XB_XCNT(b.x)], 1u);
    return b;
}
__device__ __forceinline__ void xcd_barrier_complete(unsigned* bar, unsigned x, unsigned& nloc, unsigned& nx) {
    const unsigned G = gridDim.x * gridDim.y * gridDim.z;
    unsigned sum, cnt, mine, sp = 0u;
    for (;;) {
        sum = 0u; cnt = 0u; mine = 0u;
#pragma unroll
        for (unsigned j = 0; j < 16; ++j) { const unsigned c = xb_ld(&bar[XB_XCNT(j)]); sum += c; cnt += (c > 0u) ? 1u : 0u; mine = (j == x) ? c : mine; }
        if (sum == G) break;
        __builtin_amdgcn_s_sleep(1);
        if ((++sp & 255u) == 0u) { if (xb_ld(&bar[XB_TMO])) break; if (sp > XB_SPIN_CAP) { atomicAdd(&bar[XB_TMO], 1u); break; } }
    }
    nloc = mine > 0u ? mine : 1u; nx = cnt > 0u ? cnt : 1u;
}

__device__ __forceinline__ void xcd_barrier(const XcdBarrier& b) {
    asm volatile("s_waitcnt vmcnt(0)" ::: "memory");
    __syncthreads();
    if (threadIdx.x == 0) {
        unsigned* bar = b.bar;
        __builtin_amdgcn_s_waitcnt(0);
        unsigned nloc = b.st[0], nx = b.st[1];
        if (nloc == 0u) { xcd_barrier_complete(bar, b.x, nloc, nx); b.st[0] = nloc; b.st[1] = nx; }
        const unsigned old = xb_add(&bar[XB_XSUB(b.x)], 1u);
        const unsigned gen = old / nloc;
        if (old + 1u == (gen + 1u) * nloc) {
            __builtin_amdgcn_fence(__ATOMIC_RELEASE, "agent");
            asm volatile("s_waitcnt vmcnt(0)" ::: "memory");
            const unsigned og = xb_add(&bar[XB_TOP], 1u);
            const unsigned tg = og / nx;
            if (og + 1u == (tg + 1u) * nx) xb_add(&bar[XB_TOPGEN], 1u);
            else XB_SPIN(xb_ld(&bar[XB_TOPGEN]) == tg, bar);
            __builtin_amdgcn_fence(__ATOMIC_ACQUIRE, "agent");
            xb_add(&bar[XB_XGEN(b.x)], 1u);
            asm volatile("s_waitcnt vmcnt(0)" ::: "memory");
        } else {
            XB_SPIN(xb_ld(&bar[XB_XGEN(b.x)]) == gen, bar);
            __builtin_amdgcn_fence(__ATOMIC_ACQUIRE, "agent");
            asm volatile("s_waitcnt vmcnt(0)" ::: "memory");
        }
    }
    __syncthreads();
}

constexpr int NWAVES = 8, NTHR = 512;
constexpr int BATCH = 4, SEQ = 4096, DM = 1024, TOK = BATCH * SEQ;
constexpr int INW = 9728;
constexpr int C_RQ = 0, C_RK = 512, C_RV = 1024, C_RG = 2048, C_AQ = 3072, C_AK = 4608, C_AV = 6144, C_GA = 7680, C_GB = 8704;
constexpr int NEXP = 32, FF = 1024, FF2 = 2048;
constexpr int MAXROWS = TOK * 4 + NEXP * 256;
constexpr float RMS_EPS = 1e-6f, GN_EPS = 1e-5f;
constexpr size_t MiB = 1u << 20;
constexpr size_t WS_CTL = 0, CTL_ZERO_BYTES = 32 * 1024;
constexpr size_t WS_ROPE = 1 * MiB;
constexpr size_t WS_WRT = 3 * MiB;
constexpr int N16 = 3072;
constexpr size_t WS_WIN8 = 12 * MiB;
constexpr size_t WS_WIN = 4 * MiB, WS_WRET = 24 * MiB  , WS_WO = 27 * MiB;
constexpr size_t WS_W1 = 32 * MiB, WS_W2 = 160 * MiB;
constexpr size_t WS_H8 = 208 * MiB;
constexpr size_t WS_H = 224 * MiB;
constexpr size_t WS_U = 256 * MiB;
constexpr size_t WS_KV = 560 * MiB;
constexpr size_t WS_RT = 624 * MiB;
constexpr size_t WS_RET = 656 * MiB;
constexpr int RA_LD = 1536;
constexpr size_t WS_OG = 704 * MiB;
constexpr size_t WS_LSE = 752 * MiB;
constexpr size_t WS_MERGED = 753 * MiB;
constexpr size_t WS_XMID = 849 * MiB;
constexpr size_t WS_H2 = 256 * MiB;
constexpr int XCAP = 16384;
constexpr size_t WS_A = 768 * MiB;
constexpr size_t WS_YB = 913 * MiB;
constexpr size_t WS_TE = 1000 * MiB, WS_TP = WS_TE + 256 * 1024, WS_TG = WS_TP + 256 * 1024;
constexpr size_t WS_IDX = 1002 * MiB;
constexpr size_t WS_END = 1004 * MiB;
static_assert(WS_H2 + (size_t)TOK * DM <= WS_A && WS_A + (size_t)MAXROWS * 1024 <= WS_XMID && WS_XMID + (size_t)TOK * DM * 4 <= WS_YB && WS_YB + (size_t)MAXROWS * 1024 <= WS_TE, "MoE map");
constexpr int CW_BAR = 4096;
constexpr int CW_MOD = 8192;
constexpr int CW_CNT = 7680;
constexpr int CW_MODRDY = 7744;
static_assert(CW_BAR + 3456 <= CW_CNT && (CW_MODRDY + 64) * 4 <= (int)CTL_ZERO_BYTES && CW_MODRDY + 64 <= CW_MOD, "ctl");
constexpr int LDS_BYTES = 160 * 1024 - 512, MISC_OFF = LDS_BYTES - 256;

__device__ __forceinline__ float bflo(unsigned w) { return __uint_as_float(w << 16); }
__device__ __forceinline__ float bfhi(unsigned w) { return __uint_as_float(w & 0xffff0000u); }
typedef float f32x2_t_ __attribute__((ext_vector_type(2))); typedef __bf16 bf16x2_t_ __attribute__((ext_vector_type(2)));
__device__ __forceinline__ unsigned cvtpk(float lo, float hi) { const f32x2_t_ v = {lo, hi}; const bf16x2_t_ b = __builtin_convertvector(v, bf16x2_t_); return __builtin_bit_cast(unsigned, b); }
__device__ __forceinline__ unsigned f8x2bf(unsigned w, bool hi) { typedef float f32x2_ __attribute__((ext_vector_type(2))); const f32x2_ f = hi ? __builtin_amdgcn_cvt_pk_f32_fp8((int)w, true) : __builtin_amdgcn_cvt_pk_f32_fp8((int)w, false); return cvtpk(f.x, f.y); }
__device__ __forceinline__ float wave_sum(float v) {
#pragma unroll
    for (int o = 1; o < 64; o <<= 1) v += __shfl_xor(v, o);
    return v;
}
static __device__ const double ROPE_C[64] = {0.15915494309189535, 0.13782250260398285, 0.11934937021124886, 0.10335229661843406, 0.089499401608891013, 0.077503288755374058, 0.067115083005227255, 0.058119267441876246, 0.050329212104487035, 0.04358330210530733, 0.037741584717419771, 0.032682865872356998, 0.028302195830623399, 0.024508691862069852, 0.02122365276477766, 0.018378926105679667, 0.015915494309189534, 0.013782250260398284, 0.011934937021124886, 0.010335229661843406, 0.0089499401608891024, 0.0077503288755374055, 0.0067115083005227253, 0.0058119267441876241, 0.0050329212104487037, 0.0043583302105307331, 0.0037741584717419772, 0.0032682865872356993, 0.0028302195830623399, 0.0024508691862069852, 0.0021223652764777662, 0.0018378926105679667, 0.0015915494309189536, 0.0013782250260398288, 0.0011934937021124885, 0.0010335229661843405, 0.00089499401608891024, 0.00077503288755374051, 0.0006711508300522726, 0.00058119267441876239, 0.00050329212104487033, 0.00043583302105307329, 0.00037741584717419774, 0.00032682865872356992, 0.00028302195830623395, 0.00024508691862069854, 0.00021223652764777661, 0.00018378926105679666, 0.00015915494309189535, 0.00013782250260398286, 0.00011934937021124886, 0.00010335229661843406, 8.9499401608891018e-05, 7.7503288755374056e-05, 6.7115083005227254e-05, 5.8119267441876239e-05, 5.0329212104487035e-05, 4.3583302105307322e-05, 3.7741584717419777e-05, 3.2682865872356999e-05, 2.8302195830623396e-05, 2.4508691862069852e-05, 2.1223652764777659e-05, 1.8378926105679668e-05};
__device__ __forceinline__ float log2g(int h) { return h == 0 ? -0.0458036896f : (h == 1 ? -0.0227200765f : (h == 2 ? -0.0113153132f : -0.00564656314f)); }

constexpr size_t UBLK = (size_t)TOK * 256; constexpr int ULD = 256;
__device__ __forceinline__ const bf16* ucol(const unsigned char* ws, int col) { return (const bf16*)(ws + WS_U) + (size_t)(col >> 8) * UBLK + (col & 255); }
__device__ __forceinline__ const unsigned char* ucol8(const unsigned char* ws, int col) { return ws + WS_U + (size_t)(N16 / 256) * UBLK * 2 + (size_t)((col >> 8) - N16 / 256) * UBLK + (col & 255); }
typedef short v4i16_t __attribute__((ext_vector_type(4)));
struct Args { const float* in[18]; float* out; unsigned char* ws; int ph_lo, ph_hi; };
struct Frame { LAS unsigned char* lds; volatile LAS unsigned* MISC; gu32* ctl; int tid, lane, wave, vcu, G; };

template <bool F8, int NB = 32>
__device__ __forceinline__ void p0_transpose_item(const float* W, int K, int N, bf16* WT, LAS float* scr, int item, int lane, int ldk = 0) {
    if (ldk == 0) ldk = K;
    const int nblk = N / 32, kb = item / nblk, nb = item % nblk, k0 = 64 * kb, n0 = 32 * nb;
#pragma unroll
    for (int hb = 0; hb < 32 / NB; ++hb) { float t[NB];
      const float* wp = W + (size_t)(k0 + 2 * NB * hb + (lane >> 5)) * N + n0 + (lane & 31);
#pragma unroll
      for (int i = 0; i < NB; ++i) t[i] = __builtin_nontemporal_load(wp + (size_t)(2 * i) * N);
#pragma unroll
      for (int i = 0; i < NB; ++i) scr[(2 * (NB * hb + i) + (lane >> 5)) * 33 + (lane & 31)] = t[i]; }
    LDS_WAIT(); asm volatile("" ::: "memory");
    const int c = lane & 7;
#pragma unroll
    for (int j = 0; j < 4; ++j) { const int n = (lane >> 3) + 8 * j; const LAS float* s = scr + (8 * c) * 33 + n;
        if (F8) { int w0 = 0, w1 = 0;
            w0 = __builtin_amdgcn_cvt_pk_fp8_f32(s[0 * 33] * 32.f, s[1 * 33] * 32.f, w0, false); w0 = __builtin_amdgcn_cvt_pk_fp8_f32(s[2 * 33] * 32.f, s[3 * 33] * 32.f, w0, true);
            w1 = __builtin_amdgcn_cvt_pk_fp8_f32(s[4 * 33] * 32.f, s[5 * 33] * 32.f, w1, false); w1 = __builtin_amdgcn_cvt_pk_fp8_f32(s[6 * 33] * 32.f, s[7 * 33] * 32.f, w1, true);
            typedef int i32x2 __attribute__((ext_vector_type(2)));
            *(GAS i32x2*)((unsigned char*)WT + (size_t)(n0 + n) * ldk + k0 + 8 * c) = (i32x2){w0, w1};
        } else { v4u o; o.x = pk2(s[0 * 33], s[1 * 33]); o.y = pk2(s[2 * 33], s[3 * 33]); o.z = pk2(s[4 * 33], s[5 * 33]); o.w = pk2(s[6 * 33], s[7 * 33]);
            *(GAS v4u*)(WT + (size_t)(n0 + n) * ldk + k0 + 8 * c) = o; } }
    LDS_WAIT(); asm volatile("" ::: "memory");
}
__device__ __forceinline__ void p0_prologue(const Args& a, Frame& F) {
    const int gw = F.vcu * NWAVES + F.wave, NGW = F.G * NWAVES;
    { float2* rope = (float2*)(a.ws + WS_ROPE);
      for (int idx = F.vcu * NTHR + F.tid; idx < SEQ * 64; idx += F.G * NTHR) { const int pos = idx >> 6, i = idx & 63;
          double rev = (double)pos * ROPE_C[i]; rev -= __builtin_floor(rev); const float f = (float)rev;
          rope[idx] = make_float2(__builtin_amdgcn_cosf(f), __builtin_amdgcn_sinf(f)); } }
    { bf16* wrt = (bf16*)(a.ws + WS_WRT); const float* wr = a.in[11];
      for (int idx = F.vcu * NTHR + F.tid; idx < 1024 * 32; idx += F.G * NTHR) { const int k = idx >> 5, e = idx & 31; const float w = wr[idx];
          const unsigned hi = f2bf(w); const float lo = w - __uint_as_float(hi << 16); wrt[e * 1024 + k] = (bf16)hi; wrt[32768 + e * 1024 + k] = (bf16)f2bf(lo); } }
    if (F.vcu < 96) { float* mod = (float*)(a.ws + WS_CTL) + CW_MOD; const float* c = a.in[1]; const float* w_ada = a.in[2]; const float* b_ada = a.in[3];
      const int cg = F.vcu, col = cg * 64 + F.lane; LAS float* red = (LAS float*)(F.lds + 8 * 16384);
      float acc[4] = {0.f, 0.f, 0.f, 0.f};
      for (int kc = 0; kc < 2; ++kc) { const int k0 = F.wave * 128 + kc * 64; float cs[4];
#pragma unroll
          for (int b = 0; b < 4; ++b) { const float cv = c[b * DM + k0 + F.lane]; cs[b] = cv / (1.0f + __expf(-cv)); }
#pragma unroll 16
          for (int kk = 0; kk < 64; ++kk) { const float w = w_ada[(size_t)(k0 + kk) * 6144 + col];
#pragma unroll
              for (int b = 0; b < 4; ++b) acc[b] += __shfl(cs[b], kk) * w; } }
#pragma unroll
      for (int b = 0; b < 4; ++b) red[(F.wave * 4 + b) * 64 + F.lane] = acc[b];
      __syncthreads();
      if (F.tid < 256) { const int b = F.tid >> 6, ln = F.tid & 63; float s = b_ada[cg * 64 + ln];
#pragma unroll
          for (int w = 0; w < 8; ++w) s += red[(w * 4 + b) * 64 + ln];
          mod[b * 6144 + cg * 64 + ln] = s; }
      asm volatile("s_waitcnt vmcnt(0)" ::: "memory"); __syncthreads();
      if (F.tid == 0) { __builtin_amdgcn_fence(__ATOMIC_RELEASE, "agent"); asm volatile("s_waitcnt vmcnt(0)" ::: "memory"); __hip_atomic_fetch_add(F.ctl + CW_MODRDY, 1u, RLX_AGENT); } }
    { LAS float* scr = (LAS float*)(F.lds + F.wave * 16384);
      constexpr int I_IN = 16 * (INW / 32), I_RET = 16 * 32, I_ATT = 8 * 32, I_O = 16 * 32, I_1E = 16 * 64, I_2E = 16 * 32;
      constexpr int NITEMS = I_IN + I_RET + I_ATT + I_O;
      if (F.vcu >= 96 || F.G <= 96)
      for (int it = (F.G > 96 ? gw - 96 * NWAVES : gw); it < NITEMS; it += (F.G > 96 ? NGW - 96 * NWAVES : NGW)) { int r = it;
          if (r < I_IN) { const int nb = r % (INW / 32);
              if (nb < N16 / 32) p0_transpose_item<false>(a.in[5], 1024, INW, (bf16*)(a.ws + WS_WIN), scr, r, F.lane);
              else p0_transpose_item<true>(a.in[5], 1024, INW, (bf16*)(a.ws + WS_WIN8 - (size_t)N16 * 1024), scr, r, F.lane);
              continue; } r -= I_IN;
          if (r < I_RET) { p0_transpose_item<true>(a.in[7], 1024, 1024, (bf16*)(a.ws + WS_WRET), scr, r, F.lane, RA_LD); continue; } r -= I_RET;
          if (r < I_ATT) { p0_transpose_item<true>(a.in[8], 512, 1024, (bf16*)(a.ws + WS_WRET + 1024), scr, r, F.lane, RA_LD); continue; } r -= I_ATT;
          p0_transpose_item<false>(a.in[9], 1024, 1024, (bf16*)(a.ws + WS_WO), scr, r, F.lane); } }
}
__device__ __forceinline__ void moe_item8(const float* W, int N, unsigned char* WT8, LAS bf16* scr, int item, int lane) {
    const int nblk = N / 32, kb = item / nblk, nb = item % nblk, k0 = 128 * kb, n0 = 32 * nb, rr = lane >> 3, cq = lane & 7;
    typedef unsigned u32x2 __attribute__((ext_vector_type(2)));
    f32x4 t[16];
    { const float* wp = W + (size_t)(k0 + rr) * N + n0 + 4 * cq;
#pragma unroll
      for (int i = 0; i < 16; ++i) t[i] = __builtin_nontemporal_load((const GAS f32x4*)(wp + (size_t)(8 * i) * N)); }
#pragma unroll
    for (int i = 0; i < 16; ++i) *(LAS u32x2*)(scr + (8 * i + rr) * 40 + 4 * cq) = (u32x2){cvtpk(t[i].x, t[i].y), cvtpk(t[i].z, t[i].w)};
    LDS_WAIT(); asm volatile("" ::: "memory");
    const int g = lane >> 4, i15 = lane & 15, qq = i15 >> 2, p = i15 & 3;
#pragma unroll
    for (int c0 = 0; c0 < 32; c0 += 16)
#pragma unroll
        for (int kh = 0; kh < 2; ++kh) { const LAS bf16* a0 = scr + (64 * kh + 16 * g + qq) * 40 + c0 + 4 * p; v4u o;
#pragma unroll
            for (int sb = 0; sb < 4; ++sb) { const v4i16_t v = __builtin_amdgcn_ds_read_tr16_b64_v4i16((LAS v4i16_t*)(a0 + 4 * sb * 40)); const u32x2 w2 = __builtin_bit_cast(u32x2, v);
                int w8 = 0; w8 = __builtin_amdgcn_cvt_pk_fp8_f32(bflo(w2.x) * 32.f, bfhi(w2.x) * 32.f, w8, false); w8 = __builtin_amdgcn_cvt_pk_fp8_f32(bflo(w2.y) * 32.f, bfhi(w2.y) * 32.f, w8, true);
                if (sb == 0) o.x = (unsigned)w8; else if (sb == 1) o.y = (unsigned)w8; else if (sb == 2) o.z = (unsigned)w8; else o.w = (unsigned)w8; }
            *(GAS v4u*)(WT8 + (size_t)(n0 + c0 + i15) * 1024 + k0 + 64 * kh + 16 * g) = o; }
    LDS_WAIT(); asm volatile("" ::: "memory");
}
__device__ __forceinline__ void moe_convert(const Args& a, Frame& F, int k0, int nk) {
    LAS bf16* scr = (LAS bf16*)(F.lds + F.wave * 16384); const int gw = F.vcu * NWAVES + F.wave, NGW = F.G * NWAVES;
    constexpr int I_1E = 8 * 64, I_2E = 8 * 32;
    for (int k = k0; k < k0 + nk; ++k) { int r = gw + NGW * k;
        if (r < NEXP * I_1E) { const int e = r / I_1E; moe_item8(a.in[13] + (size_t)e * 1024 * FF2, FF2, a.ws + WS_W1 + (size_t)e * FF2 * 1024, scr, r % I_1E, F.lane); continue; } r -= NEXP * I_1E;
        if (r < NEXP * I_2E) { const int e = r / I_2E; moe_item8(a.in[15] + (size_t)e * FF * 1024, 1024, a.ws + WS_W2 + (size_t)e * 1024 * FF, scr, r % I_2E, F.lane); } }
}
__device__ __forceinline__ void norm_mod_row(const float* xrow, const float* g, const float* sc, const float* sh, bf16* orow, unsigned char* orow8, int lane) {
    const GAS f32x4* xr = (const GAS f32x4*)xrow + lane; f32x4 v[4]; float s = 0.f;
#pragma unroll
    for (int j = 0; j < 4; ++j) { v[j] = __builtin_nontemporal_load(xr + 64 * j); s += (v[j].x * v[j].x + v[j].y * v[j].y) + (v[j].z * v[j].z + v[j].w * v[j].w); }
    const float rstd = 1.0f / sqrtf(wave_sum(s) * (1.0f / DM) + RMS_EPS);
    GAS int* o4 = (GAS int*)orow8 + lane; GAS unsigned long long* o8 = (GAS unsigned long long*)orow + lane;
#pragma unroll
    for (int j = 0; j < 4; ++j) { const int c = 4 * (64 * j + lane); const f32x4 gg = *(const f32x4*)(g + c), ss = *(const f32x4*)(sc + c), hh = *(const f32x4*)(sh + c);
        const f32x4 o = v[j] * rstd * gg * (ss + 1.0f) + hh;
        int w8 = 0; w8 = __builtin_amdgcn_cvt_pk_fp8_f32(o.x, o.y, w8, false); w8 = __builtin_amdgcn_cvt_pk_fp8_f32(o.z, o.w, w8, true);
        o4[64 * j] = w8; o8[64 * j] = (unsigned long long)cvtpk(o.x, o.y) | ((unsigned long long)cvtpk(o.z, o.w) << 32); }
}
__device__ __forceinline__ void p1_norm1(const Args& a, Frame& F) {
    const int gw = F.vcu * NWAVES + F.wave, NGW = F.G * NWAVES, lane = F.lane; const float* mod = (const float*)(a.ws + WS_CTL) + CW_MOD;
    bool waited = false;
    for (int m0 = gw; m0 < TOK; m0 += 4 * NGW) {
        f32x4 v[4][4]; float rstd[4];
#pragma unroll
        for (int r = 0; r < 4; ++r) { const int m = m0 + r * NGW; const GAS f32x4* xr = (const GAS f32x4*)(a.in[0] + (size_t)(m < TOK ? m : m0) * DM) + lane;
#pragma unroll
            for (int j = 0; j < 4; ++j) v[r][j] = __builtin_nontemporal_load(xr + 64 * j); }
#pragma unroll
        for (int r = 0; r < 4; ++r) { float s = 0.f;
#pragma unroll
            for (int j = 0; j < 4; ++j) s += (v[r][j].x * v[r][j].x + v[r][j].y * v[r][j].y) + (v[r][j].z * v[r][j].z + v[r][j].w * v[r][j].w);
            rstd[r] = 1.0f / sqrtf(wave_sum(s) * (1.0f / DM) + RMS_EPS); }
        if (!waited) { waited = true;
            if (F.tid == 0) { unsigned sp = 0;
                while (__hip_atomic_load(F.ctl + CW_MODRDY, RLX_AGENT) < 96u && ++sp < (1u << 22)) __builtin_amdgcn_s_sleep(2);
                __builtin_amdgcn_fence(__ATOMIC_ACQUIRE, "agent"); asm volatile("s_waitcnt vmcnt(0)" ::: "memory"); }
            __syncthreads(); }
#pragma unroll
        for (int r = 0; r < 4; ++r) { const int m = m0 + r * NGW; if (m < TOK) { const int b = m / SEQ; const float* g = a.in[4]; const float* sc = mod + b * 6144 + 1024; const float* sh = mod + b * 6144;
            GAS int* o4 = (GAS int*)(a.ws + WS_H8 + (size_t)m * DM) + lane; GAS unsigned long long* o8 = (GAS unsigned long long*)((bf16*)(a.ws + WS_H) + (size_t)m * DM) + lane;
#pragma unroll
            for (int j = 0; j < 4; ++j) { const int c = 4 * (64 * j + lane); const f32x4 gg = *(const f32x4*)(g + c), ss = *(const f32x4*)(sc + c), hh = *(const f32x4*)(sh + c);
                const f32x4 o = v[r][j] * rstd[r] * gg * (ss + 1.0f) + hh;
                int w8 = 0; w8 = __builtin_amdgcn_cvt_pk_fp8_f32(o.x, o.y, w8, false); w8 = __builtin_amdgcn_cvt_pk_fp8_f32(o.z, o.w, w8, true);
                o4[64 * j] = w8; o8[64 * j] = (unsigned long long)cvtpk(o.x, o.y) | ((unsigned long long)cvtpk(o.z, o.w) << 32); } } }
    }
    if (!waited) { __syncthreads(); }
}

#define MFMA16(a, b, c) __builtin_amdgcn_mfma_f32_16x16x32_bf16((a), (b), (c), 0, 0, 0)
__device__ __forceinline__ bf16x8 ldsfrag(const LAS bf16* base, int pitch, int row0, int k0, int lane) { return *(const LAS bf16x8*)(base + (row0 + (lane & 15)) * pitch + k0 + 8 * (lane >> 4)); }

__device__ __forceinline__ bf16x8 ldsfrag_tr(const LAS bf16* M, int pitch, int k0, int c0, int lane) {
    const int g = lane >> 4, i = lane & 15, qq = i >> 2, p = i & 3;
    const LAS bf16* a0 = M + (k0 + 8 * g + qq) * pitch + c0 + 4 * p;
    const v4i16_t lo = __builtin_amdgcn_ds_read_tr16_b64_v4i16((LAS v4i16_t*)a0), hi = __builtin_amdgcn_ds_read_tr16_b64_v4i16((LAS v4i16_t*)(a0 + 4 * pitch));
    return (bf16x8){lo[0], lo[1], lo[2], lo[3], hi[0], hi[1], hi[2], hi[3]};
}
constexpr int AT_KP = 136, AT_PP = 168;
constexpr int AT_KS = 0, AT_VS = 256 * AT_KP * 2, AT_BIAS = AT_VS + 272 * AT_KP * 2;
struct AttnU { const unsigned char *Qb, *Kb, *Vb; size_t rstride; int i0, r, g, hh; size_t tok0; };
__device__ __forceinline__ AttnU attn_decode(const Args& a, int U) {
    AttnU u; const int ub = U & 31; u.hh = (U >> 5) & 3; u.g = (U >> 7) % 3; const int b = U / 384;
    const int rs = 2 * u.g; u.r = 1 << rs; const int ares = ub & (u.r - 1), blk = ub >> rs; u.i0 = blk * 128;
    u.tok0 = (size_t)(b * SEQ + ares); u.rstride = (size_t)u.r * ULD; const int hc = (u.g * 4 + u.hh) * 128;
    u.Qb = ucol8(a.ws, C_AQ + hc) + u.tok0 * ULD; u.Kb = ucol8(a.ws, C_AK + hc) + u.tok0 * ULD; u.Vb = ucol8(a.ws, C_AV + hc) + u.tok0 * ULD;
    return u;
}
__device__ __forceinline__ void attn_phase(const Args& a, Frame& F) {
    LAS bf16* KS = (LAS bf16*)(F.lds + AT_KS); LAS bf16* VS = (LAS bf16*)(F.lds + AT_VS); LAS float* BIAS = (LAS float*)(F.lds + AT_BIAS);
    const int tid = F.tid, lane = F.lane, w = F.wave, q = lane >> 4, l15 = lane & 15;
    typedef unsigned u32x2 __attribute__((ext_vector_type(2)));
    int U = F.vcu; if (U >= 1536) return;
    v4u kreg[4], vreg[4];
    { const AttnU u = attn_decode(a, U);
#pragma unroll
      for (int it = 0; it < 4; ++it) { const int c = tid + NTHR * it, kk = c >> 3, ch = c & 7; int i = u.i0 - 128 + kk; i = i < 0 ? 0 : i;
          const size_t ro = (size_t)i * u.rstride + ch * 16; kreg[it] = *(const GAS v4u*)(u.Kb + ro); vreg[it] = *(const GAS v4u*)(u.Vb + ro); }
    }
    if (tid < 256) { LAS v4u* z = (LAS v4u*)(VS + (256 + (tid >> 4)) * AT_KP + (tid & 15) * 8); z[0] = (v4u){0u, 0u, 0u, 0u}; }
    const bool bg_pre = (F.vcu & 1) != 0; int slot = 0;
    for (; U < 1536; U += F.G, ++slot) {
        if (bg_pre) { moe_convert(a, F, 2 * slot, 2); __syncthreads(); }
        const AttnU u = attn_decode(a, U);
        bf16x8 qf[4];
        { const unsigned char* qrow = u.Qb + (size_t)(u.i0 + 16 * w + l15) * u.rstride + 8 * q; typedef unsigned u32x2q __attribute__((ext_vector_type(2)));
          u32x2q qb[4];
#pragma unroll
          for (int ks = 0; ks < 4; ++ks) qb[ks] = *(const GAS u32x2q*)(qrow + 32 * ks);
#pragma unroll
          for (int ks = 0; ks < 4; ++ks) qf[ks] = __builtin_bit_cast(bf16x8, (v4u){f8x2bf(qb[ks].x, false), f8x2bf(qb[ks].x, true), f8x2bf(qb[ks].y, false), f8x2bf(qb[ks].y, true)}); }
#pragma unroll
        for (int it = 0; it < 4; ++it) { const int c = tid + NTHR * it, kk = c >> 3, ch = c & 7; const bool ok = (u.i0 - 128 + kk) >= 0;
            const v4u kz = ok ? kreg[it] : (v4u){0u, 0u, 0u, 0u}, vz = ok ? vreg[it] : (v4u){0u, 0u, 0u, 0u};
            *(LAS v4u*)(KS + kk * AT_KP + ch * 16) = (v4u){f8x2bf(kz.x, false), f8x2bf(kz.x, true), f8x2bf(kz.y, false), f8x2bf(kz.y, true)};
            *(LAS v4u*)(KS + kk * AT_KP + ch * 16 + 8) = (v4u){f8x2bf(kz.z, false), f8x2bf(kz.z, true), f8x2bf(kz.w, false), f8x2bf(kz.w, true)};
            *(LAS v4u*)(VS + kk * AT_KP + ch * 16) = (v4u){f8x2bf(vz.x, false), f8x2bf(vz.x, true), f8x2bf(vz.y, false), f8x2bf(vz.y, true)};
            *(LAS v4u*)(VS + kk * AT_KP + ch * 16 + 8) = (v4u){f8x2bf(vz.z, false), f8x2bf(vz.z, true), f8x2bf(vz.w, false), f8x2bf(vz.w, true)}; }
        if (tid < 129) { const int dist = u.r * tid; int bk;
            if (dist < 16) bk = dist; else { bk = 16 + (int)(__log2f((float)dist * 0.0625f) * (16.0f / 7.0f)); bk = bk > 31 ? 31 : bk; }
            BIAS[tid] = a.in[6][bk * 12 + u.g * 4 + u.hh]; }
        __syncthreads();
        if (U + F.G < 1536) { const AttnU n = attn_decode(a, U + F.G);
#pragma unroll
            for (int it = 0; it < 4; ++it) { const int c = tid + NTHR * it, kk = c >> 3, ch = c & 7; int i = n.i0 - 128 + kk; i = i < 0 ? 0 : i;
                const size_t ro = (size_t)i * n.rstride + ch * 16; kreg[it] = *(const GAS v4u*)(n.Kb + ro); vreg[it] = *(const GAS v4u*)(n.Vb + ro); } }
        f32x4 s[9];
#pragma unroll
        for (int t9 = 0; t9 < 9; ++t9) { f32x4 acc = (f32x4){0.f, 0.f, 0.f, 0.f};
#pragma unroll
            for (int ks = 0; ks < 4; ++ks) acc = MFMA16(ldsfrag(KS, AT_KP, 16 * (w + t9), 32 * ks, lane), qf[ks], acc);
            s[t9] = acc; }
        const float scale = 0.08838834764831845f;
        float mx = -INFINITY;
#pragma unroll
        for (int t9 = 0; t9 < 9; ++t9)
#pragma unroll
            for (int rr = 0; rr < 4; ++rr) { const int krel = 16 * t9 + 4 * q + rr, dist = 128 + l15 - krel; const bool valid = (dist >= 0) && (dist <= 128) && (u.i0 - 128 + 16 * w + krel >= 0);
                const float v = valid ? s[t9][rr] * scale + BIAS[valid ? dist : 0] : -INFINITY; s[t9][rr] = v; mx = fmaxf(mx, v); }
        mx = fmaxf(mx, __shfl_xor(mx, 16)); mx = fmaxf(mx, __shfl_xor(mx, 32));
        float lsum = 0.f;
#pragma unroll
        for (int t9 = 0; t9 < 9; ++t9)
#pragma unroll
            for (int rr = 0; rr < 4; ++rr) { const float p = __expf(s[t9][rr] - mx); s[t9][rr] = p; lsum += p; }
        lsum += __shfl_xor(lsum, 16); lsum += __shfl_xor(lsum, 32);
        __syncthreads();
        LAS bf16* PS = KS + w * 16 * AT_PP;
#pragma unroll
        for (int t9 = 0; t9 < 9; ++t9) *(LAS u32x2*)(PS + l15 * AT_PP + 16 * t9 + 4 * q) = (u32x2){cvtpk(s[t9][0], s[t9][1]), cvtpk(s[t9][2], s[t9][3])};
        *(LAS u32x2*)(PS + l15 * AT_PP + 144 + 4 * q) = (u32x2){0u, 0u};
        __syncthreads();
        bf16x8 pf[5];
#pragma unroll
        for (int ks = 0; ks < 5; ++ks) pf[ks] = ldsfrag(PS, AT_PP, 0, 32 * ks, lane);
        const float inv = 16.0f / lsum;
        const size_t tokrow = u.tok0 + (size_t)(u.i0 + 16 * w + l15) * u.r;
        unsigned char* og = a.ws + WS_OG + (size_t)u.g * TOK * 512 + tokrow * 512 + u.hh * 128 + 4 * (q & 2);
#pragma unroll
        for (int dp = 0; dp < 8; dp += 2) { int pc[2];
#pragma unroll
            for (int d2 = 0; d2 < 2; ++d2) { f32x4 acc = (f32x4){0.f, 0.f, 0.f, 0.f};
#pragma unroll
                for (int ks = 0; ks < 5; ++ks) acc = MFMA16(ldsfrag_tr(VS, AT_KP, 16 * w + 32 * ks, 16 * (dp + d2), lane), pf[ks], acc);
                int pk = 0; pk = __builtin_amdgcn_cvt_pk_fp8_f32(acc[0] * inv, acc[1] * inv, pk, false); pk = __builtin_amdgcn_cvt_pk_fp8_f32(acc[2] * inv, acc[3] * inv, pk, true); pc[d2] = pk; }
            const bool odd = (q & 1) != 0;
            const int r0 = __shfl_xor(odd ? pc[0] : pc[1], 16);
            typedef int i32x2 __attribute__((ext_vector_type(2)));
            *(GAS i32x2*)(og + 16 * (dp + (odd ? 1 : 0))) = odd ? (i32x2){r0, pc[1]} : (i32x2){pc[0], r0}; }
        if (q == 0) ((float*)(a.ws + WS_LSE))[(size_t)u.g * TOK * 4 + tokrow * 4 + u.hh] = mx + __logf(lsum);
        __syncthreads();
        if (!bg_pre) { moe_convert(a, F, 2 * slot, 2); __syncthreads(); }
    }
}

constexpr int RT_P = 136, RV_P = 264;
struct RotRegs { v4u lo[2], hi[2]; };
__device__ __forceinline__ void rot_issue(Frame& F, const bf16* src, RotRegs& r) {
#pragma unroll
    for (int it = 0; it < 2; ++it) { const int pc = F.tid + NTHR * it, j = pc >> 3, d0 = (pc & 7) * 8; r.lo[it] = *(const GAS v4u*)(src + (size_t)j * ULD + d0); r.hi[it] = *(const GAS v4u*)(src + (size_t)j * ULD + d0 + 64); }
}
__device__ __forceinline__ void rope_issue(const Args& a, Frame& F, int pos0, f32x4 (&cs)[2][4]) {
    const float* rope = (const float*)(a.ws + WS_ROPE);
#pragma unroll
    for (int it = 0; it < 2; ++it) { const int pc = F.tid + NTHR * it, j = pc >> 3, d0 = (pc & 7) * 8; const GAS f32x4* rp = (const GAS f32x4*)(rope + ((size_t)(pos0 + j) * 64 + d0) * 2);
#pragma unroll
        for (int i = 0; i < 4; ++i) cs[it][i] = rp[i]; }
}
template <bool ZETA>
__device__ __forceinline__ void rot_finish(Frame& F, const RotRegs& r, const f32x4 (&cs)[2][4], float mul, float l2g, LAS bf16* dst) {
#pragma unroll
    for (int it = 0; it < 2; ++it) { const int pc = F.tid + NTHR * it, j = pc >> 3, d0 = (pc & 7) * 8;
        const float m = ZETA ? mul * __builtin_amdgcn_exp2f((float)(127 - j) * l2g) : mul;
        float ol[8], oh[8];
#pragma unroll
        for (int i = 0; i < 8; ++i) { const unsigned wl = i < 2 ? r.lo[it].x : (i < 4 ? r.lo[it].y : (i < 6 ? r.lo[it].z : r.lo[it].w)), wh = i < 2 ? r.hi[it].x : (i < 4 ? r.hi[it].y : (i < 6 ? r.hi[it].z : r.hi[it].w));
            const float tl = (i & 1) ? bfhi(wl) : bflo(wl), th = (i & 1) ? bfhi(wh) : bflo(wh); const float c = (i & 1) ? cs[it][i >> 1].z : cs[it][i >> 1].x, sn = (i & 1) ? cs[it][i >> 1].w : cs[it][i >> 1].y;
            ol[i] = (tl * c - th * sn) * m; oh[i] = (tl * sn + th * c) * m; }
        *(LAS v4u*)(dst + j * RT_P + d0) = (v4u){cvtpk(ol[0], ol[1]), cvtpk(ol[2], ol[3]), cvtpk(ol[4], ol[5]), cvtpk(ol[6], ol[7])};
        *(LAS v4u*)(dst + j * RT_P + d0 + 64) = (v4u){cvtpk(oh[0], oh[1]), cvtpk(oh[2], oh[3]), cvtpk(oh[4], oh[5]), cvtpk(oh[6], oh[7])}; }
}
__device__ __forceinline__ void v_issue(Frame& F, const bf16* src, v4u (&t)[8]) {
#pragma unroll
    for (int it = 0; it < 8; ++it) { const int c = F.tid + NTHR * it, j = c >> 5, ch = c & 31; t[it] = *(const GAS v4u*)(src + (size_t)j * ULD + ch * 8); }
}
__device__ __forceinline__ void v_finish(Frame& F, const v4u (&t)[8], LAS bf16* VS) {
#pragma unroll
    for (int it = 0; it < 8; ++it) { const int c = F.tid + NTHR * it, j = c >> 5, ch = c & 31; *(LAS v4u*)(VS + j * RV_P + ch * 8) = t[it]; }
}
__device__ __forceinline__ void ret_kv_item(const Args& a, Frame& F, int item) {
    const int h = item & 3, n = (item >> 2) & 31, b = item >> 7; const float l2g = log2g(h);
    const size_t r0 = (size_t)(b * SEQ + n * 128) * ULD;
    LAS bf16* KZ = (LAS bf16*)F.lds; LAS bf16* VS = (LAS bf16*)(F.lds + 128 * RT_P * 2);
    { RotRegs kr; f32x4 cs[2][4]; v4u vt[8];
      rot_issue(F, ucol(a.ws, C_RK + h * 128) + r0, kr); rope_issue(a, F, n * 128, cs); v_issue(F, ucol(a.ws, C_RV + h * 256) + r0, vt);
      rot_finish<true>(F, kr, cs, 0.08838834764831845f, l2g, KZ); v_finish(F, vt, VS); }
    __syncthreads();
    const int lane = F.lane, w = F.wave, q = lane >> 4, l15 = lane & 15;
    f32x4 acc[2][8];
#pragma unroll
    for (int e2 = 0; e2 < 2; ++e2)
#pragma unroll
        for (int dt = 0; dt < 8; ++dt) acc[e2][dt] = (f32x4){0.f, 0.f, 0.f, 0.f};
#pragma unroll
    for (int ks = 0; ks < 4; ++ks) { const bf16x8 v0 = ldsfrag_tr(VS, RV_P, 32 * ks, 32 * w, lane), v1 = ldsfrag_tr(VS, RV_P, 32 * ks, 32 * w + 16, lane);
#pragma unroll
        for (int dt = 0; dt < 8; ++dt) { const bf16x8 kk = ldsfrag_tr(KZ, RT_P, 32 * ks, 16 * dt, lane); acc[0][dt] = MFMA16(kk, v0, acc[0][dt]); acc[1][dt] = MFMA16(kk, v1, acc[1][dt]); } }
    bf16* kv = (bf16*)(a.ws + WS_KV) + (size_t)item * 32768; typedef unsigned u32x2 __attribute__((ext_vector_type(2)));
#pragma unroll
    for (int e2 = 0; e2 < 2; ++e2)
#pragma unroll
        for (int dt = 0; dt < 8; ++dt) *(GAS u32x2*)(kv + (32 * w + 16 * e2 + l15) * 128 + 16 * dt + 4 * q) = (u32x2){cvtpk(acc[e2][dt][0], acc[e2][dt][1]), cvtpk(acc[e2][dt][2], acc[e2][dt][3])};
    __syncthreads();
}
__device__ __forceinline__ void p4_scan_merge(const Args& a, Frame& F) {
    const bf16* kv = (const bf16*)(a.ws + WS_KV); bf16* rt = (bf16*)(a.ws + WS_RT);
    for (int idx = F.vcu * NTHR + F.tid; idx < 16 * 8192; idx += F.G * NTHR) {
        const int bh = idx >> 13, el = (idx & 8191) * 4, b = bh >> 2, h = bh & 3; const float gch = exp2f(128.0f * log2g(h));
        f32x4 R = (f32x4){0.f, 0.f, 0.f, 0.f};
        for (int n0 = 0; n0 < 32; n0 += 8) { unsigned long long k8[8];
#pragma unroll
            for (int i = 0; i < 8; ++i) k8[i] = __builtin_nontemporal_load((const GAS unsigned long long*)(kv + (size_t)(((b * 32 + n0 + i) << 2) + h) * 32768 + el));
#pragma unroll
            for (int i = 0; i < 8; ++i) { const size_t off = (size_t)(((b * 32 + n0 + i) << 2) + h) * 32768 + el;
                *(GAS unsigned long long*)(rt + off) = (unsigned long long)cvtpk(R.x, R.y) | ((unsigned long long)cvtpk(R.z, R.w) << 32);
                const unsigned lo = (unsigned)k8[i], hi = (unsigned)(k8[i] >> 32); R = R * gch + (f32x4){bflo(lo), bfhi(lo), bflo(hi), bfhi(hi)}; } } }
    const int gw = F.vcu * NWAVES + F.wave, NGW = F.G * NWAVES;
    const unsigned char* og = a.ws + WS_OG; const float* lse = (const float*)(a.ws + WS_LSE);
    for (int t2 = gw; t2 < TOK / 2; t2 += NGW) { const int t = 2 * t2 + (F.lane >> 5), l31 = F.lane & 31, hh = l31 >> 3;
        const float l0 = lse[(size_t)t * 4 + hh], l1 = lse[(size_t)TOK * 4 + (size_t)t * 4 + hh], l2 = lse[(size_t)2 * TOK * 4 + (size_t)t * 4 + hh];
        const float m = fmaxf(l0, fmaxf(l1, l2)); float a0 = __expf(l0 - m), a1 = __expf(l1 - m), a2 = __expf(l2 - m); const float is = 0.0625f / (a0 + a1 + a2); a0 *= is; a1 *= is; a2 *= is;
        const size_t o = (size_t)t * 512 + l31 * 16;
        const v4u x0 = *(const GAS v4u*)(og + o), x1 = *(const GAS v4u*)(og + (size_t)TOK * 512 + o), x2 = *(const GAS v4u*)(og + (size_t)2 * TOK * 512 + o);
        v4u r;
#pragma unroll
        for (int j = 0; j < 4; ++j) { const unsigned w0 = j == 0 ? x0.x : (j == 1 ? x0.y : (j == 2 ? x0.z : x0.w)), w1 = j == 0 ? x1.x : (j == 1 ? x1.y : (j == 2 ? x1.z : x1.w)), w2 = j == 0 ? x2.x : (j == 1 ? x2.y : (j == 2 ? x2.z : x2.w));
            const f32x2_t_ p0 = __builtin_amdgcn_cvt_pk_f32_fp8((int)w0, false), q0 = __builtin_amdgcn_cvt_pk_f32_fp8((int)w0, true);
            const f32x2_t_ p1 = __builtin_amdgcn_cvt_pk_f32_fp8((int)w1, false), q1 = __builtin_amdgcn_cvt_pk_f32_fp8((int)w1, true);
            const f32x2_t_ p2 = __builtin_amdgcn_cvt_pk_f32_fp8((int)w2, false), q2 = __builtin_amdgcn_cvt_pk_f32_fp8((int)w2, true);
            int pk = 0; pk = __builtin_amdgcn_cvt_pk_fp8_f32(a0 * p0.x + a1 * p1.x + a2 * p2.x, a0 * p0.y + a1 * p1.y + a2 * p2.y, pk, false);
            pk = __builtin_amdgcn_cvt_pk_fp8_f32(a0 * q0.x + a1 * q1.x + a2 * q2.x, a0 * q0.y + a1 * q1.y + a2 * q2.y, pk, true);
            if (j == 0) r.x = (unsigned)pk; else if (j == 1) r.y = (unsigned)pk; else if (j == 2) r.z = (unsigned)pk; else r.w = (unsigned)pk; }
        *(GAS v4u*)(a.ws + WS_RET + (size_t)t * RA_LD + 1024 + l31 * 16) = r; }
}
__device__ __forceinline__ void ret_out_item(const Args& a, Frame& F, int item) {
    const int h = item & 3, n = (item >> 2) & 31, b = item >> 7; const float l2g = log2g(h);
    const size_t r0 = (size_t)(b * SEQ + n * 128) * ULD;
    LAS bf16* QS = (LAS bf16*)F.lds; LAS bf16* KS = (LAS bf16*)(F.lds + 128 * RT_P * 2); LAS bf16* VS = (LAS bf16*)(F.lds + 2 * 128 * RT_P * 2);
    LAS float* RED = (LAS float*)(F.lds + 2 * 128 * RT_P * 2 + 128 * RV_P * 2);
    { RotRegs qr, kr; f32x4 cs[2][4]; v4u vt[8];
      rot_issue(F, ucol(a.ws, C_RQ + h * 128) + r0, qr); rot_issue(F, ucol(a.ws, C_RK + h * 128) + r0, kr); rope_issue(a, F, n * 128, cs); v_issue(F, ucol(a.ws, C_RV + h * 256) + r0, vt);
      rot_finish<false>(F, qr, cs, 1.0f, l2g, QS); rot_finish<false>(F, kr, cs, 0.08838834764831845f, l2g, KS); v_finish(F, vt, VS); }
    __syncthreads();
    const int lane = F.lane, w = F.wave, q = lane >> 4, l15 = lane & 15;
    typedef unsigned u32x2 __attribute__((ext_vector_type(2)));
    u32x2 pw[8];
    bf16x8 rf0[4], rf1[4];
    { const bf16* rtg = (const bf16*)(a.ws + WS_RT) + (size_t)item * 32768 + (size_t)(32 * w + l15) * 128 + 8 * q;
#pragma unroll
      for (int ks = 0; ks < 4; ++ks) { rf0[ks] = *(const GAS bf16x8*)(rtg + 32 * ks); rf1[ks] = *(const GAS bf16x8*)(rtg + 16 * 128 + 32 * ks); } }
    { bf16x8 qf[4];
#pragma unroll
      for (int ks = 0; ks < 4; ++ks) qf[ks] = ldsfrag(QS, RT_P, 16 * w, 32 * ks, lane);
#pragma unroll
      for (int jt = 0; jt < 8; ++jt) { f32x4 acc = (f32x4){0.f, 0.f, 0.f, 0.f};
          if (jt <= w) {
#pragma unroll
              for (int ks = 0; ks < 4; ++ks) acc = MFMA16(ldsfrag(KS, RT_P, 16 * jt, 32 * ks, lane), qf[ks], acc); }
          float p[4];
#pragma unroll
          for (int rr = 0; rr < 4; ++rr) { const int j = 16 * jt + 4 * q + rr, i = 16 * w + l15; p[rr] = (j <= i) ? acc[rr] * __builtin_amdgcn_exp2f(-(float)(j + 1) * l2g) : 0.f; }
          pw[jt] = (u32x2){cvtpk(p[0], p[1]), cvtpk(p[2], p[3])}; } }
    __syncthreads();
#pragma unroll
    for (int jt = 0; jt < 8; ++jt) *(LAS u32x2*)(KS + (16 * w + l15) * RT_P + 16 * jt + 4 * q) = pw[jt];
    __syncthreads();
    f32x4 acc[2][8];
#pragma unroll
    for (int e2 = 0; e2 < 2; ++e2)
#pragma unroll
        for (int it = 0; it < 8; ++it) acc[e2][it] = (f32x4){0.f, 0.f, 0.f, 0.f};
#pragma unroll
    for (int ks = 0; ks < 4; ++ks) { const bf16x8 a0 = ldsfrag_tr(VS, RV_P, 32 * ks, 32 * w, lane), a1 = ldsfrag_tr(VS, RV_P, 32 * ks, 32 * w + 16, lane);
#pragma unroll
        for (int it = 2 * ks; it < 8; ++it) { const bf16x8 pf = ldsfrag(KS, RT_P, 16 * it, 32 * ks, lane); acc[0][it] = MFMA16(a0, pf, acc[0][it]); acc[1][it] = MFMA16(a1, pf, acc[1][it]); } }
#pragma unroll
    for (int ks = 0; ks < 4; ++ks) {
#pragma unroll
        for (int it = 0; it < 8; ++it) { const bf16x8 qf = ldsfrag(QS, RT_P, 16 * it, 32 * ks, lane); acc[0][it] = MFMA16(rf0[ks], qf, acc[0][it]); acc[1][it] = MFMA16(rf1[ks], qf, acc[1][it]); } }
#pragma unroll
    for (int it = 0; it < 8; ++it) { const float xi = __builtin_amdgcn_exp2f((float)(16 * it + l15 + 1) * l2g); acc[0][it] = acc[0][it] * xi; acc[1][it] = acc[1][it] * xi;
        float s1 = (acc[0][it][0] + acc[0][it][1]) + (acc[0][it][2] + acc[0][it][3]) + (acc[1][it][0] + acc[1][it][1]) + (acc[1][it][2] + acc[1][it][3]);
        float s2 = (acc[0][it][0] * acc[0][it][0] + acc[0][it][1] * acc[0][it][1]) + (acc[0][it][2] * acc[0][it][2] + acc[0][it][3] * acc[0][it][3]) + (acc[1][it][0] * acc[1][it][0] + acc[1][it][1] * acc[1][it][1]) + (acc[1][it][2] * acc[1][it][2] + acc[1][it][3] * acc[1][it][3]);
        s1 += __shfl_xor(s1, 16); s1 += __shfl_xor(s1, 32); s2 += __shfl_xor(s2, 16); s2 += __shfl_xor(s2, 32);
        if (q == 0) *(LAS u32x2*)(RED + (16 * it + l15) * 16 + 2 * w) = (u32x2){__float_as_uint(s1), __float_as_uint(s2)}; }
    __syncthreads();
#pragma unroll
    for (int it = 0; it < 8; ++it) { const LAS f32x4* rp = (const LAS f32x4*)(RED + (16 * it + l15) * 16); const f32x4 r0 = rp[0], r1 = rp[1], r2 = rp[2], r3 = rp[3];
        const float s1 = (r0[0] + r0[2]) + (r1[0] + r1[2]) + (r2[0] + r2[2]) + (r3[0] + r3[2]), s2 = (r0[1] + r0[3]) + (r1[1] + r1[3]) + (r2[1] + r2[3]) + (r3[1] + r3[3]);
        const float mean = s1 * (1.0f / 256.0f), var = fmaxf(s2 * (1.0f / 256.0f) - mean * mean, 0.f), rstd = 1.0f / sqrtf(var + GN_EPS);
        const size_t tok = (size_t)(b * SEQ + n * 128 + 16 * it + l15);
        const bf16* gp = ucol(a.ws, C_RG + h * 256) + tok * ULD + 32 * w + 4 * q; unsigned char* op = a.ws + WS_RET + tok * RA_LD + h * 256 + 32 * w + 4 * q;
        int w8p[2];
#pragma unroll
        for (int e2 = 0; e2 < 2; ++e2) { const u32x2 gg = *(const GAS u32x2*)(gp + 16 * e2);
            const float g0 = bflo(gg.x), g1 = bfhi(gg.x), g2 = bflo(gg.y), g3 = bfhi(gg.y);
#define SILU_(x) ((x) * __builtin_amdgcn_rcpf(1.0f + __expf(-(x))))
            const float o0 = SILU_(g0) * (acc[e2][it][0] - mean) * rstd, o1 = SILU_(g1) * (acc[e2][it][1] - mean) * rstd, o2 = SILU_(g2) * (acc[e2][it][2] - mean) * rstd, o3 = SILU_(g3) * (acc[e2][it][3] - mean) * rstd;
#undef SILU_
            int w8 = 0; w8 = __builtin_amdgcn_cvt_pk_fp8_f32(o0, o1, w8, false); w8 = __builtin_amdgcn_cvt_pk_fp8_f32(o2, o3, w8, true); w8p[e2] = w8; }
        { const bool odd = (q & 1) != 0; const int recv = __shfl_xor(odd ? w8p[0] : w8p[1], 16);
          *(GAS u32x2*)(op - 4 * (q & 1) + (odd ? 16 : 0)) = odd ? (u32x2){(unsigned)recv, (unsigned)w8p[1]} : (u32x2){(unsigned)w8p[0], (unsigned)recv}; } }
    __syncthreads();
}

constexpr int P8_RSTD = 0, P8_LG = 1024, P8_CNT = P8_LG + 2 * 64 * 32 * 4, P8_LB = P8_CNT + 128, P8_LTE = P8_LB + 128, P8_LTP = P8_LTE + 1024, P8_H2 = P8_LTP + 1024;
__device__ __forceinline__ void p8_route(const Args& a, Frame& F) {
    LAS float* RSTD = (LAS float*)(F.lds + P8_RSTD); LAS float* LG = (LAS float*)(F.lds + P8_LG); LAS int* CNT = (LAS int*)(F.lds + P8_CNT);
    if (F.tid < 32) CNT[F.tid] = 0;
    const float* mod = (const float*)(a.ws + WS_CTL) + CW_MOD; const int lane = F.lane, w = F.wave, q = lane >> 4, l15 = lane & 15;
    const bf16* xm = (const bf16*)(a.ws + WS_XMID);
    LAS int* LB = (LAS int*)(F.lds + P8_LB); LAS int* LTE = (LAS int*)(F.lds + P8_LTE); LAS int* LTP = (LAS int*)(F.lds + P8_LTP);
    int* TE = (int*)(a.ws + WS_TE); int* TP = (int*)(a.ws + WS_TP); float* TG = (float*)(a.ws + WS_TG);
    const int t0 = F.vcu * 64, b = t0 / SEQ;
    const float* gf = a.in[10]; const float* scf = mod + b * 6144 + 4096; const float* shf = mod + b * 6144 + 3072;
#pragma unroll
    for (int hb = 0; hb < 2; ++hb) { v4u v[4][2];
#pragma unroll
        for (int ri = 0; ri < 4; ++ri) { const GAS v4u* xr = (const GAS v4u*)(xm + (size_t)(t0 + 8 * w + 4 * hb + ri) * DM) + lane;
#pragma unroll
            for (int j = 0; j < 2; ++j) v[ri][j] = xr[64 * j]; }
#pragma unroll
        for (int ri = 0; ri < 4; ++ri) { float s = 0.f; f32x4 f[2][2];
#pragma unroll
            for (int j = 0; j < 2; ++j) { f[j][0] = (f32x4){bflo(v[ri][j].x), bfhi(v[ri][j].x), bflo(v[ri][j].y), bfhi(v[ri][j].y)}; f[j][1] = (f32x4){bflo(v[ri][j].z), bfhi(v[ri][j].z), bflo(v[ri][j].w), bfhi(v[ri][j].w)};
#pragma unroll
                for (int k = 0; k < 2; ++k) s += (f[j][k].x * f[j][k].x + f[j][k].y * f[j][k].y) + (f[j][k].z * f[j][k].z + f[j][k].w * f[j][k].w); }
            const float rstd = 1.0f / sqrtf(wave_sum(s) * (1.0f / DM) + RMS_EPS);
            if (lane == 0) RSTD[8 * w + 4 * hb + ri] = rstd;
            typedef int i32x2 __attribute__((ext_vector_type(2)));
            GAS i32x2* o8 = (GAS i32x2*)(a.ws + WS_H2 + (size_t)(t0 + 8 * w + 4 * hb + ri) * DM) + lane;
#pragma unroll
            for (int j = 0; j < 2; ++j) { i32x2 w8;
#pragma unroll
                for (int k = 0; k < 2; ++k) { const int c = 8 * (64 * j + lane) + 4 * k; const f32x4 gg = *(const f32x4*)(gf + c), ss = *(const f32x4*)(scf + c), hh = *(const f32x4*)(shf + c);
                    const f32x4 o = f[j][k] * rstd * gg * (ss + 1.0f) + hh;
                    int p = 0; p = __builtin_amdgcn_cvt_pk_fp8_f32(o.x, o.y, p, false); p = __builtin_amdgcn_cvt_pk_fp8_f32(o.z, o.w, p, true); if (k == 0) w8.x = p; else w8.y = p; }
                o8[64 * j] = w8; } } }
    __syncthreads();
    { const int rt = w & 3, kh = w >> 2; const float rstd = RSTD[16 * rt + l15];
      const bf16* xrow = xm + (size_t)(t0 + 16 * rt + l15) * DM + 512 * kh + 8 * q;
      const bf16* wh = (const bf16*)(a.ws + WS_WRT) + (size_t)l15 * 1024 + 512 * kh + 8 * q; const bf16* wl = wh + 32768;
      f32x4 acc0 = (f32x4){0.f, 0.f, 0.f, 0.f}, acc1 = (f32x4){0.f, 0.f, 0.f, 0.f};
#pragma unroll 4
      for (int ks = 0; ks < 16; ++ks) { const int kc = 512 * kh + 32 * ks + 8 * q;
          const v4u xw = *(const GAS v4u*)(xrow + 32 * ks); const f32x4 x0 = (f32x4){bflo(xw.x), bfhi(xw.x), bflo(xw.y), bfhi(xw.y)}, x1 = (f32x4){bflo(xw.z), bfhi(xw.z), bflo(xw.w), bfhi(xw.w)};
          const f32x4 g0 = *(const f32x4*)(gf + kc), g1 = *(const f32x4*)(gf + kc + 4), s0 = *(const f32x4*)(scf + kc), s1 = *(const f32x4*)(scf + kc + 4), h0 = *(const f32x4*)(shf + kc), h1 = *(const f32x4*)(shf + kc + 4);
          const f32x4 o0 = x0 * rstd * g0 * (s0 + 1.0f) + h0, o1 = x1 * rstd * g1 * (s1 + 1.0f) + h1;
          v4u hi; hi.x = cvtpk(o0.x, o0.y); hi.y = cvtpk(o0.z, o0.w); hi.z = cvtpk(o1.x, o1.y); hi.w = cvtpk(o1.z, o1.w);
          v4u lo; lo.x = cvtpk(o0.x - bflo(hi.x), o0.y - bfhi(hi.x)); lo.y = cvtpk(o0.z - bflo(hi.y), o0.w - bfhi(hi.y)); lo.z = cvtpk(o1.x - bflo(hi.z), o1.y - bfhi(hi.z)); lo.w = cvtpk(o1.z - bflo(hi.w), o1.w - bfhi(hi.w));
          const bf16x8 ah = __builtin_bit_cast(bf16x8, hi), al = __builtin_bit_cast(bf16x8, lo);
          const bf16x8 wh0 = *(const GAS bf16x8*)(wh + 32 * ks), wh1 = *(const GAS bf16x8*)(wh + 16 * 1024 + 32 * ks), wl0 = *(const GAS bf16x8*)(wl + 32 * ks), wl1 = *(const GAS bf16x8*)(wl + 16 * 1024 + 32 * ks);
          acc0 = MFMA16(ah, wh0, acc0); acc0 = MFMA16(al, wh0, acc0); acc0 = MFMA16(ah, wl0, acc0);
          acc1 = MFMA16(ah, wh1, acc1); acc1 = MFMA16(al, wh1, acc1); acc1 = MFMA16(ah, wl1, acc1); }
#pragma unroll
      for (int rr = 0; rr < 4; ++rr) { LG[(kh * 64 + 16 * rt + 4 * q + rr) * 32 + l15] = acc0[rr]; LG[(kh * 64 + 16 * rt + 4 * q + rr) * 32 + 16 + l15] = acc1[rr]; } }
    __syncthreads();
    { const int e = lane & 31; const float br = a.in[12][e];
      for (int ri = 0; ri < 8; ++ri) { const int row = 8 * w + ri, t = t0 + row;
          float v = LG[row * 32 + e] + LG[(64 + row) * 32 + e] + br; float tv[4]; int ti[4];
#pragma unroll
          for (int k = 0; k < 4; ++k) { float m = v;
#pragma unroll
              for (int o = 1; o < 32; o <<= 1) m = fmaxf(m, __shfl_xor(m, o));
              const unsigned long long bal = __ballot(v == m); const int idx = __ffsll((long long)(bal & 0xffffffffull)) - 1;
              tv[k] = m; ti[k] = idx; if (e == idx) v = -INFINITY; }
          const float e1 = __expf(tv[1] - tv[0]), e2 = __expf(tv[2] - tv[0]), e3 = __expf(tv[3] - tv[0]); const float is = 1.0f / (1.0f + e1 + e2 + e3);
          if (lane < 4) { const int k = lane; const int ek = k == 0 ? ti[0] : (k == 1 ? ti[1] : (k == 2 ? ti[2] : ti[3])); const float gk = (k == 0 ? 1.0f : (k == 1 ? e1 : (k == 2 ? e2 : e3))) * is;
              const int lp = __hip_atomic_fetch_add(&CNT[ek], 1, __ATOMIC_RELAXED, __HIP_MEMORY_SCOPE_WORKGROUP);
              LTE[row * 4 + k] = ek; LTP[row * 4 + k] = lp; TE[t * 4 + k] = ek; TG[t * 4 + k] = gk; } } }
    __syncthreads();
    if (F.tid < 32) { const int cnt = CNT[F.tid]; LB[F.tid] = (int)__hip_atomic_fetch_add(F.ctl + CW_CNT + F.tid, (unsigned)cnt, RLX_AGENT); }
    __syncthreads();
    if (F.tid < 256) { const int p = F.tid, ek = LTE[p], pos = LB[ek] + LTP[p]; TP[(t0 + (p >> 2)) * 4 + (p & 3)] = pos; ((int*)(a.ws + WS_IDX))[(size_t)ek * XCAP + pos] = t0 + (p >> 2); }
    __syncthreads();
}
constexpr int MT_CS = 131072, MT_PM = MT_CS + 128, MT_E = MT_PM + 1280, MT_NT = MT_E + 1280, MT_IDXL = 136 * 1024;
__device__ __forceinline__ int moe_tables(Frame& F, bool sparse_a) {
    LAS int* CS = (LAS int*)(F.lds + MT_CS); LAS int* TPM = (LAS int*)(F.lds + MT_PM); LAS int* TEX = (LAS int*)(F.lds + MT_E); LAS int* NT = (LAS int*)(F.lds + MT_NT);
    if (F.tid < 64) { const int e = F.tid & 31; const int cnt = (int)__hip_atomic_load(F.ctl + CW_CNT + e, RLX_AGENT), n = (cnt + 255) >> 8;
        int incl = n;
#pragma unroll
        for (int o = 1; o < 32; o <<= 1) { const int v = __shfl_up(incl, o, 32); if (e >= o) incl += v; }
        const int t = incl - n;
        if (F.tid < 32) { CS[e] = t << 8;
            for (int j = 0; j < n; ++j) { TPM[t + j] = sparse_a ? e * (XCAP / 256) + j : t + j; TEX[t + j] = e; }
            if (e == 31) NT[0] = incl; } }
    __syncthreads();
    return __builtin_amdgcn_readfirstlane(NT[0]);
}
__device__ __forceinline__ void p12_final(const Args& a, Frame& F, bool with_moe, bool tables_ready) {
    LAS int* CS = (LAS int*)(F.lds + MT_CS); if (with_moe && !tables_ready) (void)moe_tables(F, false);
    const int gw = F.vcu * NWAVES + F.wave, NGW = F.G * NWAVES, lane = F.lane; const float* mod = (const float*)(a.ws + WS_CTL) + CW_MOD;
    const bf16* xm = (const bf16*)(a.ws + WS_XMID); const unsigned char* yb = a.ws + WS_YB; const int* TE = (const int*)(a.ws + WS_TE); const int* TP = (const int*)(a.ws + WS_TP); const float* TG = (const float*)(a.ws + WS_TG);
    for (int t = gw; t < TOK; t += NGW) { const int b = t / SEQ;
        f32x4 v[4], m4[4];
#pragma unroll
        for (int j = 0; j < 4; ++j) { const unsigned long long xw = __builtin_nontemporal_load((const GAS unsigned long long*)(xm + (size_t)t * DM) + lane + 64 * j); const unsigned lo = (unsigned)xw, hi = (unsigned)(xw >> 32);
            v[j] = (f32x4){bflo(lo), bfhi(lo), bflo(hi), bfhi(hi)}; m4[j] = (f32x4){0.f, 0.f, 0.f, 0.f}; }
        if (with_moe) {
#pragma unroll
            for (int k = 0; k < 4; ++k) { const int row = CS[TE[t * 4 + k]] + TP[t * 4 + k]; const float gk = TG[t * 4 + k]; const GAS int* yr = (const GAS int*)(yb + (size_t)row * DM) + lane;
#pragma unroll
                for (int j = 0; j < 4; ++j) { const int y4 = __builtin_nontemporal_load(yr + 64 * j); typedef float f32x2_ __attribute__((ext_vector_type(2)));
                    const f32x2_ lo = __builtin_amdgcn_cvt_pk_f32_fp8(y4, false), hi = __builtin_amdgcn_cvt_pk_f32_fp8(y4, true);
                    m4[j].x += gk * lo.x; m4[j].y += gk * lo.y; m4[j].z += gk * hi.x; m4[j].w += gk * hi.y; } }
        }
        float s = 0.f;
#pragma unroll
        for (int j = 0; j < 4; ++j) { const f32x4 gt = *(const f32x4*)(mod + b * 6144 + 5120 + 4 * (64 * j + lane)); v[j] = v[j] + gt * m4[j]; s += (v[j].x * v[j].x + v[j].y * v[j].y) + (v[j].z * v[j].z + v[j].w * v[j].w); }
        const float rstd = 1.0f / sqrtf(wave_sum(s) * (1.0f / DM) + RMS_EPS);
#pragma unroll
        for (int j = 0; j < 4; ++j) { const f32x4 gf = *(const f32x4*)(a.in[17] + 4 * (64 * j + lane)); __builtin_nontemporal_store(v[j] * rstd * gf, (GAS f32x4*)(a.out + (size_t)t * DM) + lane + 64 * j); } }
}

#ifndef ABL_NOMIX
#define ABL_NOMIX 0
#endif
#ifndef ABL_NOMOE
#define ABL_NOMOE 0
#endif
#ifndef ONE_LAUNCH
#define ONE_LAUNCH 1
#endif
constexpr int NPHASE = 13;
__global__ void __launch_bounds__(NTHR, 2) mk_fwd(Args args) {
    extern __shared__ __attribute__((aligned(16))) unsigned char lds[];
    Frame F;
    F.lds = (LAS unsigned char*)lds; F.MISC = (volatile LAS unsigned*)(F.lds + MISC_OFF);
    F.tid = threadIdx.x; F.lane = F.tid & 63; F.wave = __builtin_amdgcn_readfirstlane(F.tid >> 6);
    F.G = gridDim.x; { const int bx = blockIdx.x; F.vcu = (F.G % 8 == 0) ? (bx % 8) * (F.G / 8) + bx / 8 : bx; }
    unsigned char* ws = args.ws; F.ctl = (gu32*)(ws + WS_CTL);
    if (F.tid < 64) F.MISC[F.tid] = 0u;
    __syncthreads();
    XcdBarrier bar = xcd_barrier_post((unsigned*)(F.ctl + CW_BAR), F.MISC + 8);
    const int lo = args.ph_lo, hi = args.ph_hi;
#ifndef PHMASK
#define PHMASK 0x1fff
#endif
#define IN(k) (lo <= (k) && (k) < hi && ((PHMASK >> (k)) & 1))
#ifndef REPMASK
#define REPMASK 0
#endif
#define REP(k) for (int rep_ = 0; rep_ < ((((REPMASK) >> (k)) & 1) ? 2 : 1); ++rep_)
#ifndef XBAR
#define XBAR 0
#endif
#define SEAM(k) do { if (IN(k) && IN((k) + 1)) { xcd_barrier(bar); if ((XBAR >> (k)) & 1) { xcd_barrier(bar); xcd_barrier(bar); } } } while (0)
    typedef pg8::bf16_t pb;
    if (IN(0)) REP(0) { p0_prologue(args, F); }
#if !ABL_NOMIX
    if (IN(1)) REP(1) { p1_norm1(args, F); } SEAM(1);
    if (IN(2)) REP(2) {
        { pg8::Gemm g{(const pb*)(ws + WS_H), (const pb*)(ws + WS_WIN), TOK, N16, DM}; pg8::SplitOrder S; S.init(TOK, N16, F.G, (int)blockIdx.x); S.nx = 4; S.ny = 2;
          pg8::EpiBf16<0> E{(pb*)(ws + WS_U), ULD, nullptr, 256, UBLK, 1.f};
          pg8::gemm_phase<pg8::EpiBf16<0>, pg8::SplitOrder, true, true>(F.lds, g, S, E); }
        __syncthreads();
        { pg8::Gemm g{(const pb*)(ws + WS_H8), (const pb*)(ws + WS_WIN8), TOK, INW - N16, DM / 2}; pg8::SplitOrder S; S.init(TOK, INW - N16, F.G, (int)blockIdx.x); S.nx = 5; S.ny = 8;
          pg8::EpiFp8Blk E{ws + WS_U + (size_t)(N16 / 256) * UBLK * 2, UBLK};
          pg8::gemm_phase<pg8::EpiFp8Blk, pg8::SplitOrder, true, true, true>(F.lds, g, S, E); } } SEAM(2);
    if (IN(3)) { REP(3) { attn_phase(args, F); }
        REP(13) { for (int it = (F.vcu + 128) % F.G; it < 512; it += F.G) ret_kv_item(args, F, it); } } SEAM(3);
    if (IN(4)) REP(4) { p4_scan_merge(args, F); } SEAM(4);
    if (IN(5)) REP(5) { for (int it = F.vcu; it < 512; it += F.G) ret_out_item(args, F, it); } SEAM(5);
    if (IN(6)) REP(6) { pg8::Gemm g{(const pb*)(ws + WS_RET), (const pb*)(ws + WS_WRET), TOK, DM, RA_LD / 2}; pg8::StaticOrder S; S.init(TOK, DM, F.G, (int)blockIdx.x);
        pg8::EpiGate2<8> E{(pb*)(ws + WS_MERGED), DM, ucol8(ws, C_GA), ucol8(ws, C_GB), UBLK};
        pg8::gemm_phase<pg8::EpiGate2<8>, pg8::StaticOrder, true, true, true>(F.lds, g, S, E); } SEAM(6);
    if (IN(7)) REP(7) { pg8::Gemm g{(const pb*)(ws + WS_MERGED), (const pb*)(ws + WS_WO), TOK, DM, 1024}; pg8::StaticOrder S; S.init(TOK, DM, F.G, (int)blockIdx.x);
        pg8::EpiResid E{(pg8::bf16_t*)(ws + WS_XMID), args.in[0], DM, (const float*)(ws + WS_CTL) + CW_MOD + 2048, 6144, SEQ / 256};
        pg8::gemm_phase<pg8::EpiResid, pg8::StaticOrder, true, true>(F.lds, g, S, E); } SEAM(7);
#else
    if (IN(7)) { const f32x4* s = (const f32x4*)args.in[0]; unsigned long long* d = (unsigned long long*)(ws + WS_XMID); for (size_t i = (size_t)blockIdx.x * NTHR + F.tid; i < (size_t)TOK * DM / 4; i += (size_t)F.G * NTHR) { const f32x4 x = s[i]; d[i] = (unsigned long long)cvtpk(x.x, x.y) | ((unsigned long long)cvtpk(x.z, x.w) << 32); } } SEAM(7);
#endif
#if !ABL_NOMOE
    if (IN(8)) { p8_route(args, F); } if (IN(8) && IN(10)) xcd_barrier(bar);
    if (IN(10)) REP(10) { const int nt = moe_tables(F, true);
        pg8::Gemm g{(const pb*)(ws + WS_H2), (const pb*)(ws + WS_W1), nt * 256, NEXP * FF2, DM / 2}; pg8::MoeGather S{{nt, FF2 / 256, F.G, F.vcu  , (const LAS int*)(F.lds + MT_PM), (const LAS int*)(F.lds + MT_E)}, (const int*)(ws + WS_IDX), (LAS int*)(F.lds + MT_IDXL), TOK - 1};
        pg8::EpiSwiglu E{(pb*)(ws + WS_A), FF, args.in[14], FF2 / 256};
        pg8::gemm_phase<pg8::EpiSwiglu, pg8::MoeGather, true, true, true>(F.lds, g, S, E); } SEAM(10);
    if (IN(11)) REP(11) { const int nt = IN(10) ? __builtin_amdgcn_readfirstlane(((LAS int*)(F.lds + MT_NT))[0]) : moe_tables(F, true);
        pg8::Gemm g{(const pb*)(ws + WS_A), (const pb*)(ws + WS_W2), nt * 256, NEXP * DM, FF / 2}; pg8::MoeOrder S{nt, DM / 256, F.G, F.vcu, (const LAS int*)nullptr, (const LAS int*)(F.lds + MT_E)};
        pg8::EpiFp8Row E{ws + WS_YB, DM, args.in[16], DM / 256};
        pg8::gemm_phase<pg8::EpiFp8Row, pg8::MoeOrder, true, true, true>(F.lds, g, S, E); } SEAM(11);
#endif
    if (IN(12)) REP(12) { p12_final(args, F, !ABL_NOMOE, IN(10)); }
#undef IN
#undef SEAM
}

extern "C" void kernel_launch(void* const* d_in, const int* in_sizes, int n_in, void* d_out, int out_size, void* d_ws, size_t ws_size, hipStream_t stream) {
    static int grid = 0;
    if (grid == 0) {
        if (n_in != 18 || in_sizes[0] != TOK * DM || out_size != TOK * DM || ws_size < WS_END) { fprintf(stderr, "kernel_launch: unexpected shapes n_in %d in0 %d out %d ws %zu\n", n_in, n_in > 0 ? in_sizes[0] : -1, out_size, ws_size); grid = -1; return; }
        int dev = 0, cus = 0, per_cu = 0;
        if (hipGetDevice(&dev) != hipSuccess || hipDeviceGetAttribute(&cus, hipDeviceAttributeMultiprocessorCount, dev) != hipSuccess) { grid = -1; return; }
        if (hipFuncSetAttribute((const void*)mk_fwd, hipFuncAttributeMaxDynamicSharedMemorySize, LDS_BYTES) != hipSuccess) { fprintf(stderr, "kernel_launch: hipFuncSetAttribute failed\n"); grid = -1; return; }
        if (hipOccupancyMaxActiveBlocksPerMultiprocessor(&per_cu, (const void*)mk_fwd, NTHR, LDS_BYTES) != hipSuccess || per_cu < 1) fprintf(stderr, "kernel_launch: occupancy query says %d\n", per_cu);
        (void)hipGetLastError();
        grid = cus;
        if (grid != 256) fprintf(stderr, "kernel_launch: %d CUs (built for 256)\n", grid);
    }
    if (grid < 0) return;
    (void)hipMemsetAsync((char*)d_ws + WS_CTL, 0, CTL_ZERO_BYTES, stream);
    Args a{};
    for (int i = 0; i < 18; ++i) a.in[i] = (const float*)d_in[i];
    a.out = (float*)d_out; a.ws = (unsigned char*)d_ws;
#if ONE_LAUNCH
    a.ph_lo = 0; a.ph_hi = NPHASE;
    hipLaunchKernelGGL(mk_fwd, dim3(grid), dim3(NTHR), LDS_BYTES, stream, a);
#else
    for (int p = 0; p < NPHASE; ++p) {
#if ABL_NOMIX
        if (p >= 1 && p <= 6) continue;
#endif
#if ABL_NOMOE
        if (p >= 8 && p <= 11) continue;
#endif
        a.ph_lo = p; a.ph_hi = p + 1;
        hipLaunchKernelGGL(mk_fwd, dim3(grid), dim3(NTHR), LDS_BYTES, stream, a);
    }
#endif
}
```

```cpp
#include <hip/hip_runtime.h>
#include <cstdio>
#include <cstdint>
namespace pg8 {
#define PG8_LAS __attribute__((address_space(3)))
typedef unsigned short bf16_t;
typedef short bf16x8 __attribute__((ext_vector_type(8)));
typedef float f32x4 __attribute__((ext_vector_type(4)));
typedef unsigned u32x4 __attribute__((ext_vector_type(4)));
constexpr int BM = 256, BK = 64, HALF = 128, HTB = HALF * BK * 2  , STAGE_BYTES = 8 * HTB, NXCD = 8, WGM = 4;

__host__ __device__ __forceinline__ int lds_byte(int r, int c) { const int st = (r >> 4) * 2 + (c >> 5), rr = r & 15, cc = c & 31, ob = rr * 64 + cc * 2; return st * 1024 + (ob ^ (((ob >> 9) & 1) << 5)); }
__host__ __device__ __forceinline__ void stage_rc(int b, int& R, int& C) { const int st = b / 1024, sb = b % 1024, swz = sb ^ (((sb >> 9) & 1) << 5); R = (st >> 1) * 16 + swz / 64; C = (st & 1) * 32 + (swz % 64) / 2; }
__host__ __device__ __forceinline__ int perm32(int rho) { const int n = rho >> 4, i = rho & 15; return 8 * (i >> 2) + 4 * n + (i & 3); }

struct Unit { int pm, pn, po; };
struct Gemm { const bf16_t* A; const bf16_t* Bt; int M, N, K; };

struct StaticOrder {
    static constexpr bool GATHER = false;
    int nM, nN, nwg, G, c;
    __host__ __device__ void init(int M, int N, int G_, int c_) { nM = M / BM; nN = N / BM; nwg = nM * nN; G = G_; c = c_; }
    __host__ __device__ bool next(int i, Unit& u) const {
        const long L = (long)i * G + c; if (L >= nwg) return false;
        int wgid = (int)L; { const int q = nwg / NXCD, r = nwg % NXCD, xcd = wgid % NXCD, off = wgid / NXCD; wgid = (xcd < r ? xcd * (q + 1) : r * (q + 1) + (xcd - r) * q) + off; }
        const int nig = WGM * nN, gid = wgid / nig, fm = gid * WGM, gsz = (nM - fm) < WGM ? (nM - fm) : WGM;
        u.pm = fm + ((wgid % nig) % gsz); u.pn = (wgid % nig) / gsz; u.po = u.pm; return true;
    }
    __device__ __forceinline__ void a_ready(const Unit&) const {}
    __device__ __forceinline__ void done(const Unit&) const {}
};

__device__ __forceinline__ unsigned cvt_pk_bf16(float lo, float hi) { unsigned r; asm volatile("v_cvt_pk_bf16_f32 %0, %1, %2" : "=v"(r) : "v"(lo), "v"(hi)); return r; }
typedef float f32x2 __attribute__((ext_vector_type(2)));
__device__ __forceinline__ f32x2 gelu_pk(f32x2 v) {
    const f32x2 av = __builtin_elementwise_abs(v), d = av * 0.2316418882f + 1.0f;
    f32x2 t; t.x = __builtin_amdgcn_rcpf(d.x); t.y = __builtin_amdgcn_rcpf(d.y);
    f32x2 q = t * 0.5307027145f + (-0.7265760135f); q = q * t + 0.7107068705f; q = q * t + (-0.142248368f); q = q * t + 0.127414796f; q = q * t;
    const f32x2 s = (v * v) * (-0.72134752044f);
    f32x2 e; e.x = __builtin_amdgcn_exp2f(s.x); e.y = __builtin_amdgcn_exp2f(s.y);
    const f32x2 m = v * (q * e), r = v - m;
    f32x2 o; o.x = v.x < 0.f ? m.x : r.x; o.y = v.y < 0.f ? m.y : r.y; return o;
}

template <int ACT  > struct EpiBf16 {
    static constexpr bool PERM = true, AFTER_DRAIN = false; static constexpr int MID_T = 0; static_assert(ACT == 0 || ACT == 1, "EpiBf16: ACT is 0 (none) or 1 (gelu_pk)");
    bf16_t* O; int ldc; const float* bias; int split_cols; size_t split_stride; float scale0;
    __device__ __forceinline__ void operator()(const f32x4 (&acc)[2][2][4][2], const Unit& u, int wr, int wc, int fr, int fq) const {
        const int row0 = u.pm * BM + wr * 64 + fr; int colt = u.pn * BM; bf16_t* base = O;
        float sc = 1.f; if (split_cols) { const int t = colt / split_cols; base += (size_t)t * split_stride; colt -= t * split_cols; if (t == 0) sc = scale0; }
        const int col0 = colt + wc * 32 + 8 * fq, bcol0 = u.pn * BM + wc * 32 + 8 * fq;
        f32x4 bv[2][2];
#pragma unroll
        for (int bj = 0; bj < 2; ++bj)
#pragma unroll
            for (int n = 0; n < 2; ++n) bv[bj][n] = bias ? *(const f32x4*)(bias + bcol0 + bj * HALF + 4 * n) : (f32x4){0.f, 0.f, 0.f, 0.f};
#pragma unroll
        for (int ai = 0; ai < 2; ++ai)
#pragma unroll
            for (int m = 0; m < 4; ++m) { bf16_t* rowp = base + (size_t)(row0 + ai * HALF + m * 16) * ldc + col0;
#pragma unroll
                for (int bj = 0; bj < 2; ++bj) { f32x4 v0 = acc[ai][bj][m][0] + bv[bj][0], v1 = acc[ai][bj][m][1] + bv[bj][1];
                    if (ACT == 1) { f32x2 a = gelu_pk((f32x2){v0[0], v0[1]}), b = gelu_pk((f32x2){v0[2], v0[3]}), c = gelu_pk((f32x2){v1[0], v1[1]}), d = gelu_pk((f32x2){v1[2], v1[3]});
                        v0 = (f32x4){a.x, a.y, b.x, b.y}; v1 = (f32x4){c.x, c.y, d.x, d.y}; }
                    v0 = v0 * sc; v1 = v1 * sc; u32x4 w; w.x = cvt_pk_bf16(v0[0], v0[1]); w.y = cvt_pk_bf16(v0[2], v0[3]); w.z = cvt_pk_bf16(v1[0], v1[1]); w.w = cvt_pk_bf16(v1[2], v1[3]);
                    *(u32x4*)(rowp + bj * HALF) = w; } }
    }
};
__device__ __forceinline__ float bf_lo(unsigned w) { return __uint_as_float(w << 16); }
__device__ __forceinline__ float bf_hi(unsigned w) { return __uint_as_float(w & 0xffff0000u); }
__device__ __forceinline__ float sigmf(float x) { return __builtin_amdgcn_rcpf(1.0f + __expf(-x)); }

template <int MIDT> struct EpiGate2 {
    static constexpr bool PERM = true, AFTER_DRAIN = false; static constexpr int MID_T = MIDT;
    bf16_t* O; int ldc; const unsigned char* Ga; const unsigned char* Gb; size_t gblk;
    __device__ __forceinline__ void mid(f32x4 (&acc)[2][2][4][2], const Unit& u, int wr, int wc, int fr, int fq) const {
        int row0 = u.pm * BM + wr * 64 + fr, col0 = wc * 32 + 8 * fq;
        asm volatile("" : "+v"(row0), "+v"(col0));
        const unsigned char* Gat = Ga + (size_t)u.pn * gblk; const unsigned char* Gbt = Gb + (size_t)u.pn * gblk;
        typedef int i32x2 __attribute__((ext_vector_type(2))); typedef float f32x2_ __attribute__((ext_vector_type(2)));
#pragma unroll
        for (int ai = 0; ai < 2; ++ai) { i32x2 qa[4][2], qb[4][2];
#pragma unroll
            for (int m = 0; m < 4; ++m)
#pragma unroll
                for (int bj = 0; bj < 2; ++bj) { const size_t o = (size_t)(row0 + ai * HALF + m * 16) * 256 + (col0 + bj * HALF); qa[m][bj] = *(const i32x2*)(Gat + o); qb[m][bj] = *(const i32x2*)(Gbt + o); }
#pragma unroll
            for (int m = 0; m < 4; ++m)
#pragma unroll
                for (int bj = 0; bj < 2; ++bj) { const i32x2 a = qa[m][bj], b = qb[m][bj];
#define RAT_(x, y) ((1.0f + __expf(-(y))) * __builtin_amdgcn_rcpf(1.0f + __expf(-(x))))
                    const f32x2_ a0 = __builtin_amdgcn_cvt_pk_f32_fp8(a.x, false), a1 = __builtin_amdgcn_cvt_pk_f32_fp8(a.x, true), a2 = __builtin_amdgcn_cvt_pk_f32_fp8(a.y, false), a3 = __builtin_amdgcn_cvt_pk_f32_fp8(a.y, true);
                    const f32x2_ b0 = __builtin_amdgcn_cvt_pk_f32_fp8(b.x, false), b1 = __builtin_amdgcn_cvt_pk_f32_fp8(b.x, true), b2 = __builtin_amdgcn_cvt_pk_f32_fp8(b.y, false), b3 = __builtin_amdgcn_cvt_pk_f32_fp8(b.y, true);
                    f32x4 v0 = acc[ai][bj][m][0], v1 = acc[ai][bj][m][1];
                    v0[0] *= RAT_(a0.x, b0.x); v0[1] *= RAT_(a0.y, b0.y); v0[2] *= RAT_(a1.x, b1.x); v0[3] *= RAT_(a1.y, b1.y);
                    v1[0] *= RAT_(a2.x, b2.x); v1[1] *= RAT_(a2.y, b2.y); v1[2] *= RAT_(a3.x, b3.x); v1[3] *= RAT_(a3.y, b3.y);
#undef RAT_
                    acc[ai][bj][m][0] = v0; acc[ai][bj][m][1] = v1; }
            asm volatile("" ::: "memory"); }
    }
    __device__ __forceinline__ void operator()(const f32x4 (&acc)[2][2][4][2], const Unit& u, int wr, int wc, int fr, int fq) const {
        const int row0 = u.pm * BM + wr * 64 + fr, col0 = u.pn * BM + wc * 32 + 8 * fq;
        typedef int i32x2 __attribute__((ext_vector_type(2))); typedef float f32x2_ __attribute__((ext_vector_type(2)));
        i32x2 gq[2][4][2];
#pragma unroll
        for (int ai = 0; ai < 2; ++ai)
#pragma unroll
            for (int m = 0; m < 4; ++m)
#pragma unroll
                for (int bj = 0; bj < 2; ++bj) gq[ai][m][bj] = *(const i32x2*)(Gb + (size_t)u.pn * gblk + (size_t)(row0 + ai * HALF + m * 16) * 256 + (col0 + bj * HALF - u.pn * BM));
#pragma unroll
        for (int ai = 0; ai < 2; ++ai)
#pragma unroll
            for (int m = 0; m < 4; ++m) { const size_t row = (size_t)(row0 + ai * HALF + m * 16);
#pragma unroll
                for (int bj = 0; bj < 2; ++bj) { const int col = col0 + bj * HALF;
                    const i32x2 g = gq[ai][m][bj];
                    const f32x2_ g0 = __builtin_amdgcn_cvt_pk_f32_fp8(g.x, false), g1 = __builtin_amdgcn_cvt_pk_f32_fp8(g.x, true), g2 = __builtin_amdgcn_cvt_pk_f32_fp8(g.y, false), g3 = __builtin_amdgcn_cvt_pk_f32_fp8(g.y, true);
                    f32x4 v0 = acc[ai][bj][m][0], v1 = acc[ai][bj][m][1];
                    v0[0] *= sigmf(g0.x); v0[1] *= sigmf(g0.y); v0[2] *= sigmf(g1.x); v0[3] *= sigmf(g1.y);
                    v1[0] *= sigmf(g2.x); v1[1] *= sigmf(g2.y); v1[2] *= sigmf(g3.x); v1[3] *= sigmf(g3.y);
                    u32x4 w; w.x = cvt_pk_bf16(v0[0], v0[1]); w.y = cvt_pk_bf16(v0[2], v0[3]); w.z = cvt_pk_bf16(v1[0], v1[1]); w.w = cvt_pk_bf16(v1[2], v1[3]);
                    *(u32x4*)(O + row * ldc + col) = w; } }
    }
};
struct EpiResid {
    static constexpr bool PERM = true, AFTER_DRAIN = false; static constexpr int MID_T = 0;
    bf16_t* O; const float* base; int ldc; const float* gvec; int gstride; int tiles_per_b;
    __device__ __forceinline__ void operator()(const f32x4 (&acc)[2][2][4][2], const Unit& u, int wr, int wc, int fr, int fq) const {
        const int row0 = u.pm * BM + wr * 64 + fr, col0 = u.pn * BM + wc * 32 + 8 * fq;
        const float* gv = gvec + (size_t)(u.pm / tiles_per_b) * gstride;
#pragma unroll
        for (int bj = 0; bj < 2; ++bj) { const int col = col0 + bj * HALF; const f32x4 g0 = *(const f32x4*)(gv + col), g1 = *(const f32x4*)(gv + col + 4);
#pragma unroll
            for (int ai = 0; ai < 2; ++ai)
#pragma unroll
                for (int m = 0; m < 4; ++m) { const size_t off = (size_t)(row0 + ai * HALF + m * 16) * ldc + col;
                    const f32x4 b0 = *(const f32x4*)(base + off), b1 = *(const f32x4*)(base + off + 4);
                    const f32x4 r0 = b0 + g0 * acc[ai][bj][m][0], r1 = b1 + g1 * acc[ai][bj][m][1];
                    typedef float f32x2_ __attribute__((ext_vector_type(2))); typedef __bf16 bf16x2_ __attribute__((ext_vector_type(2)));
                    u32x4 o;
                    o.x = __builtin_bit_cast(unsigned, __builtin_convertvector((f32x2_){r0[0], r0[1]}, bf16x2_)); o.y = __builtin_bit_cast(unsigned, __builtin_convertvector((f32x2_){r0[2], r0[3]}, bf16x2_));
                    o.z = __builtin_bit_cast(unsigned, __builtin_convertvector((f32x2_){r1[0], r1[1]}, bf16x2_)); o.w = __builtin_bit_cast(unsigned, __builtin_convertvector((f32x2_){r1[2], r1[3]}, bf16x2_));
                    *(u32x4*)(O + off) = o; } }
    }
};
struct EpiSwiglu {
    static constexpr bool PERM = true, AFTER_DRAIN = false; static constexpr int MID_T = 0;
    bf16_t* O; int lda; const float* bias; int nN;
    __device__ __forceinline__ int act4(const f32x4& v0, const f32x4& v1) const {
        f32x4 G = (f32x4){v0[0], v0[2], v1[0], v1[2]}, L = (f32x4){v0[1], v0[3], v1[1], v1[3]};
        G = __builtin_elementwise_min(G, (f32x4){7.f, 7.f, 7.f, 7.f});
        L = __builtin_elementwise_min(__builtin_elementwise_max(L, (f32x4){-7.f, -7.f, -7.f, -7.f}), (f32x4){7.f, 7.f, 7.f, 7.f}) + 1.0f;
        const f32x4 X = G * (-1.702f * 1.4426950408889634f);
        f32x4 S; S[0] = __builtin_amdgcn_exp2f(X[0]); S[1] = __builtin_amdgcn_exp2f(X[1]); S[2] = __builtin_amdgcn_exp2f(X[2]); S[3] = __builtin_amdgcn_exp2f(X[3]);
        S = S + 1.0f; S[0] = __builtin_amdgcn_rcpf(S[0]); S[1] = __builtin_amdgcn_rcpf(S[1]); S[2] = __builtin_amdgcn_rcpf(S[2]); S[3] = __builtin_amdgcn_rcpf(S[3]);
        const f32x4 A4 = G * S * L;
        int w8 = 0; w8 = __builtin_amdgcn_cvt_pk_fp8_f32(A4[0], A4[1], w8, false); w8 = __builtin_amdgcn_cvt_pk_fp8_f32(A4[2], A4[3], w8, true); return w8;
    }
    __device__ __forceinline__ void operator()(const f32x4 (&acc)[2][2][4][2], const Unit& u, int wr, int wc, int fr, int fq) const {
        const int row0 = u.po * BM + wr * 64 + fr; const int pnl = u.pn % nN;
        const int bcol0 = u.pn * BM + wc * 32 + 8 * fq; const bool odd = (fq & 1) != 0;
        const int bytecol = (pnl * BM + wc * 32 + 8 * (fq & ~1)) / 2 + (odd ? 64 : 0);
        f32x4 bv[2][2];
#pragma unroll
        for (int bj = 0; bj < 2; ++bj)
#pragma unroll
            for (int n = 0; n < 2; ++n) bv[bj][n] = *(const f32x4*)(bias + bcol0 + bj * HALF + 4 * n);
        typedef int i32x2 __attribute__((ext_vector_type(2)));
#pragma unroll
        for (int ai = 0; ai < 2; ++ai)
#pragma unroll
            for (int m = 0; m < 4; ++m) {
                const int wA = act4(acc[ai][0][m][0] + bv[0][0], acc[ai][0][m][1] + bv[0][1]), wB = act4(acc[ai][1][m][0] + bv[1][0], acc[ai][1][m][1] + bv[1][1]);
                const int recv = __shfl_xor(odd ? wA : wB, 16);
                *(i32x2*)((unsigned char*)O + (size_t)(row0 + ai * HALF + m * 16) * lda + bytecol) = odd ? (i32x2){recv, wB} : (i32x2){wA, recv}; }
    }
};
struct EpiFp8Blk {
    static constexpr bool PERM = true, AFTER_DRAIN = false; static constexpr int MID_T = 0;
    unsigned char* O; size_t blk;
    __device__ __forceinline__ void operator()(const f32x4 (&acc)[2][2][4][2], const Unit& u, int wr, int wc, int fr, int fq) const {
        const bool odd = (fq & 1) != 0;
        const int row0 = u.pm * BM + wr * 64 + fr, col0 = wc * 32 + 8 * (fq & ~1) + (odd ? HALF : 0); unsigned char* base = O + (size_t)u.pn * blk;
#pragma unroll
        for (int ai = 0; ai < 2; ++ai)
#pragma unroll
            for (int m = 0; m < 4; ++m) { unsigned char* rowp = base + (size_t)(row0 + ai * HALF + m * 16) * 256 + col0; int w[2][2];
#pragma unroll
                for (int bj = 0; bj < 2; ++bj) { const f32x4 v0 = acc[ai][bj][m][0], v1 = acc[ai][bj][m][1]; int w0 = 0, w1 = 0;
                    w0 = __builtin_amdgcn_cvt_pk_fp8_f32(v0[0], v0[1], w0, false); w0 = __builtin_amdgcn_cvt_pk_fp8_f32(v0[2], v0[3], w0, true);
                    w1 = __builtin_amdgcn_cvt_pk_fp8_f32(v1[0], v1[1], w1, false); w1 = __builtin_amdgcn_cvt_pk_fp8_f32(v1[2], v1[3], w1, true); w[bj][0] = w0; w[bj][1] = w1; }
                const int r0 = __shfl_xor(odd ? w[0][0] : w[1][0], 16), r1 = __shfl_xor(odd ? w[0][1] : w[1][1], 16);
                *(u32x4*)rowp = odd ? (u32x4){(unsigned)r0, (unsigned)r1, (unsigned)w[1][0], (unsigned)w[1][1]} : (u32x4){(unsigned)w[0][0], (unsigned)w[0][1], (unsigned)r0, (unsigned)r1}; }
    }
};
struct EpiMixed {
    static constexpr bool PERM = true, AFTER_DRAIN = false; static constexpr int MID_T = 0;
    EpiBf16<0> a; EpiFp8Blk b; int nb16;
    __device__ __forceinline__ void operator()(const f32x4 (&acc)[2][2][4][2], const Unit& u, int wr, int wc, int fr, int fq) const {
        if (u.pn < nb16) a(acc, u, wr, wc, fr, fq); else { Unit v = u; v.pn -= nb16; b(acc, v, wr, wc, fr, fq); }
    }
};
struct EpiFp8Row {
    static constexpr bool PERM = true, AFTER_DRAIN = false; static constexpr int MID_T = 0;
    unsigned char* O; int ldc; const float* bias; int nN;
    __device__ __forceinline__ void operator()(const f32x4 (&acc)[2][2][4][2], const Unit& u, int wr, int wc, int fr, int fq) const {
        const bool odd = (fq & 1) != 0;
        const int row0 = u.po * BM + wr * 64 + fr, col0 = (u.pn % nN) * BM + wc * 32 + 8 * (fq & ~1) + (odd ? HALF : 0), bcol0 = u.pn * BM + wc * 32 + 8 * fq;
        f32x4 bv[2][2];
#pragma unroll
        for (int bj = 0; bj < 2; ++bj)
#pragma unroll
            for (int n = 0; n < 2; ++n) bv[bj][n] = *(const f32x4*)(bias + bcol0 + bj * HALF + 4 * n);
#pragma unroll
        for (int ai = 0; ai < 2; ++ai)
#pragma unroll
            for (int m = 0; m < 4; ++m) { unsigned char* rowp = O + (size_t)(row0 + ai * HALF + m * 16) * ldc + col0; int w[2][2];
#pragma unroll
                for (int bj = 0; bj < 2; ++bj) { const f32x4 v0 = acc[ai][bj][m][0] + bv[bj][0], v1 = acc[ai][bj][m][1] + bv[bj][1]; int w0 = 0, w1 = 0;
                    w0 = __builtin_amdgcn_cvt_pk_fp8_f32(v0[0], v0[1], w0, false); w0 = __builtin_amdgcn_cvt_pk_fp8_f32(v0[2], v0[3], w0, true);
                    w1 = __builtin_amdgcn_cvt_pk_fp8_f32(v1[0], v1[1], w1, false); w1 = __builtin_amdgcn_cvt_pk_fp8_f32(v1[2], v1[3], w1, true); w[bj][0] = w0; w[bj][1] = w1; }
                const int r0 = __shfl_xor(odd ? w[0][0] : w[1][0], 16), r1 = __shfl_xor(odd ? w[0][1] : w[1][1], 16);
                *(u32x4*)rowp = odd ? (u32x4){(unsigned)r0, (unsigned)r1, (unsigned)w[1][0], (unsigned)w[1][1]} : (u32x4){(unsigned)w[0][0], (unsigned)w[0][1], (unsigned)r0, (unsigned)r1}; }
    }
};
struct MoeOrder {
    static constexpr bool GATHER = false;
    int ntiles, nN, G, c; const PG8_LAS int* tpm; const PG8_LAS int* te; bool xmap = false;
    __device__ bool next(int i, Unit& u) const {
        int t, pnl;
        if (xmap) {
            const int x = c >> 5, r = c & 31, base = ntiles >> 3, rem = ntiles & 7, nx = base + (x < rem ? 1 : 0), start = x * base + (x < rem ? x : rem), l = r + 32 * i;
            if (l >= nN * nx) return false; t = start + l / nN; pnl = l % nN; }
        else { const long L = (long)i * G + c; if (L >= (long)ntiles * nN) return false; t = (int)(L / nN); pnl = (int)(L % nN); }
        u.pm = tpm ? __builtin_amdgcn_readfirstlane(tpm[t]) : t; u.po = t; u.pn = __builtin_amdgcn_readfirstlane(te[t]) * nN + pnl; return true;
    }
    __device__ __forceinline__ void a_ready(const Unit&) const {}
    __device__ __forceinline__ void done(const Unit&) const {}
};
struct MoeGather : MoeOrder {
    static constexpr bool GATHER = true;
    const int* idx; PG8_LAS int* idxl; int maxrow;
};

struct SplitOrder : StaticOrder {
    int nx, ny;
    __device__ bool next(int i, Unit& u) const {
        const int half = G >> 1, grp = (c >> 3) & 1, ci = ((c >> 4) << 3) | (c & 7);
        long L; if (grp == 0) { if (i >= nx) return false; L = (long)i * half + ci; } else { if (i >= ny) return false; L = (long)nx * half + (long)i * half + ci; }
        if (L >= nwg) return false;
        int wgid = (int)L; { const int q = nwg / NXCD, r = nwg % NXCD, xcd = wgid % NXCD, off = wgid / NXCD; wgid = (xcd < r ? xcd * (q + 1) : r * (q + 1) + (xcd - r) * q) + off; }
        const int nig = WGM * nN, gid = wgid / nig, fm = gid * WGM, gsz = (nM - fm) < WGM ? (nM - fm) : WGM;
        u.pm = fm + ((wgid % nig) % gsz); u.pn = (wgid % nig) / gsz; u.po = u.pm; return true;
    }
};
typedef int v4i_ __attribute__((ext_vector_type(4))); typedef int v8i_ __attribute__((ext_vector_type(8)));
template <bool F8> struct FragT { bf16x8 h[2]; __device__ __forceinline__ void set(int k, bf16x8 v) { h[k] = v; } };
template <> struct FragT<true> { v8i_ w; __device__ __forceinline__ void set(int k, bf16x8 v) { if (k == 0) w.lo = __builtin_bit_cast(v4i_, v); else w.hi = __builtin_bit_cast(v4i_, v); } };
template <class Epi, class Sched, bool ALIGN_EPI = false, bool SP2 = false, bool F8 = false>
__device__ __forceinline__ void gemm_phase(PG8_LAS unsigned char* lds, const Gemm g, const Sched& S, const Epi& E) {
    int tid = threadIdx.x; asm volatile("" : "+v"(tid));
    const int wid = __builtin_amdgcn_readfirstlane(tid >> 6), lane = tid & 63, wr = wid >> 2, wc = wid & 3, fr = lane & 15, fq = lane >> 4;
    const int K = g.K, nt = K / BK;
    unsigned voffA[2], voffB[2];
#pragma unroll
    for (int i = 0; i < 2; ++i) { int R, C; stage_rc(tid * 16 + i * 8192, R, C); const int Rb = Epi::PERM ? ((R & ~31) + perm32(R & 31)) : R;
        voffA[i] = (unsigned)(R * K + C) * 2u; voffB[i] = (unsigned)(Rb * K + C) * 2u; }
    constexpr bool GA = Sched::GATHER;
    unsigned gc[2][2];
    static_assert(!GA || SP2, "gather is wired into the SP2 loop only");
    auto dma_idx = [&](int slot, const Unit& u) { if constexpr (GA) { if (wid < 4) __builtin_amdgcn_global_load_lds((const unsigned*)(S.idx + (size_t)u.pm * 256 + wid * 64 + lane), (PG8_LAS unsigned*)(S.idxl + slot * 256 + wid * 64), 4, 0, 0); } };
    auto fetch_half = [&](int slot, int h, unsigned (&dst)[2]) { if constexpr (GA) {
        _Pragma("unroll") for (int i = 0; i < 2; ++i) { int R, C; stage_rc(tid * 16 + i * 8192, R, C);
            const unsigned tok = (unsigned)S.idxl[slot * 256 + h * HALF + R]; dst[i] = (tok < (unsigned)S.maxrow ? tok : (unsigned)S.maxrow) * (unsigned)(K * 2) + (unsigned)(C * 2); } } };
    const size_t kstep = (size_t)(BK * 2);
    const size_t hstep = (size_t)HALF * K * 2;
    const size_t tstep = 2 * hstep;
    const unsigned ldsw = (unsigned)wid * 1024u;
    const int aoff = lds_byte(wr * 64 + fr, fq * 8), boff = lds_byte(wc * 32 + fr, fq * 8);
#define PG8_SA(b, h) (((b) * 2 + (h)) * HTB)
#define PG8_SB(b, h) ((4 + (b) * 2 + (h)) * HTB)
#define PG8_STAGE(bufoff, gbase, voff) do { _Pragma("unroll") for (int _i = 0; _i < 2; ++_i) \
        __builtin_amdgcn_global_load_lds((const unsigned*)((const char*)(gbase) + (voff)[_i]), (PG8_LAS unsigned*)(lds + (bufoff) + ldsw + _i * 8192), 16, 0, 0); } while (0)
#define PG8_STAGE_A(bufoff, gbase, h, goff) do { if constexpr (GA) { PG8_STAGE(bufoff, gbase, goff); } else { PG8_STAGE(bufoff, (gbase) + (h) * hstep, voffA); } } while (0)
#define PG8_LDA(dst, b, h) do { _Pragma("unroll") for (int m = 0; m < 4; ++m) _Pragma("unroll") for (int k = 0; k < 2; ++k) dst[m].set(k, *(const PG8_LAS bf16x8*)(lds + PG8_SA(b, h) + aoff + m * 2048 + k * 1024)); } while (0)
#define PG8_LDB(dst, b, h) do { _Pragma("unroll") for (int n = 0; n < 2; ++n) _Pragma("unroll") for (int k = 0; k < 2; ++k) dst[n].set(k, *(const PG8_LAS bf16x8*)(lds + PG8_SB(b, h) + boff + n * 2048 + k * 1024)); } while (0)
#define PG8_MMA(ai, bj, At, Bt) do { __builtin_amdgcn_s_setprio(1); \
        if constexpr (F8) { _Pragma("unroll") for (int m = 0; m < 4; ++m) _Pragma("unroll") for (int n = 0; n < 2; ++n) \
            asm volatile("v_mfma_scale_f32_16x16x128_f8f6f4 %0, %1, %2, %0, %3, %4 op_sel_hi:[0,0,0]" : "+v"(acc[ai][bj][m][n]) : "v"(Bt[n].w), "v"(At[m].w), "v"(sc_w), "v"(sc_x)); \
        } else { _Pragma("unroll") for (int k = 0; k < 2; ++k) _Pragma("unroll") for (int m = 0; m < 4; ++m) _Pragma("unroll") for (int n = 0; n < 2; ++n) \
            asm volatile("v_mfma_f32_16x16x32_bf16 %0, %1, %2, %0" : "+v"(acc[ai][bj][m][n]) : "v"(Bt[n].h[k]), "v"(At[m].h[k])); } \
        __builtin_amdgcn_s_setprio(0); } while (0)
#define PG8_MMAZ(ai, bj, At, Bt, z) do { if (z) { __builtin_amdgcn_s_setprio(1); \
        if constexpr (F8) { _Pragma("unroll") for (int m = 0; m < 4; ++m) _Pragma("unroll") for (int n = 0; n < 2; ++n) \
            asm volatile("v_mfma_scale_f32_16x16x128_f8f6f4 %0, %1, %2, 0, %3, %4 op_sel_hi:[0,0,0]" : "=&v"(acc[ai][bj][m][n]) : "v"(Bt[n].w), "v"(At[m].w), "v"(sc_w), "v"(sc_x)); \
        } else { _Pragma("unroll") for (int m = 0; m < 4; ++m) _Pragma("unroll") for (int n = 0; n < 2; ++n) \
            asm volatile("v_mfma_f32_16x16x32_bf16 %0, %1, %2, 0" : "=&v"(acc[ai][bj][m][n]) : "v"(Bt[n].h[0]), "v"(At[m].h[0])); \
          _Pragma("unroll") for (int m = 0; m < 4; ++m) _Pragma("unroll") for (int n = 0; n < 2; ++n) \
            asm volatile("v_mfma_f32_16x16x32_bf16 %0, %1, %2, %0" : "+v"(acc[ai][bj][m][n]) : "v"(Bt[n].h[1]), "v"(At[m].h[1])); } \
        __builtin_amdgcn_s_setprio(0); } else PG8_MMA(ai, bj, At, Bt); } while (0)
#define PG8_WAIT_V(n) asm volatile("s_waitcnt vmcnt(" #n ")" ::: "memory")
#define PG8_WAIT_L(n) asm volatile("s_waitcnt lgkmcnt(" #n ")" ::: "memory")
#define PG8_BAR __builtin_amdgcn_s_barrier()
#define PG8_SCHED __builtin_amdgcn_sched_barrier(0)
    Unit cur, nxt; int ui = 0;
    if (!S.next(0, cur)) return;
    f32x4 acc[2][2][4][2];
#pragma unroll
    for (int a = 0; a < 2; ++a)
#pragma unroll
        for (int b = 0; b < 2; ++b)
#pragma unroll
            for (int m = 0; m < 4; ++m)
#pragma unroll
                for (int n = 0; n < 2; ++n) { if constexpr (!SP2) acc[a][b][m][n] = (f32x4){0.f, 0.f, 0.f, 0.f}; }
    FragT<F8> At[4], B0[2], B1[2];
    int sc_w = 0x7a7a7a7a, sc_x = 0x7f7f7f7f;
    if constexpr (F8) { asm volatile("" : "+v"(sc_w), "+v"(sc_x)); }
    const char* cA = (const char*)g.A + (GA ? (size_t)0 : (size_t)cur.pm * tstep); const char* cB = (const char*)g.Bt + (size_t)cur.pn * tstep;
    S.a_ready(cur);
    if constexpr (GA) { dma_idx(0, cur); PG8_WAIT_V(0); PG8_BAR; fetch_half(0, 0, gc[0]); fetch_half(0, 1, gc[1]); }
    if constexpr (SP2) {
        PG8_STAGE(PG8_SB(0, 0), cB, voffB); PG8_STAGE(PG8_SB(0, 1), cB + hstep, voffB); PG8_STAGE_A(PG8_SA(0, 0), cA, 0, gc[0]); PG8_STAGE_A(PG8_SA(0, 1), cA, 1, gc[1]);
        if (wr == 1) PG8_BAR;
        PG8_WAIT_V(2); PG8_BAR;
        PG8_STAGE(PG8_SB(1, 0), cB + kstep, voffB); PG8_STAGE_A(PG8_SA(1, 0), cA + kstep, 0, gc[0]); PG8_STAGE(PG8_SB(1, 1), cB + hstep + kstep, voffB);
        PG8_WAIT_V(6); PG8_BAR;
    } else {
        PG8_STAGE(PG8_SB(0, 0), cB, voffB); PG8_STAGE(PG8_SA(0, 0), cA, voffA); PG8_STAGE(PG8_SB(0, 1), cB + hstep, voffB); PG8_STAGE(PG8_SA(0, 1), cA + hstep, voffA);
        if (wr == 1) PG8_BAR;
        PG8_WAIT_V(4); PG8_BAR;
        PG8_STAGE(PG8_SB(1, 0), cB + kstep, voffB); PG8_STAGE(PG8_SA(1, 0), cA + kstep, voffA); PG8_STAGE(PG8_SB(1, 1), cB + hstep + kstep, voffB);
        PG8_WAIT_V(6); PG8_BAR;
    }
    for (;;) {
        const bool has_next = S.next(ui + 1, nxt);
        const char* nA = has_next ? (const char*)g.A + (GA ? (size_t)0 : (size_t)nxt.pm * tstep) : cA;
        if constexpr (GA) { if (has_next) dma_idx((ui + 1) & 1, nxt); } const char* nB = has_next ? (const char*)g.Bt + (size_t)nxt.pn * tstep : cB;
        for (int t = 0; t < nt; t += 2) {
            if constexpr (Epi::MID_T > 0) { if (t == Epi::MID_T) { if constexpr (F8) asm volatile("s_nop 15\n\ts_nop 3" ::: "memory"); E.mid(acc, cur, wr, wc, fr, fq); if constexpr (F8) asm volatile("s_nop 7" ::: "memory"); } }
            const bool last = (t == nt - 2);
            const char* a1 = cA + (size_t)(t + 1) * kstep;
            const char* a2 = last ? nA : cA + (size_t)(t + 2) * kstep; const char* b2 = last ? nB : cB + (size_t)(t + 2) * kstep;
            const char* a3 = a2 + kstep; const char* b3 = b2 + kstep;
            if (last && has_next) S.a_ready(nxt);
            if constexpr (GA) { if (last && has_next) fetch_half((ui + 1) & 1, 0, gc[0]); }
            if constexpr (SP2) {
            PG8_LDB(B0, 0, 0); PG8_LDB(B1, 0, 1); PG8_SCHED; PG8_LDA(At, 0, 0); PG8_STAGE_A(PG8_SA(1, 1), a1, 1, gc[1]);
            if constexpr (GA) { if (last && has_next) fetch_half((ui + 1) & 1, 1, gc[1]); }
            PG8_WAIT_V(8); PG8_WAIT_L(0); PG8_BAR; PG8_MMAZ(0, 0, At, B0, t == 0); PG8_MMAZ(0, 1, At, B1, t == 0); PG8_BAR; PG8_SCHED;
            PG8_LDA(At, 0, 1); PG8_STAGE(PG8_SB(0, 0), b2, voffB); PG8_STAGE(PG8_SB(0, 1), b2 + hstep, voffB); PG8_STAGE_A(PG8_SA(0, 0), a2, 0, gc[0]);
            PG8_WAIT_V(8); PG8_WAIT_L(0); PG8_BAR; PG8_MMAZ(1, 0, At, B0, t == 0); PG8_MMAZ(1, 1, At, B1, t == 0); PG8_BAR; PG8_SCHED;
            PG8_LDB(B0, 1, 0); PG8_LDB(B1, 1, 1); PG8_SCHED; PG8_LDA(At, 1, 0); PG8_STAGE_A(PG8_SA(0, 1), a2, 1, gc[1]);
            PG8_WAIT_V(8); PG8_WAIT_L(0); PG8_BAR; PG8_MMA(0, 0, At, B0); PG8_MMA(0, 1, At, B1); PG8_BAR; PG8_SCHED;
            PG8_LDA(At, 1, 1); PG8_STAGE(PG8_SB(1, 0), b3, voffB); PG8_STAGE(PG8_SB(1, 1), b3 + hstep, voffB); PG8_STAGE_A(PG8_SA(1, 0), a3, 0, gc[0]);
            PG8_WAIT_V(8); PG8_WAIT_L(0); PG8_BAR; PG8_MMA(1, 0, At, B0); PG8_MMA(1, 1, At, B1); PG8_BAR; PG8_SCHED;
            } else {
            PG8_LDB(B0, 0, 0); PG8_SCHED; PG8_LDA(At, 0, 0); PG8_STAGE(PG8_SA(1, 1), a1 + hstep, voffA);
            PG8_WAIT_L(8); PG8_BAR; PG8_WAIT_L(0); PG8_MMA(0, 0, At, B0); PG8_BAR; PG8_SCHED;
            PG8_LDB(B1, 0, 1); PG8_STAGE(PG8_SB(0, 0), b2, voffB);
            PG8_BAR; PG8_WAIT_L(0); PG8_MMA(0, 1, At, B1); PG8_BAR;
            PG8_LDA(At, 0, 1); PG8_STAGE(PG8_SA(0, 0), a2, voffA);
            PG8_BAR; PG8_WAIT_L(0); PG8_MMA(1, 0, At, B0); PG8_BAR; PG8_SCHED;
            PG8_STAGE(PG8_SB(0, 1), b2 + hstep, voffB);
            PG8_WAIT_V(6); PG8_BAR; PG8_MMA(1, 1, At, B1); PG8_BAR;
            PG8_LDB(B0, 1, 0); PG8_SCHED; PG8_LDA(At, 1, 0); PG8_STAGE(PG8_SA(0, 1), a2 + hstep, voffA);
            PG8_WAIT_L(8); PG8_BAR; PG8_WAIT_L(0); PG8_MMA(0, 0, At, B0); PG8_BAR; PG8_SCHED;
            PG8_LDB(B1, 1, 1); PG8_STAGE(PG8_SB(1, 0), b3, voffB);
            PG8_BAR; PG8_WAIT_L(0); PG8_MMA(0, 1, At, B1); PG8_BAR;
            PG8_LDA(At, 1, 1); PG8_STAGE(PG8_SA(1, 0), a3, voffA);
            PG8_BAR; PG8_WAIT_L(0); PG8_MMA(1, 0, At, B0); PG8_BAR; PG8_SCHED;
            PG8_STAGE(PG8_SB(1, 1), b3 + hstep, voffB);
            PG8_WAIT_V(6); PG8_BAR; PG8_MMA(1, 1, At, B1); PG8_BAR;
            }
        }
#define PG8_ACC8(a, b) "+v"(acc[a][b][0][0]), "+v"(acc[a][b][0][1]), "+v"(acc[a][b][1][0]), "+v"(acc[a][b][1][1]), "+v"(acc[a][b][2][0]), "+v"(acc[a][b][2][1]), "+v"(acc[a][b][3][0]), "+v"(acc[a][b][3][1])
        asm volatile("s_nop 15\n\ts_nop 3" : PG8_ACC8(0, 0), PG8_ACC8(0, 1) :: "memory"); asm volatile("" : PG8_ACC8(1, 0), PG8_ACC8(1, 1) :: "memory");
#undef PG8_ACC8
        if constexpr (ALIGN_EPI) { if (wr == 0) PG8_BAR; }
        if constexpr (!Epi::AFTER_DRAIN) { E(acc, cur, wr, wc, fr, fq); S.done(cur); }
        if (!has_next) break;
#pragma unroll
        for (int a = 0; a < 2; ++a)
#pragma unroll
            for (int b = 0; b < 2; ++b)
#pragma unroll
                for (int m = 0; m < 4; ++m)
#pragma unroll
                    for (int n = 0; n < 2; ++n) { if constexpr (!SP2) acc[a][b][m][n] = (f32x4){0.f, 0.f, 0.f, 0.f}; }
        cur = nxt; cA = nA; cB = nB; ++ui;
        if constexpr (ALIGN_EPI) { if (wr == 1) PG8_BAR; }
    }
    PG8_WAIT_V(0);
    if constexpr (!ALIGN_EPI) { if (wr == 0) PG8_BAR; }
    PG8_BAR;
    if constexpr (Epi::AFTER_DRAIN) { E.fused(acc, cur, wr, wc, fr, fq, lds, wid, lane); S.done(cur); }
#undef PG8_SA
#undef PG8_SB
#undef PG8_STAGE
#undef PG8_STAGE_A
#undef PG8_LDA
#undef PG8_LDB
#undef PG8_MMA
#undef PG8_MMAZ
#undef PG8_WAIT_V
#undef PG8_WAIT_L
#undef PG8_BAR
#undef PG8_SCHED
}
}
#define GAS __attribute__((address_space(1)))
#define LAS __attribute__((address_space(3)))
typedef unsigned short bf16;
typedef unsigned v4u __attribute__((ext_vector_type(4)));
typedef float f32x4 __attribute__((ext_vector_type(4)));
typedef short bf16x8 __attribute__((ext_vector_type(8)));
typedef GAS unsigned gu32;
typedef GAS unsigned long long gu64;
#define RLX_AGENT __ATOMIC_RELAXED, __HIP_MEMORY_SCOPE_AGENT
#define LDS_WAIT() asm volatile("s_waitcnt lgkmcnt(0)" ::: "memory")
#define VM_WAIT() asm volatile("s_waitcnt vmcnt(0)" ::: "memory")
__device__ __forceinline__ unsigned long long rt() { return __builtin_amdgcn_s_memrealtime(); }
__device__ __forceinline__ unsigned f2bf(float f) { unsigned u = __builtin_bit_cast(unsigned, f); return (u + 0x7fffu + ((u >> 16) & 1u)) >> 16; }
__device__ __forceinline__ unsigned pk2(float lo, float hi) { return f2bf(lo) | (f2bf(hi) << 16); }

#define XB_TMO      128
#define XB_XCNT(j)  (256  + 64 * (j))
#define XB_XSUB(j)  (1280 + 64 * (j))
#define XB_XGEN(j)  (2304 + 64 * (j))
#define XB_TOP      3328
#define XB_TOPGEN   3392
#define XCD_BAR_WORDS 3456
#define XB_SPIN_CAP (1u << 18)

__device__ __forceinline__ unsigned xb_ld(unsigned* p)              { return __hip_atomic_load(p, __ATOMIC_RELAXED, __HIP_MEMORY_SCOPE_AGENT); }
__device__ __forceinline__ unsigned xb_add(unsigned* p, unsigned v) { return __hip_atomic_fetch_add(p, v, __ATOMIC_RELAXED, __HIP_MEMORY_SCOPE_AGENT); }
__device__ __forceinline__ unsigned xb_xcc_id() { return (unsigned)__builtin_amdgcn_s_getreg((3 << 11) | 20) & 0xFu; }
#define XB_SPIN(cond, bar) do { unsigned _sp = 0; while (cond) { __builtin_amdgcn_s_sleep(1); \
    if ((++_sp & 255u) == 0u) { if (xb_ld(&(bar)[XB_TMO])) break; if (_sp > XB_SPIN_CAP) { atomicAdd(&(bar)[XB_TMO], 1u); break; } } } } while (0)

struct XcdBarrier {
    unsigned* bar; unsigned x;
    volatile LAS unsigned* st;
};

__device__ __forceinline__ XcdBarrier xcd_barrier_post(unsigned* bar, volatile LAS unsigned* st) {
    XcdBarrier b; b.bar = bar; b.x = xb_xcc_id(); b.st = st;
    if (threadIdx.x == 0) (void)xb_add(&bar[XB_XCNT(b.x)], 1u);
    return b;
}
__device__ __forceinline__ void xcd_barrier_complete(unsigned* bar, unsigned x, unsigned& nloc, unsigned& nx) {
    const unsigned G = gridDim.x * gridDim.y * gridDim.z;
    unsigned sum, cnt, mine, sp = 0u;
    for (;;) {
        sum = 0u; cnt = 0u; mine = 0u;
#pragma unroll
        for (unsigned j = 0; j < 16; ++j) { const unsigned c = xb_ld(&bar[XB_XCNT(j)]); sum += c; cnt += (c > 0u) ? 1u : 0u; mine = (j == x) ? c : mine; }
        if (sum == G) break;
        __builtin_amdgcn_s_sleep(1);
        if ((++sp & 255u) == 0u) { if (xb_ld(&bar[XB_TMO])) break; if (sp > XB_SPIN_CAP) { atomicAdd(&bar[XB_TMO], 1u); break; } }
    }
    nloc = mine > 0u ? mine : 1u; nx = cnt > 0u ? cnt : 1u;
}

__device__ __forceinline__ void xcd_barrier(const XcdBarrier& b) {
    asm volatile("s_waitcnt vmcnt(0)" ::: "memory");
    __syncthreads();
    if (threadIdx.x == 0) {
        unsigned* bar = b.bar;
        __builtin_amdgcn_s_waitcnt(0);
        unsigned nloc = b.st[0], nx = b.st[1];
        if (nloc == 0u) { xcd_barrier_complete(bar, b.x, nloc, nx); b.st[0] = nloc; b.st[1] = nx; }
        const unsigned old = xb_add(&bar[XB_XSUB(b.x)], 1u);
        const unsigned gen = old / nloc;
        if (old + 1u == (gen + 1u) * nloc) {
            __builtin_amdgcn_fence(__ATOMIC_RELEASE, "agent");
            asm volatile("s_waitcnt vmcnt(0)" ::: "memory");
            const unsigned og = xb_add(&bar[XB_TOP], 1u);
            const unsigned tg = og / nx;
            if (og + 1u == (tg + 1u) * nx) xb_add(&bar[XB_TOPGEN], 1u);
            else XB_SPIN(xb_ld(&bar[XB_TOPGEN]) == tg, bar);
            __builtin_amdgcn_fence(__ATOMIC_ACQUIRE, "agent");
            xb_add(&bar[XB_XGEN(b.x)], 1u);
            asm volatile("s_waitcnt vmcnt(0)" ::: "memory");
        } else {
            XB_SPIN(xb_ld(&bar[XB_XGEN(b.x)]) == gen, bar);
            __builtin_amdgcn_fence(__ATOMIC_ACQUIRE, "agent");
            asm volatile("s_waitcnt vmcnt(0)" ::: "memory");
        }
    }
    __syncthreads();
}

__device__ __forceinline__ void xcd_local_barrier(const XcdBarrier& b) {
    asm volatile("s_waitcnt vmcnt(0)" ::: "memory");
    __syncthreads();
    if (threadIdx.x == 0) {
        unsigned* bar = b.bar;
        __builtin_amdgcn_s_waitcnt(0);
        unsigned nloc = b.st[0], nx = b.st[1];
        if (nloc == 0u) { xcd_barrier_complete(bar, b.x, nloc, nx); b.st[0] = nloc; b.st[1] = nx; }
        const unsigned old = xb_add(&bar[XB_XSUB(b.x)], 1u);
        const unsigned gen = old / nloc;
        if (old + 1u == (gen + 1u) * nloc) xb_add(&bar[XB_XGEN(b.x)], 1u);
        else XB_SPIN(xb_ld(&bar[XB_XGEN(b.x)]) == gen, bar);
        asm volatile("s_waitcnt vmcnt(0)" ::: "memory");
    }
    __syncthreads();
}

constexpr int NWAVES = 8, NTHR = 512;
constexpr int BATCH = 4, SEQ = 4096, DM = 1024, TOK = BATCH * SEQ;
constexpr int INW = 9728;
constexpr int C_RQ = 0, C_RK = 512, C_RV = 1024, C_RG = 2048, C_AQ = 3072, C_AK = 4608, C_AV = 6144, C_GA = 7680, C_GB = 8704;
constexpr int NEXP = 32, FF = 1024, FF2 = 2048;
constexpr int MAXROWS = TOK * 4 + NEXP * 256;
constexpr float RMS_EPS = 1e-6f, GN_EPS = 1e-5f;
constexpr size_t MiB = 1u << 20;
constexpr size_t WS_CTL = 0, CTL_ZERO_BYTES = 32 * 1024;
constexpr size_t WS_ROPE = 1 * MiB;
constexpr size_t WS_WRT = 3 * MiB;
constexpr int N16 = 3072;
constexpr size_t WS_WIN8 = 12 * MiB;
constexpr size_t WS_WIN = 4 * MiB, WS_WRET = 24 * MiB  , WS_WO = 27 * MiB;
constexpr size_t WS_W1 = 32 * MiB, WS_W2 = 160 * MiB;
constexpr size_t WS_H8 = 208 * MiB;
constexpr size_t WS_H = 224 * MiB;
constexpr size_t WS_U = 768 * MiB;
constexpr size_t WS_KV = 560 * MiB;
constexpr size_t WS_RT = 624 * MiB;
constexpr size_t WS_RET = 656 * MiB;
constexpr int RA_LD = 1536;
constexpr size_t WS_OG = 704 * MiB;
constexpr size_t WS_LSE = 752 * MiB;
constexpr size_t WS_MERGED = 512 * MiB;
constexpr size_t WS_XMID = 368 * MiB;
constexpr size_t WS_H2 = 256 * MiB;
constexpr int XCAP = 16384;
constexpr size_t WS_A = 288 * MiB;
constexpr size_t WS_YB = 432 * MiB;
constexpr size_t WS_TE = 1000 * MiB, WS_TP = WS_TE + 256 * 1024, WS_TG = WS_TP + 256 * 1024;
constexpr size_t WS_IDX = 1002 * MiB;
constexpr size_t WS_END = 1004 * MiB;
static_assert(WS_H2 + (size_t)TOK * DM <= WS_A && WS_A + (size_t)MAXROWS * 1024 <= WS_XMID && WS_XMID + (size_t)TOK * DM * 4 <= WS_YB && WS_YB + (size_t)MAXROWS * 1024 <= WS_MERGED && WS_MERGED + (size_t)TOK * DM * 2 <= WS_KV && WS_U + (size_t)200 * MiB <= WS_TE, "map");
constexpr int CW_BAR = 4096;
constexpr int CW_MOD = 8192;
constexpr int CW_CNT = 7680;
#ifndef FORCE_NOLOCAL
#define FORCE_NOLOCAL 0
#endif
constexpr int CW_NOLOCAL = 7808;
constexpr int CW_MODRDY = 7744;
static_assert(CW_BAR + 3456 <= CW_CNT && (CW_NOLOCAL + 64) * 4 <= (int)CTL_ZERO_BYTES && CW_NOLOCAL + 64 <= CW_MOD, "ctl");
constexpr int LDS_BYTES = 160 * 1024 - 512, MISC_OFF = LDS_BYTES - 256;

__device__ __forceinline__ float bflo(unsigned w) { return __uint_as_float(w << 16); }
__device__ __forceinline__ float bfhi(unsigned w) { return __uint_as_float(w & 0xffff0000u); }
typedef float f32x2_t_ __attribute__((ext_vector_type(2))); typedef __bf16 bf16x2_t_ __attribute__((ext_vector_type(2)));
__device__ __forceinline__ unsigned cvtpk(float lo, float hi) { const f32x2_t_ v = {lo, hi}; const bf16x2_t_ b = __builtin_convertvector(v, bf16x2_t_); return __builtin_bit_cast(unsigned, b); }
__device__ __forceinline__ unsigned f8x2bf(unsigned w, bool hi) { typedef float f32x2_ __attribute__((ext_vector_type(2))); const f32x2_ f = hi ? __builtin_amdgcn_cvt_pk_f32_fp8((int)w, true) : __builtin_amdgcn_cvt_pk_f32_fp8((int)w, false); return cvtpk(f.x, f.y); }
__device__ __forceinline__ float wave_sum(float v) {
#pragma unroll
    for (int o = 1; o < 64; o <<= 1) v += __shfl_xor(v, o);
    return v;
}
static __device__ const double ROPE_C[64] = {0.15915494309189535, 0.13782250260398285, 0.11934937021124886, 0.10335229661843406, 0.089499401608891013, 0.077503288755374058, 0.067115083005227255, 0.058119267441876246, 0.050329212104487035, 0.04358330210530733, 0.037741584717419771, 0.032682865872356998, 0.028302195830623399, 0.024508691862069852, 0.02122365276477766, 0.018378926105679667, 0.015915494309189534, 0.013782250260398284, 0.011934937021124886, 0.010335229661843406, 0.0089499401608891024, 0.0077503288755374055, 0.0067115083005227253, 0.0058119267441876241, 0.0050329212104487037, 0.0043583302105307331, 0.0037741584717419772, 0.0032682865872356993, 0.0028302195830623399, 0.0024508691862069852, 0.0021223652764777662, 0.0018378926105679667, 0.0015915494309189536, 0.0013782250260398288, 0.0011934937021124885, 0.0010335229661843405, 0.00089499401608891024, 0.00077503288755374051, 0.0006711508300522726, 0.00058119267441876239, 0.00050329212104487033, 0.00043583302105307329, 0.00037741584717419774, 0.00032682865872356992, 0.00028302195830623395, 0.00024508691862069854, 0.00021223652764777661, 0.00018378926105679666, 0.00015915494309189535, 0.00013782250260398286, 0.00011934937021124886, 0.00010335229661843406, 8.9499401608891018e-05, 7.7503288755374056e-05, 6.7115083005227254e-05, 5.8119267441876239e-05, 5.0329212104487035e-05, 4.3583302105307322e-05, 3.7741584717419777e-05, 3.2682865872356999e-05, 2.8302195830623396e-05, 2.4508691862069852e-05, 2.1223652764777659e-05, 1.8378926105679668e-05};
__device__ __forceinline__ float log2g(int h) { return h == 0 ? -0.0458036896f : (h == 1 ? -0.0227200765f : (h == 2 ? -0.0113153132f : -0.00564656314f)); }

#ifndef UPAD
#define UPAD 2176
#endif
constexpr size_t UBLK = (size_t)TOK * 256 + UPAD; constexpr int ULD = 256;
__device__ __forceinline__ const bf16* ucol(const unsigned char* ws, int col) { return (const bf16*)(ws + WS_U) + (size_t)(col >> 8) * UBLK + (col & 255); }
__device__ __forceinline__ const unsigned char* ucol8(const unsigned char* ws, int col) { return ws + WS_U + (size_t)(N16 / 256) * UBLK * 2 + (size_t)((col >> 8) - N16 / 256) * UBLK + (col & 255); }
typedef short v4i16_t __attribute__((ext_vector_type(4)));
struct Args { const float* in[18]; float* out; unsigned char* ws; int ph_lo, ph_hi; };
struct Frame { LAS unsigned char* lds; volatile LAS unsigned* MISC; gu32* ctl; int tid, lane, wave, vcu, G; };

template <bool F8, int NB = 32>
__device__ __forceinline__ void p0_transpose_item(const float* W, int K, int N, bf16* WT, LAS float* scr, int item, int lane, int ldk = 0) {
    if (ldk == 0) ldk = K;
    const int nblk = N / 32, kb = item / nblk, nb = item % nblk, k0 = 64 * kb, n0 = 32 * nb;
#pragma unroll
    for (int hb = 0; hb < 32 / NB; ++hb) { float t[NB];
      const float* wp = W + (size_t)(k0 + 2 * NB * hb + (lane >> 5)) * N + n0 + (lane & 31);
#pragma unroll
      for (int i = 0; i < NB; ++i) t[i] = __builtin_nontemporal_load(wp + (size_t)(2 * i) * N);
#pragma unroll
      for (int i = 0; i < NB; ++i) scr[(2 * (NB * hb + i) + (lane >> 5)) * 33 + (lane & 31)] = t[i]; }
    LDS_WAIT(); asm volatile("" ::: "memory");
    const int c = lane & 7;
#pragma unroll
    for (int j = 0; j < 4; ++j) { const int n = (lane >> 3) + 8 * j; const LAS float* s = scr + (8 * c) * 33 + n;
        if (F8) { int w0 = 0, w1 = 0;
            w0 = __builtin_amdgcn_cvt_pk_fp8_f32(s[0 * 33] * 32.f, s[1 * 33] * 32.f, w0, false); w0 = __builtin_amdgcn_cvt_pk_fp8_f32(s[2 * 33] * 32.f, s[3 * 33] * 32.f, w0, true);
            w1 = __builtin_amdgcn_cvt_pk_fp8_f32(s[4 * 33] * 32.f, s[5 * 33] * 32.f, w1, false); w1 = __builtin_amdgcn_cvt_pk_fp8_f32(s[6 * 33] * 32.f, s[7 * 33] * 32.f, w1, true);
            typedef int i32x2 __attribute__((ext_vector_type(2)));
            *(GAS i32x2*)((unsigned char*)WT + (size_t)(n0 + n) * ldk + k0 + 8 * c) = (i32x2){w0, w1};
        } else { v4u o; o.x = pk2(s[0 * 33], s[1 * 33]); o.y = pk2(s[2 * 33], s[3 * 33]); o.z = pk2(s[4 * 33], s[5 * 33]); o.w = pk2(s[6 * 33], s[7 * 33]);
            *(GAS v4u*)(WT + (size_t)(n0 + n) * ldk + k0 + 8 * c) = o; } }
    LDS_WAIT(); asm volatile("" ::: "memory");
}
constexpr int NMODWG = 192;
__device__ __forceinline__ void p0_prologue(const Args& a, Frame& F) {
    const int gw = F.vcu * NWAVES + F.wave, NGW = F.G * NWAVES;
    { float2* rope = (float2*)(a.ws + WS_ROPE);
      for (int idx = F.vcu * NTHR + F.tid; idx < SEQ * 64; idx += F.G * NTHR) { const int pos = idx >> 6, i = idx & 63;
          double rev = (double)pos * ROPE_C[i]; rev -= __builtin_floor(rev); const float f = (float)rev;
          rope[idx] = make_float2(__builtin_amdgcn_cosf(f), __builtin_amdgcn_sinf(f)); } }
    { bf16* wrt = (bf16*)(a.ws + WS_WRT); const float* wr = a.in[11];
      for (int idx = F.vcu * NTHR + F.tid; idx < 1024 * 32; idx += F.G * NTHR) { const int k = idx >> 5, e = idx & 31; const float w = wr[idx];
          const unsigned hi = f2bf(w); const float lo = w - __uint_as_float(hi << 16); wrt[e * 1024 + k] = (bf16)hi; wrt[32768 + e * 1024 + k] = (bf16)f2bf(lo); } }
    if (F.vcu < NMODWG) { float* mod = (float*)(a.ws + WS_CTL) + CW_MOD; const float* c = a.in[1]; const float* w_ada = a.in[2]; const float* b_ada = a.in[3];
      LAS float* csl = (LAS float*)(F.lds + 8 * 16384); LAS float* red = csl + 4096;
      for (int i = F.tid; i < 4 * DM; i += NTHR) { const float cv = c[i]; csl[i] = cv / (1.0f + __expf(-cv)); }
      for (int cg = F.vcu; cg < NMODWG; cg += F.G) {
      const int cq = F.lane & 7, rk = F.lane >> 3; const float* wp = w_ada + (size_t)(F.wave * 128 + rk) * 6144 + cg * 32 + 4 * cq;
      f32x4 wv[16];
#pragma unroll
      for (int i = 0; i < 16; ++i) wv[i] = __builtin_nontemporal_load((const GAS f32x4*)(wp + (size_t)(8 * i) * 6144));
      __syncthreads();
      f32x4 acc[4];
#pragma unroll
      for (int b = 0; b < 4; ++b) acc[b] = (f32x4){0.f, 0.f, 0.f, 0.f};
#pragma unroll
      for (int i = 0; i < 16; ++i) { const int k = F.wave * 128 + rk + 8 * i;
#pragma unroll
          for (int b = 0; b < 4; ++b) acc[b] = acc[b] + wv[i] * csl[b * DM + k]; }
#pragma unroll
      for (int off = 8; off < 64; off <<= 1)
#pragma unroll
          for (int b = 0; b < 4; ++b) { f32x4 o; o.x = __shfl_xor(acc[b].x, off); o.y = __shfl_xor(acc[b].y, off); o.z = __shfl_xor(acc[b].z, off); o.w = __shfl_xor(acc[b].w, off); acc[b] = acc[b] + o; }
      if (rk == 0) {
#pragma unroll
          for (int b = 0; b < 4; ++b) *(LAS f32x4*)(red + (F.wave * 4 + b) * 32 + 4 * cq) = acc[b]; }
      __syncthreads();
      if (F.tid < 128) { const int b = F.tid >> 5, cl = F.tid & 31; float s = b_ada[cg * 32 + cl];
#pragma unroll
          for (int w = 0; w < 8; ++w) s += red[(w * 4 + b) * 32 + cl];
          mod[b * 6144 + cg * 32 + cl] = s; }
      asm volatile("s_waitcnt vmcnt(0)" ::: "memory"); __syncthreads();
      if (F.tid == 0) { __builtin_amdgcn_fence(__ATOMIC_RELEASE, "agent"); asm volatile("s_waitcnt vmcnt(0)" ::: "memory"); __hip_atomic_fetch_add(F.ctl + CW_MODRDY, 1u, RLX_AGENT); } } }
    { LAS float* scr = (LAS float*)(F.lds + F.wave * 16384);
      constexpr int I_IN = 16 * (INW / 32), I_RET = 16 * 32, I_ATT = 8 * 32, I_O = 16 * 32, I_1E = 16 * 64, I_2E = 16 * 32;
      constexpr int NITEMS = I_IN + I_RET + I_ATT + I_O;
      constexpr int NFREE = 5 * (256 - NMODWG) * NWAVES; const bool split = F.G == 256, modwg = split && F.vcu < NMODWG;
      const int it0 = !split ? gw : (modwg ? NFREE + gw : gw - NMODWG * NWAVES), it1 = (split && !modwg) ? NFREE : NITEMS, its = !split ? NGW : (modwg ? NMODWG * NWAVES : (256 - NMODWG) * NWAVES);
      for (int it = it0; it < it1; it += its) { int r = it;
          if (r < I_IN) { const int nb = r % (INW / 32);
              p0_transpose_item<true>(a.in[5], 1024, INW, (bf16*)(a.ws + WS_WIN8), scr, r, F.lane);
              continue; } r -= I_IN;
          if (r < I_RET) { p0_transpose_item<true>(a.in[7], 1024, 1024, (bf16*)(a.ws + WS_WRET), scr, r, F.lane, RA_LD); continue; } r -= I_RET;
          if (r < I_ATT) { p0_transpose_item<true>(a.in[8], 512, 1024, (bf16*)(a.ws + WS_WRET + 1024), scr, r, F.lane, RA_LD); continue; } r -= I_ATT;
          p0_transpose_item<false>(a.in[9], 1024, 1024, (bf16*)(a.ws + WS_WO), scr, r, F.lane); } }
}
__device__ __forceinline__ void moe_item8(const float* W, int N, unsigned char* WT8, LAS bf16* scr, int item, int lane) {
    const int nblk = N / 32, kb = item / nblk, nb = item % nblk, k0 = 128 * kb, n0 = 32 * nb, rr = lane >> 3, cq = lane & 7;
    typedef unsigned u32x2 __attribute__((ext_vector_type(2)));
    f32x4 t[16];
    { const float* wp = W + (size_t)(k0 + rr) * N + n0 + 4 * cq;
#pragma unroll
      for (int i = 0; i < 16; ++i) t[i] = __builtin_nontemporal_load((const GAS f32x4*)(wp + (size_t)(8 * i) * N)); }
#pragma unroll
    for (int i = 0; i < 16; ++i) *(LAS u32x2*)(scr + (8 * i + rr) * 40 + 4 * cq) = (u32x2){cvtpk(t[i].x, t[i].y), cvtpk(t[i].z, t[i].w)};
    LDS_WAIT(); asm volatile("" ::: "memory");
    const int g = lane >> 4, i15 = lane & 15, qq = i15 >> 2, p = i15 & 3;
#pragma unroll
    for (int c0 = 0; c0 < 32; c0 += 16)
#pragma unroll
        for (int kh = 0; kh < 2; ++kh) { const LAS bf16* a0 = scr + (64 * kh + 16 * g + qq) * 40 + c0 + 4 * p; v4u o;
#pragma unroll
            for (int sb = 0; sb < 4; ++sb) { const v4i16_t v = __builtin_amdgcn_ds_read_tr16_b64_v4i16((LAS v4i16_t*)(a0 + 4 * sb * 40)); const u32x2 w2 = __builtin_bit_cast(u32x2, v);
                int w8 = 0; w8 = __builtin_amdgcn_cvt_pk_fp8_f32(bflo(w2.x) * 32.f, bfhi(w2.x) * 32.f, w8, false); w8 = __builtin_amdgcn_cvt_pk_fp8_f32(bflo(w2.y) * 32.f, bfhi(w2.y) * 32.f, w8, true);
                if (sb == 0) o.x = (unsigned)w8; else if (sb == 1) o.y = (unsigned)w8; else if (sb == 2) o.z = (unsigned)w8; else o.w = (unsigned)w8; }
            *(GAS v4u*)(WT8 + (size_t)(n0 + c0 + i15) * 1024 + k0 + 64 * kh + 16 * g) = o; }
    LDS_WAIT(); asm volatile("" ::: "memory");
}
__device__ __forceinline__ void moe_convert(const Args& a, Frame& F, int k0, int nk) {
    LAS bf16* scr = (LAS bf16*)(F.lds + F.wave * 16384); const int gw = F.vcu * NWAVES + F.wave, NGW = F.G * NWAVES;
    constexpr int I_1E = 8 * 64, I_2E = 8 * 32;
    for (int k = k0; k < k0 + nk; ++k) { int r = gw + NGW * k;
        if (r < NEXP * I_1E) { const int e = r / I_1E; moe_item8(a.in[13] + (size_t)e * 1024 * FF2, FF2, a.ws + WS_W1 + (size_t)e * FF2 * 1024, scr, r % I_1E, F.lane); continue; } r -= NEXP * I_1E;
        if (r < NEXP * I_2E) { const int e = r / I_2E; moe_item8(a.in[15] + (size_t)e * FF * 1024, 1024, a.ws + WS_W2 + (size_t)e * 1024 * FF, scr, r % I_2E, F.lane); } }
}
__device__ __forceinline__ void norm_mod_row(const float* xrow, const float* g, const float* sc, const float* sh, bf16* orow, unsigned char* orow8, int lane) {
    const GAS f32x4* xr = (const GAS f32x4*)xrow + lane; f32x4 v[4]; float s = 0.f;
#pragma unroll
    for (int j = 0; j < 4; ++j) { v[j] = __builtin_nontemporal_load(xr + 64 * j); s += (v[j].x * v[j].x + v[j].y * v[j].y) + (v[j].z * v[j].z + v[j].w * v[j].w); }
    const float rstd = 1.0f / sqrtf(wave_sum(s) * (1.0f / DM) + RMS_EPS);
    GAS int* o4 = (GAS int*)orow8 + lane; GAS unsigned long long* o8 = (GAS unsigned long long*)orow + lane;
#pragma unroll
    for (int j = 0; j < 4; ++j) { const int c = 4 * (64 * j + lane); const f32x4 gg = *(const f32x4*)(g + c), ss = *(const f32x4*)(sc + c), hh = *(const f32x4*)(sh + c);
        const f32x4 o = v[j] * rstd * gg * (ss + 1.0f) + hh;
        int w8 = 0; w8 = __builtin_amdgcn_cvt_pk_fp8_f32(o.x, o.y, w8, false); w8 = __builtin_amdgcn_cvt_pk_fp8_f32(o.z, o.w, w8, true);
        o4[64 * j] = w8; o8[64 * j] = (unsigned long long)cvtpk(o.x, o.y) | ((unsigned long long)cvtpk(o.z, o.w) << 32); }
}
__device__ __forceinline__ void p1_norm1(const Args& a, Frame& F) {
    const int gw = F.vcu * NWAVES + F.wave, NGW = F.G * NWAVES, lane = F.lane; const float* mod = (const float*)(a.ws + WS_CTL) + CW_MOD;
    const bool xl = F.G == 256; auto rowmap = [&](int q) -> int { return xl ? 2048 * ((q >> 8) & 7) + 256 * (q >> 11) + (q & 255) : q; };
    f32x4 GS[4], HS[4]; int bcur = -1;
    bool waited = false;
    for (int m0 = gw; m0 < TOK; m0 += 4 * NGW) {
        f32x4 v[4][4]; float rstd[4];
#pragma unroll
        for (int r = 0; r < 4; ++r) { const int m = rowmap(m0 + r * NGW); const GAS f32x4* xr = (const GAS f32x4*)(a.in[0] + (size_t)(m < TOK ? m : 0) * DM) + lane;
#pragma unroll
            for (int j = 0; j < 4; ++j) v[r][j] = __builtin_nontemporal_load(xr + 64 * j); }
#pragma unroll
        for (int r = 0; r < 4; ++r) { float s = 0.f;
#pragma unroll
            for (int j = 0; j < 4; ++j) s += (v[r][j].x * v[r][j].x + v[r][j].y * v[r][j].y) + (v[r][j].z * v[r][j].z + v[r][j].w * v[r][j].w);
            rstd[r] = 1.0f / sqrtf(wave_sum(s) * (1.0f / DM) + RMS_EPS); }
        if (!waited) { waited = true;
            if (F.tid == 0) { unsigned sp = 0;
                while (__hip_atomic_load(F.ctl + CW_MODRDY, RLX_AGENT) < (unsigned)NMODWG && ++sp < (1u << 22)) __builtin_amdgcn_s_sleep(2);
                __builtin_amdgcn_fence(__ATOMIC_ACQUIRE, "agent"); asm volatile("s_waitcnt vmcnt(0)" ::: "memory"); }
            __syncthreads(); }
#pragma unroll
        for (int r = 0; r < 4; ++r) { const int m = rowmap(m0 + r * NGW); if (m < TOK) { const int b = m / SEQ;
            if (b != bcur) { bcur = b; const float* g = a.in[4]; const float* sc = mod + b * 6144 + 1024; const float* sh = mod + b * 6144;
#pragma unroll
                for (int j = 0; j < 4; ++j) { const int c = 4 * (64 * j + lane); GS[j] = *(const f32x4*)(g + c) * (*(const f32x4*)(sc + c) + 1.0f); HS[j] = *(const f32x4*)(sh + c); } }
            GAS int* o4 = (GAS int*)(a.ws + WS_H8 + (size_t)m * DM) + lane;
#pragma unroll
            for (int j = 0; j < 4; ++j) {
                const f32x4 o = v[r][j] * rstd[r] * GS[j] + HS[j];
                int w8 = 0; w8 = __builtin_amdgcn_cvt_pk_fp8_f32(o.x, o.y, w8, false); w8 = __builtin_amdgcn_cvt_pk_fp8_f32(o.z, o.w, w8, true);
                o4[64 * j] = w8; } } }
    }
    if (!waited) { __syncthreads(); }
}

#define MFMA16(a, b, c) __builtin_amdgcn_mfma_f32_16x16x32_bf16((a), (b), (c), 0, 0, 0)
__device__ __forceinline__ bf16x8 ldsfrag(const LAS bf16* base, int pitch, int row0, int k0, int lane) { return *(const LAS bf16x8*)(base + (row0 + (lane & 15)) * pitch + k0 + 8 * (lane >> 4)); }

__device__ __forceinline__ bf16x8 ldsfrag_tr(const LAS bf16* M, int pitch, int k0, int c0, int lane) {
    const int g = lane >> 4, i = lane & 15, qq = i >> 2, p = i & 3;
    const LAS bf16* a0 = M + (k0 + 8 * g + qq) * pitch + c0 + 4 * p;
    const v4i16_t lo = __builtin_amdgcn_ds_read_tr16_b64_v4i16((LAS v4i16_t*)a0), hi = __builtin_amdgcn_ds_read_tr16_b64_v4i16((LAS v4i16_t*)(a0 + 4 * pitch));
    return (bf16x8){lo[0], lo[1], lo[2], lo[3], hi[0], hi[1], hi[2], hi[3]};
}
constexpr int AT_KP = 136, AT_PP = 168;
constexpr int AT_KS = 0, AT_VS = 256 * AT_KP * 2, AT_BIAS = AT_VS + 272 * AT_KP * 2;
struct AttnU { const unsigned char *Qb, *Kb, *Vb; size_t rstride; int i0, r, g, hh; size_t tok0; };
__device__ __forceinline__ AttnU attn_decode(const Args& a, int U) {
    AttnU u; const int ub = U & 31; u.hh = (U >> 5) & 3; u.g = (U >> 7) % 3; const int b = U / 384;
    const int rs = 2 * u.g; u.r = 1 << rs; const int ares = ub & (u.r - 1), blk = ub >> rs; u.i0 = blk * 128;
    u.tok0 = (size_t)(b * SEQ + ares); u.rstride = (size_t)u.r * ULD; const int hc = (u.g * 4 + u.hh) * 128;
    u.Qb = ucol8(a.ws, C_AQ + hc) + u.tok0 * ULD; u.Kb = ucol8(a.ws, C_AK + hc) + u.tok0 * ULD; u.Vb = ucol8(a.ws, C_AV + hc) + u.tok0 * ULD;
    return u;
}
__device__ __forceinline__ void attn_phase(const Args& a, Frame& F) {
    LAS bf16* KS = (LAS bf16*)(F.lds + AT_KS); LAS bf16* VS = (LAS bf16*)(F.lds + AT_VS); LAS float* BIAS = (LAS float*)(F.lds + AT_BIAS);
    const int tid = F.tid, lane = F.lane, w = F.wave, q = lane >> 4, l15 = lane & 15;
    typedef unsigned u32x2 __attribute__((ext_vector_type(2)));
    int U = F.vcu; if (U >= 1536) return;
    v4u kreg[4], vreg[4];
    { const AttnU u = attn_decode(a, U);
#pragma unroll
      for (int it = 0; it < 4; ++it) { const int c = tid + NTHR * it, kk = c >> 3, ch = c & 7; int i = u.i0 - 128 + kk; i = i < 0 ? 0 : i;
          const size_t ro = (size_t)i * u.rstride + ch * 16; kreg[it] = *(const GAS v4u*)(u.Kb + ro); vreg[it] = *(const GAS v4u*)(u.Vb + ro); }
    }
    if (tid < 256) { LAS v4u* z = (LAS v4u*)(VS + (256 + (tid >> 4)) * AT_KP + (tid & 15) * 8); z[0] = (v4u){0u, 0u, 0u, 0u}; }
    const bool bg_pre = (F.vcu & 1) != 0; int slot = 0;
    for (; U < 1536; U += F.G, ++slot) {
        if (bg_pre) { moe_convert(a, F, 2 * slot, 2); __syncthreads(); }
        const AttnU u = attn_decode(a, U);
        bf16x8 qf[4];
        { const unsigned char* qrow = u.Qb + (size_t)(u.i0 + 16 * w + l15) * u.rstride + 8 * q; typedef unsigned u32x2q __attribute__((ext_vector_type(2)));
          u32x2q qb[4];
#pragma unroll
          for (int ks = 0; ks < 4; ++ks) qb[ks] = *(const GAS u32x2q*)(qrow + 32 * ks);
#pragma unroll
          for (int ks = 0; ks < 4; ++ks) qf[ks] = __builtin_bit_cast(bf16x8, (v4u){f8x2bf(qb[ks].x, false), f8x2bf(qb[ks].x, true), f8x2bf(qb[ks].y, false), f8x2bf(qb[ks].y, true)}); }
#pragma unroll
        for (int it = 0; it < 4; ++it) { const int c = tid + NTHR * it, kk = c >> 3, ch = c & 7; const bool ok = (u.i0 - 128 + kk) >= 0;
            const v4u kz = ok ? kreg[it] : (v4u){0u, 0u, 0u, 0u}, vz = ok ? vreg[it] : (v4u){0u, 0u, 0u, 0u};
            *(LAS v4u*)(KS + kk * AT_KP + ch * 16) = (v4u){f8x2bf(kz.x, false), f8x2bf(kz.x, true), f8x2bf(kz.y, false), f8x2bf(kz.y, true)};
            *(LAS v4u*)(KS + kk * AT_KP + ch * 16 + 8) = (v4u){f8x2bf(kz.z, false), f8x2bf(kz.z, true), f8x2bf(kz.w, false), f8x2bf(kz.w, true)};
            *(LAS v4u*)(VS + kk * AT_KP + ch * 16) = (v4u){f8x2bf(vz.x, false), f8x2bf(vz.x, true), f8x2bf(vz.y, false), f8x2bf(vz.y, true)};
            *(LAS v4u*)(VS + kk * AT_KP + ch * 16 + 8) = (v4u){f8x2bf(vz.z, false), f8x2bf(vz.z, true), f8x2bf(vz.w, false), f8x2bf(vz.w, true)}; }
        if (tid < 129) { const int dist = u.r * tid; int bk;
            if (dist < 16) bk = dist; else { bk = 16 + (int)(__log2f((float)dist * 0.0625f) * (16.0f / 7.0f)); bk = bk > 31 ? 31 : bk; }
            BIAS[tid] = a.in[6][bk * 12 + u.g * 4 + u.hh]; }
        __syncthreads();
        if (U + F.G < 1536) { const AttnU n = attn_decode(a, U + F.G);
#pragma unroll
            for (int it = 0; it < 4; ++it) { const int c = tid + NTHR * it, kk = c >> 3, ch = c & 7; int i = n.i0 - 128 + kk; i = i < 0 ? 0 : i;
                const size_t ro = (size_t)i * n.rstride + ch * 16; kreg[it] = *(const GAS v4u*)(n.Kb + ro); vreg[it] = *(const GAS v4u*)(n.Vb + ro); } }
        f32x4 s[9];
#pragma unroll
        for (int t9 = 0; t9 < 9; ++t9) { f32x4 acc = (f32x4){0.f, 0.f, 0.f, 0.f};
#pragma unroll
            for (int ks = 0; ks < 4; ++ks) acc = MFMA16(ldsfrag(KS, AT_KP, 16 * (w + t9), 32 * ks, lane), qf[ks], acc);
            s[t9] = acc; }
        const float scale = 0.08838834764831845f;
        float mx = -INFINITY;
#pragma unroll
        for (int t9 = 0; t9 < 9; ++t9)
#pragma unroll
            for (int rr = 0; rr < 4; ++rr) { const int krel = 16 * t9 + 4 * q + rr, dist = 128 + l15 - krel; const bool valid = (dist >= 0) && (dist <= 128) && (u.i0 - 128 + 16 * w + krel >= 0);
                const float v = valid ? s[t9][rr] * scale + BIAS[valid ? dist : 0] : -INFINITY; s[t9][rr] = v; mx = fmaxf(mx, v); }
        mx = fmaxf(mx, __shfl_xor(mx, 16)); mx = fmaxf(mx, __shfl_xor(mx, 32));
        float lsum = 0.f;
#pragma unroll
        for (int t9 = 0; t9 < 9; ++t9)
#pragma unroll
            for (int rr = 0; rr < 4; ++rr) { const float p = __expf(s[t9][rr] - mx); s[t9][rr] = p; lsum += p; }
        lsum += __shfl_xor(lsum, 16); lsum += __shfl_xor(lsum, 32);
        __syncthreads();
        LAS bf16* PS = KS + w * 16 * AT_PP;
#pragma unroll
        for (int t9 = 0; t9 < 9; ++t9) *(LAS u32x2*)(PS + l15 * AT_PP + 16 * t9 + 4 * q) = (u32x2){cvtpk(s[t9][0], s[t9][1]), cvtpk(s[t9][2], s[t9][3])};
        *(LAS u32x2*)(PS + l15 * AT_PP + 144 + 4 * q) = (u32x2){0u, 0u};
        __syncthreads();
        bf16x8 pf[5];
#pragma unroll
        for (int ks = 0; ks < 5; ++ks) pf[ks] = ldsfrag(PS, AT_PP, 0, 32 * ks, lane);
        const float inv = 16.0f / lsum;
        const size_t tokrow = u.tok0 + (size_t)(u.i0 + 16 * w + l15) * u.r;
        unsigned char* og = a.ws + WS_OG + (size_t)u.g * TOK * 512 + tokrow * 512 + u.hh * 128 + 4 * (q & 2);
#pragma unroll
        for (int dp = 0; dp < 8; dp += 2) { int pc[2];
#pragma unroll
            for (int d2 = 0; d2 < 2; ++d2) { f32x4 acc = (f32x4){0.f, 0.f, 0.f, 0.f};
#pragma unroll
                for (int ks = 0; ks < 5; ++ks) acc = MFMA16(ldsfrag_tr(VS, AT_KP, 16 * w + 32 * ks, 16 * (dp + d2), lane), pf[ks], acc);
                int pk = 0; pk = __builtin_amdgcn_cvt_pk_fp8_f32(acc[0] * inv, acc[1] * inv, pk, false); pk = __builtin_amdgcn_cvt_pk_fp8_f32(acc[2] * inv, acc[3] * inv, pk, true); pc[d2] = pk; }
            const bool odd = (q & 1) != 0;
            const int r0 = __shfl_xor(odd ? pc[0] : pc[1], 16);
            typedef int i32x2 __attribute__((ext_vector_type(2)));
            *(GAS i32x2*)(og + 16 * (dp + (odd ? 1 : 0))) = odd ? (i32x2){r0, pc[1]} : (i32x2){pc[0], r0}; }
        if (q == 0) ((float*)(a.ws + WS_LSE))[(size_t)u.g * TOK * 4 + tokrow * 4 + u.hh] = mx + __logf(lsum);
        __syncthreads();
        if (!bg_pre) { moe_convert(a, F, 2 * slot, 2); __syncthreads(); }
    }
}

constexpr int RT_P = 136, RV_P = 264;
struct RotRegs { v4u lo[2], hi[2]; };
__device__ __forceinline__ void rot_issue(Frame& F, const bf16* src, RotRegs& r) {
#pragma unroll
    for (int it = 0; it < 2; ++it) { const int pc = F.tid + NTHR * it, j = pc >> 3, d0 = (pc & 7) * 8; r.lo[it] = *(const GAS v4u*)(src + (size_t)j * ULD + d0); r.hi[it] = *(const GAS v4u*)(src + (size_t)j * ULD + d0 + 64); }
}
__device__ __forceinline__ void rope_issue(const Args& a, Frame& F, int pos0, f32x4 (&cs)[2][4]) {
    const float* rope = (const float*)(a.ws + WS_ROPE);
#pragma unroll
    for (int it = 0; it < 2; ++it) { const int pc = F.tid + NTHR * it, j = pc >> 3, d0 = (pc & 7) * 8; const GAS f32x4* rp = (const GAS f32x4*)(rope + ((size_t)(pos0 + j) * 64 + d0) * 2);
#pragma unroll
        for (int i = 0; i < 4; ++i) cs[it][i] = rp[i]; }
}
template <bool ZETA>
__device__ __forceinline__ void rot_finish(Frame& F, const RotRegs& r, const f32x4 (&cs)[2][4], float mul, float l2g, LAS bf16* dst) {
#pragma unroll
    for (int it = 0; it < 2; ++it) { const int pc = F.tid + NTHR * it, j = pc >> 3, d0 = (pc & 7) * 8;
        const float m = ZETA ? mul * __builtin_amdgcn_exp2f((float)(127 - j) * l2g) : mul;
        float ol[8], oh[8];
#pragma unroll
        for (int i = 0; i < 8; ++i) { const unsigned wl = i < 2 ? r.lo[it].x : (i < 4 ? r.lo[it].y : (i < 6 ? r.lo[it].z : r.lo[it].w)), wh = i < 2 ? r.hi[it].x : (i < 4 ? r.hi[it].y : (i < 6 ? r.hi[it].z : r.hi[it].w));
            const float tl = (i & 1) ? bfhi(wl) : bflo(wl), th = (i & 1) ? bfhi(wh) : bflo(wh); const float c = (i & 1) ? cs[it][i >> 1].z : cs[it][i >> 1].x, sn = (i & 1) ? cs[it][i >> 1].w : cs[it][i >> 1].y;
            ol[i] = (tl * c - th * sn) * m; oh[i] = (tl * sn + th * c) * m; }
        *(LAS v4u*)(dst + j * RT_P + d0) = (v4u){cvtpk(ol[0], ol[1]), cvtpk(ol[2], ol[3]), cvtpk(ol[4], ol[5]), cvtpk(ol[6], ol[7])};
        *(LAS v4u*)(dst + j * RT_P + d0 + 64) = (v4u){cvtpk(oh[0], oh[1]), cvtpk(oh[2], oh[3]), cvtpk(oh[4], oh[5]), cvtpk(oh[6], oh[7])}; }
}
__device__ __forceinline__ void v_issue(Frame& F, const bf16* src, v4u (&t)[8]) {
#pragma unroll
    for (int it = 0; it < 8; ++it) { const int c = F.tid + NTHR * it, j = c >> 5, ch = c & 31; t[it] = *(const GAS v4u*)(src + (size_t)j * ULD + ch * 8); }
}
__device__ __forceinline__ void v_finish(Frame& F, const v4u (&t)[8], LAS bf16* VS) {
#pragma unroll
    for (int it = 0; it < 8; ++it) { const int c = F.tid + NTHR * it, j = c >> 5, ch = c & 31; *(LAS v4u*)(VS + j * RV_P + ch * 8) = t[it]; }
}
__device__ __forceinline__ void ret_kv_item(const Args& a, Frame& F, int item) {
    const int h = item & 3, n = (item >> 2) & 31, b = item >> 7; const float l2g = log2g(h);
    const size_t r0 = (size_t)(b * SEQ + n * 128) * ULD;
    LAS bf16* KZ = (LAS bf16*)F.lds; LAS bf16* VS = (LAS bf16*)(F.lds + 128 * RT_P * 2);
    { RotRegs kr; f32x4 cs[2][4]; v4u vt[8];
      rot_issue(F, ucol(a.ws, C_RK + h * 128) + r0, kr); rope_issue(a, F, n * 128, cs); v_issue(F, ucol(a.ws, C_RV + h * 256) + r0, vt);
      rot_finish<true>(F, kr, cs, 0.08838834764831845f, l2g, KZ); v_finish(F, vt, VS); }
    __syncthreads();
    const int lane = F.lane, w = F.wave, q = lane >> 4, l15 = lane & 15;
    f32x4 acc[2][8];
#pragma unroll
    for (int e2 = 0; e2 < 2; ++e2)
#pragma unroll
        for (int dt = 0; dt < 8; ++dt) acc[e2][dt] = (f32x4){0.f, 0.f, 0.f, 0.f};
#pragma unroll
    for (int ks = 0; ks < 4; ++ks) { const bf16x8 v0 = ldsfrag_tr(VS, RV_P, 32 * ks, 32 * w, lane), v1 = ldsfrag_tr(VS, RV_P, 32 * ks, 32 * w + 16, lane);
#pragma unroll
        for (int dt = 0; dt < 8; ++dt) { const bf16x8 kk = ldsfrag_tr(KZ, RT_P, 32 * ks, 16 * dt, lane); acc[0][dt] = MFMA16(kk, v0, acc[0][dt]); acc[1][dt] = MFMA16(kk, v1, acc[1][dt]); } }
    bf16* kv = (bf16*)(a.ws + WS_KV) + (size_t)item * 32768; typedef unsigned u32x2 __attribute__((ext_vector_type(2)));
#pragma unroll
    for (int e2 = 0; e2 < 2; ++e2)
#pragma unroll
        for (int dt = 0; dt < 8; ++dt) *(GAS u32x2*)(kv + (32 * w + 16 * e2 + l15) * 128 + 16 * dt + 4 * q) = (u32x2){cvtpk(acc[e2][dt][0], acc[e2][dt][1]), cvtpk(acc[e2][dt][2], acc[e2][dt][3])};
    __syncthreads();
}
__device__ __forceinline__ void p4_scan(const Args& a, Frame& F, bool loc) {
    const bf16* kv = (const bf16*)(a.ws + WS_KV); bf16* rt = (bf16*)(a.ws + WS_RT);
    const int i0 = loc ? (F.vcu >> 5) * 16384 + (F.vcu & 31) * NTHR + F.tid : F.vcu * NTHR + F.tid, is = loc ? 16 * 8192 : F.G * NTHR;
    for (int idx = i0; idx < 16 * 8192; idx += is) {
        const int bh = idx >> 13, el = (idx & 8191) * 4, b = bh >> 2, h = bh & 3; const float gch = exp2f(128.0f * log2g(h));
        f32x4 R = (f32x4){0.f, 0.f, 0.f, 0.f};
        for (int n0 = 0; n0 < 32; n0 += 8) { unsigned long long k8[8];
#pragma unroll
            for (int i = 0; i < 8; ++i) k8[i] = *(const GAS unsigned long long*)(kv + (size_t)(((b * 32 + n0 + i) << 2) + h) * 32768 + el);
#pragma unroll
            for (int i = 0; i < 8; ++i) { const size_t off = (size_t)(((b * 32 + n0 + i) << 2) + h) * 32768 + el;
                *(GAS unsigned long long*)(rt + off) = (unsigned long long)cvtpk(R.x, R.y) | ((unsigned long long)cvtpk(R.z, R.w) << 32);
                const unsigned lo = (unsigned)k8[i], hi = (unsigned)(k8[i] >> 32); R = R * gch + (f32x4){bflo(lo), bfhi(lo), bflo(hi), bfhi(hi)}; } } }
}
__device__ __forceinline__ void p4_merge(const Args& a, Frame& F, bool loc) {
    const int gw = loc ? (F.vcu >> 5) * 1024 + (F.vcu & 31) * NWAVES + F.wave : F.vcu * NWAVES + F.wave, NGW = loc ? 256 : F.G * NWAVES, tend = loc ? (F.vcu >> 5) * 1024 + 1024 : TOK / 2;
    const unsigned char* og = a.ws + WS_OG; const float* lse = (const float*)(a.ws + WS_LSE);
    for (int t2 = gw; t2 < tend; t2 += NGW) { const int t = 2 * t2 + (F.lane >> 5), l31 = F.lane & 31, hh = l31 >> 3;
        const float l0 = lse[(size_t)t * 4 + hh], l1 = lse[(size_t)TOK * 4 + (size_t)t * 4 + hh], l2 = lse[(size_t)2 * TOK * 4 + (size_t)t * 4 + hh];
        const float m = fmaxf(l0, fmaxf(l1, l2)); float a0 = __expf(l0 - m), a1 = __expf(l1 - m), a2 = __expf(l2 - m); const float is = 0.0625f / (a0 + a1 + a2); a0 *= is; a1 *= is; a2 *= is;
        const size_t o = (size_t)t * 512 + l31 * 16;
        const v4u x0 = *(const GAS v4u*)(og + o), x1 = *(const GAS v4u*)(og + (size_t)TOK * 512 + o), x2 = *(const GAS v4u*)(og + (size_t)2 * TOK * 512 + o);
        v4u r;
#pragma unroll
        for (int j = 0; j < 4; ++j) { const unsigned w0 = j == 0 ? x0.x : (j == 1 ? x0.y : (j == 2 ? x0.z : x0.w)), w1 = j == 0 ? x1.x : (j == 1 ? x1.y : (j == 2 ? x1.z : x1.w)), w2 = j == 0 ? x2.x : (j == 1 ? x2.y : (j == 2 ? x2.z : x2.w));
            const f32x2_t_ p0 = __builtin_amdgcn_cvt_pk_f32_fp8((int)w0, false), q0 = __builtin_amdgcn_cvt_pk_f32_fp8((int)w0, true);
            const f32x2_t_ p1 = __builtin_amdgcn_cvt_pk_f32_fp8((int)w1, false), q1 = __builtin_amdgcn_cvt_pk_f32_fp8((int)w1, true);
            const f32x2_t_ p2 = __builtin_amdgcn_cvt_pk_f32_fp8((int)w2, false), q2 = __builtin_amdgcn_cvt_pk_f32_fp8((int)w2, true);
            int pk = 0; pk = __builtin_amdgcn_cvt_pk_fp8_f32(a0 * p0.x + a1 * p1.x + a2 * p2.x, a0 * p0.y + a1 * p1.y + a2 * p2.y, pk, false);
            pk = __builtin_amdgcn_cvt_pk_fp8_f32(a0 * q0.x + a1 * q1.x + a2 * q2.x, a0 * q0.y + a1 * q1.y + a2 * q2.y, pk, true);
            if (j == 0) r.x = (unsigned)pk; else if (j == 1) r.y = (unsigned)pk; else if (j == 2) r.z = (unsigned)pk; else r.w = (unsigned)pk; }
        *(GAS v4u*)(a.ws + WS_RET + (size_t)t * RA_LD + 1024 + l31 * 16) = r; }
}
struct RetLoad { RotRegs qr, kr; v4u vt[8]; };
__device__ __forceinline__ void ret_out_issue(const Args& a, Frame& F, int item, RetLoad& L) {
    const int h = item & 3, n = (item >> 2) & 31, b = item >> 7; const size_t r0 = (size_t)(b * SEQ + n * 128) * ULD;
    rot_issue(F, ucol(a.ws, C_RQ + h * 128) + r0, L.qr); rot_issue(F, ucol(a.ws, C_RK + h * 128) + r0, L.kr); v_issue(F, ucol(a.ws, C_RV + h * 256) + r0, L.vt);
}
__device__ __forceinline__ void ret_out_item(const Args& a, Frame& F0, int item, RetLoad& L, int next) {
    Frame F = F0; asm volatile("" : "+v"(F.tid), "+v"(F.lane));
    const int h = item & 3, n = (item >> 2) & 31, b = item >> 7; const float l2g = log2g(h);
    LAS bf16* QS = (LAS bf16*)F.lds; LAS bf16* KS = (LAS bf16*)(F.lds + 128 * RT_P * 2); LAS bf16* VS = (LAS bf16*)(F.lds + 2 * 128 * RT_P * 2);
    LAS float* RED = (LAS float*)(F.lds + 2 * 128 * RT_P * 2 + 128 * RV_P * 2);
    { f32x4 cs[2][4]; rope_issue(a, F, n * 128, cs);
      v_finish(F, L.vt, VS); rot_finish<false>(F, L.qr, cs, 1.0f, l2g, QS); rot_finish<false>(F, L.kr, cs, 0.08838834764831845f, l2g, KS); }
    __syncthreads();
    const int lane = F.lane, w = F.wave, q = lane >> 4, l15 = lane & 15;
    typedef unsigned u32x2 __attribute__((ext_vector_type(2)));
    u32x2 pw[8];
    bf16x8 rf0[4], rf1[4];
    { const bf16* rtg = (const bf16*)(a.ws + WS_RT) + (size_t)item * 32768 + (size_t)(32 * w + l15) * 128 + 8 * q;
#pragma unroll
      for (int ks = 0; ks < 4; ++ks) { rf0[ks] = *(const GAS bf16x8*)(rtg + 32 * ks); rf1[ks] = *(const GAS bf16x8*)(rtg + 16 * 128 + 32 * ks); } }
    if (next >= 0) ret_out_issue(a, F, next, L);
    { bf16x8 qf[4];
#pragma unroll
      for (int ks = 0; ks < 4; ++ks) qf[ks] = ldsfrag(QS, RT_P, 16 * w, 32 * ks, lane);
#pragma unroll
      for (int jt = 0; jt < 8; ++jt) { f32x4 acc = (f32x4){0.f, 0.f, 0.f, 0.f};
          if (jt <= w) {
#pragma unroll
              for (int ks = 0; ks < 4; ++ks) acc = MFMA16(ldsfrag(KS, RT_P, 16 * jt, 32 * ks, lane), qf[ks], acc); }
          float p[4];
#pragma unroll
          for (int rr = 0; rr < 4; ++rr) { const int j = 16 * jt + 4 * q + rr, i = 16 * w + l15; p[rr] = (j <= i) ? acc[rr] * __builtin_amdgcn_exp2f(-(float)(j + 1) * l2g) : 0.f; }
          pw[jt] = (u32x2){cvtpk(p[0], p[1]), cvtpk(p[2], p[3])}; } }
    __syncthreads();
#pragma unroll
    for (int jt = 0; jt < 8; ++jt) *(LAS u32x2*)(KS + (16 * w + l15) * RT_P + 16 * jt + 4 * q) = pw[jt];
    __syncthreads();
    f32x4 acc[2][8];
#pragma unroll
    for (int e2 = 0; e2 < 2; ++e2)
#pragma unroll
        for (int it = 0; it < 8; ++it) acc[e2][it] = (f32x4){0.f, 0.f, 0.f, 0.f};
#pragma unroll
    for (int ks = 0; ks < 4; ++ks) { const bf16x8 a0 = ldsfrag_tr(VS, RV_P, 32 * ks, 32 * w, lane), a1 = ldsfrag_tr(VS, RV_P, 32 * ks, 32 * w + 16, lane);
#pragma unroll
        for (int it = 2 * ks; it < 8; ++it) { const bf16x8 pf = ldsfrag(KS, RT_P, 16 * it, 32 * ks, lane); acc[0][it] = MFMA16(a0, pf, acc[0][it]); acc[1][it] = MFMA16(a1, pf, acc[1][it]); } }
#pragma unroll
    for (int ks = 0; ks < 4; ++ks) {
#pragma unroll
        for (int it = 0; it < 8; ++it) { const bf16x8 qf = ldsfrag(QS, RT_P, 16 * it, 32 * ks, lane); acc[0][it] = MFMA16(rf0[ks], qf, acc[0][it]); acc[1][it] = MFMA16(rf1[ks], qf, acc[1][it]); } }
    typedef unsigned u32x2g __attribute__((ext_vector_type(2))); u32x2g gq[8][2];
#pragma unroll
    for (int it = 0; it < 8; ++it) { const size_t tok = (size_t)(b * SEQ + n * 128 + 16 * it + l15); const bf16* gp = ucol(a.ws, C_RG + h * 256) + tok * ULD + 32 * w + 4 * q;
#pragma unroll
        for (int e2 = 0; e2 < 2; ++e2) gq[it][e2] = *(const GAS u32x2g*)(gp + 16 * e2); }
#pragma unroll
    for (int it = 0; it < 8; ++it) { const float xi = __builtin_amdgcn_exp2f((float)(16 * it + l15 + 1) * l2g); acc[0][it] = acc[0][it] * xi; acc[1][it] = acc[1][it] * xi;
        float s1 = (acc[0][it][0] + acc[0][it][1]) + (acc[0][it][2] + acc[0][it][3]) + (acc[1][it][0] + acc[1][it][1]) + (acc[1][it][2] + acc[1][it][3]);
        float s2 = (acc[0][it][0] * acc[0][it][0] + acc[0][it][1] * acc[0][it][1]) + (acc[0][it][2] * acc[0][it][2] + acc[0][it][3] * acc[0][it][3]) + (acc[1][it][0] * acc[1][it][0] + acc[1][it][1] * acc[1][it][1]) + (acc[1][it][2] * acc[1][it][2] + acc[1][it][3] * acc[1][it][3]);
        s1 += __shfl_xor(s1, 16); s1 += __shfl_xor(s1, 32); s2 += __shfl_xor(s2, 16); s2 += __shfl_xor(s2, 32);
        if (q == 0) *(LAS u32x2*)(RED + (16 * it + l15) * 16 + 2 * w) = (u32x2){__float_as_uint(s1), __float_as_uint(s2)}; }
    __syncthreads();
#pragma unroll
    for (int it = 0; it < 8; ++it) { const LAS f32x4* rp = (const LAS f32x4*)(RED + (16 * it + l15) * 16); const f32x4 r0 = rp[0], r1 = rp[1], r2 = rp[2], r3 = rp[3];
        const float s1 = (r0[0] + r0[2]) + (r1[0] + r1[2]) + (r2[0] + r2[2]) + (r3[0] + r3[2]), s2 = (r0[1] + r0[3]) + (r1[1] + r1[3]) + (r2[1] + r2[3]) + (r3[1] + r3[3]);
        const float mean = s1 * (1.0f / 256.0f), var = fmaxf(s2 * (1.0f / 256.0f) - mean * mean, 0.f), rstd = 1.0f / sqrtf(var + GN_EPS);
        const size_t tok = (size_t)(b * SEQ + n * 128 + 16 * it + l15);
        const bf16* gp = ucol(a.ws, C_RG + h * 256) + tok * ULD + 32 * w + 4 * q; unsigned char* op = a.ws + WS_RET + tok * RA_LD + h * 256 + 32 * w + 4 * q;
        int w8p[2];
#pragma unroll
        for (int e2 = 0; e2 < 2; ++e2) { const u32x2 gg = (u32x2){gq[it][e2].x, gq[it][e2].y};
            const float g0 = bflo(gg.x), g1 = bfhi(gg.x), g2 = bflo(gg.y), g3 = bfhi(gg.y);
#define SILU_(x) ((x) * __builtin_amdgcn_rcpf(1.0f + __expf(-(x))))
            const float o0 = SILU_(g0) * (acc[e2][it][0] - mean) * rstd, o1 = SILU_(g1) * (acc[e2][it][1] - mean) * rstd, o2 = SILU_(g2) * (acc[e2][it][2] - mean) * rstd, o3 = SILU_(g3) * (acc[e2][it][3] - mean) * rstd;
#undef SILU_
            int w8 = 0; w8 = __builtin_amdgcn_cvt_pk_fp8_f32(o0, o1, w8, false); w8 = __builtin_amdgcn_cvt_pk_fp8_f32(o2, o3, w8, true); w8p[e2] = w8; }
        { const bool odd = (q & 1) != 0; const int recv = __shfl_xor(odd ? w8p[0] : w8p[1], 16);
          *(GAS u32x2*)(op - 4 * (q & 1) + (odd ? 16 : 0)) = odd ? (u32x2){(unsigned)recv, (unsigned)w8p[1]} : (u32x2){(unsigned)w8p[0], (unsigned)recv}; } }
    __syncthreads();
}

constexpr int P8_RSTD = 0, P8_LG = 1024, P8_CNT = P8_LG + 2 * 64 * 32 * 4, P8_LB = P8_CNT + 128, P8_LTE = P8_LB + 128, P8_LTP = P8_LTE + 1024, P8_H2 = P8_LTP + 1024;
constexpr int P8_GS = P8_H2, P8_HS = P8_GS + 4096, P8_WL = 28672, P8_WP = 1032;
static_assert(P8_HS + 4096 <= P8_WL && P8_WL + 2 * 32 * P8_WP * 2 <= MISC_OFF, "P8 LDS map");
__device__ __forceinline__ void p8_route(const Args& a, Frame& F) {
    LAS float* RSTD = (LAS float*)(F.lds + P8_RSTD); LAS float* LG = (LAS float*)(F.lds + P8_LG); LAS int* CNT = (LAS int*)(F.lds + P8_CNT);
    if (F.tid < 32) CNT[F.tid] = 0;
    const float* mod = (const float*)(a.ws + WS_CTL) + CW_MOD; const int lane = F.lane, w = F.wave, q = lane >> 4, l15 = lane & 15;
    const bf16* xm = (const bf16*)(a.ws + WS_XMID);
    LAS int* LB = (LAS int*)(F.lds + P8_LB); LAS int* LTE = (LAS int*)(F.lds + P8_LTE); LAS int* LTP = (LAS int*)(F.lds + P8_LTP);
    int* TE = (int*)(a.ws + WS_TE); int* TP = (int*)(a.ws + WS_TP); float* TG = (float*)(a.ws + WS_TG);
    const int t0 = F.vcu * 64, b = t0 / SEQ;
    const float* gf = a.in[10]; const float* scf = mod + b * 6144 + 4096; const float* shf = mod + b * 6144 + 3072;
    LAS bf16* WL = (LAS bf16*)(F.lds + P8_WL);
    { const bf16* wsrc = (const bf16*)(a.ws + WS_WRT); v4u wv[16];
#pragma unroll
      for (int i = 0; i < 16; ++i) wv[i] = *(const GAS v4u*)(wsrc + (size_t)(F.tid + NTHR * i) * 8);
#pragma unroll
      for (int i = 0; i < 16; ++i) { const int p = F.tid + NTHR * i; *(LAS v4u*)(WL + (p >> 7) * P8_WP + (p & 127) * 8) = wv[i]; } }
    { f32x4 gg[2][2], ss[2][2], hh[2][2];
#pragma unroll
      for (int j = 0; j < 2; ++j)
#pragma unroll
          for (int k = 0; k < 2; ++k) { const int c = 8 * (64 * j + lane) + 4 * k; gg[j][k] = *(const f32x4*)(gf + c); ss[j][k] = *(const f32x4*)(scf + c) + 1.0f; hh[j][k] = *(const f32x4*)(shf + c); }
      if (w == 0) {
#pragma unroll
          for (int j = 0; j < 2; ++j)
#pragma unroll
              for (int k = 0; k < 2; ++k) { const int c = 8 * (64 * j + lane) + 4 * k; *(LAS f32x4*)(F.lds + P8_GS + 4 * c) = gg[j][k] * ss[j][k]; *(LAS f32x4*)(F.lds + P8_HS + 4 * c) = hh[j][k]; } }
      v4u v[8][2];
#pragma unroll
      for (int ri = 0; ri < 8; ++ri) { const GAS v4u* xr = (const GAS v4u*)(xm + (size_t)(t0 + 8 * w + ri) * DM) + lane;
#pragma unroll
          for (int j = 0; j < 2; ++j) v[ri][j] = xr[64 * j]; }
#pragma unroll
      for (int ri = 0; ri < 8; ++ri) { float s = 0.f; f32x4 f[2][2];
#pragma unroll
          for (int j = 0; j < 2; ++j) { f[j][0] = (f32x4){bflo(v[ri][j].x), bfhi(v[ri][j].x), bflo(v[ri][j].y), bfhi(v[ri][j].y)}; f[j][1] = (f32x4){bflo(v[ri][j].z), bfhi(v[ri][j].z), bflo(v[ri][j].w), bfhi(v[ri][j].w)};
#pragma unroll
              for (int k = 0; k < 2; ++k) s += (f[j][k].x * f[j][k].x + f[j][k].y * f[j][k].y) + (f[j][k].z * f[j][k].z + f[j][k].w * f[j][k].w); }
          const float rstd = 1.0f / sqrtf(wave_sum(s) * (1.0f / DM) + RMS_EPS);
          if (lane == 0) RSTD[8 * w + ri] = rstd;
          typedef int i32x2 __attribute__((ext_vector_type(2)));
          GAS i32x2* o8 = (GAS i32x2*)(a.ws + WS_H2 + (size_t)(t0 + 8 * w + ri) * DM) + lane;
#pragma unroll
          for (int j = 0; j < 2; ++j) { i32x2 w8;
#pragma unroll
              for (int k = 0; k < 2; ++k) { const f32x4 o = f[j][k] * rstd * gg[j][k] * ss[j][k] + hh[j][k];
                  int p = 0; p = __builtin_amdgcn_cvt_pk_fp8_f32(o.x, o.y, p, false); p = __builtin_amdgcn_cvt_pk_fp8_f32(o.z, o.w, p, true); if (k == 0) w8.x = p; else w8.y = p; }
              o8[64 * j] = w8; } } }
    __syncthreads();
    { const int rt = w & 3, kh = w >> 2; const float rstd = RSTD[16 * rt + l15];
      const bf16* xrow = xm + (size_t)(t0 + 16 * rt + l15) * DM + 512 * kh + 8 * q;
      const LAS bf16* wh = WL + l15 * P8_WP + 512 * kh + 8 * q; const LAS bf16* wl = wh + 32 * P8_WP;
      const LAS float* GS = (const LAS float*)(F.lds + P8_GS); const LAS float* HS = (const LAS float*)(F.lds + P8_HS);
      f32x4 acc0 = (f32x4){0.f, 0.f, 0.f, 0.f}, acc1 = (f32x4){0.f, 0.f, 0.f, 0.f};
      v4u xw[16];
#pragma unroll
      for (int ks = 0; ks < 16; ++ks) xw[ks] = *(const GAS v4u*)(xrow + 32 * ks);
#pragma unroll
      for (int ks = 0; ks < 16; ++ks) { const int kc = 512 * kh + 32 * ks + 8 * q;
          const f32x4 x0 = (f32x4){bflo(xw[ks].x), bfhi(xw[ks].x), bflo(xw[ks].y), bfhi(xw[ks].y)}, x1 = (f32x4){bflo(xw[ks].z), bfhi(xw[ks].z), bflo(xw[ks].w), bfhi(xw[ks].w)};
          const f32x4 g0 = *(const LAS f32x4*)(GS + kc), g1 = *(const LAS f32x4*)(GS + kc + 4), h0 = *(const LAS f32x4*)(HS + kc), h1 = *(const LAS f32x4*)(HS + kc + 4);
          const f32x4 o0 = x0 * rstd * g0 + h0, o1 = x1 * rstd * g1 + h1;
          v4u hi; hi.x = cvtpk(o0.x, o0.y); hi.y = cvtpk(o0.z, o0.w); hi.z = cvtpk(o1.x, o1.y); hi.w = cvtpk(o1.z, o1.w);
          v4u lo; lo.x = cvtpk(o0.x - bflo(hi.x), o0.y - bfhi(hi.x)); lo.y = cvtpk(o0.z - bflo(hi.y), o0.w - bfhi(hi.y)); lo.z = cvtpk(o1.x - bflo(hi.z), o1.y - bfhi(hi.z)); lo.w = cvtpk(o1.z - bflo(hi.w), o1.w - bfhi(hi.w));
          const bf16x8 ah = __builtin_bit_cast(bf16x8, hi), al = __builtin_bit_cast(bf16x8, lo);
          const bf16x8 wh0 = *(const LAS bf16x8*)(wh + 32 * ks), wh1 = *(const LAS bf16x8*)(wh + 16 * P8_WP + 32 * ks), wl0 = *(const LAS bf16x8*)(wl + 32 * ks), wl1 = *(const LAS bf16x8*)(wl + 16 * P8_WP + 32 * ks);
          acc0 = MFMA16(ah, wh0, acc0); acc0 = MFMA16(al, wh0, acc0); acc0 = MFMA16(ah, wl0, acc0);
          acc1 = MFMA16(ah, wh1, acc1); acc1 = MFMA16(al, wh1, acc1); acc1 = MFMA16(ah, wl1, acc1); }
#pragma unroll
      for (int rr = 0; rr < 4; ++rr) { LG[(kh * 64 + 16 * rt + 4 * q + rr) * 32 + l15] = acc0[rr]; LG[(kh * 64 + 16 * rt + 4 * q + rr) * 32 + 16 + l15] = acc1[rr]; } }
    __syncthreads();
    { const int e = lane & 31; const float br = a.in[12][e];
      const int hsel = lane >> 5;
      for (int ri = 0; ri < 4; ++ri) { const int row = 8 * w + 2 * ri + hsel, t = t0 + row;
          float v = LG[row * 32 + e] + LG[(64 + row) * 32 + e] + br; float tv[4]; int ti[4];
#pragma unroll
          for (int k = 0; k < 4; ++k) { float m = v;
#pragma unroll
              for (int o = 1; o < 32; o <<= 1) m = fmaxf(m, __shfl_xor(m, o));
              const unsigned long long bal = __ballot(v == m); const unsigned half = hsel ? (unsigned)(bal >> 32) : (unsigned)bal; const int idx = __ffs((int)half) - 1;
              tv[k] = m; ti[k] = idx; if (e == idx) v = -INFINITY; }
          const float e1 = __expf(tv[1] - tv[0]), e2 = __expf(tv[2] - tv[0]), e3 = __expf(tv[3] - tv[0]); const float is = 1.0f / (1.0f + e1 + e2 + e3);
          if (e < 4) { const int k = e; const int ek = k == 0 ? ti[0] : (k == 1 ? ti[1] : (k == 2 ? ti[2] : ti[3])); const float gk = (k == 0 ? 1.0f : (k == 1 ? e1 : (k == 2 ? e2 : e3))) * is;
              const int lp = __hip_atomic_fetch_add(&CNT[ek], 1, __ATOMIC_RELAXED, __HIP_MEMORY_SCOPE_WORKGROUP);
              LTE[row * 4 + k] = ek; LTP[row * 4 + k] = lp; TE[t * 4 + k] = ek; TG[t * 4 + k] = gk; } } }
    __syncthreads();
    if (F.tid < 32) { const int cnt = CNT[F.tid]; LB[F.tid] = (int)__hip_atomic_fetch_add(F.ctl + CW_CNT + F.tid, (unsigned)cnt, RLX_AGENT); }
    __syncthreads();
    if (F.tid < 256) { const int p = F.tid, ek = LTE[p], pos = LB[ek] + LTP[p]; TP[(t0 + (p >> 2)) * 4 + (p & 3)] = pos; ((int*)(a.ws + WS_IDX))[(size_t)ek * XCAP + pos] = t0 + (p >> 2); }
    __syncthreads();
}
constexpr int MT_CS = 131072, MT_PM = MT_CS + 128, MT_E = MT_PM + 1280, MT_NT = MT_E + 1280, MT_IDXL = 136 * 1024;
__device__ __forceinline__ int moe_tables(Frame& F, bool sparse_a) {
    LAS int* CS = (LAS int*)(F.lds + MT_CS); LAS int* TPM = (LAS int*)(F.lds + MT_PM); LAS int* TEX = (LAS int*)(F.lds + MT_E); LAS int* NT = (LAS int*)(F.lds + MT_NT);
    if (F.tid < 64) { const int e = F.tid & 31; const int cnt = (int)__hip_atomic_load(F.ctl + CW_CNT + e, RLX_AGENT), n = (cnt + 255) >> 8;
        int incl = n;
#pragma unroll
        for (int o = 1; o < 32; o <<= 1) { const int v = __shfl_up(incl, o, 32); if (e >= o) incl += v; }
        const int t = incl - n;
        if (F.tid < 32) { CS[e] = t << 8;
            for (int j = 0; j < n; ++j) { TPM[t + j] = sparse_a ? e * (XCAP / 256) + j : t + j; TEX[t + j] = e; }
            if (e == 31) NT[0] = incl; } }
    __syncthreads();
    return __builtin_amdgcn_readfirstlane(NT[0]);
}
__device__ __forceinline__ void p12_final(const Args& a, Frame& F, bool with_moe, bool tables_ready) {
    LAS int* CS = (LAS int*)(F.lds + MT_CS); if (with_moe && !tables_ready) (void)moe_tables(F, false);
    const int gw = F.vcu * NWAVES + F.wave, NGW = F.G * NWAVES, lane = F.lane; const float* mod = (const float*)(a.ws + WS_CTL) + CW_MOD;
    const bf16* xm = (const bf16*)(a.ws + WS_XMID); const unsigned char* yb = a.ws + WS_YB; const int* TE = (const int*)(a.ws + WS_TE); const int* TP = (const int*)(a.ws + WS_TP); const float* TG = (const float*)(a.ws + WS_TG);
    const bool xl = F.G == 256; f32x4 GF[4], GT[4]; int bcur = -1;
#pragma unroll
    for (int j = 0; j < 4; ++j) GF[j] = *(const f32x4*)(a.in[17] + 4 * (64 * j + lane));
    for (int tq = gw; tq < TOK; tq += NGW) { const int t = xl ? 2048 * ((tq >> 8) & 7) + 256 * (tq >> 11) + (tq & 255) : tq; const int b = t / SEQ;
        if (b != bcur) { bcur = b;
#pragma unroll
            for (int j = 0; j < 4; ++j) GT[j] = *(const f32x4*)(mod + b * 6144 + 5120 + 4 * (64 * j + lane)); }
        f32x4 v[4], m4[4];
#pragma unroll
        for (int j = 0; j < 4; ++j) { const unsigned long long xw = __builtin_nontemporal_load((const GAS unsigned long long*)(xm + (size_t)t * DM) + lane + 64 * j); const unsigned lo = (unsigned)xw, hi = (unsigned)(xw >> 32);
            v[j] = (f32x4){bflo(lo), bfhi(lo), bflo(hi), bfhi(hi)}; m4[j] = (f32x4){0.f, 0.f, 0.f, 0.f}; }
        if (with_moe) {
#pragma unroll
            for (int k = 0; k < 4; ++k) { const int row = CS[TE[t * 4 + k]] + TP[t * 4 + k]; const float gk = TG[t * 4 + k]; const GAS int* yr = (const GAS int*)(yb + (size_t)row * DM) + lane;
#pragma unroll
                for (int j = 0; j < 4; ++j) { const int y4 = __builtin_nontemporal_load(yr + 64 * j); typedef float f32x2_ __attribute__((ext_vector_type(2)));
                    const f32x2_ lo = __builtin_amdgcn_cvt_pk_f32_fp8(y4, false), hi = __builtin_amdgcn_cvt_pk_f32_fp8(y4, true);
                    m4[j].x += gk * lo.x; m4[j].y += gk * lo.y; m4[j].z += gk * hi.x; m4[j].w += gk * hi.y; } }
        }
        float s = 0.f;
#pragma unroll
        for (int j = 0; j < 4; ++j) { v[j] = v[j] + GT[j] * m4[j]; s += (v[j].x * v[j].x + v[j].y * v[j].y) + (v[j].z * v[j].z + v[j].w * v[j].w); }
        const float rstd = 1.0f / sqrtf(wave_sum(s) * (1.0f / DM) + RMS_EPS);
#pragma unroll
        for (int j = 0; j < 4; ++j) { __builtin_nontemporal_store(v[j] * rstd * GF[j], (GAS f32x4*)(a.out + (size_t)t * DM) + lane + 64 * j); } }
}

#ifndef ABL_NOMIX
#define ABL_NOMIX 0
#endif
#ifndef ABL_NOMOE
#define ABL_NOMOE 0
#endif
#ifndef ONE_LAUNCH
#define ONE_LAUNCH 1
#endif
constexpr int NPHASE = 13;
__global__ void __launch_bounds__(NTHR, 2) mk_fwd(Args args) {
    extern __shared__ __attribute__((aligned(16))) unsigned char lds[];
    Frame F;
    F.lds = (LAS unsigned char*)lds; F.MISC = (volatile LAS unsigned*)(F.lds + MISC_OFF);
    F.tid = threadIdx.x; F.lane = F.tid & 63; F.wave = __builtin_amdgcn_readfirstlane(F.tid >> 6);
    F.G = gridDim.x; { const int bx = blockIdx.x; F.vcu = (F.G % 8 == 0) ? (bx % 8) * (F.G / 8) + bx / 8 : bx; }
    unsigned char* ws = args.ws; F.ctl = (gu32*)(ws + WS_CTL);
    if (F.tid < 64) F.MISC[F.tid] = 0u;
    __syncthreads();
    XcdBarrier bar = xcd_barrier_post((unsigned*)(F.ctl + CW_BAR), F.MISC + 8);
    if (F.tid == 0 && (FORCE_NOLOCAL || F.G != 256 || xb_xcc_id() != (unsigned)(blockIdx.x & 7))) __hip_atomic_fetch_or(F.ctl + CW_NOLOCAL, 1u, RLX_AGENT);
    const int lo = args.ph_lo, hi = args.ph_hi;
#ifndef PHMASK
#define PHMASK 0x1fff
#endif
#define IN(k) (lo <= (k) && (k) < hi && ((PHMASK >> (k)) & 1))
#ifndef REPMASK
#define REPMASK 0
#endif
#define REP(k) for (int rep_ = 0; rep_ < ((((REPMASK) >> (k)) & 1) ? 2 : 1); ++rep_)
#ifndef XBAR
#define XBAR 0
#endif
#define SEAM(k) do { if (IN(k) && IN((k) + 1)) { xcd_barrier(bar); if ((XBAR >> (k)) & 1) { xcd_barrier(bar); xcd_barrier(bar); } } } while (0)
    typedef pg8::bf16_t pb;
    if (IN(0)) REP(0) { p0_prologue(args, F); }
#if !ABL_NOMIX
    if (IN(1)) REP(1) { p1_norm1(args, F); } SEAM(1);
    const bool loc = IN(1) && __builtin_amdgcn_readfirstlane((int)__hip_atomic_load(F.ctl + CW_NOLOCAL, RLX_AGENT)) == 0;
#define SEAML(k) do { if (IN(k) && IN((k) + 1)) { if (loc) xcd_local_barrier(bar); else xcd_barrier(bar); } } while (0)
    if (IN(2)) REP(2) { pg8::Gemm g{(const pb*)(ws + WS_H8), (const pb*)(ws + WS_WIN8), TOK, INW, DM / 2}; pg8::StaticOrder S; S.init(TOK, INW, F.G, (int)blockIdx.x);
        pg8::EpiMixed E{pg8::EpiBf16<0>{(pb*)(ws + WS_U), ULD, nullptr, 256, UBLK, 1.f}, pg8::EpiFp8Blk{ws + WS_U + (size_t)(N16 / 256) * UBLK * 2, UBLK}, N16 / 256};
        pg8::gemm_phase<pg8::EpiMixed, pg8::StaticOrder, true, true, true>(F.lds, g, S, E); } SEAM(2);
    if (IN(3)) { REP(3) { attn_phase(args, F); }
        REP(13) { if (loc) { for (int k = 0; k < 2; ++k) { const int j = (F.vcu & 31) + 32 * k, pair = 2 * (F.vcu >> 5) + (j >> 5); ret_kv_item(args, F, (((pair >> 2) * 32 + (j & 31)) << 2) + (pair & 3)); } }
                  else for (int it = (F.vcu + 128) % F.G; it < 512; it += F.G) ret_kv_item(args, F, it); } } SEAML(3);
    if (IN(4)) REP(4) { p4_scan(args, F, loc); }
    const int it5 = loc ? 64 * (F.vcu >> 5) + (F.vcu & 31) : F.vcu, st5 = loc ? 32 : F.G;
    const int n5 = loc ? 2 : (512 - F.vcu + F.G - 1) / F.G;
    RetLoad rl5; if (IN(5) && n5 > 0) ret_out_issue(args, F, it5, rl5);
    SEAM(4);
    if (IN(5)) REP(5) { if (rep_ > 0 && n5 > 0) ret_out_issue(args, F, it5, rl5); for (int k = 0; k < n5; ++k) ret_out_item(args, F, it5 + k * st5, rl5, k + 1 < n5 ? it5 + (k + 1) * st5 : -1); p4_merge(args, F, loc); } SEAML(5);
    if (IN(6)) REP(6) { pg8::Gemm g{(const pb*)(ws + WS_RET), (const pb*)(ws + WS_WRET), TOK, DM, RA_LD / 2}; pg8::StaticOrder S; S.init(TOK, DM, F.G, (int)blockIdx.x);
        pg8::EpiGate2<8> E{(pb*)(ws + WS_MERGED), DM, ucol8(ws, C_GA), ucol8(ws, C_GB), UBLK};
        pg8::gemm_phase<pg8::EpiGate2<8>, pg8::StaticOrder, true, true, true>(F.lds, g, S, E); } SEAML(6);
    if (IN(7)) REP(7) { pg8::Gemm g{(const pb*)(ws + WS_MERGED), (const pb*)(ws + WS_WO), TOK, DM, 1024}; pg8::StaticOrder S; S.init(TOK, DM, F.G, (int)blockIdx.x);
        pg8::EpiResid E{(pg8::bf16_t*)(ws + WS_XMID), args.in[0], DM, (const float*)(ws + WS_CTL) + CW_MOD + 2048, 6144, SEQ / 256};
        pg8::gemm_phase<pg8::EpiResid, pg8::StaticOrder, true, true>(F.lds, g, S, E); } SEAML(7);
#else
    if (IN(7)) { const f32x4* s = (const f32x4*)args.in[0]; unsigned long long* d = (unsigned long long*)(ws + WS_XMID); for (size_t i = (size_t)blockIdx.x * NTHR + F.tid; i < (size_t)TOK * DM / 4; i += (size_t)F.G * NTHR) { const f32x4 x = s[i]; d[i] = (unsigned long long)cvtpk(x.x, x.y) | ((unsigned long long)cvtpk(x.z, x.w) << 32); } } SEAM(7);
#endif
#if !ABL_NOMOE
    if (IN(8)) { p8_route(args, F); } if (IN(8) && IN(10)) xcd_barrier(bar);
    if (IN(10)) REP(10) { const int nt = moe_tables(F, true);
        pg8::Gemm g{(const pb*)(ws + WS_H2), (const pb*)(ws + WS_W1), nt * 256, NEXP * FF2, DM / 2}; pg8::MoeGather S{{nt, FF2 / 256, F.G, F.vcu  , (const LAS int*)(F.lds + MT_PM), (const LAS int*)(F.lds + MT_E), loc}, (const int*)(ws + WS_IDX), (LAS int*)(F.lds + MT_IDXL), TOK - 1};
        pg8::EpiSwiglu E{(pb*)(ws + WS_A), FF, args.in[14], FF2 / 256};
        pg8::gemm_phase<pg8::EpiSwiglu, pg8::MoeGather, true, true, true>(F.lds, g, S, E); } SEAML(10);
    if (IN(11)) REP(11) { const int nt = IN(10) ? __builtin_amdgcn_readfirstlane(((LAS int*)(F.lds + MT_NT))[0]) : moe_tables(F, true);
        pg8::Gemm g{(const pb*)(ws + WS_A), (const pb*)(ws + WS_W2), nt * 256, NEXP * DM, FF / 2}; pg8::MoeOrder S{nt, DM / 256, F.G, F.vcu, (const LAS int*)nullptr, (const LAS int*)(F.lds + MT_E), loc};
        pg8::EpiFp8Row E{ws + WS_YB, DM, args.in[16], DM / 256};
        pg8::gemm_phase<pg8::EpiFp8Row, pg8::MoeOrder, true, true, true>(F.lds, g, S, E); } SEAM(11);
#endif
    if (IN(12)) REP(12) { p12_final(args, F, !ABL_NOMOE, IN(10)); }
#undef IN
#undef SEAM
}

extern "C" void kernel_launch(void* const* d_in, const int* in_sizes, int n_in, void* d_out, int out_size, void* d_ws, size_t ws_size, hipStream_t stream) {
    static int grid = 0;
    if (grid == 0) {
        if (n_in != 18 || in_sizes[0] != TOK * DM || out_size != TOK * DM || ws_size < WS_END) { fprintf(stderr, "kernel_launch: unexpected shapes n_in %d in0 %d out %d ws %zu\n", n_in, n_in > 0 ? in_sizes[0] : -1, out_size, ws_size); grid = -1; return; }
        int dev = 0, cus = 0, per_cu = 0;
        if (hipGetDevice(&dev) != hipSuccess || hipDeviceGetAttribute(&cus, hipDeviceAttributeMultiprocessorCount, dev) != hipSuccess) { grid = -1; return; }
        if (hipFuncSetAttribute((const void*)mk_fwd, hipFuncAttributeMaxDynamicSharedMemorySize, LDS_BYTES) != hipSuccess) { fprintf(stderr, "kernel_launch: hipFuncSetAttribute failed\n"); grid = -1; return; }
        if (hipOccupancyMaxActiveBlocksPerMultiprocessor(&per_cu, (const void*)mk_fwd, NTHR, LDS_BYTES) != hipSuccess || per_cu < 1) fprintf(stderr, "kernel_launch: occupancy query says %d\n", per_cu);
        (void)hipGetLastError();
        grid = cus;
        if (grid != 256) fprintf(stderr, "kernel_launch: %d CUs (built for 256)\n", grid);
    }
    if (grid < 0) return;
    (void)hipMemsetAsync((char*)d_ws + WS_CTL, 0, CTL_ZERO_BYTES, stream);
    Args a{};
    for (int i = 0; i < 18; ++i) a.in[i] = (const float*)d_in[i];
    a.out = (float*)d_out; a.ws = (unsigned char*)d_ws;
#if ONE_LAUNCH
    a.ph_lo = 0; a.ph_hi = NPHASE;
    hipLaunchKernelGGL(mk_fwd, dim3(grid), dim3(NTHR), LDS_BYTES, stream, a);
#else
    for (int p = 0; p < NPHASE; ++p) {
#if ABL_NOMIX
        if (p >= 1 && p <= 6) continue;
#endif
#if ABL_NOMOE
        if (p >= 8 && p <= 11) continue;
#endif
        a.ph_lo = p; a.ph_hi = p + 1;
        hipLaunchKernelGGL(mk_fwd, dim3(grid), dim3(NTHR), LDS_BYTES, stream, a);
    }
#endif
}
```
